# Optimizing an MI355X kernel written in HIP

```python
import jax
import jax.numpy as jnp
from jax import lax
import numpy as np

D_MODEL = 1024
BATCH = 16
SEQ = 4096
DEPTH = 2

HEAD_DIM = 64
ROPE_THETA = 10000.0
NORM_EPS = 1e-6
Q_BLOCK = 128

CONV_CHANNELS = 512
CONV_WIDTH = 3
DSA_HEADS = 8
IDX_HEADS = 4
IDX_DIM = HEAD_DIM
DSA_TOPK_MAX = 256
DIL_HEADS = 16
DIL_KV_HEADS = 4
DIL_PATTERNS = ((128, 1), (512, 4), (2048, 16))
N_GROUPS = 4
EXPERTS_PER_GROUP = 8
N_EXPERTS = N_GROUPS * EXPERTS_PER_GROUP
TOP_K_INNER = 2
D_EXPERT = 512
MOE_BLOCK = 256

EVEN_SPLITS = (CONV_CHANNELS, CONV_CHANNELS, CONV_CHANNELS,
               DSA_HEADS * HEAD_DIM, HEAD_DIM, HEAD_DIM,
               IDX_HEADS * IDX_DIM, IDX_DIM, IDX_HEADS)
ODD_SPLITS = (DIL_HEADS * HEAD_DIM, DIL_KV_HEADS * HEAD_DIM, DIL_KV_HEADS * HEAD_DIM)
EVEN_IN_WIDTH = sum(EVEN_SPLITS)
ODD_IN_WIDTH = sum(ODD_SPLITS)
EVEN_MIX_WIDTH = CONV_CHANNELS + DSA_HEADS * HEAD_DIM
ODD_MIX_WIDTH = DIL_HEADS * HEAD_DIM

kernel_name = 'hybrid_conv_dsa_dilated_hmoe'


def rms_norm(x, gain):
    xf = x.astype(jnp.float32)
    y = xf * lax.rsqrt(jnp.mean(xf * xf, axis=-1, keepdims=True) + NORM_EPS)
    return (y * gain.astype(jnp.float32)).astype(x.dtype)


def rope_tables(seq_len):
    half = HEAD_DIM // 2
    inv_freq = ROPE_THETA ** (-jnp.arange(half, dtype=jnp.float32) / half)
    ang = jnp.arange(seq_len, dtype=jnp.float32)[:, None] * inv_freq[None, :]
    return jnp.cos(ang), jnp.sin(ang)


def apply_rope(x, cos, sin):
    xf = x.astype(jnp.float32)
    x1, x2 = jnp.split(xf, 2, axis=-1)
    c = cos[None, :, None, :]
    s = sin[None, :, None, :]
    return jnp.concatenate([x1 * c - x2 * s, x1 * s + x2 * c], axis=-1).astype(x.dtype)


def split_cols(proj, sizes):
    return jnp.split(proj, np.cumsum(sizes)[:-1].tolist(), axis=-1)


def short_gated_conv(gate_b, gate_c, h, conv_w):
    u = gate_c * h
    seq = u.shape[1]
    u_pad = jnp.pad(u, ((0, 0), (CONV_WIDTH - 1, 0), (0, 0)))
    y = sum(u_pad[:, j:j + seq, :] * conv_w[:, j] for j in range(CONV_WIDTH))
    return gate_b * y


def _gather_rows(table, idx):
    return jax.vmap(lambda t, i: t[i])(table, idx)


def dsa_attention(q, k, v, iq, ik, iw):
    bsz, seq, n_heads, hd = q.shape
    top_k = min(DSA_TOPK_MAX, seq // 4)
    ikf = ik.astype(jnp.float32)
    key_pos = jnp.arange(seq)

    def block(start):
        qb = lax.dynamic_slice_in_dim(q, start, Q_BLOCK, axis=1)
        iqb = lax.dynamic_slice_in_dim(iq, start, Q_BLOCK, axis=1).astype(jnp.float32)
        iwb = lax.dynamic_slice_in_dim(iw, start, Q_BLOCK, axis=1).astype(jnp.float32)
        q_pos = start + jnp.arange(Q_BLOCK)
        rel = jax.nn.relu(jnp.einsum('bqhd,bsd->bqhs', iqb, ikf) * IDX_DIM ** -0.5)
        score = jnp.einsum('bqhs,bqh->bqs', rel, iwb)
        causal = key_pos[None, :] <= q_pos[:, None]
        score = jnp.where(causal[None], score, -jnp.inf)
        _, idx = lax.top_k(score, top_k)
        valid = idx <= q_pos[None, :, None]
        ks = _gather_rows(k, idx)
        vs = _gather_rows(v, idx)
        logits = jnp.einsum('bqhd,bqjd->bqhj', qb, ks).astype(jnp.float32) * hd ** -0.5
        logits = jnp.where(valid[:, :, None, :], logits, -jnp.inf)
        p = jax.nn.softmax(logits, axis=-1).astype(vs.dtype)
        return jnp.einsum('bqhj,bqjd->bqhd', p, vs)

    starts = jnp.arange(seq // Q_BLOCK) * Q_BLOCK
    out = lax.map(block, starts)
    return out.transpose(1, 0, 2, 3, 4).reshape(bsz, seq, n_heads * hd)


def dilated_attention(q, k, v):
    bsz, seq, n_heads, hd = q.shape
    n_kv = k.shape[2]
    qg = q.reshape(bsz, seq, n_kv, n_heads // n_kv, hd)

    def block(start):
        qb = lax.dynamic_slice_in_dim(qg, start, Q_BLOCK, axis=1)
        q_pos = start + jnp.arange(Q_BLOCK)
        lses, outs = [], []
        for window, dilation in DIL_PATTERNS:
            n_keys = window // dilation + 1
            pos = q_pos[:, None] - dilation * jnp.arange(n_keys)[None, :]
            valid = pos >= 0
            pos = jnp.maximum(pos, 0)
            ks = jnp.take(k, pos, axis=1)
            vs = jnp.take(v, pos, axis=1)
            logits = jnp.einsum('bqkgd,bqjkd->bqkgj', qb, ks).astype(jnp.float32) * hd ** -0.5
            logits = jnp.where(valid[None, :, None, None, :], logits, -jnp.inf)
            lse = jax.nn.logsumexp(logits, axis=-1, keepdims=True)
            p = jnp.exp(logits - lse).astype(vs.dtype)
            outs.append(jnp.einsum('bqkgj,bqjkd->bqkgd', p, vs).astype(jnp.float32))
            lses.append(lse)
        wts = jax.nn.softmax(jnp.stack(lses), axis=0)
        return jnp.sum(wts * jnp.stack(outs), axis=0).astype(q.dtype)

    starts = jnp.arange(seq // Q_BLOCK) * Q_BLOCK
    out = lax.map(block, starts)
    return out.transpose(1, 0, 2, 3, 4, 5).reshape(bsz, seq, n_heads * hd)


def grouped_expert_ffn(xt, expert_ids, gates, w_gate, w_up, w_down):
    n_tok, d = xt.shape
    n_assign = n_tok * TOP_K_INNER
    flat_e = expert_ids.reshape(n_assign)
    flat_tok = jnp.arange(n_assign) // TOP_K_INNER
    flat_gate = gates.reshape(n_assign)
    order = jnp.argsort(flat_e)
    sorted_e = flat_e[order]
    counts = jnp.bincount(flat_e, length=N_EXPERTS)
    padded = ((counts + MOE_BLOCK - 1) // MOE_BLOCK) * MOE_BLOCK
    start_sorted = jnp.cumsum(counts) - counts
    pad_end = jnp.cumsum(padded)
    start_pad = pad_end - padded
    rank = jnp.arange(n_assign) - start_sorted[sorted_e]
    dest = start_pad[sorted_e] + rank
    n_blocks = -(-n_assign // MOE_BLOCK) + N_EXPERTS
    n_rows = n_blocks * MOE_BLOCK
    row_tok = jnp.full((n_rows,), n_tok, dtype=jnp.int32).at[dest].set(flat_tok[order].astype(jnp.int32))
    row_gate = jnp.zeros((n_rows,), dtype=flat_gate.dtype).at[dest].set(flat_gate[order])
    block_expert = jnp.clip(jnp.searchsorted(pad_end, jnp.arange(n_blocks) * MOE_BLOCK, side='right'), 0, N_EXPERTS - 1)
    x_pad = jnp.concatenate([xt, jnp.zeros((1, d), xt.dtype)], axis=0)
    xs = x_pad[row_tok].reshape(n_blocks, MOE_BLOCK, d)

    def expert_block(args):
        xb, e = args
        h = jax.nn.silu(xb @ w_gate[e]) * (xb @ w_up[e])
        return h @ w_down[e]

    ys = lax.map(expert_block, (xs, block_expert)).reshape(n_rows, d)
    out = jnp.zeros((n_tok + 1, d), ys.dtype).at[row_tok].add(ys * row_gate[:, None].astype(ys.dtype))
    return out[:n_tok]


def hierarchical_moe(x, w_rg, b_rg, w_re, b_re, w_gate, w_up, w_down):
    bsz, seq, d = x.shape
    xt = x.reshape(bsz * seq, d)
    p_group = jax.nn.softmax((xt @ w_rg + b_rg).astype(jnp.float32), axis=-1)
    pg_top, g_sel = lax.top_k(p_group, 1)
    le = (jnp.einsum('nd,gde->nge', xt, w_re) + b_re).astype(jnp.float32)
    le_sel = jnp.take_along_axis(le, g_sel[:, :, None], axis=1)[:, 0]
    pe_top, e_sel = lax.top_k(jax.nn.softmax(le_sel, axis=-1), TOP_K_INNER)
    pe_top = pe_top / jnp.sum(pe_top, axis=-1, keepdims=True)
    gates = pg_top * pe_top
    expert_ids = g_sel * EXPERTS_PER_GROUP + e_sel
    y = grouped_expert_ffn(xt, expert_ids, gates, w_gate, w_up, w_down)
    return y.reshape(bsz, seq, d)


def even_mixer(x, cos, sin, attn_norm, w_in, conv_w, q_norm, k_norm, w_out):
    bsz, seq, _ = x.shape
    h = rms_norm(x, attn_norm)
    cb, cc, ch, q, k, v, iq, ik, iw = split_cols(h @ w_in, EVEN_SPLITS)
    a_out = short_gated_conv(cb, cc, ch, conv_w)
    q = apply_rope(rms_norm(q.reshape(bsz, seq, DSA_HEADS, HEAD_DIM), q_norm), cos, sin)
    k = apply_rope(rms_norm(k, k_norm)[:, :, None, :], cos, sin)[:, :, 0]
    iq = apply_rope(iq.reshape(bsz, seq, IDX_HEADS, IDX_DIM), cos, sin)
    ik = apply_rope(ik[:, :, None, :], cos, sin)[:, :, 0]
    b_out = dsa_attention(q, k, v, iq, ik, iw * IDX_HEADS ** -0.5)
    return x + jnp.concatenate([a_out, b_out], axis=-1) @ w_out


def odd_mixer(x, cos, sin, attn_norm, w_in, q_norm, k_norm, w_out):
    bsz, seq, _ = x.shape
    h = rms_norm(x, attn_norm)
    q, k, v = split_cols(h @ w_in, ODD_SPLITS)
    q = apply_rope(rms_norm(q.reshape(bsz, seq, DIL_HEADS, HEAD_DIM), q_norm), cos, sin)
    k = apply_rope(rms_norm(k.reshape(bsz, seq, DIL_KV_HEADS, HEAD_DIM), k_norm), cos, sin)
    v = v.reshape(bsz, seq, DIL_KV_HEADS, HEAD_DIM)
    return x + dilated_attention(q, k, v) @ w_out


def moe_sublayer(x, ffn_norm, w_rg, b_rg, w_re, b_re, w_gate, w_up, w_down):
    return x + hierarchical_moe(rms_norm(x, ffn_norm), w_rg, b_rg, w_re, b_re, w_gate, w_up, w_down)


def setup_inputs(seed: int = 0) -> dict:
    key = jax.random.key(seed)
    ks = jax.random.split(key, 32)
    f32 = jnp.float32

    def nrm(k, shape, scale):
        return jax.random.normal(k, shape, f32) * scale

    def gain(k, n):
        return 1.0 + 0.02 * jax.random.normal(k, (n,), f32)

    d = D_MODEL
    inp = {}
    inp['x'] = nrm(ks[0], (BATCH, SEQ, d), 1.0)
    inp['attn_norm_0'] = gain(ks[1], d)
    inp['w_in_0'] = nrm(ks[2], (d, EVEN_IN_WIDTH), d ** -0.5)
    inp['conv_w_0'] = nrm(ks[3], (CONV_CHANNELS, CONV_WIDTH), CONV_WIDTH ** -0.5)
    inp['q_norm_0'] = gain(ks[4], HEAD_DIM)
    inp['k_norm_0'] = gain(ks[5], HEAD_DIM)
    inp['w_out_0'] = nrm(ks[6], (EVEN_MIX_WIDTH, d), EVEN_MIX_WIDTH ** -0.5)
    inp['ffn_norm_0'] = gain(ks[7], d)
    inp['w_rg_0'] = nrm(ks[8], (d, N_GROUPS), d ** -0.5)
    inp['b_rg_0'] = nrm(ks[9], (N_GROUPS,), 0.01)
    inp['w_re_0'] = nrm(ks[10], (N_GROUPS, d, EXPERTS_PER_GROUP), d ** -0.5)
    inp['b_re_0'] = nrm(ks[11], (N_GROUPS, EXPERTS_PER_GROUP), 0.01)
    inp['w_gate_0'] = nrm(ks[12], (N_EXPERTS, d, D_EXPERT), d ** -0.5)
    inp['w_up_0'] = nrm(ks[13], (N_EXPERTS, d, D_EXPERT), d ** -0.5)
    inp['w_down_0'] = nrm(ks[14], (N_EXPERTS, D_EXPERT, d), D_EXPERT ** -0.5)
    inp['attn_norm_1'] = gain(ks[15], d)
    inp['w_in_1'] = nrm(ks[16], (d, ODD_IN_WIDTH), d ** -0.5)
    inp['q_norm_1'] = gain(ks[17], HEAD_DIM)
    inp['k_norm_1'] = gain(ks[18], HEAD_DIM)
    inp['w_out_1'] = nrm(ks[19], (ODD_MIX_WIDTH, d), ODD_MIX_WIDTH ** -0.5)
    inp['ffn_norm_1'] = gain(ks[20], d)
    inp['w_rg_1'] = nrm(ks[21], (d, N_GROUPS), d ** -0.5)
    inp['b_rg_1'] = nrm(ks[22], (N_GROUPS,), 0.01)
    inp['w_re_1'] = nrm(ks[23], (N_GROUPS, d, EXPERTS_PER_GROUP), d ** -0.5)
    inp['b_re_1'] = nrm(ks[24], (N_GROUPS, EXPERTS_PER_GROUP), 0.01)
    inp['w_gate_1'] = nrm(ks[25], (N_EXPERTS, d, D_EXPERT), d ** -0.5)
    inp['w_up_1'] = nrm(ks[26], (N_EXPERTS, d, D_EXPERT), d ** -0.5)
    inp['w_down_1'] = nrm(ks[27], (N_EXPERTS, D_EXPERT, d), D_EXPERT ** -0.5)
    return inp


def reference(x, attn_norm_0, w_in_0, conv_w_0, q_norm_0, k_norm_0, w_out_0, ffn_norm_0,
              w_rg_0, b_rg_0, w_re_0, b_re_0, w_gate_0, w_up_0, w_down_0,
              attn_norm_1, w_in_1, q_norm_1, k_norm_1, w_out_1, ffn_norm_1,
              w_rg_1, b_rg_1, w_re_1, b_re_1, w_gate_1, w_up_1, w_down_1):
    cos, sin = rope_tables(x.shape[1])
    mixer_params = ((attn_norm_0, w_in_0, conv_w_0, q_norm_0, k_norm_0, w_out_0),
                    (attn_norm_1, w_in_1, q_norm_1, k_norm_1, w_out_1))
    moe_params = ((ffn_norm_0, w_rg_0, b_rg_0, w_re_0, b_re_0, w_gate_0, w_up_0, w_down_0),
                  (ffn_norm_1, w_rg_1, b_rg_1, w_re_1, b_re_1, w_gate_1, w_up_1, w_down_1))
    for layer in range(DEPTH):
        if layer % 2 == 0:
            x = even_mixer(x, cos, sin, *mixer_params[layer])
        else:
            x = odd_mixer(x, cos, sin, *mixer_params[layer])
        x = moe_sublayer(x, *moe_params[layer])
    return x
```

```cpp
#include <hip/hip_runtime.h>
#include <hip/hip_cooperative_groups.h>
#include <cstdio>
#include <cstdint>
namespace cg = cooperative_groups;

#define LAS __attribute__((address_space(3)))
#define DI __device__ __forceinline__
typedef unsigned short bf16_t;
typedef short bf16x8 __attribute__((ext_vector_type(8)));
typedef short s16x4 __attribute__((ext_vector_type(4)));
typedef float f32x2 __attribute__((ext_vector_type(2)));
typedef float f32x4 __attribute__((ext_vector_type(4)));
typedef float f32x16 __attribute__((ext_vector_type(16)));
typedef unsigned u32x2 __attribute__((ext_vector_type(2)));
typedef unsigned u32x4 __attribute__((ext_vector_type(4)));
typedef __bf16 bf16x2_t __attribute__((ext_vector_type(2)));

constexpr int NTOK = 65536, DM = 1024, SEQ = 4096, NBATCH = 16;
constexpr int W0P = 2560, W0V = 2500;
constexpr int W1 = 1536;
constexpr int C_CB = 0, C_CC = 512, C_CH = 1024, C_Q = 1536, C_K = 2048, C_V = 2112, C_IQ = 2176, C_IK = 2432, C_IW = 2496;
constexpr int NEXP = 32, DEXP = 512;
constexpr int MAXROWS = 139264;
constexpr float NORM_EPS = 1e-6f;
constexpr float LOG2E = 1.4426950408889634f;

constexpr size_t MiB = 1u << 20;
constexpr size_t WS_CTL = 0;
constexpr size_t WS_ROPE = 1 * MiB;
constexpr size_t WS_WR0 = 2 * MiB, WS_WR1 = 2 * MiB + 256 * 1024;
constexpr size_t WS_WIN0 = 3 * MiB, WS_WOUT0 = 8 * MiB, WS_WIN1 = 10 * MiB, WS_WOUT1 = 13 * MiB;
constexpr size_t WS_WGU0 = 16 * MiB, WS_WD0 = 80 * MiB, WS_WGU1 = 112 * MiB, WS_WD1 = 176 * MiB;
constexpr size_t WS_XN = 208 * MiB;
constexpr size_t WS_MIX = 337 * MiB;
constexpr size_t WS_H = 465 * MiB;
constexpr size_t WS_PROJ = 601 * MiB;
constexpr size_t WS_LIST = 921 * MiB;
constexpr size_t WS_ASG = 929 * MiB;
constexpr size_t WS_ASGG = 930 * MiB;
constexpr size_t WS_END = 931 * MiB;

constexpr int LDS_BYTES = 155648;
constexpr int LDS_LIST = 131072;
constexpr int LDS_MISC = 131072 + 4096;

DI unsigned pk2(float lo, float hi) { f32x2 v = {lo, hi}; bf16x2_t b = __builtin_convertvector(v, bf16x2_t); return __builtin_bit_cast(unsigned, b); }
DI float bflo(unsigned w) { return __uint_as_float(w << 16); }
DI float bfhi(unsigned w) { return __uint_as_float(w & 0xffff0000u); }
DI float bf1(bf16_t h) { return __uint_as_float((unsigned)h << 16); }
DI int opaque(int x) { asm volatile("" : "+v"(x)); return x; }
DI int lane_id_v() { int l; asm volatile("v_mbcnt_lo_u32_b32 %0, -1, 0\n\tv_mbcnt_hi_u32_b32 %0, -1, %0" : "=v"(l)); return l; }
DI float wave_sum(float v) {
#pragma unroll
  for (int o = 1; o < 64; o <<= 1) v += __shfl_xor(v, o);
  return v;
}
DI float wave_max(float v) {
#pragma unroll
  for (int o = 1; o < 64; o <<= 1) v = fmaxf(v, __shfl_xor(v, o));
  return v;
}
DI unsigned wave_sum_u(unsigned v) {
#pragma unroll
  for (int o = 1; o < 64; o <<= 1) v += (unsigned)__shfl_xor((int)v, o);
  return v;
}

namespace pg8 {
constexpr int BM = 256, BK = 64, HALF = 128, HTB = HALF * BK * 2, STAGE_BYTES = 8 * HTB, NXCD = 8, WGM = 8;
DI int lds_byte(int r, int c) { const int st = (r >> 4) * 2 + (c >> 5), rr = r & 15, cc = c & 31, ob = rr * 64 + cc * 2; return st * 1024 + (ob ^ (((ob >> 9) & 1) << 5)); }
DI void stage_rc(int b, int& R, int& C) { const int st = b / 1024, sb = b % 1024, swz = sb ^ (((sb >> 9) & 1) << 5); R = (st >> 1) * 16 + swz / 64; C = (st & 1) * 32 + (swz % 64) / 2; }
DI int perm32(int rho) { const int n = rho >> 4, i = rho & 15; return 8 * (i >> 2) + 4 * n + (i & 3); }

struct Unit { const char* b; int p0, p1, p2, p3; };

struct EpiBf16 {
  static constexpr bool PERM = true;
  bf16_t* O; int ldc;
  DI void operator()(const f32x4 (&acc)[2][2][4][2], const Unit& u, int wr, int wc, int fr, int fq) const {
    const int row0 = u.p0 + wr * 64 + fr, col0 = u.p1 + wc * 32 + 8 * fq;
#pragma unroll
    for (int ai = 0; ai < 2; ++ai)
#pragma unroll
      for (int m = 0; m < 4; ++m) { bf16_t* rowp = O + (size_t)(row0 + ai * HALF + m * 16) * ldc + col0;
#pragma unroll
        for (int bj = 0; bj < 2; ++bj) { const f32x4 v0 = acc[ai][bj][m][0], v1 = acc[ai][bj][m][1];
          u32x4 w; w.x = pk2(v0[0], v0[1]); w.y = pk2(v0[2], v0[3]); w.z = pk2(v1[0], v1[1]); w.w = pk2(v1[2], v1[3]);
          *(u32x4*)(rowp + bj * HALF) = w; } }
  }
};
struct EpiResF32 {
  static constexpr bool PERM = false;
  const float* base; float* out; int ldc;
  DI void operator()(const f32x4 (&acc)[2][2][4][2], const Unit& u, int wr, int wc, int fr, int fq) const {
    const int row0 = u.p0 + wr * 64 + fr, col0 = u.p1 + wc * 32 + 4 * fq;
#pragma unroll
    for (int ai = 0; ai < 2; ++ai)
#pragma unroll
      for (int m = 0; m < 4; ++m) { const size_t off = (size_t)(row0 + ai * HALF + m * 16) * ldc + col0;
#pragma unroll
        for (int bj = 0; bj < 2; ++bj)
#pragma unroll
          for (int n = 0; n < 2; ++n) { const f32x4 bs = *(const f32x4*)(base + off + bj * HALF + n * 16); *(f32x4*)(out + off + bj * HALF + n * 16) = bs + acc[ai][bj][m][n]; } }
  }
};
DI float silu_mul(float g, float u) { return g * u * __builtin_amdgcn_rcpf(1.0f + __builtin_amdgcn_exp2f(-g * LOG2E)); }
struct EpiSwiGLU {
  static constexpr bool PERM = true;
  bf16_t* H;
  DI void operator()(const f32x4 (&acc)[2][2][4][2], const Unit& u, int wr, int wc, int fr, int fq) const {
    const int row0 = u.p0 + wr * 64 + fr, col0 = u.p1 + wc * 32 + 8 * fq;
#pragma unroll
    for (int ai = 0; ai < 2; ++ai)
#pragma unroll
      for (int m = 0; m < 4; ++m) { bf16_t* rowp = H + (size_t)(row0 + ai * HALF + m * 16) * DEXP + col0;
        const f32x4 g0 = acc[ai][0][m][0], g1 = acc[ai][0][m][1], u0 = acc[ai][1][m][0], u1 = acc[ai][1][m][1];
        u32x4 w; w.x = pk2(silu_mul(g0[0], u0[0]), silu_mul(g0[1], u0[1])); w.y = pk2(silu_mul(g0[2], u0[2]), silu_mul(g0[3], u0[3]));
        w.z = pk2(silu_mul(g1[0], u1[0]), silu_mul(g1[1], u1[1])); w.w = pk2(silu_mul(g1[2], u1[2]), silu_mul(g1[3], u1[3]));
        *(u32x4*)rowp = w; }
  }
};

struct DenseSched {
  int nM, nN, nwg, G, c, K; const char* Bt;
  DI void init(int M, int N, int K_, const void* Bt_, int G_, int c_) { nM = M / BM; nN = N / BM; nwg = nM * nN; G = G_; c = c_; K = K_; Bt = (const char*)Bt_; }
  DI bool next(int i, Unit& u) const {
    const long L = (long)i * G + c; if (L >= nwg) return false;
    int wgid = (int)L; { const int q = nwg / NXCD, r = nwg % NXCD, xcd = wgid % NXCD, off = wgid / NXCD; wgid = (xcd < r ? xcd * (q + 1) : r * (q + 1) + (xcd - r) * q) + off; }
    const int nig = WGM * nN, gid = wgid / nig, fm = gid * WGM, gsz = (nM - fm) < WGM ? (nM - fm) : WGM;
    const int pm = fm + ((wgid % nig) % gsz), pn = (wgid % nig) / gsz;
    u.p0 = pm * BM; u.p1 = pn * BM; u.p2 = 0; u.p3 = 0; u.b = Bt + (size_t)pn * BM * K * 2; return true;
  }
  DI void a_off(const Unit& u, const int (&R)[2], const int (&C)[2], unsigned (&o)[2][2]) const {
#pragma unroll
    for (int h = 0; h < 2; ++h)
#pragma unroll
      for (int i = 0; i < 2; ++i) o[h][i] = (unsigned)((u.p0 + h * HALF + R[i]) * K + C[i]) * 2u;
  }
};
template <bool GATHER> struct MoeSched {
  const LAS int* pb; const LAS int* cnt; const int* list; const char* W; int G, c, K;
  DI bool next(int i, Unit& u) const {
    const int L = i * G + c; const int total = pb[NEXP] * 4; if (L >= total) return false;
    const int rbg = L >> 2, pn = L & 3; int e = 0;
    for (int j = 1; j < NEXP; ++j) e = (pb[j] <= rbg) ? j : e;
    u.p0 = rbg * BM; u.p1 = pn * (GATHER ? 128 : 256); u.p2 = e; u.p3 = rbg - pb[e];
    u.b = W + (size_t)(e * 1024 + pn * 256) * K * 2; return true;
  }
  DI void a_off(const Unit& u, const int (&R)[2], const int (&C)[2], unsigned (&o)[2][2]) const {
    if (GATHER) {
      const int ce = cnt[u.p2];
#pragma unroll
      for (int h = 0; h < 2; ++h)
#pragma unroll
        for (int i = 0; i < 2; ++i) { const int row = u.p3 * BM + h * HALF + R[i]; const int tok = (row < ce) ? list[u.p2 * 65536 + row] : NTOK; o[h][i] = (unsigned)(tok * K + C[i]) * 2u; }
    } else {
#pragma unroll
      for (int h = 0; h < 2; ++h)
#pragma unroll
        for (int i = 0; i < 2; ++i) o[h][i] = (unsigned)((u.p0 + h * HALF + R[i]) * K + C[i]) * 2u;
    }
  }
};

template <class Epi, class Sched, bool ALIGN_EPI>
DI void gemm_phase(LAS unsigned char* lds, const int wave_id, const char* gA, const int K, const Sched& S, const Epi& E) {
  const int lane = lane_id_v(), wid = wave_id, tid = wid * 64 + lane, wr = wid >> 2, wc = wid & 3, fr = lane & 15, fq = lane >> 4;
  const int nt = K / BK;
  int Rp[2], Cp[2]; unsigned voffB[2];
#pragma unroll
  for (int i = 0; i < 2; ++i) { int R, C; stage_rc(tid * 16 + i * 8192, R, C); Rp[i] = R; Cp[i] = C; const int Rb = Epi::PERM ? ((R & ~31) + perm32(R & 31)) : R; voffB[i] = (unsigned)(Rb * K + C) * 2u; }
  const size_t kstep = (size_t)(BK * 2);
  const size_t hstep = (size_t)HALF * K * 2;
  const unsigned ldsw = (unsigned)wid * 1024u;
  const int aoff = lds_byte(wr * 64 + fr, fq * 8), boff = lds_byte(wc * 32 + fr, fq * 8);
#define PG8_SA(b, h) (((b) * 2 + (h)) * HTB)
#define PG8_SB(b, h) ((4 + (b) * 2 + (h)) * HTB)
#define PG8_STAGE_B(bufoff, gbase) do { _Pragma("unroll") for (int _i = 0; _i < 2; ++_i) \
    __builtin_amdgcn_global_load_lds((const unsigned*)((const char*)(gbase) + voffB[_i]), (LAS unsigned*)(lds + (bufoff) + ldsw + _i * 8192), 16, 0, 0); } while (0)
#define PG8_STAGE_A(bufoff, kb, offs) do { _Pragma("unroll") for (int _i = 0; _i < 2; ++_i) \
    __builtin_amdgcn_global_load_lds((const unsigned*)(gA + (size_t)(kb) + (offs)[_i]), (LAS unsigned*)(lds + (bufoff) + ldsw + _i * 8192), 16, 0, 0); } while (0)
#define PG8_LDA(dst, b, h) do { _Pragma("unroll") for (int m = 0; m < 4; ++m) _Pragma("unroll") for (int k = 0; k < 2; ++k) dst[m][k] = *(const LAS bf16x8*)(lds + PG8_SA(b, h) + aoff + m * 2048 + k * 1024); } while (0)
#define PG8_LDB(dst, b, h) do { _Pragma("unroll") for (int n = 0; n < 2; ++n) _Pragma("unroll") for (int k = 0; k < 2; ++k) dst[n][k] = *(const LAS bf16x8*)(lds + PG8_SB(b, h) + boff + n * 2048 + k * 1024); } while (0)
#define PG8_MMA(ai, bj, At, Bt) do { __builtin_amdgcn_s_setprio(1); _Pragma("unroll") for (int m = 0; m < 4; ++m) _Pragma("unroll") for (int n = 0; n < 2; ++n) _Pragma("unroll") for (int k = 0; k < 2; ++k) \
    acc[ai][bj][m][n] = __builtin_amdgcn_mfma_f32_16x16x32_bf16(Bt[n][k], At[m][k], acc[ai][bj][m][n], 0, 0, 0); __builtin_amdgcn_s_setprio(0); } while (0)
#define PG8_WAIT_V(n) asm volatile("s_waitcnt vmcnt(" #n ")" ::: "memory")
#define PG8_WAIT_L(n) asm volatile("s_waitcnt lgkmcnt(" #n ")" ::: "memory")
#define PG8_BAR __builtin_amdgcn_s_barrier()
#define PG8_SCHED __builtin_amdgcn_sched_barrier(0)
  Unit cur, nxt; int ui = 0;
  if (!S.next(0, cur)) return;
  unsigned ca[2][2], na[2][2];
  S.a_off(cur, Rp, Cp, ca);
  f32x4 acc[2][2][4][2];
#pragma unroll
  for (int a = 0; a < 2; ++a)
#pragma unroll
    for (int b = 0; b < 2; ++b)
#pragma unroll
      for (int m = 0; m < 4; ++m)
#pragma unroll
        for (int n = 0; n < 2; ++n) acc[a][b][m][n] = (f32x4){0.f, 0.f, 0.f, 0.f};
  bf16x8 At[4][2], B0[2][2], B1[2][2];
  const char* cB = cur.b;
  PG8_STAGE_B(PG8_SB(0, 0), cB); PG8_STAGE_B(PG8_SB(0, 1), cB + hstep); PG8_STAGE_A(PG8_SA(0, 0), 0, ca[0]); PG8_STAGE_A(PG8_SA(0, 1), 0, ca[1]);
  if (wr == 1) PG8_BAR;
  PG8_WAIT_V(2); PG8_BAR;
  PG8_STAGE_B(PG8_SB(1, 0), cB + kstep); PG8_STAGE_A(PG8_SA(1, 0), kstep, ca[0]); PG8_STAGE_B(PG8_SB(1, 1), cB + hstep + kstep);
  PG8_WAIT_V(6); PG8_BAR;
  for (;;) {
    const bool has_next = S.next(ui + 1, nxt);
    if (has_next) S.a_off(nxt, Rp, Cp, na);
    else {
#pragma unroll
      for (int h = 0; h < 2; ++h)
#pragma unroll
        for (int i = 0; i < 2; ++i) na[h][i] = ca[h][i];
    }
    const char* nB = has_next ? nxt.b : cB;
    for (int t = 0; t < nt; t += 2) {
      const bool last = (t == nt - 2);
      PG8_LDB(B0, 0, 0); PG8_LDB(B1, 0, 1); PG8_SCHED; PG8_LDA(At, 0, 0); PG8_STAGE_A(PG8_SA(1, 1), (size_t)(t + 1) * kstep, ca[1]);
      PG8_WAIT_V(8); PG8_WAIT_L(0); PG8_BAR; PG8_MMA(0, 0, At, B0); PG8_MMA(0, 1, At, B1); PG8_BAR; PG8_SCHED;
      const size_t kb2 = last ? 0 : (size_t)(t + 2) * kstep;
      const char* b2 = last ? nB : cB + (size_t)(t + 2) * kstep;
      if (last) {
#pragma unroll
        for (int h = 0; h < 2; ++h)
#pragma unroll
          for (int i = 0; i < 2; ++i) ca[h][i] = na[h][i];
      }
      PG8_LDA(At, 0, 1); PG8_STAGE_B(PG8_SB(0, 0), b2); PG8_STAGE_B(PG8_SB(0, 1), b2 + hstep); PG8_STAGE_A(PG8_SA(0, 0), kb2, ca[0]);
      PG8_WAIT_V(8); PG8_WAIT_L(0); PG8_BAR; PG8_MMA(1, 0, At, B0); PG8_MMA(1, 1, At, B1); PG8_BAR; PG8_SCHED;
      PG8_LDB(B0, 1, 0); PG8_LDB(B1, 1, 1); PG8_SCHED; PG8_LDA(At, 1, 0); PG8_STAGE_A(PG8_SA(0, 1), kb2, ca[1]);
      PG8_WAIT_V(8); PG8_WAIT_L(0); PG8_BAR; PG8_MMA(0, 0, At, B0); PG8_MMA(0, 1, At, B1); PG8_BAR; PG8_SCHED;
      PG8_LDA(At, 1, 1); PG8_STAGE_B(PG8_SB(1, 0), b2 + kstep); PG8_STAGE_B(PG8_SB(1, 1), b2 + kstep + hstep); PG8_STAGE_A(PG8_SA(1, 0), kb2 + kstep, ca[0]);
      PG8_WAIT_V(8); PG8_WAIT_L(0); PG8_BAR; PG8_MMA(1, 0, At, B0); PG8_MMA(1, 1, At, B1); PG8_BAR; PG8_SCHED;
    }
    if constexpr (ALIGN_EPI) { if (wr == 0) PG8_BAR; }
    E(acc, cur, wr, wc, fr, fq);
    if (!has_next) break;
#pragma unroll
    for (int a = 0; a < 2; ++a)
#pragma unroll
      for (int b = 0; b < 2; ++b)
#pragma unroll
        for (int m = 0; m < 4; ++m)
#pragma unroll
          for (int n = 0; n < 2; ++n) acc[a][b][m][n] = (f32x4){0.f, 0.f, 0.f, 0.f};
    cur = nxt; cB = nB; ++ui;
    if constexpr (ALIGN_EPI) { if (wr == 1) PG8_BAR; }
  }
  PG8_WAIT_V(0);
  if constexpr (!ALIGN_EPI) { if (wr == 0) PG8_BAR; }
  PG8_BAR;
#undef PG8_SA
#undef PG8_SB
#undef PG8_STAGE_A
#undef PG8_STAGE_B
#undef PG8_LDA
#undef PG8_LDB
#undef PG8_MMA
#undef PG8_WAIT_V
#undef PG8_WAIT_L
#undef PG8_BAR
#undef PG8_SCHED
}
}

struct Params { const float* in[28]; float* out; unsigned char* ws; };
enum { I_X = 0, I_ANORM0, I_WIN0, I_CONVW, I_QN0, I_KN0, I_WOUT0, I_FNORM0, I_WRG0, I_BRG0, I_WRE0, I_BRE0, I_WG0, I_WU0, I_WD0,
       I_ANORM1, I_WIN1, I_QN1, I_KN1, I_WOUT1, I_FNORM1, I_WRG1, I_BRG1, I_WRE1, I_BRE1, I_WG1, I_WU1, I_WD1 };

struct Ctx { LAS unsigned char* lds; int wave, G, gw, NGW; };

DI void tr_item(const float* W, int K, int N, int nvalid, const float* gain, bf16_t* WT, int mode, LAS float* scr, int item, int nblk, int lane) {
  const int kb = item / nblk, nb = item % nblk, k0 = 64 * kb, n0 = 32 * nb;
  const int n = n0 + (lane & 31);
#pragma unroll 8
  for (int i = 0; i < 32; ++i) { const int kk = 2 * i + (lane >> 5); float v = 0.f; if (n < nvalid) { v = W[(size_t)(k0 + kk) * N + n]; if (gain) v *= gain[k0 + kk]; } scr[kk * 33 + (lane & 31)] = v; }
  asm volatile("s_waitcnt lgkmcnt(0)" ::: "memory");
  const int c = lane & 7;
#pragma unroll
  for (int j = 0; j < 4; ++j) { const int nn = (lane >> 3) + 8 * j; const LAS float* s = scr + (8 * c) * 33 + nn;
    u32x4 o; o.x = pk2(s[0 * 33], s[1 * 33]); o.y = pk2(s[2 * 33], s[3 * 33]); o.z = pk2(s[4 * 33], s[5 * 33]); o.w = pk2(s[6 * 33], s[7 * 33]);
    const int ng = n0 + nn; const int drow = (mode == 0) ? ng : ((ng >> 7) * 256 + (ng & 127) + (mode == 2 ? 128 : 0));
    *(u32x4*)(WT + (size_t)drow * K + k0 + 8 * c) = o; }
  asm volatile("s_waitcnt lgkmcnt(0)" ::: "memory");
}
DI void rms_row_to_bf16(const float* xrow, bf16_t* orow, int lane) {
  const f32x4* xr = (const f32x4*)xrow + lane;
  f32x4 v[4]; float s = 0.f;
#pragma unroll
  for (int j = 0; j < 4; ++j) { v[j] = xr[64 * j]; s += (v[j].x * v[j].x + v[j].y * v[j].y) + (v[j].z * v[j].z + v[j].w * v[j].w); }
  const float rstd = 1.0f / sqrtf(wave_sum(s) * (1.f / DM) + NORM_EPS);
  unsigned long long* o8 = (unsigned long long*)orow + lane;
#pragma unroll
  for (int j = 0; j < 4; ++j) o8[64 * j] = (unsigned long long)pk2(v[j].x * rstd, v[j].y * rstd) | ((unsigned long long)pk2(v[j].z * rstd, v[j].w * rstd) << 32);
}
DI void p0_prologue(const Ctx& F, const Params& P) {
  unsigned char* ws = P.ws; const int lane = lane_id_v(); const int tid = F.wave * 64 + lane;
  LAS float* scr = (LAS float*)(F.lds + F.wave * 16384);
  constexpr int I_IN0 = 16 * 80, I_OUT = 16 * 32, I_GU = 32 * 16 * 16, I_DN = 32 * 8 * 32, I_IN1 = 16 * 48;
  constexpr int PER_LAYER0 = I_IN0 + I_OUT + 2 * I_GU + I_DN, PER_LAYER1 = I_IN1 + I_OUT + 2 * I_GU + I_DN;
  for (int it = F.gw; it < PER_LAYER0 + PER_LAYER1; it += F.NGW) {
    int r = it; const int L = (r >= PER_LAYER0) ? 1 : 0; if (L) r -= PER_LAYER0;
    const int i_in = L ? I_IN1 : I_IN0;
    const float* anorm = P.in[L ? I_ANORM1 : I_ANORM0]; const float* fnorm = P.in[L ? I_FNORM1 : I_FNORM0];
    if (r < i_in) { if (L) tr_item(P.in[I_WIN1], 1024, W1, W1, anorm, (bf16_t*)(ws + WS_WIN1), 0, scr, r, 48, lane); else tr_item(P.in[I_WIN0], 1024, W0V, W0V, anorm, (bf16_t*)(ws + WS_WIN0), 0, scr, r, 80, lane); continue; }
    r -= i_in;
    if (r < I_OUT) { tr_item(P.in[L ? I_WOUT1 : I_WOUT0], 1024, 1024, 1024, nullptr, (bf16_t*)(ws + (L ? WS_WOUT1 : WS_WOUT0)), 0, scr, r, 32, lane); continue; }
    r -= I_OUT;
    if (r < I_GU) { const int e = r >> 8; tr_item(P.in[L ? I_WG1 : I_WG0] + (size_t)e * 1024 * 512, 1024, 512, 512, fnorm, (bf16_t*)(ws + (L ? WS_WGU1 : WS_WGU0)) + (size_t)e * 1024 * 1024, 1, scr, r & 255, 16, lane); continue; }
    r -= I_GU;
    if (r < I_GU) { const int e = r >> 8; tr_item(P.in[L ? I_WU1 : I_WU0] + (size_t)e * 1024 * 512, 1024, 512, 512, fnorm, (bf16_t*)(ws + (L ? WS_WGU1 : WS_WGU0)) + (size_t)e * 1024 * 1024, 2, scr, r & 255, 16, lane); continue; }
    r -= I_GU;
    { const int e = r >> 8; tr_item(P.in[L ? I_WD1 : I_WD0] + (size_t)e * 512 * 1024, 512, 1024, 1024, nullptr, (bf16_t*)(ws + (L ? WS_WD1 : WS_WD0)) + (size_t)e * 1024 * 512, 0, scr, r & 255, 32, lane); }
  }
  for (int m = F.gw; m < NTOK; m += F.NGW) rms_row_to_bf16(P.in[I_X] + (size_t)m * DM, (bf16_t*)(ws + WS_XN) + (size_t)m * DM, lane);
  const int gt = blockIdx.x * 512 + tid, NGT = F.G * 512;
  for (int i = gt; i < 512; i += NGT) ((unsigned*)(ws + WS_XN + (size_t)NTOK * DM * 2))[i] = 0u;
  for (int i = gt; i < 128; i += NGT) ((int*)(ws + WS_CTL))[i] = 0;
  for (int i = gt; i < SEQ * 32; i += NGT) {
    const int t = i >> 5, k = i & 31;
    const float inv = (float)exp2(-(double)k * (13.287712379549449 / 32.0));
    const float ang = (float)t * inv;
    const double rev = (double)ang * 0.15915494309189535; const float fr = (float)(rev - rint(rev));
    ((float*)(ws + WS_ROPE))[i] = __builtin_amdgcn_cosf(fr); ((float*)(ws + WS_ROPE))[SEQ * 32 + i] = __builtin_amdgcn_sinf(fr);
  }
  for (int i = gt; i < 2 * 36 * 1024; i += NGT) {
    const int L = i / (36 * 1024), r = i % (36 * 1024), j = r >> 10, k = r & 1023;
    const float g = P.in[L ? I_FNORM1 : I_FNORM0][k];
    float w; if (j < 4) w = P.in[L ? I_WRG1 : I_WRG0][k * 4 + j]; else { const int gg = (j - 4) >> 3, e = (j - 4) & 7; w = P.in[L ? I_WRE1 : I_WRE0][((size_t)gg * 1024 + k) * 8 + e]; }
    ((float*)(ws + (L ? WS_WR1 : WS_WR0)))[r] = w * g;
  }
  for (int i = gt; i < 2 * 36; i += NGT) { const int L = i / 36, j = i % 36; ((float*)(ws + (L ? WS_WR1 : WS_WR0)))[36 * 1024 + j] = (j < 4) ? P.in[L ? I_BRG1 : I_BRG0][j] : P.in[L ? I_BRE1 : I_BRE0][j - 4]; }
}

DI void head_normrope(bf16_t* p, const float* gain, bool do_norm, const float* cosr, const float* sinr, int sub) {
  const u32x4 w = *(const u32x4*)p;
  float v[8] = {bflo(w.x), bfhi(w.x), bflo(w.y), bfhi(w.y), bflo(w.z), bfhi(w.z), bflo(w.w), bfhi(w.w)};
  if (do_norm) {
    float s = 0.f;
#pragma unroll
    for (int j = 0; j < 8; ++j) s += v[j] * v[j];
    s += __shfl_xor(s, 1); s += __shfl_xor(s, 2); s += __shfl_xor(s, 4);
    const float rstd = 1.0f / sqrtf(s * (1.f / 64.f) + NORM_EPS);
#pragma unroll
    for (int j = 0; j < 8; ++j) v[j] = v[j] * rstd * gain[8 * sub + j];
  }
  const int i0 = 8 * (sub & 3); const float sg = (sub & 4) ? 1.f : -1.f;
  float o[8];
#pragma unroll
  for (int j = 0; j < 8; ++j) { const float pr = __shfl_xor(v[j], 4); o[j] = v[j] * cosr[i0 + j] + sg * pr * sinr[i0 + j]; }
  u32x4 r; r.x = pk2(o[0], o[1]); r.y = pk2(o[2], o[3]); r.z = pk2(o[4], o[5]); r.w = pk2(o[6], o[7]);
  *(u32x4*)p = r;
}
DI void p1b_transform0(const Ctx& F, const Params& P) {
  bf16_t* PROJ = (bf16_t*)(P.ws + WS_PROJ); bf16_t* MIX = (bf16_t*)(P.ws + WS_MIX);
  const float* cosT = (const float*)(P.ws + WS_ROPE); const float* sinT = cosT + SEQ * 32;
  const float* convw = P.in[I_CONVW];
  const int lane = lane_id_v(), sub = lane & 7, grp = lane >> 3;
  for (int m = F.gw; m < NTOK; m += F.NGW) {
    const int t = m & (SEQ - 1);
    bf16_t* row = PROJ + (size_t)m * W0P;
    const float* cr = cosT + t * 32; const float* sr = sinT + t * 32;
    head_normrope(row + C_Q + grp * 64 + sub * 8, P.in[I_QN0], true, cr, sr, sub);
    {
      const int g2 = grp < 6 ? grp : 5;
      bf16_t* p = row + (g2 == 0 ? C_K : (g2 <= 4 ? C_IQ + (g2 - 1) * 64 : C_IK)) + sub * 8;
      if (grp < 6) head_normrope(p, P.in[I_KN0], g2 == 0, cr, sr, sub);
    }
    {
      const int c0 = 8 * lane;
      const u32x4 cb = *(const u32x4*)(row + C_CB + c0);
      float u[3][8];
#pragma unroll
      for (int d = 0; d < 3; ++d) {
        const int back = 2 - d;
        if (t >= back) { const bf16_t* r2 = row - (size_t)back * W0P; const u32x4 a = *(const u32x4*)(r2 + C_CC + c0), b = *(const u32x4*)(r2 + C_CH + c0);
          u[d][0] = bflo(a.x) * bflo(b.x); u[d][1] = bfhi(a.x) * bfhi(b.x); u[d][2] = bflo(a.y) * bflo(b.y); u[d][3] = bfhi(a.y) * bfhi(b.y);
          u[d][4] = bflo(a.z) * bflo(b.z); u[d][5] = bfhi(a.z) * bfhi(b.z); u[d][6] = bflo(a.w) * bflo(b.w); u[d][7] = bfhi(a.w) * bfhi(b.w); }
        else {
#pragma unroll
          for (int j = 0; j < 8; ++j) u[d][j] = 0.f; }
      }
      const float cbv[8] = {bflo(cb.x), bfhi(cb.x), bflo(cb.y), bfhi(cb.y), bflo(cb.z), bfhi(cb.z), bflo(cb.w), bfhi(cb.w)};
      float o[8];
#pragma unroll
      for (int j = 0; j < 8; ++j) { const float* w = convw + (c0 + j) * 3; o[j] = cbv[j] * (u[0][j] * w[0] + u[1][j] * w[1] + u[2][j] * w[2]); }
      u32x4 r; r.x = pk2(o[0], o[1]); r.y = pk2(o[2], o[3]); r.z = pk2(o[4], o[5]); r.w = pk2(o[6], o[7]);
      *(u32x4*)(MIX + (size_t)m * DM + c0) = r;
    }
  }
}


DI unsigned f2key(float f) { const unsigned b = __float_as_uint(f); return b ^ ((unsigned)((int)b >> 31) | 0x80000000u); }
DI s16x4 tr_read(LAS unsigned char* p) { typedef short v4i16_t __attribute__((ext_vector_type(4))); return __builtin_bit_cast(s16x4, __builtin_amdgcn_ds_read_tr16_b64_v4i16((LAS v4i16_t*)p)); }
DI unsigned lane_prefix(unsigned long long m) { return __builtin_amdgcn_mbcnt_hi((unsigned)(m >> 32), __builtin_amdgcn_mbcnt_lo((unsigned)m, 0u)); }

DI void dsa_phase(const Ctx& F, const Params& P) {
  const bf16_t* PROJ = (const bf16_t*)(P.ws + WS_PROJ); bf16_t* MIX = (bf16_t*)(P.ws + WS_MIX);
  LAS unsigned* sc = (LAS unsigned*)F.lds;
  LAS unsigned short* lst = (LAS unsigned short*)(F.lds + LDS_LIST + F.wave * 512);
  LAS unsigned char* vst = F.lds + F.wave * 16384;
  const int lane = lane_id_v(), w = F.wave;
  const float cshift = 8.f * wave_max(fabsf(P.in[I_QN0][lane])) * wave_max(fabsf(P.in[I_KN0][lane])) * 1.02f;
  const float c1 = 0.125f * LOG2E, c2 = cshift * LOG2E;
  for (int v = blockIdx.x; v < 8192; v += gridDim.x) {
    const int cidx = v & 255, jj = v >> 8, b = jj >> 1, tb = (jj & 1) ? (511 - cidx) : cidx;
    const int t0 = tb * 8; const size_t rb = (size_t)b * SEQ;
    {
      const int r32 = lane & 31, half = lane >> 5;
      const bf16_t* ap = PROJ + (rb + t0 + (r32 >> 2)) * W0P + C_IQ + (r32 & 3) * 64 + 8 * half;
      bf16x8 af[4];
#pragma unroll
      for (int ks = 0; ks < 4; ++ks) af[ks] = *(const bf16x8*)(ap + 16 * ks);
      float wq[4][4];
#pragma unroll
      for (int g = 0; g < 4; ++g) { const u32x2 ww = *(const u32x2*)(PROJ + (rb + t0 + 2 * g + half) * W0P + C_IW);
        wq[g][0] = bflo(ww.x) * 0.0625f; wq[g][1] = bfhi(ww.x) * 0.0625f; wq[g][2] = bflo(ww.y) * 0.0625f; wq[g][3] = bfhi(ww.y) * 0.0625f; }
      const int ntile = 2 * (((t0 + 7) >> 6) + 1);
      for (int T = w; T < ntile; T += 8) {
        const int s = 32 * T + r32;
        const bf16_t* bp = PROJ + (rb + s) * W0P + C_IK + 8 * half;
        bf16x8 bfr[4];
#pragma unroll
        for (int ks = 0; ks < 4; ++ks) bfr[ks] = *(const bf16x8*)(bp + 16 * ks);
        f32x16 acc;
#pragma unroll
        for (int i = 0; i < 16; ++i) acc[i] = 0.f;
#pragma unroll
        for (int ks = 0; ks < 4; ++ks) acc = __builtin_amdgcn_mfma_f32_32x32x16_bf16(af[ks], bfr[ks], acc, 0, 0, 0);
#pragma unroll
        for (int g = 0; g < 4; ++g) {
          float sv = wq[g][0] * fmaxf(acc[4 * g], 0.f) + wq[g][1] * fmaxf(acc[4 * g + 1], 0.f) + wq[g][2] * fmaxf(acc[4 * g + 2], 0.f) + wq[g][3] * fmaxf(acc[4 * g + 3], 0.f);
          sv = (sv == 0.f) ? 0.f : sv;
          const int ql = 2 * g + half;
          sc[ql * 4096 + s] = (s <= t0 + ql) ? f2key(sv) : 0u;
        }
      }
    }
    __syncthreads();
    const int t = t0 + w;
    int nvalid;
    if (t < 256) {
      nvalid = t + 1;
#pragma unroll
      for (int p = 0; p < 4; ++p) lst[p * 64 + lane] = (unsigned short)(p * 64 + lane);
    } else {
      nvalid = 256;
      const int nch = (t >> 10) + 1;
      unsigned u[64];
#pragma unroll
      for (int ch = 0; ch < 4; ++ch) {
        if (ch < nch) {
#pragma unroll
          for (int jj = 0; jj < 16; ++jj) { const int j = 16 * ch + jj; const unsigned x = sc[w * 4096 + 64 * j + lane]; u[j] = (64 * j + lane <= t) ? x : 0u; }
        } else {
#pragma unroll
          for (int jj = 0; jj < 16; ++jj) u[16 * ch + jj] = 0u;
        }
      }
      unsigned prefix = 0u; bool exact = false;
      for (int bit = 31; bit >= 0; --bit) {
        const unsigned trial = prefix | (1u << bit);
        unsigned cnt = 0u;
#pragma unroll
        for (int ch = 0; ch < 4; ++ch) if (ch < nch) {
#pragma unroll
          for (int jj = 0; jj < 16; ++jj) cnt += (u[16 * ch + jj] >= trial) ? 1u : 0u;
        }
        cnt = wave_sum_u(cnt);
        if (cnt >= 256u) prefix = trial;
        if (cnt == 256u) { exact = true; break; }
      }
      unsigned thr; int need = 0;
      if (exact) thr = prefix - 1u;
      else { thr = prefix; unsigned cgt = 0u;
#pragma unroll
        for (int j = 0; j < 64; ++j) cgt += (u[j] > thr) ? 1u : 0u;
        cgt = wave_sum_u(cgt); need = 256 - (int)cgt; }
      int base = 0;
#pragma unroll
      for (int ch = 0; ch < 4; ++ch) if (ch < nch) {
#pragma unroll
        for (int jj = 0; jj < 16; ++jj) { const int j = 16 * ch + jj; const bool sel = u[j] > thr; const unsigned long long m = __ballot(sel); const int pos = base + (int)lane_prefix(m); if (sel) lst[pos] = (unsigned short)(64 * j + lane); base += __builtin_popcountll(m); }
      }
      if (need > 0) { int tbf = 0;
#pragma unroll
        for (int ch = 0; ch < 4; ++ch) if (ch < nch) {
#pragma unroll
          for (int jj = 0; jj < 16; ++jj) { const int j = 16 * ch + jj; const bool eq = u[j] == thr; const unsigned long long m = __ballot(eq); const int r = tbf + (int)lane_prefix(m); if (eq && r < need) lst[base + r] = (unsigned short)(64 * j + lane); tbf += __builtin_popcountll(m); }
        } }
    }
    asm volatile("" ::: "memory");
    {
      const int hcol = lane & 15, g = lane >> 4;
      bf16x8 qf[2];
      { const bf16_t* qp = PROJ + (rb + t) * W0P + C_Q + (hcol & 7) * 64 + 8 * g;
#pragma unroll
        for (int ks = 0; ks < 2; ++ks) { bf16x8 q = *(const bf16x8*)(qp + 32 * ks); if (hcol >= 8) q = (bf16x8){0, 0, 0, 0, 0, 0, 0, 0}; qf[ks] = q; } }
      f32x4 acc[16];
#pragma unroll
      for (int T = 0; T < 16; ++T) {
        const int kidx = lst[16 * T + hcol];
        const bf16_t* kp = PROJ + (rb + kidx) * W0P + C_K + 8 * g;
        const bf16x8 k0 = *(const bf16x8*)kp, k1 = *(const bf16x8*)(kp + 32);
        f32x4 a = {0.f, 0.f, 0.f, 0.f};
        a = __builtin_amdgcn_mfma_f32_16x16x32_bf16(k0, qf[0], a, 0, 0, 0);
        a = __builtin_amdgcn_mfma_f32_16x16x32_bf16(k1, qf[1], a, 0, 0, 0);
        acc[T] = a;
        if ((T & 3) == 3) asm volatile("" ::: "memory");
      }
      float lsum = 0.f;
#pragma unroll
      for (int T = 0; T < 16; ++T)
#pragma unroll
        for (int r = 0; r < 4; ++r) { const int pos = 16 * T + 4 * g + r; const float p = (pos < nvalid) ? __builtin_amdgcn_exp2f(acc[T][r] * c1 - c2) : 0.f; acc[T][r] = p; lsum += p; }
      lsum += __shfl_xor(lsum, 16); lsum += __shfl_xor(lsum, 32);
      bf16x8 pf[8];
#pragma unroll
      for (int m = 0; m < 8; ++m) { u32x4 pw; pw.x = pk2(acc[2 * m][0], acc[2 * m][1]); pw.y = pk2(acc[2 * m][2], acc[2 * m][3]); pw.z = pk2(acc[2 * m + 1][0], acc[2 * m + 1][1]); pw.w = pk2(acc[2 * m + 1][2], acc[2 * m + 1][3]); pf[m] = __builtin_bit_cast(bf16x8, pw); }
      f32x4 o[4];
#pragma unroll
      for (int n = 0; n < 4; ++n) o[n] = (f32x4){0.f, 0.f, 0.f, 0.f};
      const int q4 = (lane & 15) >> 2, p4 = lane & 3;
#pragma unroll
      for (int hh = 0; hh < 2; ++hh) {
#pragma unroll 4
        for (int i = 0; i < 16; ++i) { const int ci = i * 64 + lane, row = ci >> 3, ch = ci & 7; const int kidx = lst[128 * hh + row];
          const u32x4 vv = *(const u32x4*)(PROJ + (rb + kidx) * W0P + C_V + ch * 8); *(LAS u32x4*)(vst + row * 128 + ch * 16) = vv; }
        asm volatile("" ::: "memory");
#pragma unroll
        for (int mm = 0; mm < 4; ++mm) {
#pragma unroll
          for (int n = 0; n < 4; ++n) {
            const int r1 = 32 * mm + 4 * g + q4;
            const s16x4 lo = tr_read(vst + r1 * 128 + (16 * n + 4 * p4) * 2), hi = tr_read(vst + (r1 + 16) * 128 + (16 * n + 4 * p4) * 2);
            const bf16x8 vf = __builtin_shufflevector(lo, hi, 0, 1, 2, 3, 4, 5, 6, 7);
            o[n] = __builtin_amdgcn_mfma_f32_16x16x32_bf16(vf, pf[4 * hh + mm], o[n], 0, 0, 0);
          }
        }
        asm volatile("" ::: "memory");
      }
      if (hcol < 8) { const float inv = 1.0f / lsum; bf16_t* op = MIX + (rb + t) * DM + 512 + hcol * 64 + 4 * g;
#pragma unroll
        for (int n = 0; n < 4; ++n) { u32x2 w2; w2.x = pk2(o[n][0] * inv, o[n][1] * inv); w2.y = pk2(o[n][2] * inv, o[n][3] * inv); *(u32x2*)(op + 16 * n) = w2; } }
    }
    __syncthreads();
  }
}

DI void router_phase(const Ctx& F, const Params& P, int L) {
  unsigned char* ws = P.ws;
  LAS float* wl = (LAS float*)F.lds;
  const float* wrg = (const float*)(ws + (L ? WS_WR1 : WS_WR0));
  { const int tid0 = F.wave * 64 + lane_id_v(); for (int i = tid0; i < 36 * 1024 / 4; i += 512) ((LAS f32x4*)wl)[i] = ((const f32x4*)wrg)[i]; }
  __syncthreads();
  int* cnt = (int*)(ws + WS_CTL) + L * 64; int* list = (int*)(ws + WS_LIST);
  int4* asg = (int4*)(ws + WS_ASG); float2* asgg = (float2*)(ws + WS_ASGG);
  bf16_t* XN = (bf16_t*)(ws + WS_XN);
  const int lane = lane_id_v();
  for (int m = F.gw; m < NTOK; m += F.NGW) {
    const f32x4* xr = (const f32x4*)(P.out + (size_t)m * DM) + lane;
    f32x4 v[4]; float ss = 0.f;
#pragma unroll
    for (int j = 0; j < 4; ++j) { v[j] = xr[64 * j]; ss += (v[j].x * v[j].x + v[j].y * v[j].y) + (v[j].z * v[j].z + v[j].w * v[j].w); }
    const float rstd = 1.0f / sqrtf(wave_sum(ss) * (1.f / DM) + NORM_EPS);
#pragma unroll
    for (int j = 0; j < 4; ++j) v[j] = v[j] * rstd;
    { unsigned long long* o8 = (unsigned long long*)(XN + (size_t)m * DM) + lane;
#pragma unroll
      for (int j = 0; j < 4; ++j) o8[64 * j] = (unsigned long long)pk2(v[j].x, v[j].y) | ((unsigned long long)pk2(v[j].z, v[j].w) << 32); }
    float lg[36];
#pragma unroll
    for (int jc = 0; jc < 36; ++jc) { float a = 0.f;
#pragma unroll
      for (int j = 0; j < 4; ++j) { const f32x4 w4 = *(const LAS f32x4*)(wl + jc * 1024 + 256 * j + 4 * lane); a += (v[j].x * w4.x + v[j].y * w4.y) + (v[j].z * w4.z + v[j].w * w4.w); }
      lg[jc] = a; if ((jc & 1) == 1) asm volatile("" ::: "memory"); }
#pragma unroll
    for (int jc = 0; jc < 36; ++jc) lg[jc] = wave_sum(lg[jc]) + wrg[36 * 1024 + jc];
    int gs = 0; float gm = lg[0];
#pragma unroll
    for (int j = 1; j < 4; ++j) if (lg[j] > gm) { gm = lg[j]; gs = j; }
    float z = 0.f;
#pragma unroll
    for (int j = 0; j < 4; ++j) z += __expf(lg[j] - gm);
    const float pg = 1.0f / z;
    float le[8];
#pragma unroll
    for (int i = 0; i < 8; ++i) le[i] = gs == 0 ? lg[4 + i] : (gs == 1 ? lg[12 + i] : (gs == 2 ? lg[20 + i] : lg[28 + i]));
    int i0 = 0; float m0 = le[0];
#pragma unroll
    for (int i = 1; i < 8; ++i) if (le[i] > m0) { m0 = le[i]; i0 = i; }
    int i1 = -1; float m1 = -INFINITY;
#pragma unroll
    for (int i = 0; i < 8; ++i) if (i != i0 && le[i] > m1) { m1 = le[i]; i1 = i; }
    const float e1 = __expf(m1 - m0); const float g0 = pg / (1.0f + e1), g1 = pg * e1 / (1.0f + e1);
    const int x0 = gs * 8 + i0, x1 = gs * 8 + i1;
    if (lane == 0) {
      const int r0 = atomicAdd(cnt + x0, 1); list[x0 * 65536 + r0] = m;
      const int r1 = atomicAdd(cnt + x1, 1); list[x1 * 65536 + r1] = m;
      asg[m] = make_int4(x0, x1, r0, r1); asgg[m] = make_float2(g0, g1);
    }
  }
}
DI void moe_setup(const Ctx& F, const Params& P, int L) {
  LAS int* pb = (LAS int*)(F.lds + LDS_MISC); LAS int* cl = pb + 64;
  const int* cnt = (const int*)(P.ws + WS_CTL) + L * 64;
  const int tid = F.wave * 64 + lane_id_v();
  __syncthreads();
  if (tid < 32) cl[tid] = cnt[tid];
  __syncthreads();
  if (tid == 0) { int a = 0; for (int e = 0; e < NEXP; ++e) { pb[e] = a; a += (cl[e] + 255) >> 8; } pb[NEXP] = a; }
  __syncthreads();
}
DI void combine_phase(const Ctx& F, const Params& P, int L, bool with_norm) {
  unsigned char* ws = P.ws;
  moe_setup(F, P, L);
  const LAS int* pb = (const LAS int*)(F.lds + LDS_MISC);
  const int4* asg = (const int4*)(ws + WS_ASG); const float2* asgg = (const float2*)(ws + WS_ASGG);
  const bf16_t* Y = (const bf16_t*)(ws + WS_PROJ); bf16_t* XN = (bf16_t*)(ws + WS_XN);
  const int lane = lane_id_v();
  for (int m = F.gw; m < NTOK; m += F.NGW) {
    const int4 a = asg[m]; const float2 gg = asgg[m];
    const size_t row0 = (size_t)pb[a.x] * 256 + a.z, row1 = (size_t)pb[a.y] * 256 + a.w;
    f32x4* xr = (f32x4*)(P.out + (size_t)m * DM) + lane;
    const u32x2* y0 = (const u32x2*)(Y + row0 * DM) + lane; const u32x2* y1 = (const u32x2*)(Y + row1 * DM) + lane;
    f32x4 v[4]; float ss = 0.f;
#pragma unroll
    for (int j = 0; j < 4; ++j) { f32x4 x = xr[64 * j]; const u32x2 a0 = y0[64 * j], a1 = y1[64 * j];
      x.x += gg.x * bflo(a0.x) + gg.y * bflo(a1.x); x.y += gg.x * bfhi(a0.x) + gg.y * bfhi(a1.x); x.z += gg.x * bflo(a0.y) + gg.y * bflo(a1.y); x.w += gg.x * bfhi(a0.y) + gg.y * bfhi(a1.y);
      xr[64 * j] = x; v[j] = x; ss += (x.x * x.x + x.y * x.y) + (x.z * x.z + x.w * x.w); }
    if (with_norm) {
      const float rstd = 1.0f / sqrtf(wave_sum(ss) * (1.f / DM) + NORM_EPS);
      unsigned long long* o8 = (unsigned long long*)(XN + (size_t)m * DM) + lane;
#pragma unroll
      for (int j = 0; j < 4; ++j) o8[64 * j] = (unsigned long long)pk2(v[j].x * rstd, v[j].y * rstd) | ((unsigned long long)pk2(v[j].z * rstd, v[j].w * rstd) << 32);
    }
  }
}
DI void moe_gemms(const Ctx& F, const Params& P, int L, cg::grid_group& grid) {
  unsigned char* ws = P.ws;
  const int vcu = (F.G % 8 == 0) ? ((int)(blockIdx.x % 8) * (F.G / 8) + (int)(blockIdx.x / 8)) : (int)blockIdx.x;
  moe_setup(F, P, L);
  {
    pg8::MoeSched<true> S{(const LAS int*)(F.lds + LDS_MISC), (const LAS int*)(F.lds + LDS_MISC) + 64, (const int*)(ws + WS_LIST), (const char*)(ws + (L ? WS_WGU1 : WS_WGU0)), F.G, vcu, 1024};
    pg8::EpiSwiGLU E{(bf16_t*)(ws + WS_H)};
    pg8::gemm_phase<pg8::EpiSwiGLU, pg8::MoeSched<true>, true>(F.lds, F.wave, (const char*)(ws + WS_XN), 1024, S, E);
  }
  grid.sync();
  {
    pg8::MoeSched<false> S{(const LAS int*)(F.lds + LDS_MISC), (const LAS int*)(F.lds + LDS_MISC) + 64, nullptr, (const char*)(ws + (L ? WS_WD1 : WS_WD0)), F.G, vcu, 512};
    pg8::EpiBf16 E{(bf16_t*)(ws + WS_PROJ), DM};
    pg8::gemm_phase<pg8::EpiBf16, pg8::MoeSched<false>, true>(F.lds, F.wave, (const char*)(ws + WS_H), 512, S, E);
  }
}

DI void p8b_transform1(const Ctx& F, const Params& P) {
  bf16_t* QKV = (bf16_t*)(P.ws + WS_PROJ);
  const float* cosT = (const float*)(P.ws + WS_ROPE); const float* sinT = cosT + SEQ * 32;
  const int lane = lane_id_v(), sub = lane & 7, grp = lane >> 3;
  for (int m = F.gw; m < NTOK; m += F.NGW) {
    const int t = m & (SEQ - 1);
    bf16_t* row = QKV + (size_t)m * W1;
    const float* cr = cosT + t * 32; const float* sr = sinT + t * 32;
    head_normrope(row + grp * 64 + sub * 8, P.in[I_QN1], true, cr, sr, sub);
    head_normrope(row + 512 + grp * 64 + sub * 8, P.in[I_QN1], true, cr, sr, sub);
    if (grp < 4) head_normrope(row + 1024 + grp * 64 + sub * 8, P.in[I_KN1], true, cr, sr, sub);
  }
}

DI void dil_phase(const Ctx& F, const Params& P) {
  const bf16_t* QKV = (const bf16_t*)(P.ws + WS_PROJ); bf16_t* MIX = (bf16_t*)(P.ws + WS_MIX);
  LAS unsigned char* vst = F.lds + F.wave * 8192;
  const int lane = lane_id_v(), c = lane & 31, half = lane >> 5, qi = c >> 2, gq = c & 3;
  const float cshift = 8.f * wave_max(fabsf(P.in[I_QN1][lane])) * wave_max(fabsf(P.in[I_KN1][lane])) * 1.02f;
  const float c1 = 0.125f * LOG2E, c2 = cshift * LOG2E;
  const int q4 = (lane & 15) >> 2, p4 = lane & 3, blk = (lane >> 4) & 1;
  for (int it = F.gw; it < 32768; it += F.NGW) {
    const int r = it & 15, tile = (it >> 4) & 31, kh = (it >> 9) & 3, b = it >> 11;
    const size_t rb = (size_t)b * SEQ; const int tmax = tile * 128 + r + 112, tq = tile * 128 + r + 16 * qi;
    bf16x8 qf[4];
    { const bf16_t* qp = QKV + (rb + tq) * W1 + (4 * kh + gq) * 64 + 32 * half;
#pragma unroll
      for (int ks = 0; ks < 4; ++ks) qf[ks] = *(const bf16x8*)(qp + 8 * ks); }
    f32x16 o0, o1;
#pragma unroll
    for (int i = 0; i < 16; ++i) { o0[i] = 0.f; o1[i] = 0.f; }
    float lsum = 0.f;
#pragma unroll 1
    for (int pat = 0; pat < 3; ++pat) {
      const int sh = 2 * pat;
      const int ei = (16 >> sh) * (7 - qi);
      const int ntile = pat == 0 ? 8 : 5;
#pragma unroll 1
      for (int T = 0; T < ntile; ++T) {
        const int n = 32 * T + c; const int pos = tmax - (n << sh); const int posc = pos < 0 ? 0 : pos;
        const bf16_t* kp = QKV + (rb + posc) * W1 + 1024 + kh * 64 + 32 * half;
        bf16x8 kf[4]; u32x4 vv[4];
#pragma unroll
        for (int ks = 0; ks < 4; ++ks) kf[ks] = *(const bf16x8*)(kp + 8 * ks);
#pragma unroll
        for (int ks = 0; ks < 4; ++ks) vv[ks] = *(const u32x4*)(kp + 256 + 8 * ks);
#pragma unroll
        for (int ks = 0; ks < 4; ++ks) *(LAS u32x4*)(vst + c * 128 + 64 * half + 16 * ks) = vv[ks];
        f32x16 s;
#pragma unroll
        for (int i = 0; i < 16; ++i) s[i] = 0.f;
#pragma unroll
        for (int ks = 0; ks < 4; ++ks) s = __builtin_amdgcn_mfma_f32_32x32x16_bf16(kf[ks], qf[ks], s, 0, 0, 0);
#pragma unroll
        for (int reg = 0; reg < 16; ++reg) { const int nn = 32 * T + (reg & 3) + 8 * (reg >> 2) + 4 * half; const int ps = tmax - (nn << sh);
          const bool ok = (nn >= ei) && (nn <= ei + 128) && (ps >= 0);
          const float p = ok ? __builtin_amdgcn_exp2f(s[reg] * c1 - c2) : 0.f; s[reg] = p; lsum += p; }
        asm volatile("" ::: "memory");
#pragma unroll
        for (int st = 0; st < 2; ++st) {
          u32x4 pw; pw.x = pk2(s[8 * st], s[8 * st + 1]); pw.y = pk2(s[8 * st + 2], s[8 * st + 3]); pw.z = pk2(s[8 * st + 4], s[8 * st + 5]); pw.w = pk2(s[8 * st + 6], s[8 * st + 7]);
          const bf16x8 pf = __builtin_bit_cast(bf16x8, pw);
          const int r1 = 16 * st + 4 * half + q4;
#pragma unroll
          for (int dblk = 0; dblk < 2; ++dblk) {
            const int cb = (32 * dblk + 16 * blk + 4 * p4) * 2;
            const s16x4 lo = tr_read(vst + r1 * 128 + cb), hi = tr_read(vst + (r1 + 8) * 128 + cb);
            const bf16x8 vf = __builtin_shufflevector(lo, hi, 0, 1, 2, 3, 4, 5, 6, 7);
            if (dblk == 0) o0 = __builtin_amdgcn_mfma_f32_32x32x16_bf16(vf, pf, o0, 0, 0, 0); else o1 = __builtin_amdgcn_mfma_f32_32x32x16_bf16(vf, pf, o1, 0, 0, 0);
          }
        }
        asm volatile("" ::: "memory");
      }
    }
    lsum += __shfl_xor(lsum, 32);
    const float inv = 1.0f / lsum;
    bf16_t* op = MIX + (rb + tq) * DM + (4 * kh + gq) * 64 + 4 * half;
#pragma unroll
    for (int gI = 0; gI < 4; ++gI) {
      u32x2 w0; w0.x = pk2(o0[4 * gI] * inv, o0[4 * gI + 1] * inv); w0.y = pk2(o0[4 * gI + 2] * inv, o0[4 * gI + 3] * inv); *(u32x2*)(op + 8 * gI) = w0;
      u32x2 w1; w1.x = pk2(o1[4 * gI] * inv, o1[4 * gI + 1] * inv); w1.y = pk2(o1[4 * gI + 2] * inv, o1[4 * gI + 3] * inv); *(u32x2*)(op + 32 + 8 * gI) = w1;
    }
  }
}

__global__ void __launch_bounds__(512, 2) fwd_megakernel(Params P) {
  extern __shared__ __attribute__((aligned(16))) unsigned char lds_raw[];
  cg::grid_group grid = cg::this_grid();
  Ctx F; F.lds = (LAS unsigned char*)lds_raw; F.wave = __builtin_amdgcn_readfirstlane((int)threadIdx.x >> 6);
  F.G = gridDim.x; F.gw = blockIdx.x * 8 + F.wave; F.NGW = F.G * 8;
  unsigned char* ws = P.ws;

#ifndef PHMASK
#define PHMASK 0xFFFFFFFFu
#endif
#define PH(n) if ((PHMASK >> (n)) & 1u)
  PH(0) p0_prologue(F, P);
  grid.sync();
  PH(1) {
    pg8::DenseSched S; S.init(NTOK, W0P, 1024, ws + WS_WIN0, F.G, (int)blockIdx.x);
    pg8::EpiBf16 E{(bf16_t*)(ws + WS_PROJ), W0P};
    pg8::gemm_phase<pg8::EpiBf16, pg8::DenseSched, true>(F.lds, F.wave, (const char*)(ws + WS_XN), 1024, S, E);
  }
  grid.sync();
  PH(2) p1b_transform0(F, P);
  grid.sync();
  PH(3) dsa_phase(F, P);
  grid.sync();
  PH(4) {
    pg8::DenseSched S; S.init(NTOK, 1024, 1024, ws + WS_WOUT0, F.G, (int)blockIdx.x);
    pg8::EpiResF32 E{P.in[I_X], P.out, DM};
    pg8::gemm_phase<pg8::EpiResF32, pg8::DenseSched, true>(F.lds, F.wave, (const char*)(ws + WS_MIX), 1024, S, E);
  }
  grid.sync();
  PH(5) router_phase(F, P, 0);
  grid.sync();
  PH(6) moe_gemms(F, P, 0, grid);
  grid.sync();
  PH(7) combine_phase(F, P, 0, true);
  grid.sync();
  PH(8) {
    pg8::DenseSched S; S.init(NTOK, W1, 1024, ws + WS_WIN1, F.G, (int)blockIdx.x);
    pg8::EpiBf16 E{(bf16_t*)(ws + WS_PROJ), W1};
    pg8::gemm_phase<pg8::EpiBf16, pg8::DenseSched, true>(F.lds, F.wave, (const char*)(ws + WS_XN), 1024, S, E);
  }
  grid.sync();
  PH(9) p8b_transform1(F, P);
  grid.sync();
  PH(10) dil_phase(F, P);
  grid.sync();
  PH(11) {
    pg8::DenseSched S; S.init(NTOK, 1024, 1024, ws + WS_WOUT1, F.G, (int)blockIdx.x);
    pg8::EpiResF32 E{P.out, P.out, DM};
    pg8::gemm_phase<pg8::EpiResF32, pg8::DenseSched, true>(F.lds, F.wave, (const char*)(ws + WS_MIX), 1024, S, E);
  }
  grid.sync();
  PH(12) router_phase(F, P, 1);
  grid.sync();
  PH(13) moe_gemms(F, P, 1, grid);
  grid.sync();
  PH(14) combine_phase(F, P, 1, false);
}

extern "C" void kernel_launch(void* const* d_in, const int* in_sizes, int n_in, void* d_out, int out_size, void* d_ws, size_t ws_size, hipStream_t stream) {
  static int grid_blocks = 0;
  if (!grid_blocks) {
    if (n_in != 28 || out_size != NTOK * DM || ws_size < WS_END) { fprintf(stderr, "kernel_launch: unexpected shapes (n_in %d out %d ws %zu)\n", n_in, out_size, ws_size); grid_blocks = -1; return; }
    int dev = 0, cus = 0, per_cu = 0;
    (void)hipGetDevice(&dev);
    (void)hipDeviceGetAttribute(&cus, hipDeviceAttributeMultiprocessorCount, dev);
    (void)hipFuncSetAttribute((const void*)fwd_megakernel, hipFuncAttributeMaxDynamicSharedMemorySize, LDS_BYTES);
    (void)hipOccupancyMaxActiveBlocksPerMultiprocessor(&per_cu, (const void*)fwd_megakernel, 512, LDS_BYTES);
    if (per_cu < 1) per_cu = 1;
    grid_blocks = cus * per_cu;
  }
  if (grid_blocks < 0) return;
  Params p{};
  for (int i = 0; i < 28; ++i) p.in[i] = (const float*)d_in[i];
  p.out = (float*)d_out; p.ws = (unsigned char*)d_ws;
  void* args[] = {&p};
  hipError_t e = hipLaunchCooperativeKernel((const void*)fwd_megakernel, dim3(grid_blocks), dim3(512), args, LDS_BYTES, stream);
  if (e != hipSuccess) fprintf(stderr, "cooperative launch failed: %s (grid %d)\n", hipGetErrorString(e), grid_blocks);
}
```

```cpp
#include <hip/hip_runtime.h>
#include <hip/hip_cooperative_groups.h>
#include <cstdio>
#include <cstdint>
namespace cg = cooperative_groups;

#define LAS __attribute__((address_space(3)))
#define DI __device__ __forceinline__
typedef unsigned short bf16_t;
typedef short bf16x8 __attribute__((ext_vector_type(8)));
typedef short s16x4 __attribute__((ext_vector_type(4)));
typedef float f32x2 __attribute__((ext_vector_type(2)));
typedef float f32x4 __attribute__((ext_vector_type(4)));
typedef float f32x16 __attribute__((ext_vector_type(16)));
typedef unsigned u32x2 __attribute__((ext_vector_type(2)));
typedef unsigned u32x4 __attribute__((ext_vector_type(4)));
typedef int i32x4 __attribute__((ext_vector_type(4)));
typedef __bf16 bf16x2_t __attribute__((ext_vector_type(2)));

constexpr int NTOK = 65536, DM = 1024, SEQ = 4096, NBATCH = 16;
constexpr int W0P = 2560, W0V = 2500;
constexpr int W1 = 1536;
constexpr int C_CB = 0, C_CC = 512, C_CH = 1024, C_Q = 1536, C_K = 2048, C_V = 2112, C_IQ = 2176, C_IK = 2432, C_IW = 2496;
constexpr int NEXP = 32, DEXP = 512;
constexpr int MAXROWS = 139264;
constexpr float NORM_EPS = 1e-6f;
constexpr float LOG2E = 1.4426950408889634f;

constexpr size_t MiB = 1u << 20;
constexpr size_t WS_CTL = 0;
constexpr size_t WS_ROPE = 1 * MiB;
constexpr size_t WS_WR0 = 2 * MiB, WS_WR1 = 2 * MiB + 256 * 1024;
constexpr size_t WS_WIN0 = 3 * MiB, WS_WOUT0 = 8 * MiB, WS_WIN1 = 10 * MiB, WS_WOUT1 = 13 * MiB;
constexpr size_t WS_WGU0 = 16 * MiB, WS_WD0 = 80 * MiB, WS_WGU1 = 112 * MiB, WS_WD1 = 176 * MiB;
constexpr size_t WS_XN = 208 * MiB;
constexpr size_t WS_MIX = 337 * MiB;
constexpr size_t WS_H = 465 * MiB;
constexpr size_t WS_PROJ = 601 * MiB;
constexpr size_t WS_LIST = 921 * MiB;
constexpr size_t WS_ASG = 929 * MiB;
constexpr size_t WS_ASGG = 930 * MiB;
constexpr size_t WS_END = 931 * MiB;

constexpr int LDS_BYTES = 155648;
constexpr int LDS_LIST = 131072;
constexpr int LDS_MISC = 131072 + 16384;

DI unsigned pk2(float lo, float hi) { f32x2 v = {lo, hi}; bf16x2_t b = __builtin_convertvector(v, bf16x2_t); return __builtin_bit_cast(unsigned, b); }
DI float bflo(unsigned w) { return __uint_as_float(w << 16); }
DI float bfhi(unsigned w) { return __uint_as_float(w & 0xffff0000u); }
DI float bf1(bf16_t h) { return __uint_as_float((unsigned)h << 16); }
DI int opaque(int x) { asm volatile("" : "+v"(x)); return x; }
DI int lane_id_v() { int l; asm volatile("v_mbcnt_lo_u32_b32 %0, -1, 0\n\tv_mbcnt_hi_u32_b32 %0, -1, %0" : "=v"(l)); return l; }
DI float wave_sum(float v) {
#pragma unroll
  for (int o = 1; o < 64; o <<= 1) v += __shfl_xor(v, o);
  return v;
}
DI float wave_max(float v) {
#pragma unroll
  for (int o = 1; o < 64; o <<= 1) v = fmaxf(v, __shfl_xor(v, o));
  return v;
}
DI unsigned wave_sum_u(unsigned v) {
#pragma unroll
  for (int o = 1; o < 64; o <<= 1) v += (unsigned)__shfl_xor((int)v, o);
  return v;
}

namespace pg8 {
constexpr int BM = 256, BK = 64, HALF = 128, HTB = HALF * BK * 2, STAGE_BYTES = 8 * HTB, NXCD = 8, WGM = 8;
DI int lds_byte(int r, int c) { const int st = (r >> 4) * 2 + (c >> 5), rr = r & 15, cc = c & 31, ob = rr * 64 + cc * 2; return st * 1024 + (ob ^ (((ob >> 9) & 1) << 5)); }
DI void stage_rc(int b, int& R, int& C) { const int st = b / 1024, sb = b % 1024, swz = sb ^ (((sb >> 9) & 1) << 5); R = (st >> 1) * 16 + swz / 64; C = (st & 1) * 32 + (swz % 64) / 2; }
DI int perm32(int rho) { const int n = rho >> 4, i = rho & 15; return 8 * (i >> 2) + 4 * n + (i & 3); }

struct Unit { const char* b; int p0, p1, p2, p3; };

struct EpiBf16 {
  static constexpr bool PERM = true;
  bf16_t* O; int ldc;
  DI void operator()(const f32x4 (&acc)[2][2][4][2], const Unit& u, int wr, int wc, int fr, int fq) const {
    const int row0 = u.p0 + wr * 64 + fr, col0 = u.p1 + wc * 32 + 8 * fq;
#pragma unroll
    for (int ai = 0; ai < 2; ++ai)
#pragma unroll
      for (int m = 0; m < 4; ++m) { bf16_t* rowp = O + (size_t)(row0 + ai * HALF + m * 16) * ldc + col0;
#pragma unroll
        for (int bj = 0; bj < 2; ++bj) { const f32x4 v0 = acc[ai][bj][m][0], v1 = acc[ai][bj][m][1];
          u32x4 w; w.x = pk2(v0[0], v0[1]); w.y = pk2(v0[2], v0[3]); w.z = pk2(v1[0], v1[1]); w.w = pk2(v1[2], v1[3]);
          *(u32x4*)(rowp + bj * HALF) = w; } }
  }
};
struct EpiResF32 {
  static constexpr bool PERM = false;
  const float* base; float* out; int ldc;
  DI void operator()(const f32x4 (&acc)[2][2][4][2], const Unit& u, int wr, int wc, int fr, int fq) const {
    const int row0 = u.p0 + wr * 64 + fr, col0 = u.p1 + wc * 32 + 4 * fq;
#pragma unroll
    for (int ai = 0; ai < 2; ++ai)
#pragma unroll
      for (int m = 0; m < 4; ++m) { const size_t off = (size_t)(row0 + ai * HALF + m * 16) * ldc + col0;
#pragma unroll
        for (int bj = 0; bj < 2; ++bj)
#pragma unroll
          for (int n = 0; n < 2; ++n) { const f32x4 bs = *(const f32x4*)(base + off + bj * HALF + n * 16); *(f32x4*)(out + off + bj * HALF + n * 16) = bs + acc[ai][bj][m][n]; } }
  }
};
DI float silu_mul(float g, float u) { return g * u * __builtin_amdgcn_rcpf(1.0f + __builtin_amdgcn_exp2f(-g * LOG2E)); }
struct EpiSwiGLU {
  static constexpr bool PERM = true;
  bf16_t* H;
  DI void operator()(const f32x4 (&acc)[2][2][4][2], const Unit& u, int wr, int wc, int fr, int fq) const {
    const int row0 = u.p0 + wr * 64 + fr, col0 = u.p1 + wc * 32 + 8 * fq;
#pragma unroll
    for (int ai = 0; ai < 2; ++ai)
#pragma unroll
      for (int m = 0; m < 4; ++m) { bf16_t* rowp = H + (size_t)(row0 + ai * HALF + m * 16) * DEXP + col0;
        const f32x4 g0 = acc[ai][0][m][0], g1 = acc[ai][0][m][1], u0 = acc[ai][1][m][0], u1 = acc[ai][1][m][1];
        u32x4 w; w.x = pk2(silu_mul(g0[0], u0[0]), silu_mul(g0[1], u0[1])); w.y = pk2(silu_mul(g0[2], u0[2]), silu_mul(g0[3], u0[3]));
        w.z = pk2(silu_mul(g1[0], u1[0]), silu_mul(g1[1], u1[1])); w.w = pk2(silu_mul(g1[2], u1[2]), silu_mul(g1[3], u1[3]));
        *(u32x4*)rowp = w; }
  }
};

struct DenseSched {
  static constexpr bool NEXT_IN_LDS = false;
  int nM, nN, nwg, G, c, K; const char* Bt;
  DI void init(int M, int N, int K_, const void* Bt_, int G_, int c_) { nM = M / BM; nN = N / BM; nwg = nM * nN; G = G_; c = c_; K = K_; Bt = (const char*)Bt_; }
  DI bool next(int i, Unit& u) const {
    const long L = (long)i * G + c; if (L >= nwg) return false;
    int wgid = (int)L; { const int q = nwg / NXCD, r = nwg % NXCD, xcd = wgid % NXCD, off = wgid / NXCD; wgid = (xcd < r ? xcd * (q + 1) : r * (q + 1) + (xcd - r) * q) + off; }
    const int nig = WGM * nN, gid = wgid / nig, fm = gid * WGM, gsz = (nM - fm) < WGM ? (nM - fm) : WGM;
    const int pm = fm + ((wgid % nig) % gsz), pn = (wgid % nig) / gsz;
    u.p0 = pm * BM; u.p1 = pn * BM; u.p2 = 0; u.p3 = 0; u.b = Bt + (size_t)pn * BM * K * 2; return true;
  }
  DI void a_off(const Unit& u, const int (&R)[2], const int (&C)[2], unsigned (&o)[2][2]) const {
#pragma unroll
    for (int h = 0; h < 2; ++h)
#pragma unroll
      for (int i = 0; i < 2; ++i) o[h][i] = (unsigned)((u.p0 + h * HALF + R[i]) * K + C[i]) * 2u;
  }
};
template <bool GATHER> struct MoeSched {
  static constexpr bool NEXT_IN_LDS = GATHER;
  const LAS int* pb; const LAS int* cnt; const int* list; const char* W; int G, c, K;
  DI bool next(int i, Unit& u) const {
    const int L = i * G + c; const int total = pb[NEXP] * 4; if (L >= total) return false;
    const int rbg = L >> 2, pn = L & 3; int e = 0;
    for (int j = 1; j < NEXP; ++j) e = (pb[j] <= rbg) ? j : e;
    u.p0 = rbg * BM; u.p1 = pn * (GATHER ? 128 : 256); u.p2 = e; u.p3 = rbg - pb[e];
    u.b = W + (size_t)(e * 1024 + pn * 256) * K * 2; return true;
  }
  DI void a_off(const Unit& u, const int (&R)[2], const int (&C)[2], unsigned (&o)[2][2]) const {
    if (GATHER) {
      const int ce = cnt[u.p2];
#pragma unroll
      for (int h = 0; h < 2; ++h)
#pragma unroll
        for (int i = 0; i < 2; ++i) { const int row = u.p3 * BM + h * HALF + R[i]; const int tok = (row < ce) ? list[u.p2 * 65536 + row] : NTOK; o[h][i] = (unsigned)(tok * K + C[i]) * 2u; }
    } else {
#pragma unroll
      for (int h = 0; h < 2; ++h)
#pragma unroll
        for (int i = 0; i < 2; ++i) o[h][i] = (unsigned)((u.p0 + h * HALF + R[i]) * K + C[i]) * 2u;
    }
  }
};

template <class Epi, class Sched, bool ALIGN_EPI>
DI void gemm_phase(LAS unsigned char* lds, const int wave_id, const char* gA, const int K, const Sched& S, const Epi& E) {
  const int lane = lane_id_v(), wid = wave_id, tid = wid * 64 + lane, wr = wid >> 2, wc = wid & 3, fr = lane & 15, fq = lane >> 4;
  const int nt = K / BK;
  int Rp[2], Cp[2]; unsigned voffB[2];
#pragma unroll
  for (int i = 0; i < 2; ++i) { int R, C; stage_rc(tid * 16 + i * 8192, R, C); Rp[i] = R; Cp[i] = C; const int Rb = Epi::PERM ? ((R & ~31) + perm32(R & 31)) : R; voffB[i] = (unsigned)(Rb * K + C) * 2u; }
  const size_t kstep = (size_t)(BK * 2);
  const size_t hstep = (size_t)HALF * K * 2;
  const unsigned ldsw = (unsigned)wid * 1024u;
  const int aoff = lds_byte(wr * 64 + fr, fq * 8), boff = lds_byte(wc * 32 + fr, fq * 8);
#define PG8_SA(b, h) (((b) * 2 + (h)) * HTB)
#define PG8_SB(b, h) ((4 + (b) * 2 + (h)) * HTB)
#define PG8_STAGE_B(bufoff, gbase) do { _Pragma("unroll") for (int _i = 0; _i < 2; ++_i) \
    __builtin_amdgcn_global_load_lds((const unsigned*)((const char*)(gbase) + voffB[_i]), (LAS unsigned*)(lds + (bufoff) + ldsw + _i * 8192), 16, 0, 0); } while (0)
#define PG8_STAGE_A(bufoff, kb, offs) do { _Pragma("unroll") for (int _i = 0; _i < 2; ++_i) \
    __builtin_amdgcn_global_load_lds((const unsigned*)(gA + (size_t)(kb) + (offs)[_i]), (LAS unsigned*)(lds + (bufoff) + ldsw + _i * 8192), 16, 0, 0); } while (0)
#define PG8_LDA(dst, b, h) do { _Pragma("unroll") for (int m = 0; m < 4; ++m) _Pragma("unroll") for (int k = 0; k < 2; ++k) dst[m][k] = *(const LAS bf16x8*)(lds + PG8_SA(b, h) + aoff + m * 2048 + k * 1024); } while (0)
#define PG8_LDB(dst, b, h) do { _Pragma("unroll") for (int n = 0; n < 2; ++n) _Pragma("unroll") for (int k = 0; k < 2; ++k) dst[n][k] = *(const LAS bf16x8*)(lds + PG8_SB(b, h) + boff + n * 2048 + k * 1024); } while (0)
#define PG8_MMA(ai, bj, At, Bt) do { __builtin_amdgcn_s_setprio(1); _Pragma("unroll") for (int m = 0; m < 4; ++m) _Pragma("unroll") for (int n = 0; n < 2; ++n) _Pragma("unroll") for (int k = 0; k < 2; ++k) \
    acc[ai][bj][m][n] = __builtin_amdgcn_mfma_f32_16x16x32_bf16(Bt[n][k], At[m][k], acc[ai][bj][m][n], 0, 0, 0); __builtin_amdgcn_s_setprio(0); } while (0)
#define PG8_WAIT_V(n) asm volatile("s_waitcnt vmcnt(" #n ")" ::: "memory")
#define PG8_WAIT_L(n) asm volatile("s_waitcnt lgkmcnt(" #n ")" ::: "memory")
#define PG8_BAR __builtin_amdgcn_s_barrier()
#define PG8_SCHED __builtin_amdgcn_sched_barrier(0)
  Unit cur, nxt; int ui = 0;
  if (!S.next(0, cur)) return;
  unsigned ca[2][2];
  S.a_off(cur, Rp, Cp, ca);
  f32x4 acc[2][2][4][2];
#pragma unroll
  for (int a = 0; a < 2; ++a)
#pragma unroll
    for (int b = 0; b < 2; ++b)
#pragma unroll
      for (int m = 0; m < 4; ++m)
#pragma unroll
        for (int n = 0; n < 2; ++n) acc[a][b][m][n] = (f32x4){0.f, 0.f, 0.f, 0.f};
  bf16x8 At[4][2], B0[2][2], B1[2][2];
  const char* cB = cur.b;
  PG8_STAGE_B(PG8_SB(0, 0), cB); PG8_STAGE_B(PG8_SB(0, 1), cB + hstep); PG8_STAGE_A(PG8_SA(0, 0), 0, ca[0]); PG8_STAGE_A(PG8_SA(0, 1), 0, ca[1]);
  if (wr == 1) PG8_BAR;
  PG8_WAIT_V(2); PG8_BAR;
  PG8_STAGE_B(PG8_SB(1, 0), cB + kstep); PG8_STAGE_A(PG8_SA(1, 0), kstep, ca[0]); PG8_STAGE_B(PG8_SB(1, 1), cB + hstep + kstep);
  PG8_WAIT_V(6); PG8_BAR;
  for (;;) {
    const bool has_next = S.next(ui + 1, nxt);
    if (Sched::NEXT_IN_LDS) {
      unsigned na[2][2];
      if (has_next) S.a_off(nxt, Rp, Cp, na);
      else {
#pragma unroll
        for (int h = 0; h < 2; ++h)
#pragma unroll
          for (int i = 0; i < 2; ++i) na[h][i] = ca[h][i];
      }
      *(LAS u32x4*)(lds + STAGE_BYTES + 8192 + tid * 16) = (u32x4){na[0][0], na[0][1], na[1][0], na[1][1]};
    }
    const char* nB = has_next ? nxt.b : cB;
    for (int t = 0; t < nt; t += 2) {
      const bool last = (t == nt - 2);
      PG8_LDB(B0, 0, 0); PG8_LDB(B1, 0, 1); PG8_SCHED; PG8_LDA(At, 0, 0); PG8_STAGE_A(PG8_SA(1, 1), (size_t)(t + 1) * kstep, ca[1]);
      PG8_WAIT_V(8); PG8_WAIT_L(0); PG8_BAR; PG8_MMA(0, 0, At, B0); PG8_MMA(0, 1, At, B1); PG8_BAR; PG8_SCHED;
      const size_t kb2 = last ? 0 : (size_t)(t + 2) * kstep;
      const char* b2 = last ? nB : cB + (size_t)(t + 2) * kstep;
      if (last) {
        if (Sched::NEXT_IN_LDS) { const u32x4 v = *(const LAS u32x4*)(lds + STAGE_BYTES + 8192 + tid * 16); ca[0][0] = v.x; ca[0][1] = v.y; ca[1][0] = v.z; ca[1][1] = v.w; }
        else if (has_next) S.a_off(nxt, Rp, Cp, ca);
      }
      PG8_LDA(At, 0, 1); PG8_STAGE_B(PG8_SB(0, 0), b2); PG8_STAGE_B(PG8_SB(0, 1), b2 + hstep); PG8_STAGE_A(PG8_SA(0, 0), kb2, ca[0]);
      PG8_WAIT_V(8); PG8_WAIT_L(0); PG8_BAR; PG8_MMA(1, 0, At, B0); PG8_MMA(1, 1, At, B1); PG8_BAR; PG8_SCHED;
      PG8_LDB(B0, 1, 0); PG8_LDB(B1, 1, 1); PG8_SCHED; PG8_LDA(At, 1, 0); PG8_STAGE_A(PG8_SA(0, 1), kb2, ca[1]);
      PG8_WAIT_V(8); PG8_WAIT_L(0); PG8_BAR; PG8_MMA(0, 0, At, B0); PG8_MMA(0, 1, At, B1); PG8_BAR; PG8_SCHED;
      PG8_LDA(At, 1, 1); PG8_STAGE_B(PG8_SB(1, 0), b2 + kstep); PG8_STAGE_B(PG8_SB(1, 1), b2 + kstep + hstep); PG8_STAGE_A(PG8_SA(1, 0), kb2 + kstep, ca[0]);
      PG8_WAIT_V(8); PG8_WAIT_L(0); PG8_BAR; PG8_MMA(1, 0, At, B0); PG8_MMA(1, 1, At, B1); PG8_BAR; PG8_SCHED;
    }
    if constexpr (ALIGN_EPI) { if (wr == 0) PG8_BAR; }
    E(acc, cur, wr, wc, fr, fq);
    if (!has_next) break;
#pragma unroll
    for (int a = 0; a < 2; ++a)
#pragma unroll
      for (int b = 0; b < 2; ++b)
#pragma unroll
        for (int m = 0; m < 4; ++m)
#pragma unroll
          for (int n = 0; n < 2; ++n) acc[a][b][m][n] = (f32x4){0.f, 0.f, 0.f, 0.f};
    cur = nxt; cB = nB; ++ui;
    if constexpr (ALIGN_EPI) { if (wr == 1) PG8_BAR; }
  }
  PG8_WAIT_V(0);
  if constexpr (!ALIGN_EPI) { if (wr == 0) PG8_BAR; }
  PG8_BAR;
#undef PG8_SA
#undef PG8_SB
#undef PG8_STAGE_A
#undef PG8_STAGE_B
#undef PG8_LDA
#undef PG8_LDB
#undef PG8_MMA
#undef PG8_WAIT_V
#undef PG8_WAIT_L
#undef PG8_BAR
#undef PG8_SCHED
}
}

struct Params { const float* in[28]; float* out; unsigned char* ws; };
enum { I_X = 0, I_ANORM0, I_WIN0, I_CONVW, I_QN0, I_KN0, I_WOUT0, I_FNORM0, I_WRG0, I_BRG0, I_WRE0, I_BRE0, I_WG0, I_WU0, I_WD0,
       I_ANORM1, I_WIN1, I_QN1, I_KN1, I_WOUT1, I_FNORM1, I_WRG1, I_BRG1, I_WRE1, I_BRE1, I_WG1, I_WU1, I_WD1 };

struct Ctx { LAS unsigned char* lds; int wave, G, gw, NGW; };

DI void tr_item(const float* W, int K, int N, int nvalid, const float* gain, bf16_t* WT, int mode, LAS float* scr, int item, int nblk, int lane) {
  const int kb = item / nblk, nb = item % nblk, k0 = 64 * kb, n0 = 32 * nb;
  const int n = n0 + (lane & 31);
#pragma unroll 8
  for (int i = 0; i < 32; ++i) { const int kk = 2 * i + (lane >> 5); float v = 0.f; if (n < nvalid) { v = W[(size_t)(k0 + kk) * N + n]; if (gain) v *= gain[k0 + kk]; } scr[kk * 33 + (lane & 31)] = v; }
  asm volatile("s_waitcnt lgkmcnt(0)" ::: "memory");
  const int c = lane & 7;
#pragma unroll
  for (int j = 0; j < 4; ++j) { const int nn = (lane >> 3) + 8 * j; const LAS float* s = scr + (8 * c) * 33 + nn;
    u32x4 o; o.x = pk2(s[0 * 33], s[1 * 33]); o.y = pk2(s[2 * 33], s[3 * 33]); o.z = pk2(s[4 * 33], s[5 * 33]); o.w = pk2(s[6 * 33], s[7 * 33]);
    const int ng = n0 + nn; const int drow = (mode == 0) ? ng : ((ng >> 7) * 256 + (ng & 127) + (mode == 2 ? 128 : 0));
    *(u32x4*)(WT + (size_t)drow * K + k0 + 8 * c) = o; }
  asm volatile("s_waitcnt lgkmcnt(0)" ::: "memory");
}
DI void rms_row_to_bf16(const float* xrow, bf16_t* orow, int lane) {
  const f32x4* xr = (const f32x4*)xrow + lane;
  f32x4 v[4]; float s = 0.f;
#pragma unroll
  for (int j = 0; j < 4; ++j) { v[j] = xr[64 * j]; s += (v[j].x * v[j].x + v[j].y * v[j].y) + (v[j].z * v[j].z + v[j].w * v[j].w); }
  const float rstd = 1.0f / sqrtf(wave_sum(s) * (1.f / DM) + NORM_EPS);
  unsigned long long* o8 = (unsigned long long*)orow + lane;
#pragma unroll
  for (int j = 0; j < 4; ++j) o8[64 * j] = (unsigned long long)pk2(v[j].x * rstd, v[j].y * rstd) | ((unsigned long long)pk2(v[j].z * rstd, v[j].w * rstd) << 32);
}
DI void p0_prologue(const Ctx& F, const Params& P) {
  unsigned char* ws = P.ws; const int lane = lane_id_v(); const int tid = F.wave * 64 + lane;
  LAS float* scr = (LAS float*)(F.lds + F.wave * 16384);
  constexpr int I_IN0 = 16 * 80, I_OUT = 16 * 32, I_GU = 32 * 16 * 16, I_DN = 32 * 8 * 32, I_IN1 = 16 * 48;
  constexpr int PER_LAYER0 = I_IN0 + I_OUT + 2 * I_GU + I_DN, PER_LAYER1 = I_IN1 + I_OUT + 2 * I_GU + I_DN;
  for (int it = F.gw; it < PER_LAYER0 + PER_LAYER1; it += F.NGW) {
    int r = it; const int L = (r >= PER_LAYER0) ? 1 : 0; if (L) r -= PER_LAYER0;
    const int i_in = L ? I_IN1 : I_IN0;
    const float* anorm = P.in[L ? I_ANORM1 : I_ANORM0]; const float* fnorm = P.in[L ? I_FNORM1 : I_FNORM0];
    if (r < i_in) { if (L) tr_item(P.in[I_WIN1], 1024, W1, W1, anorm, (bf16_t*)(ws + WS_WIN1), 0, scr, r, 48, lane); else tr_item(P.in[I_WIN0], 1024, W0V, W0V, anorm, (bf16_t*)(ws + WS_WIN0), 0, scr, r, 80, lane); continue; }
    r -= i_in;
    if (r < I_OUT) { tr_item(P.in[L ? I_WOUT1 : I_WOUT0], 1024, 1024, 1024, nullptr, (bf16_t*)(ws + (L ? WS_WOUT1 : WS_WOUT0)), 0, scr, r, 32, lane); continue; }
    r -= I_OUT;
    if (r < I_GU) { const int e = r >> 8; tr_item(P.in[L ? I_WG1 : I_WG0] + (size_t)e * 1024 * 512, 1024, 512, 512, fnorm, (bf16_t*)(ws + (L ? WS_WGU1 : WS_WGU0)) + (size_t)e * 1024 * 1024, 1, scr, r & 255, 16, lane); continue; }
    r -= I_GU;
    if (r < I_GU) { const int e = r >> 8; tr_item(P.in[L ? I_WU1 : I_WU0] + (size_t)e * 1024 * 512, 1024, 512, 512, fnorm, (bf16_t*)(ws + (L ? WS_WGU1 : WS_WGU0)) + (size_t)e * 1024 * 1024, 2, scr, r & 255, 16, lane); continue; }
    r -= I_GU;
    { const int e = r >> 8; tr_item(P.in[L ? I_WD1 : I_WD0] + (size_t)e * 512 * 1024, 512, 1024, 1024, nullptr, (bf16_t*)(ws + (L ? WS_WD1 : WS_WD0)) + (size_t)e * 1024 * 512, 0, scr, r & 255, 32, lane); }
  }
  for (int m = F.gw; m < NTOK; m += F.NGW) rms_row_to_bf16(P.in[I_X] + (size_t)m * DM, (bf16_t*)(ws + WS_XN) + (size_t)m * DM, lane);
  const int gt = blockIdx.x * 512 + tid, NGT = F.G * 512;
  for (int i = gt; i < 512; i += NGT) ((unsigned*)(ws + WS_XN + (size_t)NTOK * DM * 2))[i] = 0u;
  for (int i = gt; i < 128; i += NGT) ((int*)(ws + WS_CTL))[i] = 0;
  for (int i = gt; i < SEQ * 32; i += NGT) {
    const int t = i >> 5, k = i & 31;
    const float inv = (float)exp2(-(double)k * (13.287712379549449 / 32.0));
    const float ang = (float)t * inv;
    const double rev = (double)ang * 0.15915494309189535; const float fr = (float)(rev - rint(rev));
    ((float*)(ws + WS_ROPE))[i] = __builtin_amdgcn_cosf(fr); ((float*)(ws + WS_ROPE))[SEQ * 32 + i] = __builtin_amdgcn_sinf(fr);
  }
  for (int i = gt; i < 2 * 36 * 1024; i += NGT) {
    const int L = i / (36 * 1024), r = i % (36 * 1024), j = r >> 10, k = r & 1023;
    const float g = P.in[L ? I_FNORM1 : I_FNORM0][k];
    float w; if (j < 4) w = P.in[L ? I_WRG1 : I_WRG0][k * 4 + j]; else { const int gg = (j - 4) >> 3, e = (j - 4) & 7; w = P.in[L ? I_WRE1 : I_WRE0][((size_t)gg * 1024 + k) * 8 + e]; }
    ((float*)(ws + (L ? WS_WR1 : WS_WR0)))[r] = w * g;
  }
  for (int i = gt; i < 2 * 36; i += NGT) { const int L = i / 36, j = i % 36; ((float*)(ws + (L ? WS_WR1 : WS_WR0)))[36 * 1024 + j] = (j < 4) ? P.in[L ? I_BRG1 : I_BRG0][j] : P.in[L ? I_BRE1 : I_BRE0][j - 4]; }
}

DI void head_normrope(bf16_t* p, const float* gain, bool do_norm, const float* cosr, const float* sinr, int sub) {
  const u32x4 w = *(const u32x4*)p;
  float v[8] = {bflo(w.x), bfhi(w.x), bflo(w.y), bfhi(w.y), bflo(w.z), bfhi(w.z), bflo(w.w), bfhi(w.w)};
  if (do_norm) {
    float s = 0.f;
#pragma unroll
    for (int j = 0; j < 8; ++j) s += v[j] * v[j];
    s += __shfl_xor(s, 1); s += __shfl_xor(s, 2); s += __shfl_xor(s, 4);
    const float rstd = 1.0f / sqrtf(s * (1.f / 64.f) + NORM_EPS);
#pragma unroll
    for (int j = 0; j < 8; ++j) v[j] = v[j] * rstd * gain[8 * sub + j];
  }
  const int i0 = 8 * (sub & 3); const float sg = (sub & 4) ? 1.f : -1.f;
  float o[8];
#pragma unroll
  for (int j = 0; j < 8; ++j) { const float pr = __shfl_xor(v[j], 4); o[j] = v[j] * cosr[i0 + j] + sg * pr * sinr[i0 + j]; }
  u32x4 r; r.x = pk2(o[0], o[1]); r.y = pk2(o[2], o[3]); r.z = pk2(o[4], o[5]); r.w = pk2(o[6], o[7]);
  *(u32x4*)p = r;
}
DI void p1b_transform0(const Ctx& F, const Params& P) {
  bf16_t* PROJ = (bf16_t*)(P.ws + WS_PROJ); bf16_t* MIX = (bf16_t*)(P.ws + WS_MIX);
  const float* cosT = (const float*)(P.ws + WS_ROPE); const float* sinT = cosT + SEQ * 32;
  const float* convw = P.in[I_CONVW];
  const int lane = lane_id_v(), sub = lane & 7, grp = lane >> 3;
  for (int m = F.gw; m < NTOK; m += F.NGW) {
    const int t = m & (SEQ - 1);
    bf16_t* row = PROJ + (size_t)m * W0P;
    const float* cr = cosT + t * 32; const float* sr = sinT + t * 32;
    head_normrope(row + C_Q + grp * 64 + sub * 8, P.in[I_QN0], true, cr, sr, sub);
    {
      const int g2 = grp < 6 ? grp : 5;
      bf16_t* p = row + (g2 == 0 ? C_K : (g2 <= 4 ? C_IQ + (g2 - 1) * 64 : C_IK)) + sub * 8;
      if (grp < 6) head_normrope(p, P.in[I_KN0], g2 == 0, cr, sr, sub);
    }
    {
      const int c0 = 8 * lane;
      const u32x4 cb = *(const u32x4*)(row + C_CB + c0);
      float u[3][8];
#pragma unroll
      for (int d = 0; d < 3; ++d) {
        const int back = 2 - d;
        if (t >= back) { const bf16_t* r2 = row - (size_t)back * W0P; const u32x4 a = *(const u32x4*)(r2 + C_CC + c0), b = *(const u32x4*)(r2 + C_CH + c0);
          u[d][0] = bflo(a.x) * bflo(b.x); u[d][1] = bfhi(a.x) * bfhi(b.x); u[d][2] = bflo(a.y) * bflo(b.y); u[d][3] = bfhi(a.y) * bfhi(b.y);
          u[d][4] = bflo(a.z) * bflo(b.z); u[d][5] = bfhi(a.z) * bfhi(b.z); u[d][6] = bflo(a.w) * bflo(b.w); u[d][7] = bfhi(a.w) * bfhi(b.w); }
        else {
#pragma unroll
          for (int j = 0; j < 8; ++j) u[d][j] = 0.f; }
      }
      const float cbv[8] = {bflo(cb.x), bfhi(cb.x), bflo(cb.y), bfhi(cb.y), bflo(cb.z), bfhi(cb.z), bflo(cb.w), bfhi(cb.w)};
      float o[8];
#pragma unroll
      for (int j = 0; j < 8; ++j) { const float* w = convw + (c0 + j) * 3; o[j] = cbv[j] * (u[0][j] * w[0] + u[1][j] * w[1] + u[2][j] * w[2]); }
      u32x4 r; r.x = pk2(o[0], o[1]); r.y = pk2(o[2], o[3]); r.z = pk2(o[4], o[5]); r.w = pk2(o[6], o[7]);
      *(u32x4*)(MIX + (size_t)m * DM + c0) = r;
    }
  }
}


DI unsigned f2key(float f) { const unsigned b = __float_as_uint(f); return b ^ ((unsigned)((int)b >> 31) | 0x80000000u); }
DI s16x4 tr_read(LAS unsigned char* p) { typedef short v4i16_t __attribute__((ext_vector_type(4))); return __builtin_bit_cast(s16x4, __builtin_amdgcn_ds_read_tr16_b64_v4i16((LAS v4i16_t*)p)); }
DI unsigned lane_prefix(unsigned long long m) { return __builtin_amdgcn_mbcnt_hi((unsigned)(m >> 32), __builtin_amdgcn_mbcnt_lo((unsigned)m, 0u)); }

DI void dsa_phase(const Ctx& F, const Params& P) {
  const bf16_t* PROJ = (const bf16_t*)(P.ws + WS_PROJ); bf16_t* MIX = (bf16_t*)(P.ws + WS_MIX);
  LAS unsigned* sc = (LAS unsigned*)F.lds;
  LAS unsigned short* lst = (LAS unsigned short*)(F.lds + LDS_LIST + F.wave * 512);
  LAS unsigned char* vst = F.lds + F.wave * 16384;
  const int lane = lane_id_v(), w = F.wave;
  const float cshift = 8.f * wave_max(fabsf(P.in[I_QN0][lane])) * wave_max(fabsf(P.in[I_KN0][lane])) * 1.02f;
  const float c1 = 0.125f * LOG2E, c2 = cshift * LOG2E;
  for (int v = blockIdx.x; v < 8192; v += gridDim.x) {
    const int cidx = v & 255, jj = v >> 8, b = jj >> 1, tb = (jj & 1) ? (511 - cidx) : cidx;
    const int t0 = tb * 8; const size_t rb = (size_t)b * SEQ;
    {
      const int r32 = lane & 31, half = lane >> 5;
      const bf16_t* ap = PROJ + (rb + t0 + (r32 >> 2)) * W0P + C_IQ + (r32 & 3) * 64 + 8 * half;
      bf16x8 af[4];
#pragma unroll
      for (int ks = 0; ks < 4; ++ks) af[ks] = *(const bf16x8*)(ap + 16 * ks);
      float wq[4][4];
#pragma unroll
      for (int g = 0; g < 4; ++g) { const u32x2 ww = *(const u32x2*)(PROJ + (rb + t0 + 2 * g + half) * W0P + C_IW);
        wq[g][0] = bflo(ww.x) * 0.0625f; wq[g][1] = bfhi(ww.x) * 0.0625f; wq[g][2] = bflo(ww.y) * 0.0625f; wq[g][3] = bfhi(ww.y) * 0.0625f; }
      const int ntile = 2 * (((t0 + 7) >> 6) + 1);
      for (int T = w; T < ntile; T += 8) {
        const int s = 32 * T + r32;
        const bf16_t* bp = PROJ + (rb + s) * W0P + C_IK + 8 * half;
        bf16x8 bfr[4];
#pragma unroll
        for (int ks = 0; ks < 4; ++ks) bfr[ks] = *(const bf16x8*)(bp + 16 * ks);
        f32x16 acc;
#pragma unroll
        for (int i = 0; i < 16; ++i) acc[i] = 0.f;
#pragma unroll
        for (int ks = 0; ks < 4; ++ks) acc = __builtin_amdgcn_mfma_f32_32x32x16_bf16(af[ks], bfr[ks], acc, 0, 0, 0);
#pragma unroll
        for (int g = 0; g < 4; ++g) {
          float sv = wq[g][0] * fmaxf(acc[4 * g], 0.f) + wq[g][1] * fmaxf(acc[4 * g + 1], 0.f) + wq[g][2] * fmaxf(acc[4 * g + 2], 0.f) + wq[g][3] * fmaxf(acc[4 * g + 3], 0.f);
          sv = (sv == 0.f) ? 0.f : sv;
          const int ql = 2 * g + half;
          sc[ql * 4096 + s] = (s <= t0 + ql) ? f2key(sv) : 0u;
        }
      }
    }
    __syncthreads();
    const int t = t0 + w;
    int nvalid;
    if (t < 256) {
      nvalid = t + 1;
#pragma unroll
      for (int p = 0; p < 4; ++p) lst[p * 64 + lane] = (unsigned short)(p * 64 + lane);
    } else {
      nvalid = 256;
      const int nch = (t >> 10) + 1;
      unsigned u[64];
#pragma unroll
      for (int ch = 0; ch < 4; ++ch) {
        if (ch < nch) {
#pragma unroll
          for (int jj = 0; jj < 16; ++jj) { const int j = 16 * ch + jj; const unsigned x = sc[w * 4096 + 64 * j + lane]; u[j] = (64 * j + lane <= t) ? x : 0u; }
        } else {
#pragma unroll
          for (int jj = 0; jj < 16; ++jj) u[16 * ch + jj] = 0u;
        }
      }
      unsigned prefix = 0u; bool exact = false;
      for (int bit = 31; bit >= 0; --bit) {
        const unsigned trial = prefix | (1u << bit);
        unsigned cnt = 0u;
#pragma unroll
        for (int ch = 0; ch < 4; ++ch) if (ch < nch) {
#pragma unroll
          for (int jj = 0; jj < 16; ++jj) cnt += (u[16 * ch + jj] >= trial) ? 1u : 0u;
        }
        cnt = wave_sum_u(cnt);
        if (cnt >= 256u) prefix = trial;
        if (cnt == 256u) { exact = true; break; }
      }
      unsigned thr; int need = 0;
      if (exact) thr = prefix - 1u;
      else { thr = prefix; unsigned cgt = 0u;
#pragma unroll
        for (int j = 0; j < 64; ++j) cgt += (u[j] > thr) ? 1u : 0u;
        cgt = wave_sum_u(cgt); need = 256 - (int)cgt; }
      int base = 0;
#pragma unroll
      for (int ch = 0; ch < 4; ++ch) if (ch < nch) {
#pragma unroll
        for (int jj = 0; jj < 16; ++jj) { const int j = 16 * ch + jj; const bool sel = u[j] > thr; const unsigned long long m = __ballot(sel); const int pos = base + (int)lane_prefix(m); if (sel) lst[pos] = (unsigned short)(64 * j + lane); base += __builtin_popcountll(m); }
      }
      if (need > 0) { int tbf = 0;
#pragma unroll
        for (int ch = 0; ch < 4; ++ch) if (ch < nch) {
#pragma unroll
          for (int jj = 0; jj < 16; ++jj) { const int j = 16 * ch + jj; const bool eq = u[j] == thr; const unsigned long long m = __ballot(eq); const int r = tbf + (int)lane_prefix(m); if (eq && r < need) lst[base + r] = (unsigned short)(64 * j + lane); tbf += __builtin_popcountll(m); }
        } }
    }
    asm volatile("" ::: "memory");
    {
      const int hcol = lane & 15, g = lane >> 4;
      bf16x8 qf[2];
      { const bf16_t* qp = PROJ + (rb + t) * W0P + C_Q + (hcol & 7) * 64 + 8 * g;
#pragma unroll
        for (int ks = 0; ks < 2; ++ks) { bf16x8 q = *(const bf16x8*)(qp + 32 * ks); if (hcol >= 8) q = (bf16x8){0, 0, 0, 0, 0, 0, 0, 0}; qf[ks] = q; } }
      f32x4 acc[16];
#pragma unroll
      for (int T = 0; T < 16; ++T) {
        const int kidx = lst[16 * T + hcol];
        const bf16_t* kp = PROJ + (rb + kidx) * W0P + C_K + 8 * g;
        const bf16x8 k0 = *(const bf16x8*)kp, k1 = *(const bf16x8*)(kp + 32);
        f32x4 a = {0.f, 0.f, 0.f, 0.f};
        a = __builtin_amdgcn_mfma_f32_16x16x32_bf16(k0, qf[0], a, 0, 0, 0);
        a = __builtin_amdgcn_mfma_f32_16x16x32_bf16(k1, qf[1], a, 0, 0, 0);
        acc[T] = a;
        if ((T & 3) == 3) asm volatile("" ::: "memory");
      }
      float lsum = 0.f;
#pragma unroll
      for (int T = 0; T < 16; ++T)
#pragma unroll
        for (int r = 0; r < 4; ++r) { const int pos = 16 * T + 4 * g + r; const float p = (pos < nvalid) ? __builtin_amdgcn_exp2f(acc[T][r] * c1 - c2) : 0.f; acc[T][r] = p; lsum += p; }
      lsum += __shfl_xor(lsum, 16); lsum += __shfl_xor(lsum, 32);
      bf16x8 pf[8];
#pragma unroll
      for (int m = 0; m < 8; ++m) { u32x4 pw; pw.x = pk2(acc[2 * m][0], acc[2 * m][1]); pw.y = pk2(acc[2 * m][2], acc[2 * m][3]); pw.z = pk2(acc[2 * m + 1][0], acc[2 * m + 1][1]); pw.w = pk2(acc[2 * m + 1][2], acc[2 * m + 1][3]); pf[m] = __builtin_bit_cast(bf16x8, pw); }
      f32x4 o[4];
#pragma unroll
      for (int n = 0; n < 4; ++n) o[n] = (f32x4){0.f, 0.f, 0.f, 0.f};
      const int q4 = (lane & 15) >> 2, p4 = lane & 3;
#pragma unroll
      for (int hh = 0; hh < 2; ++hh) {
#pragma unroll 4
        for (int i = 0; i < 16; ++i) { const int ci = i * 64 + lane, row = ci >> 3, ch = ci & 7; const int kidx = lst[128 * hh + row];
          const u32x4 vv = *(const u32x4*)(PROJ + (rb + kidx) * W0P + C_V + ch * 8); *(LAS u32x4*)(vst + row * 128 + ch * 16) = vv; }
        asm volatile("" ::: "memory");
#pragma unroll
        for (int mm = 0; mm < 4; ++mm) {
#pragma unroll
          for (int n = 0; n < 4; ++n) {
            const int r1 = 32 * mm + 4 * g + q4;
            const s16x4 lo = tr_read(vst + r1 * 128 + (16 * n + 4 * p4) * 2), hi = tr_read(vst + (r1 + 16) * 128 + (16 * n + 4 * p4) * 2);
            const bf16x8 vf = __builtin_shufflevector(lo, hi, 0, 1, 2, 3, 4, 5, 6, 7);
            o[n] = __builtin_amdgcn_mfma_f32_16x16x32_bf16(vf, pf[4 * hh + mm], o[n], 0, 0, 0);
          }
        }
        asm volatile("" ::: "memory");
      }
      if (hcol < 8) { const float inv = 1.0f / lsum; bf16_t* op = MIX + (rb + t) * DM + 512 + hcol * 64 + 4 * g;
#pragma unroll
        for (int n = 0; n < 4; ++n) { u32x2 w2; w2.x = pk2(o[n][0] * inv, o[n][1] * inv); w2.y = pk2(o[n][2] * inv, o[n][3] * inv); *(u32x2*)(op + 16 * n) = w2; } }
    }
    __syncthreads();
  }
}

DI void router_phase(const Ctx& F, const Params& P, int L) {
  unsigned char* ws = P.ws;
  LAS float* wl = (LAS float*)F.lds;
  LAS int* lcnt = (LAS int*)(F.lds + 147456);
  LAS int* lbase = lcnt + 32;
  LAS i32x4* lasg = (LAS i32x4*)(F.lds + 147456 + 256);
  const float* wrg = (const float*)(ws + (L ? WS_WR1 : WS_WR0));
  const int lane = lane_id_v(); const int tid = F.wave * 64 + lane;
  for (int i = tid; i < 36 * 1024 / 4; i += 512) ((LAS f32x4*)wl)[i] = ((const f32x4*)wrg)[i];
  int* cnt = (int*)(ws + WS_CTL) + L * 64; int* list = (int*)(ws + WS_LIST);
  int4* asg = (int4*)(ws + WS_ASG); float2* asgg = (float2*)(ws + WS_ASGG);
  bf16_t* XN = (bf16_t*)(ws + WS_XN);
  const int niter = (NTOK + F.NGW - 1) / F.NGW;
  for (int i0 = 0; i0 < niter; i0 += 32) {
    if (tid < 32) lcnt[tid] = 0;
    __syncthreads();
    for (int ii = 0; ii < 32; ++ii) {
      const int m = F.gw + (i0 + ii) * F.NGW;
      if (i0 + ii >= niter || m >= NTOK) break;
      const f32x4* xr = (const f32x4*)(P.out + (size_t)m * DM) + lane;
      f32x4 v[4]; float ss = 0.f;
#pragma unroll
      for (int j = 0; j < 4; ++j) { v[j] = xr[64 * j]; ss += (v[j].x * v[j].x + v[j].y * v[j].y) + (v[j].z * v[j].z + v[j].w * v[j].w); }
      const float rstd = 1.0f / sqrtf(wave_sum(ss) * (1.f / DM) + NORM_EPS);
#pragma unroll
      for (int j = 0; j < 4; ++j) v[j] = v[j] * rstd;
      { unsigned long long* o8 = (unsigned long long*)(XN + (size_t)m * DM) + lane;
#pragma unroll
        for (int j = 0; j < 4; ++j) o8[64 * j] = (unsigned long long)pk2(v[j].x, v[j].y) | ((unsigned long long)pk2(v[j].z, v[j].w) << 32); }
      float lg[36];
#pragma unroll
      for (int jc = 0; jc < 36; ++jc) { float a = 0.f;
#pragma unroll
        for (int j = 0; j < 4; ++j) { const f32x4 w4 = *(const LAS f32x4*)(wl + jc * 1024 + 256 * j + 4 * lane); a += (v[j].x * w4.x + v[j].y * w4.y) + (v[j].z * w4.z + v[j].w * w4.w); }
        lg[jc] = a; if ((jc & 1) == 1) asm volatile("" ::: "memory"); }
#pragma unroll
      for (int jc = 0; jc < 36; ++jc) lg[jc] = wave_sum(lg[jc]) + wrg[36 * 1024 + jc];
      int gs = 0; float gm = lg[0];
#pragma unroll
      for (int j = 1; j < 4; ++j) if (lg[j] > gm) { gm = lg[j]; gs = j; }
      float z = 0.f;
#pragma unroll
      for (int j = 0; j < 4; ++j) z += __expf(lg[j] - gm);
      const float pg = 1.0f / z;
      float le[8];
#pragma unroll
      for (int i = 0; i < 8; ++i) le[i] = gs == 0 ? lg[4 + i] : (gs == 1 ? lg[12 + i] : (gs == 2 ? lg[20 + i] : lg[28 + i]));
      int i0e = 0; float m0 = le[0];
#pragma unroll
      for (int i = 1; i < 8; ++i) if (le[i] > m0) { m0 = le[i]; i0e = i; }
      int i1e = -1; float m1 = -INFINITY;
#pragma unroll
      for (int i = 0; i < 8; ++i) if (i != i0e && le[i] > m1) { m1 = le[i]; i1e = i; }
      const float e1 = __expf(m1 - m0); const float g0 = pg / (1.0f + e1), g1 = pg * e1 / (1.0f + e1);
      const int x0 = gs * 8 + i0e, x1 = gs * 8 + i1e;
      if (lane == 0) {
        const int r0 = __hip_atomic_fetch_add(lcnt + x0, 1, __ATOMIC_RELAXED, __HIP_MEMORY_SCOPE_WORKGROUP);
        const int r1 = __hip_atomic_fetch_add(lcnt + x1, 1, __ATOMIC_RELAXED, __HIP_MEMORY_SCOPE_WORKGROUP);
        lasg[ii * 8 + F.wave] = (i32x4){x0, x1, r0, r1}; asgg[m] = make_float2(g0, g1);
      }
    }
    __syncthreads();
    if (tid < 32) lbase[tid] = atomicAdd(cnt + tid, lcnt[tid]);
    __syncthreads();
    if (tid < 256) {
      const int ii = tid >> 3, wv = tid & 7; const int m = (int)blockIdx.x * 8 + wv + (i0 + ii) * F.NGW;
      if (i0 + ii < niter && m < NTOK) {
        const i32x4 a = lasg[tid]; const int r0 = lbase[a.x] + a.z, r1 = lbase[a.y] + a.w;
        list[a.x * 65536 + r0] = m; list[a.y * 65536 + r1] = m; asg[m] = make_int4(a.x, a.y, r0, r1);
      }
    }
    __syncthreads();
  }
}
DI void moe_setup(const Ctx& F, const Params& P, int L) {
  LAS int* pb = (LAS int*)(F.lds + LDS_MISC); LAS int* cl = pb + 64;
  const int* cnt = (const int*)(P.ws + WS_CTL) + L * 64;
  const int tid = F.wave * 64 + lane_id_v();
  __syncthreads();
  if (tid < 32) cl[tid] = cnt[tid];
  __syncthreads();
  if (tid == 0) { int a = 0; for (int e = 0; e < NEXP; ++e) { pb[e] = a; a += (cl[e] + 255) >> 8; } pb[NEXP] = a; }
  __syncthreads();
}
DI void combine_phase(const Ctx& F, const Params& P, int L, bool with_norm) {
  unsigned char* ws = P.ws;
  moe_setup(F, P, L);
  const LAS int* pb = (const LAS int*)(F.lds + LDS_MISC);
  const int4* asg = (const int4*)(ws + WS_ASG); const float2* asgg = (const float2*)(ws + WS_ASGG);
  const bf16_t* Y = (const bf16_t*)(ws + WS_PROJ); bf16_t* XN = (bf16_t*)(ws + WS_XN);
  const int lane = lane_id_v();
  for (int m = F.gw; m < NTOK; m += F.NGW) {
    const int4 a = asg[m]; const float2 gg = asgg[m];
    const size_t row0 = (size_t)pb[a.x] * 256 + a.z, row1 = (size_t)pb[a.y] * 256 + a.w;
    f32x4* xr = (f32x4*)(P.out + (size_t)m * DM) + lane;
    const u32x2* y0 = (const u32x2*)(Y + row0 * DM) + lane; const u32x2* y1 = (const u32x2*)(Y + row1 * DM) + lane;
    f32x4 v[4]; float ss = 0.f;
#pragma unroll
    for (int j = 0; j < 4; ++j) { f32x4 x = xr[64 * j]; const u32x2 a0 = y0[64 * j], a1 = y1[64 * j];
      x.x += gg.x * bflo(a0.x) + gg.y * bflo(a1.x); x.y += gg.x * bfhi(a0.x) + gg.y * bfhi(a1.x); x.z += gg.x * bflo(a0.y) + gg.y * bflo(a1.y); x.w += gg.x * bfhi(a0.y) + gg.y * bfhi(a1.y);
      xr[64 * j] = x; v[j] = x; ss += (x.x * x.x + x.y * x.y) + (x.z * x.z + x.w * x.w); }
    if (with_norm) {
      const float rstd = 1.0f / sqrtf(wave_sum(ss) * (1.f / DM) + NORM_EPS);
      unsigned long long* o8 = (unsigned long long*)(XN + (size_t)m * DM) + lane;
#pragma unroll
      for (int j = 0; j < 4; ++j) o8[64 * j] = (unsigned long long)pk2(v[j].x * rstd, v[j].y * rstd) | ((unsigned long long)pk2(v[j].z * rstd, v[j].w * rstd) << 32);
    }
  }
}
DI void moe_gemms(const Ctx& F, const Params& P, int L, cg::grid_group& grid) {
  unsigned char* ws = P.ws;
  const int vcu = (F.G % 8 == 0) ? ((int)(blockIdx.x % 8) * (F.G / 8) + (int)(blockIdx.x / 8)) : (int)blockIdx.x;
  moe_setup(F, P, L);
  {
    pg8::MoeSched<true> S{(const LAS int*)(F.lds + LDS_MISC), (const LAS int*)(F.lds + LDS_MISC) + 64, (const int*)(ws + WS_LIST), (const char*)(ws + (L ? WS_WGU1 : WS_WGU0)), F.G, vcu, 1024};
    pg8::EpiSwiGLU E{(bf16_t*)(ws + WS_H)};
    pg8::gemm_phase<pg8::EpiSwiGLU, pg8::MoeSched<true>, true>(F.lds, F.wave, (const char*)(ws + WS_XN), 1024, S, E);
  }
  grid.sync();
  {
    pg8::MoeSched<false> S{(const LAS int*)(F.lds + LDS_MISC), (const LAS int*)(F.lds + LDS_MISC) + 64, nullptr, (const char*)(ws + (L ? WS_WD1 : WS_WD0)), F.G, vcu, 512};
    pg8::EpiBf16 E{(bf16_t*)(ws + WS_PROJ), DM};
    pg8::gemm_phase<pg8::EpiBf16, pg8::MoeSched<false>, true>(F.lds, F.wave, (const char*)(ws + WS_H), 512, S, E);
  }
}

DI void p8b_transform1(const Ctx& F, const Params& P) {
  bf16_t* QKV = (bf16_t*)(P.ws + WS_PROJ);
  const float* cosT = (const float*)(P.ws + WS_ROPE); const float* sinT = cosT + SEQ * 32;
  const int lane = lane_id_v(), sub = lane & 7, grp = lane >> 3;
  for (int m = F.gw; m < NTOK; m += F.NGW) {
    const int t = m & (SEQ - 1);
    bf16_t* row = QKV + (size_t)m * W1;
    const float* cr = cosT + t * 32; const float* sr = sinT + t * 32;
    head_normrope(row + grp * 64 + sub * 8, P.in[I_QN1], true, cr, sr, sub);
    head_normrope(row + 512 + grp * 64 + sub * 8, P.in[I_QN1], true, cr, sr, sub);
    if (grp < 4) head_normrope(row + 1024 + grp * 64 + sub * 8, P.in[I_KN1], true, cr, sr, sub);
  }
}

DI void dil_phase(const Ctx& F, const Params& P) {
  const bf16_t* QKV = (const bf16_t*)(P.ws + WS_PROJ); bf16_t* MIX = (bf16_t*)(P.ws + WS_MIX);
  LAS unsigned char* vst = F.lds + F.wave * 8192;
  const int lane = lane_id_v(), c = lane & 31, half = lane >> 5, qi = c >> 2, gq = c & 3;
  const float cshift = 8.f * wave_max(fabsf(P.in[I_QN1][lane])) * wave_max(fabsf(P.in[I_KN1][lane])) * 1.02f;
  const float c1 = 0.125f * LOG2E, c2 = cshift * LOG2E;
  const int q4 = (lane & 15) >> 2, p4 = lane & 3, blk = (lane >> 4) & 1;
  for (int it = F.gw; it < 32768; it += F.NGW) {
    const int r = it & 15, tile = (it >> 4) & 31, kh = (it >> 9) & 3, b = it >> 11;
    const size_t rb = (size_t)b * SEQ; const int tmax = tile * 128 + r + 112, tq = tile * 128 + r + 16 * qi;
    bf16x8 qf[4];
    { const bf16_t* qp = QKV + (rb + tq) * W1 + (4 * kh + gq) * 64 + 32 * half;
#pragma unroll
      for (int ks = 0; ks < 4; ++ks) qf[ks] = *(const bf16x8*)(qp + 8 * ks); }
    f32x16 o0, o1;
#pragma unroll
    for (int i = 0; i < 16; ++i) { o0[i] = 0.f; o1[i] = 0.f; }
    float lsum = 0.f;
#pragma unroll 1
    for (int pat = 0; pat < 3; ++pat) {
      const int sh = 2 * pat;
      const int ei = (16 >> sh) * (7 - qi);
      const int ntile = pat == 0 ? 8 : 5;
#pragma unroll 1
      for (int T = 0; T < ntile; ++T) {
        const int n = 32 * T + c; const int pos = tmax - (n << sh); const int posc = pos < 0 ? 0 : pos;
        const bf16_t* kp = QKV + (rb + posc) * W1 + 1024 + kh * 64 + 32 * half;
        bf16x8 kf[4]; u32x4 vv[4];
#pragma unroll
        for (int ks = 0; ks < 4; ++ks) kf[ks] = *(const bf16x8*)(kp + 8 * ks);
#pragma unroll
        for (int ks = 0; ks < 4; ++ks) vv[ks] = *(const u32x4*)(kp + 256 + 8 * ks);
#pragma unroll
        for (int ks = 0; ks < 4; ++ks) *(LAS u32x4*)(vst + c * 128 + 64 * half + 16 * ks) = vv[ks];
        f32x16 s;
#pragma unroll
        for (int i = 0; i < 16; ++i) s[i] = 0.f;
#pragma unroll
        for (int ks = 0; ks < 4; ++ks) s = __builtin_amdgcn_mfma_f32_32x32x16_bf16(kf[ks], qf[ks], s, 0, 0, 0);
#pragma unroll
        for (int reg = 0; reg < 16; ++reg) { const int nn = 32 * T + (reg & 3) + 8 * (reg >> 2) + 4 * half; const int ps = tmax - (nn << sh);
          const bool ok = (nn >= ei) && (nn <= ei + 128) && (ps >= 0);
          const float p = ok ? __builtin_amdgcn_exp2f(s[reg] * c1 - c2) : 0.f; s[reg] = p; lsum += p; }
        asm volatile("" ::: "memory");
#pragma unroll
        for (int st = 0; st < 2; ++st) {
          u32x4 pw; pw.x = pk2(s[8 * st], s[8 * st + 1]); pw.y = pk2(s[8 * st + 2], s[8 * st + 3]); pw.z = pk2(s[8 * st + 4], s[8 * st + 5]); pw.w = pk2(s[8 * st + 6], s[8 * st + 7]);
          const bf16x8 pf = __builtin_bit_cast(bf16x8, pw);
          const int r1 = 16 * st + 4 * half + q4;
#pragma unroll
          for (int dblk = 0; dblk < 2; ++dblk) {
            const int cb = (32 * dblk + 16 * blk + 4 * p4) * 2;
            const s16x4 lo = tr_read(vst + r1 * 128 + cb), hi = tr_read(vst + (r1 + 8) * 128 + cb);
            const bf16x8 vf = __builtin_shufflevector(lo, hi, 0, 1, 2, 3, 4, 5, 6, 7);
            if (dblk == 0) o0 = __builtin_amdgcn_mfma_f32_32x32x16_bf16(vf, pf, o0, 0, 0, 0); else o1 = __builtin_amdgcn_mfma_f32_32x32x16_bf16(vf, pf, o1, 0, 0, 0);
          }
        }
        asm volatile("" ::: "memory");
      }
    }
    lsum += __shfl_xor(lsum, 32);
    const float inv = 1.0f / lsum;
    bf16_t* op = MIX + (rb + tq) * DM + (4 * kh + gq) * 64 + 4 * half;
#pragma unroll
    for (int gI = 0; gI < 4; ++gI) {
      u32x2 w0; w0.x = pk2(o0[4 * gI] * inv, o0[4 * gI + 1] * inv); w0.y = pk2(o0[4 * gI + 2] * inv, o0[4 * gI + 3] * inv); *(u32x2*)(op + 8 * gI) = w0;
      u32x2 w1; w1.x = pk2(o1[4 * gI] * inv, o1[4 * gI + 1] * inv); w1.y = pk2(o1[4 * gI + 2] * inv, o1[4 * gI + 3] * inv); *(u32x2*)(op + 32 + 8 * gI) = w1;
    }
  }
}

__global__ void __launch_bounds__(512, 2) fwd_megakernel(Params P) {
  extern __shared__ __attribute__((aligned(16))) unsigned char lds_raw[];
  cg::grid_group grid = cg::this_grid();
  Ctx F; F.lds = (LAS unsigned char*)lds_raw; F.wave = __builtin_amdgcn_readfirstlane((int)threadIdx.x >> 6);
  F.G = gridDim.x; F.gw = blockIdx.x * 8 + F.wave; F.NGW = F.G * 8;
  unsigned char* ws = P.ws;

#ifndef PHMASK
#define PHMASK 0xFFFFFFFFu
#endif
#define PH(n) if ((PHMASK >> (n)) & 1u)
#ifdef TIMEPH
  unsigned long long* tsw = (unsigned long long*)(ws + WS_CTL + 4096);
#define TS_BEGIN(n) if ((n) >= TIMEPH && (n) < TIMEPH + TIMEN && (n) == TIMEPH && blockIdx.x == 0 && threadIdx.x == 0) tsw[0] = __builtin_amdgcn_s_memrealtime();
#define TS_END(n) if ((n) == TIMEPH + TIMEN - 1 && blockIdx.x == 0 && threadIdx.x == 0) tsw[1] = __builtin_amdgcn_s_memrealtime();
#else
#define TS_BEGIN(n)
#define TS_END(n)
#endif
  TS_BEGIN(0)
  PH(0) p0_prologue(F, P);
  grid.sync();
  TS_END(0)
  TS_BEGIN(1)
  PH(1) {
    pg8::DenseSched S; S.init(NTOK, W0P, 1024, ws + WS_WIN0, F.G, (int)blockIdx.x);
    pg8::EpiBf16 E{(bf16_t*)(ws + WS_PROJ), W0P};
    pg8::gemm_phase<pg8::EpiBf16, pg8::DenseSched, true>(F.lds, F.wave, (const char*)(ws + WS_XN), 1024, S, E);
  }
  grid.sync();
  TS_END(1)
  TS_BEGIN(2)
  PH(2) p1b_transform0(F, P);
  grid.sync();
  TS_END(2)
  TS_BEGIN(3)
  PH(3) dsa_phase(F, P);
  grid.sync();
  TS_END(3)
  TS_BEGIN(4)
  PH(4) {
    pg8::DenseSched S; S.init(NTOK, 1024, 1024, ws + WS_WOUT0, F.G, (int)blockIdx.x);
    pg8::EpiResF32 E{P.in[I_X], P.out, DM};
    pg8::gemm_phase<pg8::EpiResF32, pg8::DenseSched, true>(F.lds, F.wave, (const char*)(ws + WS_MIX), 1024, S, E);
  }
  grid.sync();
  TS_END(4)
  TS_BEGIN(5)
  PH(5) router_phase(F, P, 0);
  grid.sync();
  TS_END(5)
  TS_BEGIN(6)
  PH(6) moe_gemms(F, P, 0, grid);
  grid.sync();
  TS_END(6)
  TS_BEGIN(7)
  PH(7) combine_phase(F, P, 0, true);
  grid.sync();
  TS_END(7)
  TS_BEGIN(8)
  PH(8) {
    pg8::DenseSched S; S.init(NTOK, W1, 1024, ws + WS_WIN1, F.G, (int)blockIdx.x);
    pg8::EpiBf16 E{(bf16_t*)(ws + WS_PROJ), W1};
    pg8::gemm_phase<pg8::EpiBf16, pg8::DenseSched, true>(F.lds, F.wave, (const char*)(ws + WS_XN), 1024, S, E);
  }
  grid.sync();
  TS_END(8)
  TS_BEGIN(9)
  PH(9) p8b_transform1(F, P);
  grid.sync();
  TS_END(9)
  TS_BEGIN(10)
  PH(10) dil_phase(F, P);
  grid.sync();
  TS_END(10)
  TS_BEGIN(11)
  PH(11) {
    pg8::DenseSched S; S.init(NTOK, 1024, 1024, ws + WS_WOUT1, F.G, (int)blockIdx.x);
    pg8::EpiResF32 E{P.out, P.out, DM};
    pg8::gemm_phase<pg8::EpiResF32, pg8::DenseSched, true>(F.lds, F.wave, (const char*)(ws + WS_MIX), 1024, S, E);
  }
  grid.sync();
  TS_END(11)
  TS_BEGIN(12)
  PH(12) router_phase(F, P, 1);
  grid.sync();
  TS_END(12)
  TS_BEGIN(13)
  PH(13) moe_gemms(F, P, 1, grid);
  grid.sync();
  TS_END(13)
  TS_BEGIN(14)
  PH(14) combine_phase(F, P, 1, false);
#ifdef TIMEPH
  grid.sync();
  TS_END(14)
  grid.sync();
  { const unsigned long long dt = (tsw[1] - tsw[0]) * 4ull; const unsigned long long t0 = __builtin_amdgcn_s_memrealtime();
    while (__builtin_amdgcn_s_memrealtime() - t0 < dt) __builtin_amdgcn_s_sleep(32); }
#endif
}

extern "C" void kernel_launch(void* const* d_in, const int* in_sizes, int n_in, void* d_out, int out_size, void* d_ws, size_t ws_size, hipStream_t stream) {
  static int grid_blocks = 0;
  if (!grid_blocks) {
    if (n_in != 28 || out_size != NTOK * DM || ws_size < WS_END) { fprintf(stderr, "kernel_launch: unexpected shapes (n_in %d out %d ws %zu)\n", n_in, out_size, ws_size); grid_blocks = -1; return; }
    int dev = 0, cus = 0, per_cu = 0;
    (void)hipGetDevice(&dev);
    (void)hipDeviceGetAttribute(&cus, hipDeviceAttributeMultiprocessorCount, dev);
    (void)hipFuncSetAttribute((const void*)fwd_megakernel, hipFuncAttributeMaxDynamicSharedMemorySize, LDS_BYTES);
    (void)hipOccupancyMaxActiveBlocksPerMultiprocessor(&per_cu, (const void*)fwd_megakernel, 512, LDS_BYTES);
    if (per_cu < 1) per_cu = 1;
    grid_blocks = cus * per_cu;
  }
  if (grid_blocks < 0) return;
  Params p{};
  for (int i = 0; i < 28; ++i) p.in[i] = (const float*)d_in[i];
  p.out = (float*)d_out; p.ws = (unsigned char*)d_ws;
  void* args[] = {&p};
  hipError_t e = hipLaunchCooperativeKernel((const void*)fwd_megakernel, dim3(grid_blocks), dim3(512), args, LDS_BYTES, stream);
  if (e != hipSuccess) fprintf(stderr, "cooperative launch failed: %s (grid %d)\n", hipGetErrorString(e), grid_blocks);
}
```

```cpp
#include <hip/hip_runtime.h>
#include <hip/hip_cooperative_groups.h>
#include <cstdio>
#include <cstdint>
namespace cg = cooperative_groups;

#define LAS __attribute__((address_space(3)))
#define DI __device__ __forceinline__
typedef unsigned short bf16_t;
typedef short bf16x8 __attribute__((ext_vector_type(8)));
typedef short s16x4 __attribute__((ext_vector_type(4)));
typedef float f32x2 __attribute__((ext_vector_type(2)));
typedef float f32x4 __attribute__((ext_vector_type(4)));
typedef float f32x16 __attribute__((ext_vector_type(16)));
typedef unsigned u32x2 __attribute__((ext_vector_type(2)));
typedef unsigned u32x4 __attribute__((ext_vector_type(4)));
typedef int i32x4 __attribute__((ext_vector_type(4)));
typedef __bf16 bf16x2_t __attribute__((ext_vector_type(2)));

constexpr int NTOK = 65536, DM = 1024, SEQ = 4096, NBATCH = 16;
constexpr int W0P = 2560, W0V = 2500;
constexpr int W1 = 1536;
constexpr int C_CB = 0, C_CC = 512, C_CH = 1024, C_Q = 1536, C_K = 2048, C_V = 2112, C_IQ = 2176, C_IK = 2432, C_IW = 2496;
constexpr int NEXP = 32, DEXP = 512;
constexpr int MAXROWS = 139264;
constexpr float NORM_EPS = 1e-6f;
constexpr float LOG2E = 1.4426950408889634f;

constexpr size_t MiB = 1u << 20;
constexpr size_t WS_CTL = 0;
constexpr size_t WS_ROPE = 1 * MiB;
constexpr size_t WS_WR0 = 2 * MiB, WS_WR1 = 2 * MiB + 256 * 1024;
constexpr size_t WS_WIN0 = 3 * MiB, WS_WOUT0 = 8 * MiB, WS_WIN1 = 10 * MiB, WS_WOUT1 = 13 * MiB;
constexpr size_t WS_WGU0 = 16 * MiB, WS_WD0 = 80 * MiB, WS_WGU1 = 112 * MiB, WS_WD1 = 176 * MiB;
constexpr size_t WS_XN = 208 * MiB;
constexpr size_t WS_MIX = 337 * MiB;
constexpr size_t WS_H = 465 * MiB;
constexpr size_t WS_PROJ = 601 * MiB;
constexpr size_t WS_LIST = 921 * MiB;
constexpr size_t WS_ASG = 929 * MiB;
constexpr size_t WS_ASGG = 930 * MiB;
constexpr size_t WS_IKF = 931 * MiB, WS_KF = 939 * MiB, WS_VTF = 947 * MiB;
constexpr size_t WS_END = 955 * MiB;

constexpr int LDS_BYTES = 155648;
constexpr int LDS_LIST = 131072;
constexpr int LDS_MISC = 131072 + 16384;

DI unsigned pk2(float lo, float hi) { f32x2 v = {lo, hi}; bf16x2_t b = __builtin_convertvector(v, bf16x2_t); return __builtin_bit_cast(unsigned, b); }
DI float bflo(unsigned w) { return __uint_as_float(w << 16); }
DI float bfhi(unsigned w) { return __uint_as_float(w & 0xffff0000u); }
DI float bf1(bf16_t h) { return __uint_as_float((unsigned)h << 16); }
DI int opaque(int x) { asm volatile("" : "+v"(x)); return x; }
DI int lane_id_v() { int l; asm volatile("v_mbcnt_lo_u32_b32 %0, -1, 0\n\tv_mbcnt_hi_u32_b32 %0, -1, %0" : "=v"(l)); return l; }
DI float wave_sum(float v) {
#pragma unroll
  for (int o = 1; o < 64; o <<= 1) v += __shfl_xor(v, o);
  return v;
}
DI float wave_max(float v) {
#pragma unroll
  for (int o = 1; o < 64; o <<= 1) v = fmaxf(v, __shfl_xor(v, o));
  return v;
}
DI unsigned wave_sum_u(unsigned v) {
#pragma unroll
  for (int o = 1; o < 64; o <<= 1) v += (unsigned)__shfl_xor((int)v, o);
  return v;
}

namespace pg8 {
constexpr int BM = 256, BK = 64, HALF = 128, HTB = HALF * BK * 2, STAGE_BYTES = 8 * HTB, NXCD = 8, WGM = 8;
DI int lds_byte(int r, int c) { const int st = (r >> 4) * 2 + (c >> 5), rr = r & 15, cc = c & 31, ob = rr * 64 + cc * 2; return st * 1024 + (ob ^ (((ob >> 9) & 1) << 5)); }
DI void stage_rc(int b, int& R, int& C) { const int st = b / 1024, sb = b % 1024, swz = sb ^ (((sb >> 9) & 1) << 5); R = (st >> 1) * 16 + swz / 64; C = (st & 1) * 32 + (swz % 64) / 2; }
DI int perm32(int rho) { const int n = rho >> 4, i = rho & 15; return 8 * (i >> 2) + 4 * n + (i & 3); }

struct Unit { const char* b; int p0, p1, p2, p3; };

struct EpiBf16 {
  static constexpr bool PERM = true;
  bf16_t* O; int ldc;
  DI void operator()(const f32x4 (&acc)[2][2][4][2], const Unit& u, int wr, int wc, int fr, int fq) const {
    const int row0 = u.p0 + wr * 64 + fr, col0 = u.p1 + wc * 32 + 8 * fq;
#pragma unroll
    for (int ai = 0; ai < 2; ++ai)
#pragma unroll
      for (int m = 0; m < 4; ++m) { bf16_t* rowp = O + (size_t)(row0 + ai * HALF + m * 16) * ldc + col0;
#pragma unroll
        for (int bj = 0; bj < 2; ++bj) { const f32x4 v0 = acc[ai][bj][m][0], v1 = acc[ai][bj][m][1];
          u32x4 w; w.x = pk2(v0[0], v0[1]); w.y = pk2(v0[2], v0[3]); w.z = pk2(v1[0], v1[1]); w.w = pk2(v1[2], v1[3]);
          *(u32x4*)(rowp + bj * HALF) = w; } }
  }
};
struct EpiResF32 {
  static constexpr bool PERM = false;
  const float* base; float* out; int ldc;
  DI void operator()(const f32x4 (&acc)[2][2][4][2], const Unit& u, int wr, int wc, int fr, int fq) const {
    const int row0 = u.p0 + wr * 64 + fr, col0 = u.p1 + wc * 32 + 4 * fq;
#pragma unroll
    for (int ai = 0; ai < 2; ++ai)
#pragma unroll
      for (int m = 0; m < 4; ++m) { const size_t off = (size_t)(row0 + ai * HALF + m * 16) * ldc + col0;
#pragma unroll
        for (int bj = 0; bj < 2; ++bj)
#pragma unroll
          for (int n = 0; n < 2; ++n) { const f32x4 bs = *(const f32x4*)(base + off + bj * HALF + n * 16); *(f32x4*)(out + off + bj * HALF + n * 16) = bs + acc[ai][bj][m][n]; } }
  }
};
DI float silu_mul(float g, float u) { return g * u * __builtin_amdgcn_rcpf(1.0f + __builtin_amdgcn_exp2f(-g * LOG2E)); }
struct EpiSwiGLU {
  static constexpr bool PERM = true;
  bf16_t* H;
  DI void operator()(const f32x4 (&acc)[2][2][4][2], const Unit& u, int wr, int wc, int fr, int fq) const {
    const int row0 = u.p0 + wr * 64 + fr, col0 = u.p1 + wc * 32 + 8 * fq;
#pragma unroll
    for (int ai = 0; ai < 2; ++ai)
#pragma unroll
      for (int m = 0; m < 4; ++m) { bf16_t* rowp = H + (size_t)(row0 + ai * HALF + m * 16) * DEXP + col0;
        const f32x4 g0 = acc[ai][0][m][0], g1 = acc[ai][0][m][1], u0 = acc[ai][1][m][0], u1 = acc[ai][1][m][1];
        u32x4 w; w.x = pk2(silu_mul(g0[0], u0[0]), silu_mul(g0[1], u0[1])); w.y = pk2(silu_mul(g0[2], u0[2]), silu_mul(g0[3], u0[3]));
        w.z = pk2(silu_mul(g1[0], u1[0]), silu_mul(g1[1], u1[1])); w.w = pk2(silu_mul(g1[2], u1[2]), silu_mul(g1[3], u1[3]));
        *(u32x4*)rowp = w; }
  }
};

struct DenseSched {
  static constexpr bool NEXT_IN_LDS = false;
  int nM, nN, nwg, G, c, K; const char* Bt;
  DI void init(int M, int N, int K_, const void* Bt_, int G_, int c_) { nM = M / BM; nN = N / BM; nwg = nM * nN; G = G_; c = c_; K = K_; Bt = (const char*)Bt_; }
  DI bool next(int i, Unit& u) const {
    const long L = (long)i * G + c; if (L >= nwg) return false;
    int wgid = (int)L; { const int q = nwg / NXCD, r = nwg % NXCD, xcd = wgid % NXCD, off = wgid / NXCD; wgid = (xcd < r ? xcd * (q + 1) : r * (q + 1) + (xcd - r) * q) + off; }
    const int nig = WGM * nN, gid = wgid / nig, fm = gid * WGM, gsz = (nM - fm) < WGM ? (nM - fm) : WGM;
    const int pm = fm + ((wgid % nig) % gsz), pn = (wgid % nig) / gsz;
    u.p0 = pm * BM; u.p1 = pn * BM; u.p2 = 0; u.p3 = 0; u.b = Bt + (size_t)pn * BM * K * 2; return true;
  }
  DI void a_off(const Unit& u, const int (&R)[2], const int (&C)[2], unsigned (&o)[2][2]) const {
#pragma unroll
    for (int h = 0; h < 2; ++h)
#pragma unroll
      for (int i = 0; i < 2; ++i) o[h][i] = (unsigned)((u.p0 + h * HALF + R[i]) * K + C[i]) * 2u;
  }
};
template <bool GATHER> struct MoeSched {
  static constexpr bool NEXT_IN_LDS = GATHER;
  const LAS int* pb; const LAS int* cnt; const int* list; const char* W; int G, c, K;
  DI bool next(int i, Unit& u) const {
    const int L = i * G + c; const int total = __builtin_amdgcn_readfirstlane(pb[NEXP]) * 4; if (L >= total) return false;
    const int rbg = L >> 2, pn = L & 3; int e = 0;
    for (int j = 1; j < NEXP; ++j) e = (__builtin_amdgcn_readfirstlane(pb[j]) <= rbg) ? j : e;
    u.p0 = rbg * BM; u.p1 = pn * (GATHER ? 128 : 256); u.p2 = e; u.p3 = rbg - __builtin_amdgcn_readfirstlane(pb[e]);
    u.b = W + (size_t)(e * 1024 + pn * 256) * K * 2; return true;
  }
  DI void a_off(const Unit& u, const int (&R)[2], const int (&C)[2], unsigned (&o)[2][2]) const {
    if (GATHER) {
      const int ce = __builtin_amdgcn_readfirstlane(cnt[u.p2]);
#pragma unroll
      for (int h = 0; h < 2; ++h)
#pragma unroll
        for (int i = 0; i < 2; ++i) { const int row = u.p3 * BM + h * HALF + R[i]; const int tok = (row < ce) ? list[u.p2 * 65536 + row] : NTOK; o[h][i] = (unsigned)(tok * K + C[i]) * 2u; }
    } else {
#pragma unroll
      for (int h = 0; h < 2; ++h)
#pragma unroll
        for (int i = 0; i < 2; ++i) o[h][i] = (unsigned)((u.p0 + h * HALF + R[i]) * K + C[i]) * 2u;
    }
  }
};

template <class Epi, class Sched, bool ALIGN_EPI>
DI void gemm_phase(LAS unsigned char* lds, const int wave_id, const char* gA, const int K, const Sched& S, const Epi& E) {
  const int lane = lane_id_v(), wid = wave_id, tid = wid * 64 + lane, wr = wid >> 2, wc = wid & 3, fr = lane & 15, fq = lane >> 4;
  const int nt = K / BK;
  unsigned voffB[2];
  { int R, C; stage_rc(tid * 16, R, C);
    const int Rb = Epi::PERM ? ((R & ~31) + perm32(R & 31)) : R; voffB[0] = (unsigned)(Rb * K + C) * 2u; voffB[1] = voffB[0] + (unsigned)(64 * K * 2); }
#define PG8_RC(Rp, Cp) int Rp[2], Cp[2]; { int R_, C_; stage_rc(opaque(tid) * 16, R_, C_); Rp[0] = R_; Cp[0] = C_; Rp[1] = R_ + 64; Cp[1] = C_; }
  const size_t kstep = (size_t)(BK * 2);
  const size_t hstep = (size_t)HALF * K * 2;
  const unsigned ldsw = (unsigned)wid * 1024u;
  const int aoff = lds_byte(wr * 64 + fr, fq * 8), boff = lds_byte(wc * 32 + fr, fq * 8);
#define PG8_SA(b, h) (((b) * 2 + (h)) * HTB)
#define PG8_SB(b, h) ((4 + (b) * 2 + (h)) * HTB)
#define PG8_STAGE_B(bufoff, gbase) do { _Pragma("unroll") for (int _i = 0; _i < 2; ++_i) \
    __builtin_amdgcn_global_load_lds((const unsigned*)((const char*)(gbase) + voffB[_i]), (LAS unsigned*)(lds + (bufoff) + ldsw + _i * 8192), 16, 0, 0); } while (0)
#define PG8_STAGE_A(bufoff, kb, offs) do { _Pragma("unroll") for (int _i = 0; _i < 2; ++_i) \
    __builtin_amdgcn_global_load_lds((const unsigned*)(gA + (size_t)(kb) + (offs)[_i]), (LAS unsigned*)(lds + (bufoff) + ldsw + _i * 8192), 16, 0, 0); } while (0)
#define PG8_LDA(dst, b, h) do { _Pragma("unroll") for (int m = 0; m < 4; ++m) _Pragma("unroll") for (int k = 0; k < 2; ++k) dst[m][k] = *(const LAS bf16x8*)(lds + PG8_SA(b, h) + aoff + m * 2048 + k * 1024); } while (0)
#define PG8_LDB(dst, b, h) do { _Pragma("unroll") for (int n = 0; n < 2; ++n) _Pragma("unroll") for (int k = 0; k < 2; ++k) dst[n][k] = *(const LAS bf16x8*)(lds + PG8_SB(b, h) + boff + n * 2048 + k * 1024); } while (0)
#define PG8_MMA(ai, bj, At, Bt) do { __builtin_amdgcn_s_setprio(1); _Pragma("unroll") for (int m = 0; m < 4; ++m) _Pragma("unroll") for (int n = 0; n < 2; ++n) _Pragma("unroll") for (int k = 0; k < 2; ++k) \
    acc[ai][bj][m][n] = __builtin_amdgcn_mfma_f32_16x16x32_bf16(Bt[n][k], At[m][k], acc[ai][bj][m][n], 0, 0, 0); __builtin_amdgcn_s_setprio(0); } while (0)
#define PG8_WAIT_V(n) asm volatile("s_waitcnt vmcnt(" #n ")" ::: "memory")
#define PG8_WAIT_L(n) asm volatile("s_waitcnt lgkmcnt(" #n ")" ::: "memory")
#define PG8_BAR __builtin_amdgcn_s_barrier()
#define PG8_SCHED __builtin_amdgcn_sched_barrier(0)
  Unit cur, nxt; int ui = 0;
  if (!S.next(0, cur)) return;
  unsigned ca[2][2];
  { PG8_RC(Rp, Cp) S.a_off(cur, Rp, Cp, ca); }
  f32x4 acc[2][2][4][2];
#pragma unroll
  for (int a = 0; a < 2; ++a)
#pragma unroll
    for (int b = 0; b < 2; ++b)
#pragma unroll
      for (int m = 0; m < 4; ++m)
#pragma unroll
        for (int n = 0; n < 2; ++n) acc[a][b][m][n] = (f32x4){0.f, 0.f, 0.f, 0.f};
  bf16x8 At[4][2], B0[2][2], B1[2][2];
  const char* cB = cur.b;
  PG8_STAGE_B(PG8_SB(0, 0), cB); PG8_STAGE_B(PG8_SB(0, 1), cB + hstep); PG8_STAGE_A(PG8_SA(0, 0), 0, ca[0]); PG8_STAGE_A(PG8_SA(0, 1), 0, ca[1]);
  if (wr == 1) PG8_BAR;
  PG8_WAIT_V(2); PG8_BAR;
  PG8_STAGE_B(PG8_SB(1, 0), cB + kstep); PG8_STAGE_A(PG8_SA(1, 0), kstep, ca[0]); PG8_STAGE_B(PG8_SB(1, 1), cB + hstep + kstep);
  PG8_WAIT_V(6); PG8_BAR;
  for (;;) {
    const bool has_next = S.next(ui + 1, nxt);
    if (Sched::NEXT_IN_LDS) {
      unsigned na[2][2];
      if (has_next) { PG8_RC(Rp, Cp) S.a_off(nxt, Rp, Cp, na); }
      else {
#pragma unroll
        for (int h = 0; h < 2; ++h)
#pragma unroll
          for (int i = 0; i < 2; ++i) na[h][i] = ca[h][i];
      }
      *(LAS u32x4*)(lds + STAGE_BYTES + 8192 + tid * 16) = (u32x4){na[0][0], na[0][1], na[1][0], na[1][1]};
    }
    const char* nB = has_next ? nxt.b : cB;
    for (int t = 0; t < nt; t += 2) {
      const bool last = (t == nt - 2);
      PG8_LDB(B0, 0, 0); PG8_LDB(B1, 0, 1); PG8_SCHED; PG8_LDA(At, 0, 0); PG8_STAGE_A(PG8_SA(1, 1), (size_t)(t + 1) * kstep, ca[1]);
      PG8_WAIT_V(8); PG8_WAIT_L(0); PG8_BAR; PG8_MMA(0, 0, At, B0); PG8_MMA(0, 1, At, B1); PG8_BAR; PG8_SCHED;
      const size_t kb2 = last ? 0 : (size_t)(t + 2) * kstep;
      const char* b2 = last ? nB : cB + (size_t)(t + 2) * kstep;
      if (last) {
        if (Sched::NEXT_IN_LDS) { const u32x4 v = *(const LAS u32x4*)(lds + STAGE_BYTES + 8192 + tid * 16); ca[0][0] = v.x; ca[0][1] = v.y; ca[1][0] = v.z; ca[1][1] = v.w; }
        else if (has_next) { PG8_RC(Rp, Cp) S.a_off(nxt, Rp, Cp, ca); }
      }
      PG8_LDA(At, 0, 1); PG8_STAGE_B(PG8_SB(0, 0), b2); PG8_STAGE_B(PG8_SB(0, 1), b2 + hstep); PG8_STAGE_A(PG8_SA(0, 0), kb2, ca[0]);
      PG8_WAIT_V(8); PG8_WAIT_L(0); PG8_BAR; PG8_MMA(1, 0, At, B0); PG8_MMA(1, 1, At, B1); PG8_BAR; PG8_SCHED;
      PG8_LDB(B0, 1, 0); PG8_LDB(B1, 1, 1); PG8_SCHED; PG8_LDA(At, 1, 0); PG8_STAGE_A(PG8_SA(0, 1), kb2, ca[1]);
      PG8_WAIT_V(8); PG8_WAIT_L(0); PG8_BAR; PG8_MMA(0, 0, At, B0); PG8_MMA(0, 1, At, B1); PG8_BAR; PG8_SCHED;
      PG8_LDA(At, 1, 1); PG8_STAGE_B(PG8_SB(1, 0), b2 + kstep); PG8_STAGE_B(PG8_SB(1, 1), b2 + kstep + hstep); PG8_STAGE_A(PG8_SA(1, 0), kb2 + kstep, ca[0]);
      PG8_WAIT_V(8); PG8_WAIT_L(0); PG8_BAR; PG8_MMA(1, 0, At, B0); PG8_MMA(1, 1, At, B1); PG8_BAR; PG8_SCHED;
    }
    if constexpr (ALIGN_EPI) { if (wr == 0) PG8_BAR; }
    E(acc, cur, wr, wc, fr, fq);
    if (!has_next) break;
#pragma unroll
    for (int a = 0; a < 2; ++a)
#pragma unroll
      for (int b = 0; b < 2; ++b)
#pragma unroll
        for (int m = 0; m < 4; ++m)
#pragma unroll
          for (int n = 0; n < 2; ++n) acc[a][b][m][n] = (f32x4){0.f, 0.f, 0.f, 0.f};
    cur = nxt; cB = nB; ++ui;
    if constexpr (ALIGN_EPI) { if (wr == 1) PG8_BAR; }
  }
  PG8_WAIT_V(0);
  if constexpr (!ALIGN_EPI) { if (wr == 0) PG8_BAR; }
  PG8_BAR;
#undef PG8_RC
#undef PG8_SA
#undef PG8_SB
#undef PG8_STAGE_A
#undef PG8_STAGE_B
#undef PG8_LDA
#undef PG8_LDB
#undef PG8_MMA
#undef PG8_WAIT_V
#undef PG8_WAIT_L
#undef PG8_BAR
#undef PG8_SCHED
}
}

struct Params { const float* in[28]; float* out; unsigned char* ws; };
enum { I_X = 0, I_ANORM0, I_WIN0, I_CONVW, I_QN0, I_KN0, I_WOUT0, I_FNORM0, I_WRG0, I_BRG0, I_WRE0, I_BRE0, I_WG0, I_WU0, I_WD0,
       I_ANORM1, I_WIN1, I_QN1, I_KN1, I_WOUT1, I_FNORM1, I_WRG1, I_BRG1, I_WRE1, I_BRE1, I_WG1, I_WU1, I_WD1 };

struct Ctx { LAS unsigned char* lds; int wave, G, gw, NGW; };

struct TrDesc { const float* W; const float* gain; bf16_t* WT; int K, N, nvalid, mode, nblk, item; };
DI void tr_load(const TrDesc& d, int lane, f32x4 (&r)[8]) {
  const int kb = d.item / d.nblk, nb = d.item % d.nblk, k0 = 64 * kb, n = 32 * nb + 4 * (lane & 7);
#pragma unroll
  for (int i = 0; i < 8; ++i) { const int kk = 8 * i + (lane >> 3); r[i] = (n < d.nvalid) ? *(const f32x4*)(d.W + (size_t)(k0 + kk) * d.N + n) : (f32x4){0.f, 0.f, 0.f, 0.f}; }
}
DI void tr_finish(const TrDesc& d, int lane, const f32x4 (&r)[8], LAS float* scr) {
  const int kb = d.item / d.nblk, nb = d.item % d.nblk, k0 = 64 * kb, n0 = 32 * nb;
#pragma unroll
  for (int i = 0; i < 8; ++i) { const int kk = 8 * i + (lane >> 3); const float g = d.gain ? d.gain[k0 + kk] : 1.f; LAS float* s = scr + kk * 33 + 4 * (lane & 7);
    s[0] = r[i].x * g; s[1] = r[i].y * g; s[2] = r[i].z * g; s[3] = r[i].w * g; }
  asm volatile("s_waitcnt lgkmcnt(0)" ::: "memory");
  const int c = lane & 7;
#pragma unroll
  for (int j = 0; j < 4; ++j) { const int nn = (lane >> 3) + 8 * j; const LAS float* s = scr + (8 * c) * 33 + nn;
    u32x4 o; o.x = pk2(s[0 * 33], s[1 * 33]); o.y = pk2(s[2 * 33], s[3 * 33]); o.z = pk2(s[4 * 33], s[5 * 33]); o.w = pk2(s[6 * 33], s[7 * 33]);
    const int ng = n0 + nn; const int drow = (d.mode == 0) ? ng : ((ng >> 7) * 256 + (ng & 127) + (d.mode == 2 ? 128 : 0));
    *(u32x4*)(d.WT + (size_t)drow * d.K + k0 + 8 * c) = o; }
  asm volatile("s_waitcnt lgkmcnt(0)" ::: "memory");
}
DI void rms_row_to_bf16(const float* xrow, bf16_t* orow, int lane) {
  const f32x4* xr = (const f32x4*)xrow + lane;
  f32x4 v[4]; float s = 0.f;
#pragma unroll
  for (int j = 0; j < 4; ++j) { v[j] = xr[64 * j]; s += (v[j].x * v[j].x + v[j].y * v[j].y) + (v[j].z * v[j].z + v[j].w * v[j].w); }
  const float rstd = 1.0f / sqrtf(wave_sum(s) * (1.f / DM) + NORM_EPS);
  unsigned long long* o8 = (unsigned long long*)orow + lane;
#pragma unroll
  for (int j = 0; j < 4; ++j) o8[64 * j] = (unsigned long long)pk2(v[j].x * rstd, v[j].y * rstd) | ((unsigned long long)pk2(v[j].z * rstd, v[j].w * rstd) << 32);
}
DI void p0_prologue(const Ctx& F, const Params& P) {
  unsigned char* ws = P.ws; const int lane = lane_id_v(); const int tid = F.wave * 64 + lane;
  LAS float* scr = (LAS float*)(F.lds + F.wave * 16384);
  constexpr int I_IN0 = 16 * 80, I_OUT = 16 * 32, I_GU = 32 * 16 * 16, I_DN = 32 * 8 * 32, I_IN1 = 16 * 48;
  constexpr int PER_LAYER0 = I_IN0 + I_OUT + 2 * I_GU + I_DN, PER_LAYER1 = I_IN1 + I_OUT + 2 * I_GU + I_DN;
  auto mkdesc = [&](int it) {
    TrDesc d; int r = it; const int L = (r >= PER_LAYER0) ? 1 : 0; if (L) r -= PER_LAYER0;
    const int i_in = L ? I_IN1 : I_IN0;
    const float* anorm = P.in[L ? I_ANORM1 : I_ANORM0]; const float* fnorm = P.in[L ? I_FNORM1 : I_FNORM0];
    if (r < i_in) { d.W = P.in[L ? I_WIN1 : I_WIN0]; d.gain = anorm; d.WT = (bf16_t*)(ws + (L ? WS_WIN1 : WS_WIN0)); d.K = 1024; d.N = L ? W1 : W0V; d.nvalid = d.N; d.mode = 0; d.nblk = L ? 48 : 80; d.item = r; return d; }
    r -= i_in;
    if (r < I_OUT) { d.W = P.in[L ? I_WOUT1 : I_WOUT0]; d.gain = nullptr; d.WT = (bf16_t*)(ws + (L ? WS_WOUT1 : WS_WOUT0)); d.K = 1024; d.N = 1024; d.nvalid = 1024; d.mode = 0; d.nblk = 32; d.item = r; return d; }
    r -= I_OUT;
    if (r < 2 * I_GU) { const int up = r >= I_GU; if (up) r -= I_GU; const int e = r >> 8;
      d.W = P.in[up ? (L ? I_WU1 : I_WU0) : (L ? I_WG1 : I_WG0)] + (size_t)e * 1024 * 512; d.gain = fnorm; d.WT = (bf16_t*)(ws + (L ? WS_WGU1 : WS_WGU0)) + (size_t)e * 1024 * 1024;
      d.K = 1024; d.N = 512; d.nvalid = 512; d.mode = up ? 2 : 1; d.nblk = 16; d.item = r & 255; return d; }
    r -= 2 * I_GU;
    { const int e = r >> 8; d.W = P.in[L ? I_WD1 : I_WD0] + (size_t)e * 512 * 1024; d.gain = nullptr; d.WT = (bf16_t*)(ws + (L ? WS_WD1 : WS_WD0)) + (size_t)e * 1024 * 512; d.K = 512; d.N = 1024; d.nvalid = 1024; d.mode = 0; d.nblk = 32; d.item = r & 255; return d; }
  };
  {
    const int NIT = PER_LAYER0 + PER_LAYER1;
    int it = F.gw;
    f32x4 ra[8], rb[8];
    TrDesc da, db;
    if (it < NIT) { da = mkdesc(it); tr_load(da, lane, ra); }
    while (it < NIT) {
      const int itn = it + F.NGW;
      if (itn < NIT) { db = mkdesc(itn); tr_load(db, lane, rb); }
      tr_finish(da, lane, ra, scr);
      if (itn >= NIT) break;
      const int itn2 = itn + F.NGW;
      if (itn2 < NIT) { da = mkdesc(itn2); tr_load(da, lane, ra); }
      tr_finish(db, lane, rb, scr);
      it = itn2;
    }
  }
  for (int m = F.gw; m < NTOK; m += F.NGW) rms_row_to_bf16(P.in[I_X] + (size_t)m * DM, (bf16_t*)(ws + WS_XN) + (size_t)m * DM, lane);
  const int gt = blockIdx.x * 512 + tid, NGT = F.G * 512;
  for (int i = gt; i < 512; i += NGT) ((unsigned*)(ws + WS_XN + (size_t)NTOK * DM * 2))[i] = 0u;
  for (int i = gt; i < 128; i += NGT) ((int*)(ws + WS_CTL))[i] = 0;
  for (int i = gt; i < SEQ * 32; i += NGT) {
    const int t = i >> 5, k = i & 31;
    const float inv = (float)exp2(-(double)k * (13.287712379549449 / 32.0));
    const float ang = (float)t * inv;
    const double rev = (double)ang * 0.15915494309189535; const float fr = (float)(rev - rint(rev));
    ((float*)(ws + WS_ROPE))[i] = __builtin_amdgcn_cosf(fr); ((float*)(ws + WS_ROPE))[SEQ * 32 + i] = __builtin_amdgcn_sinf(fr);
  }
  for (int i = gt; i < 2 * 36 * 1024; i += NGT) {
    const int L = i / (36 * 1024), r = i % (36 * 1024), j = r >> 10, k = r & 1023;
    const float g = P.in[L ? I_FNORM1 : I_FNORM0][k];
    float w; if (j < 4) w = P.in[L ? I_WRG1 : I_WRG0][k * 4 + j]; else { const int gg = (j - 4) >> 3, e = (j - 4) & 7; w = P.in[L ? I_WRE1 : I_WRE0][((size_t)gg * 1024 + k) * 8 + e]; }
    ((float*)(ws + (L ? WS_WR1 : WS_WR0)))[r] = w * g;
  }
  for (int i = gt; i < 2 * 36; i += NGT) { const int L = i / 36, j = i % 36; ((float*)(ws + (L ? WS_WR1 : WS_WR0)))[36 * 1024 + j] = (j < 4) ? P.in[L ? I_BRG1 : I_BRG0][j] : P.in[L ? I_BRE1 : I_BRE0][j - 4]; }
}

DI void head_normrope(bf16_t* p, const float* gain, bool do_norm, const float* cosr, const float* sinr, int sub, bf16_t* dst = nullptr) {
  const u32x4 w = *(const u32x4*)p;
  float v[8] = {bflo(w.x), bfhi(w.x), bflo(w.y), bfhi(w.y), bflo(w.z), bfhi(w.z), bflo(w.w), bfhi(w.w)};
  if (do_norm) {
    float s = 0.f;
#pragma unroll
    for (int j = 0; j < 8; ++j) s += v[j] * v[j];
    s += __shfl_xor(s, 1); s += __shfl_xor(s, 2); s += __shfl_xor(s, 4);
    const float rstd = 1.0f / sqrtf(s * (1.f / 64.f) + NORM_EPS);
#pragma unroll
    for (int j = 0; j < 8; ++j) v[j] = v[j] * rstd * gain[8 * sub + j];
  }
  const int i0 = 8 * (sub & 3); const float sg = (sub & 4) ? 1.f : -1.f;
  float o[8];
#pragma unroll
  for (int j = 0; j < 8; ++j) { const float pr = __shfl_xor(v[j], 4); o[j] = v[j] * cosr[i0 + j] + sg * pr * sinr[i0 + j]; }
  u32x4 r; r.x = pk2(o[0], o[1]); r.y = pk2(o[2], o[3]); r.z = pk2(o[4], o[5]); r.w = pk2(o[6], o[7]);
  *(u32x4*)(dst ? dst : p) = r;
}
DI void p1b_transform0(const Ctx& F, const Params& P) {
  bf16_t* PROJ = (bf16_t*)(P.ws + WS_PROJ); bf16_t* MIX = (bf16_t*)(P.ws + WS_MIX);
  const float* cosT = (const float*)(P.ws + WS_ROPE); const float* sinT = cosT + SEQ * 32;
  const float* convw = P.in[I_CONVW];
  const int lane = lane_id_v(), sub = lane & 7, grp = lane >> 3;
  for (int m = F.gw; m < NTOK; m += F.NGW) {
    const int t = m & (SEQ - 1);
    bf16_t* row = PROJ + (size_t)m * W0P;
    const float* cr = cosT + t * 32; const float* sr = sinT + t * 32;
    head_normrope(row + C_Q + grp * 64 + sub * 8, P.in[I_QN0], true, cr, sr, sub);
    {
      const int g2 = grp < 6 ? grp : 5;
      bf16_t* p = row + (g2 == 0 ? C_K : (g2 <= 4 ? C_IQ + (g2 - 1) * 64 : C_IK)) + sub * 8;
      const size_t fo = ((((size_t)(m >> 12) * 128 + (t >> 5)) * 4 + (sub >> 1)) * 64 + (sub & 1) * 32 + (t & 31)) * 8;
      bf16_t* dst = g2 == 0 ? (bf16_t*)(P.ws + WS_KF) + fo : (g2 == 5 ? (bf16_t*)(P.ws + WS_IKF) + fo : nullptr);
      if (grp < 6) head_normrope(p, P.in[I_KN0], g2 == 0, cr, sr, sub, dst);
    }
    {
      const int kk = t & 31, st = kk >> 4, rem = kk & 15, hf = (rem >> 2) & 1, j = 4 * (rem >> 3) + (rem & 3);
      const size_t vo = (((((size_t)(m >> 12) * 128 + (t >> 5)) * 2 + st) * 2 + (lane >> 5)) * 64 + hf * 32 + (lane & 31)) * 8 + j;
      ((bf16_t*)(P.ws + WS_VTF))[vo] = row[C_V + lane];
    }
    {
      const int c0 = 8 * lane;
      const u32x4 cb = *(const u32x4*)(row + C_CB + c0);
      float u[3][8];
#pragma unroll
      for (int d = 0; d < 3; ++d) {
        const int back = 2 - d;
        if (t >= back) { const bf16_t* r2 = row - (size_t)back * W0P; const u32x4 a = *(const u32x4*)(r2 + C_CC + c0), b = *(const u32x4*)(r2 + C_CH + c0);
          u[d][0] = bflo(a.x) * bflo(b.x); u[d][1] = bfhi(a.x) * bfhi(b.x); u[d][2] = bflo(a.y) * bflo(b.y); u[d][3] = bfhi(a.y) * bfhi(b.y);
          u[d][4] = bflo(a.z) * bflo(b.z); u[d][5] = bfhi(a.z) * bfhi(b.z); u[d][6] = bflo(a.w) * bflo(b.w); u[d][7] = bfhi(a.w) * bfhi(b.w); }
        else {
#pragma unroll
          for (int j = 0; j < 8; ++j) u[d][j] = 0.f; }
      }
      const float cbv[8] = {bflo(cb.x), bfhi(cb.x), bflo(cb.y), bfhi(cb.y), bflo(cb.z), bfhi(cb.z), bflo(cb.w), bfhi(cb.w)};
      float o[8];
#pragma unroll
      for (int j = 0; j < 8; ++j) { const float* w = convw + (c0 + j) * 3; o[j] = cbv[j] * (u[0][j] * w[0] + u[1][j] * w[1] + u[2][j] * w[2]); }
      u32x4 r; r.x = pk2(o[0], o[1]); r.y = pk2(o[2], o[3]); r.z = pk2(o[4], o[5]); r.w = pk2(o[6], o[7]);
      *(u32x4*)(MIX + (size_t)m * DM + c0) = r;
    }
  }
}


DI unsigned f2key(float f) { const unsigned b = __float_as_uint(f); return b ^ ((unsigned)((int)b >> 31) | 0x80000000u); }
DI s16x4 tr_read(LAS unsigned char* p) { typedef short v4i16_t __attribute__((ext_vector_type(4))); return __builtin_bit_cast(s16x4, __builtin_amdgcn_ds_read_tr16_b64_v4i16((LAS v4i16_t*)p)); }
#define DPP_U(v, ctrl) ((unsigned)__builtin_amdgcn_update_dpp(0, (int)(v), (ctrl), 0xF, 0xF, true))
DI unsigned wave_total_u(unsigned v) {
  v += DPP_U(v, 0xB1); v += DPP_U(v, 0x4E); v += DPP_U(v, 0x124); v += DPP_U(v, 0x128);
  return (unsigned)__builtin_amdgcn_readlane((int)v, 0) + (unsigned)__builtin_amdgcn_readlane((int)v, 16) + (unsigned)__builtin_amdgcn_readlane((int)v, 32) + (unsigned)__builtin_amdgcn_readlane((int)v, 48);
}
DI unsigned wave_maxall_u(unsigned v) {
  v = max(v, DPP_U(v, 0xB1)); v = max(v, DPP_U(v, 0x4E)); v = max(v, DPP_U(v, 0x124)); v = max(v, DPP_U(v, 0x128));
  const unsigned a = (unsigned)__builtin_amdgcn_readlane((int)v, 0), b = (unsigned)__builtin_amdgcn_readlane((int)v, 16), c = (unsigned)__builtin_amdgcn_readlane((int)v, 32), d = (unsigned)__builtin_amdgcn_readlane((int)v, 48);
  return max(max(a, b), max(c, d));
}
DI unsigned lane_prefix(unsigned long long m) { return __builtin_amdgcn_mbcnt_hi((unsigned)(m >> 32), __builtin_amdgcn_mbcnt_lo((unsigned)m, 0u)); }

DI void dsa_phase(const Ctx& F, const Params& P) {
  const bf16_t* PROJ = (const bf16_t*)(P.ws + WS_PROJ); bf16_t* MIX = (bf16_t*)(P.ws + WS_MIX);
  const bf16_t* IKF = (const bf16_t*)(P.ws + WS_IKF); const bf16_t* KF = (const bf16_t*)(P.ws + WS_KF); const bf16_t* VTF = (const bf16_t*)(P.ws + WS_VTF);
  LAS unsigned* sc = (LAS unsigned*)F.lds;
  LAS unsigned* msk32 = (LAS unsigned*)(F.lds + LDS_LIST);
  LAS float* part = (LAS float*)F.lds;
  const int w = F.wave;
  float cshift; { const int l0 = lane_id_v(); cshift = 8.f * wave_max(fabsf(P.in[I_QN0][l0])) * wave_max(fabsf(P.in[I_KN0][l0])) * 1.02f; }
  const float c1 = 0.125f * LOG2E, c2 = __builtin_amdgcn_readfirstlane(__float_as_int(cshift * LOG2E)) == 0 ? 0.f : __int_as_float(__builtin_amdgcn_readfirstlane(__float_as_int(cshift * LOG2E)));
#ifdef TIMEDSA
  unsigned long long tacc = 0ull, tmark = 0ull;
#define DSA_T0(n) if (TIMEDSA == (n)) tmark = __builtin_amdgcn_s_memrealtime();
#define DSA_T1(n) if (TIMEDSA == (n)) tacc += __builtin_amdgcn_s_memrealtime() - tmark;
#else
#define DSA_T0(n)
#define DSA_T1(n)
#endif
  for (int v = blockIdx.x; v < 8192; v += gridDim.x) {
    const int cidx = v & 255, jj = v >> 8, b = jj >> 1, tb = (jj & 1) ? (511 - cidx) : cidx;
    const int t0 = tb * 8; const size_t rb = (size_t)b * SEQ;
    const int ntile = (t0 + 8 + 31) >> 5;
    const int lane = lane_id_v();
    const int c = lane & 31, half = lane >> 5, qc = c >> 2, hx = c & 3;
    DSA_T0(1)
    {
      bf16x8 af[4];
      { const bf16_t* ap = PROJ + (rb + t0 + qc) * W0P + C_IQ + hx * 64 + 8 * half;
#pragma unroll
        for (int ks = 0; ks < 4; ++ks) af[ks] = *(const bf16x8*)(ap + 16 * ks); }
      float wq[4][4];
#pragma unroll
      for (int g = 0; g < 4; ++g) { const u32x2 ww = *(const u32x2*)(PROJ + (rb + t0 + 2 * g + half) * W0P + C_IW);
        wq[g][0] = bflo(ww.x) * 0.0625f; wq[g][1] = bfhi(ww.x) * 0.0625f; wq[g][2] = bflo(ww.y) * 0.0625f; wq[g][3] = bfhi(ww.y) * 0.0625f; }
      const bf16_t* fb = IKF + ((size_t)b * 128 * 4 * 64 + lane) * 8;
      const int Tlast = ntile - 1;
      auto ld1 = [&](bf16x8 (&d)[4], int T) { const int Tc = T < Tlast ? T : Tlast;
#pragma unroll
        for (int ks = 0; ks < 4; ++ks) d[ks] = *(const bf16x8*)(fb + (size_t)(Tc * 4 + ks) * 512); };
      auto cp1 = [&](const bf16x8 (&bfr)[4], int T) {
        f32x16 acc;
#pragma unroll
        for (int i = 0; i < 16; ++i) acc[i] = 0.f;
#pragma unroll
        for (int ks = 0; ks < 4; ++ks) acc = __builtin_amdgcn_mfma_f32_32x32x16_bf16(af[ks], bfr[ks], acc, 0, 0, 0);
        const int s = 32 * T + c;
#pragma unroll
        for (int g = 0; g < 4; ++g) {
          float sv = (wq[g][0] * fmaxf(acc[4 * g], 0.f) + wq[g][1] * fmaxf(acc[4 * g + 1], 0.f)) + (wq[g][2] * fmaxf(acc[4 * g + 2], 0.f) + wq[g][3] * fmaxf(acc[4 * g + 3], 0.f));
          sv = (sv == 0.f) ? 0.f : sv;
          const int ql = 2 * g + half;
          sc[ql * 4096 + s] = (s <= t0 + ql) ? f2key(sv) : 0u;
        } };
      bf16x8 r0[4], r1[4], r2[4], r3[4];
      if (w < ntile) { ld1(r0, w); ld1(r1, w + 8); ld1(r2, w + 16); ld1(r3, w + 24); }
      for (int T = w; T < ntile; T += 32) {
        cp1(r0, T); ld1(r0, T + 32); __builtin_amdgcn_sched_barrier(0);
        if (T + 8 < ntile) { cp1(r1, T + 8); ld1(r1, T + 40); __builtin_amdgcn_sched_barrier(0); }
        if (T + 16 < ntile) { cp1(r2, T + 16); ld1(r2, T + 48); __builtin_amdgcn_sched_barrier(0); }
        if (T + 24 < ntile) { cp1(r3, T + 24); ld1(r3, T + 56); __builtin_amdgcn_sched_barrier(0); }
      }
    }
    __syncthreads();
    asm volatile("" ::: "memory"); __builtin_amdgcn_sched_barrier(0);
    DSA_T1(1)
    DSA_T0(2)
    {
      const int lane = lane_id_v();
      {
        const int cq = lane & 31;
        const bf16_t* qp = PROJ + (rb + t0 + (cq >> 2)) * W0P + C_Q + (4 * (w >> 2) + (cq & 3)) * 64 + 16 * (w & 3) + 8 * (lane >> 5);
        *(LAS u32x4*)(F.lds + LDS_LIST + 4096 + (w * 64 + lane) * 16) = *(const u32x4*)qp;
      }
      const int t = t0 + w;
      const int nch = (t >> 10) + 1;
      unsigned u[64];
#pragma unroll
      for (int ch = 0; ch < 4; ++ch) {
        if (ch < nch) {
#pragma unroll
          for (int k2 = 0; k2 < 16; ++k2) { const int j = 16 * ch + k2; const unsigned x = sc[w * 4096 + 64 * j + lane]; u[j] = (lane <= t - 64 * j) ? x : 0u; }
        } else {
#pragma unroll
          for (int k2 = 0; k2 < 16; ++k2) u[16 * ch + k2] = 0u;
        }
      }
      unsigned thr = 0u; int sthr = -1;
      if (t >= 256) {
        unsigned prefix = 0u; bool exact = false; int startbit = 31;
        {
          unsigned mx = 0u;
#pragma unroll
          for (int ch = 0; ch < 4; ++ch) if (ch < nch) {
#pragma unroll
            for (int k2 = 0; k2 < 16; ++k2) mx = max(mx, u[16 * ch + k2]);
          }
          const unsigned trial = wave_maxall_u(mx) & 0xFF800000u;
          unsigned cnt = 0u;
#pragma unroll
          for (int ch = 0; ch < 4; ++ch) if (ch < nch) {
#pragma unroll
            for (int k2 = 0; k2 < 16; ++k2) cnt += (u[16 * ch + k2] >= trial) ? 1u : 0u;
          }
          cnt = wave_total_u(cnt);
          if (cnt >= 256u) { prefix = trial; startbit = 22; exact = (cnt == 256u); }
        }
        if (!exact) {
          for (int bit = startbit; bit >= 0; --bit) {
            const unsigned trial = prefix | (1u << bit);
            unsigned cnt = 0u;
#pragma unroll
            for (int ch = 0; ch < 4; ++ch) if (ch < nch) {
#pragma unroll
              for (int k2 = 0; k2 < 16; ++k2) cnt += (u[16 * ch + k2] >= trial) ? 1u : 0u;
            }
            cnt = wave_total_u(cnt);
            if (cnt >= 256u) prefix = trial;
            if (cnt == 256u) { exact = true; break; }
          }
        }
        if (exact) thr = prefix - 1u;
        else {
          thr = prefix; unsigned cgt = 0u;
#pragma unroll
          for (int j = 0; j < 64; ++j) cgt += (u[j] > thr) ? 1u : 0u;
          cgt = wave_total_u(cgt);
          const int need = 256 - (int)cgt;
          int tbf = 0;
#pragma unroll
          for (int ch = 0; ch < 4; ++ch) if (ch < nch) {
#pragma unroll
            for (int k2 = 0; k2 < 16; ++k2) { const int j = 16 * ch + k2; const bool eq = u[j] == thr; const unsigned long long m = __ballot(eq);
              const unsigned long long hit = __ballot(eq && (tbf + (int)lane_prefix(m) == need - 1));
              if (hit) sthr = 64 * j + __builtin_ctzll(hit);
              tbf += __builtin_popcountll(m); }
          }
        }
      }
#pragma unroll
      for (int ch = 0; ch < 4; ++ch) {
        if (ch < nch) {
#pragma unroll
          for (int k2 = 0; k2 < 16; ++k2) { const int j = 16 * ch + k2; const bool sel = (u[j] > thr) || (u[j] == thr && lane <= sthr - 64 * j); const unsigned long long m = __ballot(sel);
            if (lane == 0) *(LAS u32x2*)(msk32 + w * 128 + 2 * j) = (u32x2){(unsigned)m, (unsigned)(m >> 32)}; }
        } else if (lane < 16) *(LAS u32x2*)(msk32 + w * 128 + 2 * (16 * ch + lane)) = (u32x2){0u, 0u};
      }
    }
    __syncthreads();
    asm volatile("" ::: "memory"); __builtin_amdgcn_sched_barrier(0);
    DSA_T1(2)
    DSA_T0(3)
    {
      const int lane = lane_id_v(); const int c = lane & 31, half = lane >> 5, qc = c >> 2, hx = c & 3;
      const int tq = t0 + qc;
      const LAS unsigned char* qlds = F.lds + LDS_LIST + 4096 + lane * 16;
      f32x16 o00, o01, o10, o11;
#pragma unroll
      for (int i = 0; i < 16; ++i) { o00[i] = 0.f; o01[i] = 0.f; o10[i] = 0.f; o11[i] = 0.f; }
      float lsum0 = 0.f, lsum1 = 0.f;
      const bf16_t* kb = KF + ((size_t)b * 128 * 4 * 64 + lane) * 8;
      const bf16_t* vb = VTF + ((size_t)b * 128 * 4 * 64 + lane) * 8;
      const int Tlast = ntile - 1;
      auto ld2 = [&](bf16x8 (&kf)[4], bf16x8 (&vf)[4], int T) { const int Tc = T < Tlast ? T : Tlast;
#pragma unroll
        for (int ks = 0; ks < 4; ++ks) { kf[ks] = *(const bf16x8*)(kb + (size_t)(Tc * 4 + ks) * 512); vf[ks] = *(const bf16x8*)(vb + (size_t)(Tc * 4 + ks) * 512); } };
      auto cp2 = [&](const bf16x8 (&kf)[4], const bf16x8 (&vf)[4], int T) {
        const unsigned mw = msk32[qc * 128 + T] >> (4 * half);
#pragma unroll
        for (int cb = 0; cb < 2; ++cb) {
          bf16x8 qf[4];
#pragma unroll
          for (int ks = 0; ks < 4; ++ks) qf[ks] = *(const LAS bf16x8*)(qlds + (cb * 4 + ks) * 1024);
          f32x16 s;
#pragma unroll
          for (int i = 0; i < 16; ++i) s[i] = 0.f;
#pragma unroll
          for (int ks = 0; ks < 4; ++ks) s = __builtin_amdgcn_mfma_f32_32x32x16_bf16(kf[ks], qf[ks], s, 0, 0, 0);
          float ls = 0.f;
#pragma unroll
          for (int r = 0; r < 16; ++r) { const float p = ((mw >> ((r & 3) + 8 * (r >> 2))) & 1u) ? __builtin_amdgcn_exp2f(s[r] * c1 - c2) : 0.f; s[r] = p; ls += p; }
          if (cb == 0) lsum0 += ls; else lsum1 += ls;
#pragma unroll
          for (int st = 0; st < 2; ++st) {
            u32x4 pw; pw.x = pk2(s[8 * st], s[8 * st + 1]); pw.y = pk2(s[8 * st + 2], s[8 * st + 3]); pw.z = pk2(s[8 * st + 4], s[8 * st + 5]); pw.w = pk2(s[8 * st + 6], s[8 * st + 7]);
            const bf16x8 pf = __builtin_bit_cast(bf16x8, pw);
            if (cb == 0) { o00 = __builtin_amdgcn_mfma_f32_32x32x16_bf16(vf[2 * st], pf, o00, 0, 0, 0); o10 = __builtin_amdgcn_mfma_f32_32x32x16_bf16(vf[2 * st + 1], pf, o10, 0, 0, 0); }
            else { o01 = __builtin_amdgcn_mfma_f32_32x32x16_bf16(vf[2 * st], pf, o01, 0, 0, 0); o11 = __builtin_amdgcn_mfma_f32_32x32x16_bf16(vf[2 * st + 1], pf, o11, 0, 0, 0); }
          }
        } };
      bf16x8 ka[4], va[4], kb2[4], vb2[4];
      if (w < ntile) { ld2(ka, va, w); ld2(kb2, vb2, w + 8); }
      for (int T = w; T < ntile; T += 16) {
        cp2(ka, va, T); ld2(ka, va, T + 16); __builtin_amdgcn_sched_barrier(0);
        if (T + 8 < ntile) { cp2(kb2, vb2, T + 8); ld2(kb2, vb2, T + 24); __builtin_amdgcn_sched_barrier(0); }
      }
      lsum0 += __shfl_xor(lsum0, 32); lsum1 += __shfl_xor(lsum1, 32);
      bf16_t* opb = MIX + (rb + tq) * DM + 512 + hx * 64 + 32 * (w >> 2) + 8 * (w & 3) + 4 * half;
#pragma unroll
      for (int cb = 0; cb < 2; ++cb) {
        LAS float* pw_ = part + w * (33 * 64) + lane;
        if (cb == 1) __syncthreads();
#pragma unroll
        for (int i = 0; i < 16; ++i) { pw_[i * 64] = cb == 0 ? o00[i] : o01[i]; pw_[(16 + i) * 64] = cb == 0 ? o10[i] : o11[i]; }
        pw_[32 * 64] = cb == 0 ? lsum0 : lsum1;
        __syncthreads();
        float a4[4] = {0.f, 0.f, 0.f, 0.f}; float lt = 0.f;
#pragma unroll
        for (int k8 = 0; k8 < 8; ++k8) { const LAS float* pr = part + k8 * (33 * 64) + lane;
#pragma unroll
          for (int i = 0; i < 4; ++i) a4[i] += pr[(4 * w + i) * 64];
          lt += pr[32 * 64]; }
        const float inv = 1.0f / lt;
        u32x2 w0; w0.x = pk2(a4[0] * inv, a4[1] * inv); w0.y = pk2(a4[2] * inv, a4[3] * inv); *(u32x2*)(opb + cb * 256) = w0;
      }
    }
    __syncthreads();
    DSA_T1(3)
  }
#ifdef TIMEDSA
  if (blockIdx.x == 0 && w == 0 && lane_id_v() == 0) { unsigned long long* tsw = (unsigned long long*)(P.ws + WS_CTL + 4096); tsw[0] = 0ull; tsw[1] = tacc; }
#endif
}

DI float fswap32_add(float a, float b) { const auto r = __builtin_amdgcn_permlane32_swap(__float_as_uint(a), __float_as_uint(b), false, false); return __uint_as_float(r[0]) + __uint_as_float(r[1]); }
DI float fswap16_add(float a, float b) { const auto r = __builtin_amdgcn_permlane16_swap(__float_as_uint(a), __float_as_uint(b), false, false); return __uint_as_float(r[0]) + __uint_as_float(r[1]); }
DI void tred64(float (&v)[64], int lane) {
#pragma unroll
  for (int i = 0; i < 32; ++i) v[i] = fswap32_add(v[i], v[i + 32]);
#pragma unroll
  for (int i = 0; i < 16; ++i) v[i] = fswap16_add(v[i], v[i + 16]);
#pragma unroll
  for (int i = 0; i < 8; ++i) { const bool up = lane & 8; const float keep = up ? v[i + 8] : v[i], send = up ? v[i] : v[i + 8]; v[i] = keep + __shfl_xor(send, 8); }
#pragma unroll
  for (int i = 0; i < 4; ++i) { const bool up = lane & 4; const float keep = up ? v[i + 4] : v[i], send = up ? v[i] : v[i + 4]; v[i] = keep + __shfl_xor(send, 4); }
#pragma unroll
  for (int i = 0; i < 2; ++i) { const bool up = lane & 2; const float keep = up ? v[i + 2] : v[i], send = up ? v[i] : v[i + 2]; v[i] = keep + __shfl_xor(send, 2); }
  { const bool up = lane & 1; const float keep = up ? v[1] : v[0], send = up ? v[0] : v[1]; v[0] = keep + __shfl_xor(send, 1); }
}
DI void tred8(float (&v)[8], int lane) {
#pragma unroll
  for (int i = 0; i < 4; ++i) v[i] = fswap32_add(v[i], v[i + 4]);
#pragma unroll
  for (int i = 0; i < 2; ++i) v[i] = fswap16_add(v[i], v[i + 2]);
  { const bool up = lane & 8; const float keep = up ? v[1] : v[0], send = up ? v[0] : v[1]; v[0] = keep + __shfl_xor(send, 8); }
  v[0] += __shfl_xor(v[0], 4); v[0] += __shfl_xor(v[0], 2); v[0] += __shfl_xor(v[0], 1);
}
#define RDL(v, l) __int_as_float(__builtin_amdgcn_readlane(__float_as_int(v), (l)))
DI float wave_sum_dpp(float v) {
  v += __int_as_float(__builtin_amdgcn_update_dpp(0, __float_as_int(v), 0xB1, 0xF, 0xF, true));
  v += __int_as_float(__builtin_amdgcn_update_dpp(0, __float_as_int(v), 0x4E, 0xF, 0xF, true));
  v += __int_as_float(__builtin_amdgcn_update_dpp(0, __float_as_int(v), 0x124, 0xF, 0xF, true));
  v += __int_as_float(__builtin_amdgcn_update_dpp(0, __float_as_int(v), 0x128, 0xF, 0xF, true));
  return (RDL(v, 0) + RDL(v, 16)) + (RDL(v, 32) + RDL(v, 48));
}
DI void route_one(const float (&lg)[36], int& x0, int& x1, float& g0, float& g1) {
  int gs = 0; float gm = lg[0];
#pragma unroll
  for (int j = 1; j < 4; ++j) if (lg[j] > gm) { gm = lg[j]; gs = j; }
  float z = 0.f;
#pragma unroll
  for (int j = 0; j < 4; ++j) z += __expf(lg[j] - gm);
  const float pg = 1.0f / z;
  float le[8];
#pragma unroll
  for (int i = 0; i < 8; ++i) le[i] = gs == 0 ? lg[4 + i] : (gs == 1 ? lg[12 + i] : (gs == 2 ? lg[20 + i] : lg[28 + i]));
  int i0e = 0; float m0 = le[0];
#pragma unroll
  for (int i = 1; i < 8; ++i) if (le[i] > m0) { m0 = le[i]; i0e = i; }
  int i1e = -1; float m1 = -INFINITY;
#pragma unroll
  for (int i = 0; i < 8; ++i) if (i != i0e && le[i] > m1) { m1 = le[i]; i1e = i; }
  const float e1 = __expf(m1 - m0);
  g0 = pg / (1.0f + e1); g1 = pg * e1 / (1.0f + e1);
  x0 = gs * 8 + i0e; x1 = gs * 8 + i1e;
}
DI void router_phase(const Ctx& F, const Params& P, int L) {
  unsigned char* ws = P.ws;
  LAS float* wl = (LAS float*)F.lds;
  LAS int* lcnt = (LAS int*)(F.lds + 147456);
  LAS int* lbase = lcnt + 32;
  LAS i32x4* lasg = (LAS i32x4*)(F.lds + 147456 + 256);
  const float* wrg = (const float*)(ws + (L ? WS_WR1 : WS_WR0));
  const int lane = lane_id_v(); const int tid = F.wave * 64 + lane;
  for (int i = tid; i < 36 * 1024 / 4; i += 512) ((LAS f32x4*)wl)[i] = ((const f32x4*)wrg)[i];
  int* cnt = (int*)(ws + WS_CTL) + L * 64; int* list = (int*)(ws + WS_LIST);
  int4* asg = (int4*)(ws + WS_ASG); float2* asgg = (float2*)(ws + WS_ASGG);
  bf16_t* XN = (bf16_t*)(ws + WS_XN);
  const int niter = (NTOK + F.NGW - 1) / F.NGW;
  for (int i0 = 0; i0 < niter; i0 += 32) {
    if (tid < 32) lcnt[tid] = 0;
    __syncthreads();
    for (int i2 = 0; i2 < 32; i2 += 2) {
      if (i0 + i2 >= niter) break;
      int mk[2]; bool okk[2];
#pragma unroll
      for (int k = 0; k < 2; ++k) { const int m = F.gw + (i0 + i2 + k) * F.NGW; okk[k] = (i0 + i2 + k < niter) && (m < NTOK); mk[k] = okk[k] ? m : F.gw; }
      f32x4 v[2][4]; float rstd[2];
#pragma unroll
      for (int k = 0; k < 2; ++k) { const f32x4* xr = (const f32x4*)(P.out + (size_t)mk[k] * DM) + lane; float ss = 0.f;
#pragma unroll
        for (int j = 0; j < 4; ++j) { v[k][j] = xr[64 * j]; ss += (v[k][j].x * v[k][j].x + v[k][j].y * v[k][j].y) + (v[k][j].z * v[k][j].z + v[k][j].w * v[k][j].w); }
        rstd[k] = 1.0f / sqrtf(wave_sum_dpp(ss) * (1.f / DM) + NORM_EPS); }
#pragma unroll
      for (int k = 0; k < 2; ++k) if (okk[k]) { unsigned long long* o8 = (unsigned long long*)(XN + (size_t)mk[k] * DM) + lane;
#pragma unroll
        for (int j = 0; j < 4; ++j) o8[64 * j] = (unsigned long long)pk2(v[k][j].x * rstd[k], v[k][j].y * rstd[k]) | ((unsigned long long)pk2(v[k][j].z * rstd[k], v[k][j].w * rstd[k]) << 32); }
      float va[64], vb[8];
#pragma unroll
      for (int jc = 0; jc < 36; ++jc) {
        f32x4 w4[4];
#pragma unroll
        for (int j = 0; j < 4; ++j) w4[j] = *(const LAS f32x4*)(wl + jc * 1024 + 256 * j + 4 * lane);
#pragma unroll
        for (int k = 0; k < 2; ++k) { float a = 0.f;
#pragma unroll
          for (int j = 0; j < 4; ++j) a += (v[k][j].x * w4[j].x + v[k][j].y * w4[j].y) + (v[k][j].z * w4[j].z + v[k][j].w * w4[j].w);
          const int idx = k * 36 + jc; if (idx < 64) va[idx] = a; else vb[idx - 64] = a; }
        if ((jc & 1) == 1) asm volatile("" ::: "memory");
      }
      tred64(va, lane); tred8(vb, lane);
      const int zv = opaque(0);
      float lg0[36], lg1[36];
#pragma unroll
      for (int jc = 0; jc < 36; ++jc) {
        const float bias = wrg[36 * 1024 + jc + zv];
        { float t = RDL(va[0], jc) * rstd[0] + bias; asm volatile("" : "+v"(t)); lg0[jc] = t; }
        { const int idx = 36 + jc; const float tot = idx < 64 ? RDL(va[0], idx < 64 ? idx : 0) : RDL(vb[0], idx >= 64 ? 8 * (idx - 64) : 0); float t = tot * rstd[1] + bias; asm volatile("" : "+v"(t)); lg1[jc] = t; }
      }
#define ROUTE_K(k, LG) { int x0, x1; float g0, g1; route_one(LG, x0, x1, g0, g1); \
        if (lane == 0 && okk[k]) { \
          const int r0 = __hip_atomic_fetch_add(lcnt + x0, 1, __ATOMIC_RELAXED, __HIP_MEMORY_SCOPE_WORKGROUP); \
          const int r1 = __hip_atomic_fetch_add(lcnt + x1, 1, __ATOMIC_RELAXED, __HIP_MEMORY_SCOPE_WORKGROUP); \
          lasg[(i2 + k) * 8 + F.wave] = (i32x4){x0, x1, r0, r1}; asgg[mk[k]] = make_float2(g0, g1); } }
      ROUTE_K(0, lg0) ROUTE_K(1, lg1)
#undef ROUTE_K
    }
    __syncthreads();
    if (tid < 32) lbase[tid] = atomicAdd(cnt + tid, lcnt[tid]);
    __syncthreads();
    if (tid < 256) {
      const int ii = tid >> 3, wv = tid & 7; const int m = (int)blockIdx.x * 8 + wv + (i0 + ii) * F.NGW;
      if (i0 + ii < niter && m < NTOK) {
        const i32x4 a = lasg[tid]; const int r0 = lbase[a.x] + a.z, r1 = lbase[a.y] + a.w;
        list[a.x * 65536 + r0] = m; list[a.y * 65536 + r1] = m; asg[m] = make_int4(a.x, a.y, r0, r1);
      }
    }
    __syncthreads();
  }
}
DI void moe_setup(const Ctx& F, const Params& P, int L) {
  LAS int* pb = (LAS int*)(F.lds + LDS_MISC); LAS int* cl = pb + 64;
  const int* cnt = (const int*)(P.ws + WS_CTL) + L * 64;
  const int tid = F.wave * 64 + lane_id_v();
  __syncthreads();
  if (tid < 32) cl[tid] = cnt[tid];
  __syncthreads();
  if (tid == 0) { int a = 0; for (int e = 0; e < NEXP; ++e) { pb[e] = a; a += (cl[e] + 255) >> 8; } pb[NEXP] = a; }
  __syncthreads();
}
DI void combine_phase(const Ctx& F, const Params& P, int L, bool with_norm) {
  unsigned char* ws = P.ws;
  moe_setup(F, P, L);
  const LAS int* pb = (const LAS int*)(F.lds + LDS_MISC);
  const int4* asg = (const int4*)(ws + WS_ASG); const float2* asgg = (const float2*)(ws + WS_ASGG);
  const bf16_t* Y = (const bf16_t*)(ws + WS_PROJ); bf16_t* XN = (bf16_t*)(ws + WS_XN);
  const int lane = lane_id_v();
  for (int m = F.gw; m < NTOK; m += F.NGW) {
    const int4 a = asg[m]; const float2 gg = asgg[m];
    const size_t row0 = (size_t)pb[a.x] * 256 + a.z, row1 = (size_t)pb[a.y] * 256 + a.w;
    f32x4* xr = (f32x4*)(P.out + (size_t)m * DM) + lane;
    const u32x2* y0 = (const u32x2*)(Y + row0 * DM) + lane; const u32x2* y1 = (const u32x2*)(Y + row1 * DM) + lane;
    f32x4 v[4]; float ss = 0.f;
#pragma unroll
    for (int j = 0; j < 4; ++j) { f32x4 x = xr[64 * j]; const u32x2 a0 = y0[64 * j], a1 = y1[64 * j];
      x.x += gg.x * bflo(a0.x) + gg.y * bflo(a1.x); x.y += gg.x * bfhi(a0.x) + gg.y * bfhi(a1.x); x.z += gg.x * bflo(a0.y) + gg.y * bflo(a1.y); x.w += gg.x * bfhi(a0.y) + gg.y * bfhi(a1.y);
      xr[64 * j] = x; v[j] = x; ss += (x.x * x.x + x.y * x.y) + (x.z * x.z + x.w * x.w); }
    if (with_norm) {
      const float rstd = 1.0f / sqrtf(wave_sum(ss) * (1.f / DM) + NORM_EPS);
      unsigned long long* o8 = (unsigned long long*)(XN + (size_t)m * DM) + lane;
#pragma unroll
      for (int j = 0; j < 4; ++j) o8[64 * j] = (unsigned long long)pk2(v[j].x * rstd, v[j].y * rstd) | ((unsigned long long)pk2(v[j].z * rstd, v[j].w * rstd) << 32);
    }
  }
}
DI void moe_gemms(const Ctx& F, const Params& P, int L, cg::grid_group& grid) {
  unsigned char* ws = P.ws;
  const int vcu = (F.G % 8 == 0) ? ((int)(blockIdx.x % 8) * (F.G / 8) + (int)(blockIdx.x / 8)) : (int)blockIdx.x;
  moe_setup(F, P, L);
  {
    pg8::MoeSched<true> S{(const LAS int*)(F.lds + LDS_MISC), (const LAS int*)(F.lds + LDS_MISC) + 64, (const int*)(ws + WS_LIST), (const char*)(ws + (L ? WS_WGU1 : WS_WGU0)), F.G, vcu, 1024};
    pg8::EpiSwiGLU E{(bf16_t*)(ws + WS_H)};
    pg8::gemm_phase<pg8::EpiSwiGLU, pg8::MoeSched<true>, true>(F.lds, F.wave, (const char*)(ws + WS_XN), 1024, S, E);
  }
  grid.sync();
  {
    pg8::MoeSched<false> S{(const LAS int*)(F.lds + LDS_MISC), (const LAS int*)(F.lds + LDS_MISC) + 64, nullptr, (const char*)(ws + (L ? WS_WD1 : WS_WD0)), F.G, vcu, 512};
    pg8::EpiBf16 E{(bf16_t*)(ws + WS_PROJ), DM};
    pg8::gemm_phase<pg8::EpiBf16, pg8::MoeSched<false>, true>(F.lds, F.wave, (const char*)(ws + WS_H), 512, S, E);
  }
}

DI void p8b_transform1(const Ctx& F, const Params& P) {
  bf16_t* QKV = (bf16_t*)(P.ws + WS_PROJ);
  const float* cosT = (const float*)(P.ws + WS_ROPE); const float* sinT = cosT + SEQ * 32;
  const int lane = lane_id_v(), sub = lane & 7, grp = lane >> 3;
  for (int m = F.gw; m < NTOK; m += F.NGW) {
    const int t = m & (SEQ - 1);
    bf16_t* row = QKV + (size_t)m * W1;
    const float* cr = cosT + t * 32; const float* sr = sinT + t * 32;
    head_normrope(row + grp * 64 + sub * 8, P.in[I_QN1], true, cr, sr, sub);
    head_normrope(row + 512 + grp * 64 + sub * 8, P.in[I_QN1], true, cr, sr, sub);
    if (grp < 4) head_normrope(row + 1024 + grp * 64 + sub * 8, P.in[I_KN1], true, cr, sr, sub);
  }
}

DI void dil_phase(const Ctx& F, const Params& P) {
  const bf16_t* QKV = (const bf16_t*)(P.ws + WS_PROJ); bf16_t* MIX = (bf16_t*)(P.ws + WS_MIX);
  LAS unsigned char* vst = F.lds + F.wave * 8192;
  const int lane = lane_id_v(), c = lane & 31, half = lane >> 5, qi = c >> 2, gq = c & 3;
  const float cshift = 8.f * wave_max(fabsf(P.in[I_QN1][lane])) * wave_max(fabsf(P.in[I_KN1][lane])) * 1.02f;
  const float c1 = 0.125f * LOG2E, c2 = cshift * LOG2E;
  const int q4 = (lane & 15) >> 2, p4 = lane & 3, blk = (lane >> 4) & 1;
  for (int it = F.gw; it < 32768; it += F.NGW) {
    const int r = it & 15, tile = (it >> 4) & 31, kh = (it >> 9) & 3, b = it >> 11;
    const size_t rb = (size_t)b * SEQ; const int tmax = tile * 128 + r + 112, tq = tile * 128 + r + 16 * qi;
    bf16x8 qf[4];
    { const bf16_t* qp = QKV + (rb + tq) * W1 + (4 * kh + gq) * 64 + 32 * half;
#pragma unroll
      for (int ks = 0; ks < 4; ++ks) qf[ks] = *(const bf16x8*)(qp + 8 * ks); }
    f32x16 o0, o1;
#pragma unroll
    for (int i = 0; i < 16; ++i) { o0[i] = 0.f; o1[i] = 0.f; }
    float lsum = 0.f;
#pragma unroll 1
    for (int pat = 0; pat < 3; ++pat) {
      const int sh = 2 * pat;
      const int ei = (16 >> sh) * (7 - qi);
      const int ntile = pat == 0 ? 8 : 5;
#pragma unroll 1
      for (int T = 0; T < ntile; ++T) {
        const int n = 32 * T + c; const int pos = tmax - (n << sh); const int posc = pos < 0 ? 0 : pos;
        const bf16_t* kp = QKV + (rb + posc) * W1 + 1024 + kh * 64 + 32 * half;
        bf16x8 kf[4]; u32x4 vv[4];
#pragma unroll
        for (int ks = 0; ks < 4; ++ks) kf[ks] = *(const bf16x8*)(kp + 8 * ks);
#pragma unroll
        for (int ks = 0; ks < 4; ++ks) vv[ks] = *(const u32x4*)(kp + 256 + 8 * ks);
#pragma unroll
        for (int ks = 0; ks < 4; ++ks) *(LAS u32x4*)(vst + c * 128 + 64 * half + 16 * ks) = vv[ks];
        f32x16 s;
#pragma unroll
        for (int i = 0; i < 16; ++i) s[i] = 0.f;
#pragma unroll
        for (int ks = 0; ks < 4; ++ks) s = __builtin_amdgcn_mfma_f32_32x32x16_bf16(kf[ks], qf[ks], s, 0, 0, 0);
#pragma unroll
        for (int reg = 0; reg < 16; ++reg) { const int nn = 32 * T + (reg & 3) + 8 * (reg >> 2) + 4 * half; const int ps = tmax - (nn << sh);
          const bool ok = (nn >= ei) && (nn <= ei + 128) && (ps >= 0);
          const float p = ok ? __builtin_amdgcn_exp2f(s[reg] * c1 - c2) : 0.f; s[reg] = p; lsum += p; }
        asm volatile("" ::: "memory");
#pragma unroll
        for (int st = 0; st < 2; ++st) {
          u32x4 pw; pw.x = pk2(s[8 * st], s[8 * st + 1]); pw.y = pk2(s[8 * st + 2], s[8 * st + 3]); pw.z = pk2(s[8 * st + 4], s[8 * st + 5]); pw.w = pk2(s[8 * st + 6], s[8 * st + 7]);
          const bf16x8 pf = __builtin_bit_cast(bf16x8, pw);
          const int r1 = 16 * st + 4 * half + q4;
#pragma unroll
          for (int dblk = 0; dblk < 2; ++dblk) {
            const int cb = (32 * dblk + 16 * blk + 4 * p4) * 2;
            const s16x4 lo = tr_read(vst + r1 * 128 + cb), hi = tr_read(vst + (r1 + 8) * 128 + cb);
            const bf16x8 vf = __builtin_shufflevector(lo, hi, 0, 1, 2, 3, 4, 5, 6, 7);
            if (dblk == 0) o0 = __builtin_amdgcn_mfma_f32_32x32x16_bf16(vf, pf, o0, 0, 0, 0); else o1 = __builtin_amdgcn_mfma_f32_32x32x16_bf16(vf, pf, o1, 0, 0, 0);
          }
        }
        asm volatile("" ::: "memory");
      }
    }
    lsum += __shfl_xor(lsum, 32);
    const float inv = 1.0f / lsum;
    bf16_t* op = MIX + (rb + tq) * DM + (4 * kh + gq) * 64 + 4 * half;
#pragma unroll
    for (int gI = 0; gI < 4; ++gI) {
      u32x2 w0; w0.x = pk2(o0[4 * gI] * inv, o0[4 * gI + 1] * inv); w0.y = pk2(o0[4 * gI + 2] * inv, o0[4 * gI + 3] * inv); *(u32x2*)(op + 8 * gI) = w0;
      u32x2 w1; w1.x = pk2(o1[4 * gI] * inv, o1[4 * gI + 1] * inv); w1.y = pk2(o1[4 * gI + 2] * inv, o1[4 * gI + 3] * inv); *(u32x2*)(op + 32 + 8 * gI) = w1;
    }
  }
}

__global__ void __launch_bounds__(512, 2) fwd_megakernel(Params P) {
  extern __shared__ __attribute__((aligned(16))) unsigned char lds_raw[];
  cg::grid_group grid = cg::this_grid();
  Ctx F; F.lds = (LAS unsigned char*)lds_raw; F.wave = __builtin_amdgcn_readfirstlane((int)threadIdx.x >> 6);
  F.G = gridDim.x; F.gw = blockIdx.x * 8 + F.wave; F.NGW = F.G * 8;
  unsigned char* ws = P.ws;

#ifndef PHMASK
#define PHMASK 0xFFFFFFFFu
#endif
#define PH(n) if ((PHMASK >> (n)) & 1u)
#if defined(TIMEDSA) && !defined(TIMEPH)
#define TIMEPH 99
#define TIMEN 1
#endif
#ifdef TIMEPH
  unsigned long long* tsw = (unsigned long long*)(ws + WS_CTL + 4096);
#define TS_BEGIN(n) if ((n) >= TIMEPH && (n) < TIMEPH + TIMEN && (n) == TIMEPH && blockIdx.x == 0 && threadIdx.x == 0) tsw[0] = __builtin_amdgcn_s_memrealtime();
#define TS_END(n) if ((n) == TIMEPH + TIMEN - 1 && blockIdx.x == 0 && threadIdx.x == 0) tsw[1] = __builtin_amdgcn_s_memrealtime();
#else
#define TS_BEGIN(n)
#define TS_END(n)
#endif
  TS_BEGIN(0)
  PH(0) p0_prologue(F, P);
  grid.sync();
  TS_END(0)
  TS_BEGIN(1)
  PH(1) {
    pg8::DenseSched S; S.init(NTOK, W0P, 1024, ws + WS_WIN0, F.G, (int)blockIdx.x);
    pg8::EpiBf16 E{(bf16_t*)(ws + WS_PROJ), W0P};
    pg8::gemm_phase<pg8::EpiBf16, pg8::DenseSched, true>(F.lds, F.wave, (const char*)(ws + WS_XN), 1024, S, E);
  }
  grid.sync();
  TS_END(1)
  TS_BEGIN(2)
  PH(2) p1b_transform0(F, P);
  grid.sync();
  TS_END(2)
  TS_BEGIN(3)
  PH(3) dsa_phase(F, P);
  grid.sync();
  TS_END(3)
  TS_BEGIN(4)
  PH(4) {
    pg8::DenseSched S; S.init(NTOK, 1024, 1024, ws + WS_WOUT0, F.G, (int)blockIdx.x);
    pg8::EpiResF32 E{P.in[I_X], P.out, DM};
    pg8::gemm_phase<pg8::EpiResF32, pg8::DenseSched, true>(F.lds, F.wave, (const char*)(ws + WS_MIX), 1024, S, E);
  }
  grid.sync();
  TS_END(4)
  TS_BEGIN(5)
  PH(5) router_phase(F, P, 0);
  grid.sync();
  TS_END(5)
  TS_BEGIN(6)
  PH(6) moe_gemms(F, P, 0, grid);
  grid.sync();
  TS_END(6)
  TS_BEGIN(7)
  PH(7) combine_phase(F, P, 0, true);
  grid.sync();
  TS_END(7)
  TS_BEGIN(8)
  PH(8) {
    pg8::DenseSched S; S.init(NTOK, W1, 1024, ws + WS_WIN1, F.G, (int)blockIdx.x);
    pg8::EpiBf16 E{(bf16_t*)(ws + WS_PROJ), W1};
    pg8::gemm_phase<pg8::EpiBf16, pg8::DenseSched, true>(F.lds, F.wave, (const char*)(ws + WS_XN), 1024, S, E);
  }
  grid.sync();
  TS_END(8)
  TS_BEGIN(9)
  PH(9) p8b_transform1(F, P);
  grid.sync();
  TS_END(9)
  TS_BEGIN(10)
  PH(10) dil_phase(F, P);
  grid.sync();
  TS_END(10)
  TS_BEGIN(11)
  PH(11) {
    pg8::DenseSched S; S.init(NTOK, 1024, 1024, ws + WS_WOUT1, F.G, (int)blockIdx.x);
    pg8::EpiResF32 E{P.out, P.out, DM};
    pg8::gemm_phase<pg8::EpiResF32, pg8::DenseSched, true>(F.lds, F.wave, (const char*)(ws + WS_MIX), 1024, S, E);
  }
  grid.sync();
  TS_END(11)
  TS_BEGIN(12)
  PH(12) router_phase(F, P, 1);
  grid.sync();
  TS_END(12)
  TS_BEGIN(13)
  PH(13) moe_gemms(F, P, 1, grid);
  grid.sync();
  TS_END(13)
  TS_BEGIN(14)
  PH(14) combine_phase(F, P, 1, false);
#ifdef TIMEPH
  grid.sync();
  TS_END(14)
  grid.sync();
  { const unsigned long long dt = (tsw[1] - tsw[0]) * 4ull; const unsigned long long t0 = __builtin_amdgcn_s_memrealtime();
    while (__builtin_amdgcn_s_memrealtime() - t0 < dt) __builtin_amdgcn_s_sleep(32); }
#endif
}

extern "C" void kernel_launch(void* const* d_in, const int* in_sizes, int n_in, void* d_out, int out_size, void* d_ws, size_t ws_size, hipStream_t stream) {
  static int grid_blocks = 0;
  if (!grid_blocks) {
    if (n_in != 28 || out_size != NTOK * DM || ws_size < WS_END) { fprintf(stderr, "kernel_launch: unexpected shapes (n_in %d out %d ws %zu)\n", n_in, out_size, ws_size); grid_blocks = -1; return; }
    int dev = 0, cus = 0, per_cu = 0;
    (void)hipGetDevice(&dev);
    (void)hipDeviceGetAttribute(&cus, hipDeviceAttributeMultiprocessorCount, dev);
    (void)hipFuncSetAttribute((const void*)fwd_megakernel, hipFuncAttributeMaxDynamicSharedMemorySize, LDS_BYTES);
    (void)hipOccupancyMaxActiveBlocksPerMultiprocessor(&per_cu, (const void*)fwd_megakernel, 512, LDS_BYTES);
    if (per_cu < 1) per_cu = 1;
    grid_blocks = cus * per_cu;
  }
  if (grid_blocks < 0) return;
  Params p{};
  for (int i = 0; i < 28; ++i) p.in[i] = (const float*)d_in[i];
  p.out = (float*)d_out; p.ws = (unsigned char*)d_ws;
  void* args[] = {&p};
  hipError_t e = hipLaunchCooperativeKernel((const void*)fwd_megakernel, dim3(grid_blocks), dim3(512), args, LDS_BYTES, stream);
  if (e != hipSuccess) fprintf(stderr, "cooperative launch failed: %s (grid %d)\n", hipGetErrorString(e), grid_blocks);
}
```

```cpp
#include <hip/hip_runtime.h>
#include <hip/hip_cooperative_groups.h>
#include <cstdio>
#include <cstdint>
namespace cg = cooperative_groups;

#define LAS __attribute__((address_space(3)))
#define DI __device__ __forceinline__
typedef unsigned short bf16_t;
typedef short bf16x8 __attribute__((ext_vector_type(8)));
typedef short s16x4 __attribute__((ext_vector_type(4)));
typedef float f32x2 __attribute__((ext_vector_type(2)));
typedef float f32x4 __attribute__((ext_vector_type(4)));
typedef float f32x16 __attribute__((ext_vector_type(16)));
typedef unsigned u32x2 __attribute__((ext_vector_type(2)));
typedef unsigned u32x4 __attribute__((ext_vector_type(4)));
typedef int i32x4 __attribute__((ext_vector_type(4)));
typedef __bf16 bf16x2_t __attribute__((ext_vector_type(2)));

constexpr int NTOK = 65536, DM = 1024, SEQ = 4096, NBATCH = 16;
constexpr int W0P = 2560, W0V = 2500;
constexpr int W1 = 1536;
constexpr int C_CB = 0, C_CC = 512, C_CH = 1024, C_Q = 1536, C_K = 2048, C_V = 2112, C_IQ = 2176, C_IK = 2432, C_IW = 2496;
constexpr int NEXP = 32, DEXP = 512;
constexpr int MAXROWS = 139264;
constexpr float NORM_EPS = 1e-6f;
constexpr float LOG2E = 1.4426950408889634f;

constexpr size_t MiB = 1u << 20;
constexpr size_t WS_CTL = 0;
constexpr size_t WS_ROPE = 1 * MiB;
constexpr size_t WS_WR0 = 2 * MiB, WS_WR1 = 2 * MiB + 256 * 1024;
constexpr size_t WS_WIN0 = 3 * MiB, WS_WOUT0 = 8 * MiB, WS_WIN1 = 10 * MiB, WS_WOUT1 = 13 * MiB;
constexpr size_t WS_WGU0 = 16 * MiB, WS_WD0 = 80 * MiB, WS_WGU1 = 112 * MiB, WS_WD1 = 176 * MiB;
constexpr size_t WS_XN = 208 * MiB;
constexpr size_t WS_MIX = 337 * MiB;
constexpr size_t WS_H = 465 * MiB;
constexpr size_t WS_PROJ = 601 * MiB;
constexpr size_t WS_LIST = 921 * MiB;
constexpr size_t WS_ASG = 929 * MiB;
constexpr size_t WS_ASGG = 930 * MiB;
constexpr size_t WS_IKF = 931 * MiB, WS_KF = 939 * MiB, WS_VTF = 947 * MiB;
constexpr size_t WS_END = 955 * MiB;

constexpr int LDS_BYTES = 155648;
constexpr int LDS_LIST = 131072;
constexpr int LDS_MISC = 131072 + 16384;

DI unsigned pk2(float lo, float hi) { f32x2 v = {lo, hi}; bf16x2_t b = __builtin_convertvector(v, bf16x2_t); return __builtin_bit_cast(unsigned, b); }
DI float bflo(unsigned w) { return __uint_as_float(w << 16); }
DI float bfhi(unsigned w) { return __uint_as_float(w & 0xffff0000u); }
DI float bf1(bf16_t h) { return __uint_as_float((unsigned)h << 16); }
DI int opaque(int x) { asm volatile("" : "+v"(x)); return x; }
DI int lane_id_v() { int l; asm volatile("v_mbcnt_lo_u32_b32 %0, -1, 0\n\tv_mbcnt_hi_u32_b32 %0, -1, %0" : "=v"(l)); return l; }
DI float wave_sum(float v) {
#pragma unroll
  for (int o = 1; o < 64; o <<= 1) v += __shfl_xor(v, o);
  return v;
}
DI float wave_max(float v) {
#pragma unroll
  for (int o = 1; o < 64; o <<= 1) v = fmaxf(v, __shfl_xor(v, o));
  return v;
}
DI unsigned wave_sum_u(unsigned v) {
#pragma unroll
  for (int o = 1; o < 64; o <<= 1) v += (unsigned)__shfl_xor((int)v, o);
  return v;
}

namespace pg8 {
constexpr int BM = 256, BK = 64, HALF = 128, HTB = HALF * BK * 2, STAGE_BYTES = 8 * HTB, NXCD = 8, WGM = 8;
DI int lds_byte(int r, int c) { const int st = (r >> 4) * 2 + (c >> 5), rr = r & 15, cc = c & 31, ob = rr * 64 + cc * 2; return st * 1024 + (ob ^ (((ob >> 9) & 1) << 5)); }
DI void stage_rc(int b, int& R, int& C) { const int st = b / 1024, sb = b % 1024, swz = sb ^ (((sb >> 9) & 1) << 5); R = (st >> 1) * 16 + swz / 64; C = (st & 1) * 32 + (swz % 64) / 2; }
DI int perm32(int rho) { const int n = rho >> 4, i = rho & 15; return 8 * (i >> 2) + 4 * n + (i & 3); }

struct Unit { const char* b; int p0, p1, p2, p3; };

struct EpiBf16 {
  static constexpr bool PERM = true;
  bf16_t* O; int ldc;
  DI void operator()(const f32x4 (&acc)[2][2][4][2], const Unit& u, int wr, int wc, int fr, int fq) const {
    const int row0 = u.p0 + wr * 64 + fr, col0 = u.p1 + wc * 32 + 8 * fq;
#pragma unroll
    for (int ai = 0; ai < 2; ++ai)
#pragma unroll
      for (int m = 0; m < 4; ++m) { bf16_t* rowp = O + (size_t)(row0 + ai * HALF + m * 16) * ldc + col0;
#pragma unroll
        for (int bj = 0; bj < 2; ++bj) { const f32x4 v0 = acc[ai][bj][m][0], v1 = acc[ai][bj][m][1];
          u32x4 w; w.x = pk2(v0[0], v0[1]); w.y = pk2(v0[2], v0[3]); w.z = pk2(v1[0], v1[1]); w.w = pk2(v1[2], v1[3]);
          *(u32x4*)(rowp + bj * HALF) = w; } }
  }
};
struct EpiResF32 {
  static constexpr bool PERM = false;
  const float* base; float* out; int ldc;
  DI void operator()(const f32x4 (&acc)[2][2][4][2], const Unit& u, int wr, int wc, int fr, int fq) const {
    const int row0 = u.p0 + wr * 64 + fr, col0 = u.p1 + wc * 32 + 4 * fq;
#pragma unroll
    for (int ai = 0; ai < 2; ++ai)
#pragma unroll
      for (int m = 0; m < 4; ++m) { const size_t off = (size_t)(row0 + ai * HALF + m * 16) * ldc + col0;
#pragma unroll
        for (int bj = 0; bj < 2; ++bj)
#pragma unroll
          for (int n = 0; n < 2; ++n) { const f32x4 bs = *(const f32x4*)(base + off + bj * HALF + n * 16); *(f32x4*)(out + off + bj * HALF + n * 16) = bs + acc[ai][bj][m][n]; } }
  }
};
DI float silu_mul(float g, float u) { return g * u * __builtin_amdgcn_rcpf(1.0f + __builtin_amdgcn_exp2f(-g * LOG2E)); }
struct EpiSwiGLU {
  static constexpr bool PERM = true;
  bf16_t* H;
  DI void operator()(const f32x4 (&acc)[2][2][4][2], const Unit& u, int wr, int wc, int fr, int fq) const {
    const int row0 = u.p0 + wr * 64 + fr, col0 = u.p1 + wc * 32 + 8 * fq;
#pragma unroll
    for (int ai = 0; ai < 2; ++ai)
#pragma unroll
      for (int m = 0; m < 4; ++m) { bf16_t* rowp = H + (size_t)(row0 + ai * HALF + m * 16) * DEXP + col0;
        const f32x4 g0 = acc[ai][0][m][0], g1 = acc[ai][0][m][1], u0 = acc[ai][1][m][0], u1 = acc[ai][1][m][1];
        u32x4 w; w.x = pk2(silu_mul(g0[0], u0[0]), silu_mul(g0[1], u0[1])); w.y = pk2(silu_mul(g0[2], u0[2]), silu_mul(g0[3], u0[3]));
        w.z = pk2(silu_mul(g1[0], u1[0]), silu_mul(g1[1], u1[1])); w.w = pk2(silu_mul(g1[2], u1[2]), silu_mul(g1[3], u1[3]));
        *(u32x4*)rowp = w; }
  }
};

struct DenseSched {
  static constexpr bool NEXT_IN_LDS = false;
  int nM, nN, nwg, G, c, K; const char* Bt;
  DI void init(int M, int N, int K_, const void* Bt_, int G_, int c_) { nM = M / BM; nN = N / BM; nwg = nM * nN; G = G_; c = c_; K = K_; Bt = (const char*)Bt_; }
  DI bool next(int i, Unit& u) const {
    const long L = (long)i * G + c; if (L >= nwg) return false;
    int wgid = (int)L; { const int q = nwg / NXCD, r = nwg % NXCD, xcd = wgid % NXCD, off = wgid / NXCD; wgid = (xcd < r ? xcd * (q + 1) : r * (q + 1) + (xcd - r) * q) + off; }
    const int nig = WGM * nN, gid = wgid / nig, fm = gid * WGM, gsz = (nM - fm) < WGM ? (nM - fm) : WGM;
    const int pm = fm + ((wgid % nig) % gsz), pn = (wgid % nig) / gsz;
    u.p0 = pm * BM; u.p1 = pn * BM; u.p2 = 0; u.p3 = 0; u.b = Bt + (size_t)pn * BM * K * 2; return true;
  }
  DI void a_off(const Unit& u, const int (&R)[2], const int (&C)[2], unsigned (&o)[2][2]) const {
#pragma unroll
    for (int h = 0; h < 2; ++h)
#pragma unroll
      for (int i = 0; i < 2; ++i) o[h][i] = (unsigned)((u.p0 + h * HALF + R[i]) * K + C[i]) * 2u;
  }
};
template <bool GATHER> struct MoeSched {
  static constexpr bool NEXT_IN_LDS = GATHER;
  const LAS int* pb; const LAS int* cnt; const int* list; const char* W; int G, c, K;
  DI bool next(int i, Unit& u) const {
    const int L = i * G + c; const int total = __builtin_amdgcn_readfirstlane(pb[NEXP]) * 4; if (L >= total) return false;
    const int rbg = L >> 2, pn = L & 3; int e = 0;
    for (int j = 1; j < NEXP; ++j) e = (__builtin_amdgcn_readfirstlane(pb[j]) <= rbg) ? j : e;
    u.p0 = rbg * BM; u.p1 = pn * (GATHER ? 128 : 256); u.p2 = e; u.p3 = rbg - __builtin_amdgcn_readfirstlane(pb[e]);
    u.b = W + (size_t)(e * 1024 + pn * 256) * K * 2; return true;
  }
  DI void a_off(const Unit& u, const int (&R)[2], const int (&C)[2], unsigned (&o)[2][2]) const {
    if (GATHER) {
      const int ce = __builtin_amdgcn_readfirstlane(cnt[u.p2]);
#pragma unroll
      for (int h = 0; h < 2; ++h)
#pragma unroll
        for (int i = 0; i < 2; ++i) { const int row = u.p3 * BM + h * HALF + R[i]; const int tok = (row < ce) ? list[u.p2 * 65536 + row] : NTOK; o[h][i] = (unsigned)(tok * K + C[i]) * 2u; }
    } else {
#pragma unroll
      for (int h = 0; h < 2; ++h)
#pragma unroll
        for (int i = 0; i < 2; ++i) o[h][i] = (unsigned)((u.p0 + h * HALF + R[i]) * K + C[i]) * 2u;
    }
  }
};

template <class Epi, class Sched, bool ALIGN_EPI>
DI void gemm_phase(LAS unsigned char* lds, const int wave_id, const char* gA, const int K, const Sched& S, const Epi& E) {
  const int lane = lane_id_v(), wid = wave_id, tid = wid * 64 + lane, wr = wid >> 2, wc = wid & 3, fr = lane & 15, fq = lane >> 4;
  const int nt = K / BK;
  unsigned voffB[2];
  { int R, C; stage_rc(tid * 16, R, C);
    const int Rb = Epi::PERM ? ((R & ~31) + perm32(R & 31)) : R; voffB[0] = (unsigned)(Rb * K + C) * 2u; voffB[1] = voffB[0] + (unsigned)(64 * K * 2); }
#define PG8_RC(Rp, Cp) int Rp[2], Cp[2]; { int R_, C_; stage_rc(opaque(tid) * 16, R_, C_); Rp[0] = R_; Cp[0] = C_; Rp[1] = R_ + 64; Cp[1] = C_; }
  const size_t kstep = (size_t)(BK * 2);
  const size_t hstep = (size_t)HALF * K * 2;
  const unsigned ldsw = (unsigned)wid * 1024u;
  const int aoff = lds_byte(wr * 64 + fr, fq * 8), boff = lds_byte(wc * 32 + fr, fq * 8);
#define PG8_SA(b, h) (((b) * 2 + (h)) * HTB)
#define PG8_SB(b, h) ((4 + (b) * 2 + (h)) * HTB)
#define PG8_STAGE_B(bufoff, gbase) do { _Pragma("unroll") for (int _i = 0; _i < 2; ++_i) \
    __builtin_amdgcn_global_load_lds((const unsigned*)((const char*)(gbase) + voffB[_i]), (LAS unsigned*)(lds + (bufoff) + ldsw + _i * 8192), 16, 0, 0); } while (0)
#define PG8_STAGE_A(bufoff, kb, offs) do { _Pragma("unroll") for (int _i = 0; _i < 2; ++_i) \
    __builtin_amdgcn_global_load_lds((const unsigned*)(gA + (size_t)(kb) + (offs)[_i]), (LAS unsigned*)(lds + (bufoff) + ldsw + _i * 8192), 16, 0, 0); } while (0)
#define PG8_LDA(dst, b, h) do { _Pragma("unroll") for (int m = 0; m < 4; ++m) _Pragma("unroll") for (int k = 0; k < 2; ++k) dst[m][k] = *(const LAS bf16x8*)(lds + PG8_SA(b, h) + aoff + m * 2048 + k * 1024); } while (0)
#define PG8_LDB(dst, b, h) do { _Pragma("unroll") for (int n = 0; n < 2; ++n) _Pragma("unroll") for (int k = 0; k < 2; ++k) dst[n][k] = *(const LAS bf16x8*)(lds + PG8_SB(b, h) + boff + n * 2048 + k * 1024); } while (0)
#define PG8_MMA(ai, bj, At, Bt) do { __builtin_amdgcn_s_setprio(1); _Pragma("unroll") for (int m = 0; m < 4; ++m) _Pragma("unroll") for (int n = 0; n < 2; ++n) _Pragma("unroll") for (int k = 0; k < 2; ++k) \
    acc[ai][bj][m][n] = __builtin_amdgcn_mfma_f32_16x16x32_bf16(Bt[n][k], At[m][k], acc[ai][bj][m][n], 0, 0, 0); __builtin_amdgcn_s_setprio(0); } while (0)
#define PG8_WAIT_V(n) asm volatile("s_waitcnt vmcnt(" #n ")" ::: "memory")
#define PG8_WAIT_L(n) asm volatile("s_waitcnt lgkmcnt(" #n ")" ::: "memory")
#define PG8_BAR __builtin_amdgcn_s_barrier()
#define PG8_SCHED __builtin_amdgcn_sched_barrier(0)
  Unit cur, nxt; int ui = 0;
  if (!S.next(0, cur)) return;
  unsigned ca[2][2];
  { PG8_RC(Rp, Cp) S.a_off(cur, Rp, Cp, ca); }
  f32x4 acc[2][2][4][2];
#pragma unroll
  for (int a = 0; a < 2; ++a)
#pragma unroll
    for (int b = 0; b < 2; ++b)
#pragma unroll
      for (int m = 0; m < 4; ++m)
#pragma unroll
        for (int n = 0; n < 2; ++n) acc[a][b][m][n] = (f32x4){0.f, 0.f, 0.f, 0.f};
  bf16x8 At[4][2], B0[2][2], B1[2][2];
  const char* cB = cur.b;
  PG8_STAGE_B(PG8_SB(0, 0), cB); PG8_STAGE_B(PG8_SB(0, 1), cB + hstep); PG8_STAGE_A(PG8_SA(0, 0), 0, ca[0]); PG8_STAGE_A(PG8_SA(0, 1), 0, ca[1]);
  if (wr == 1) PG8_BAR;
  PG8_WAIT_V(2); PG8_BAR;
  PG8_STAGE_B(PG8_SB(1, 0), cB + kstep); PG8_STAGE_A(PG8_SA(1, 0), kstep, ca[0]); PG8_STAGE_B(PG8_SB(1, 1), cB + hstep + kstep);
  PG8_WAIT_V(6); PG8_BAR;
  for (;;) {
    const bool has_next = S.next(ui + 1, nxt);
    if (Sched::NEXT_IN_LDS) {
      unsigned na[2][2];
      if (has_next) { PG8_RC(Rp, Cp) S.a_off(nxt, Rp, Cp, na); }
      else {
#pragma unroll
        for (int h = 0; h < 2; ++h)
#pragma unroll
          for (int i = 0; i < 2; ++i) na[h][i] = ca[h][i];
      }
      *(LAS u32x4*)(lds + STAGE_BYTES + 8192 + tid * 16) = (u32x4){na[0][0], na[0][1], na[1][0], na[1][1]};
    }
    const char* nB = has_next ? nxt.b : cB;
    for (int t = 0; t < nt; t += 2) {
      const bool last = (t == nt - 2);
      PG8_LDB(B0, 0, 0); PG8_LDB(B1, 0, 1); PG8_SCHED; PG8_LDA(At, 0, 0); PG8_STAGE_A(PG8_SA(1, 1), (size_t)(t + 1) * kstep, ca[1]);
      PG8_WAIT_V(8); PG8_WAIT_L(0); PG8_BAR; PG8_MMA(0, 0, At, B0); PG8_MMA(0, 1, At, B1); PG8_BAR; PG8_SCHED;
      const size_t kb2 = last ? 0 : (size_t)(t + 2) * kstep;
      const char* b2 = last ? nB : cB + (size_t)(t + 2) * kstep;
      if (last) {
        if (Sched::NEXT_IN_LDS) { const u32x4 v = *(const LAS u32x4*)(lds + STAGE_BYTES + 8192 + tid * 16); ca[0][0] = v.x; ca[0][1] = v.y; ca[1][0] = v.z; ca[1][1] = v.w; }
        else if (has_next) { PG8_RC(Rp, Cp) S.a_off(nxt, Rp, Cp, ca); }
      }
      PG8_LDA(At, 0, 1); PG8_STAGE_B(PG8_SB(0, 0), b2); PG8_STAGE_B(PG8_SB(0, 1), b2 + hstep); PG8_STAGE_A(PG8_SA(0, 0), kb2, ca[0]);
      PG8_WAIT_V(8); PG8_WAIT_L(0); PG8_BAR; PG8_MMA(1, 0, At, B0); PG8_MMA(1, 1, At, B1); PG8_BAR; PG8_SCHED;
      PG8_LDB(B0, 1, 0); PG8_LDB(B1, 1, 1); PG8_SCHED; PG8_LDA(At, 1, 0); PG8_STAGE_A(PG8_SA(0, 1), kb2, ca[1]);
      PG8_WAIT_V(8); PG8_WAIT_L(0); PG8_BAR; PG8_MMA(0, 0, At, B0); PG8_MMA(0, 1, At, B1); PG8_BAR; PG8_SCHED;
      PG8_LDA(At, 1, 1); PG8_STAGE_B(PG8_SB(1, 0), b2 + kstep); PG8_STAGE_B(PG8_SB(1, 1), b2 + kstep + hstep); PG8_STAGE_A(PG8_SA(1, 0), kb2 + kstep, ca[0]);
      PG8_WAIT_V(8); PG8_WAIT_L(0); PG8_BAR; PG8_MMA(1, 0, At, B0); PG8_MMA(1, 1, At, B1); PG8_BAR; PG8_SCHED;
    }
    if constexpr (ALIGN_EPI) { if (wr == 0) PG8_BAR; }
    E(acc, cur, wr, wc, fr, fq);
    if (!has_next) break;
#pragma unroll
    for (int a = 0; a < 2; ++a)
#pragma unroll
      for (int b = 0; b < 2; ++b)
#pragma unroll
        for (int m = 0; m < 4; ++m)
#pragma unroll
          for (int n = 0; n < 2; ++n) acc[a][b][m][n] = (f32x4){0.f, 0.f, 0.f, 0.f};
    cur = nxt; cB = nB; ++ui;
    if constexpr (ALIGN_EPI) { if (wr == 1) PG8_BAR; }
  }
  PG8_WAIT_V(0);
  if constexpr (!ALIGN_EPI) { if (wr == 0) PG8_BAR; }
  PG8_BAR;
#undef PG8_RC
#undef PG8_SA
#undef PG8_SB
#undef PG8_STAGE_A
#undef PG8_STAGE_B
#undef PG8_LDA
#undef PG8_LDB
#undef PG8_MMA
#undef PG8_WAIT_V
#undef PG8_WAIT_L
#undef PG8_BAR
#undef PG8_SCHED
}
}

struct Params { const float* in[28]; float* out; unsigned char* ws; };
enum { I_X = 0, I_ANORM0, I_WIN0, I_CONVW, I_QN0, I_KN0, I_WOUT0, I_FNORM0, I_WRG0, I_BRG0, I_WRE0, I_BRE0, I_WG0, I_WU0, I_WD0,
       I_ANORM1, I_WIN1, I_QN1, I_KN1, I_WOUT1, I_FNORM1, I_WRG1, I_BRG1, I_WRE1, I_BRE1, I_WG1, I_WU1, I_WD1 };

struct Ctx { LAS unsigned char* lds; int wave, G, gw, NGW; };

struct TrDesc { const float* W; const float* gain; bf16_t* WT; int K, N, nvalid, mode, nblk, item; };
DI void tr_load(const TrDesc& d, int lane, f32x4 (&r)[8]) {
  const int kb = d.item / d.nblk, nb = d.item % d.nblk, k0 = 64 * kb, n = 32 * nb + 4 * (lane & 7);
#pragma unroll
  for (int i = 0; i < 8; ++i) { const int kk = 8 * i + (lane >> 3); r[i] = (n < d.nvalid) ? *(const f32x4*)(d.W + (size_t)(k0 + kk) * d.N + n) : (f32x4){0.f, 0.f, 0.f, 0.f}; }
}
DI void tr_finish(const TrDesc& d, int lane, const f32x4 (&r)[8], LAS float* scr) {
  const int kb = d.item / d.nblk, nb = d.item % d.nblk, k0 = 64 * kb, n0 = 32 * nb;
#pragma unroll
  for (int i = 0; i < 8; ++i) { const int kk = 8 * i + (lane >> 3); const float g = d.gain ? d.gain[k0 + kk] : 1.f; LAS float* s = scr + kk * 33 + 4 * (lane & 7);
    s[0] = r[i].x * g; s[1] = r[i].y * g; s[2] = r[i].z * g; s[3] = r[i].w * g; }
  asm volatile("s_waitcnt lgkmcnt(0)" ::: "memory");
  const int c = lane & 7;
#pragma unroll
  for (int j = 0; j < 4; ++j) { const int nn = (lane >> 3) + 8 * j; const LAS float* s = scr + (8 * c) * 33 + nn;
    u32x4 o; o.x = pk2(s[0 * 33], s[1 * 33]); o.y = pk2(s[2 * 33], s[3 * 33]); o.z = pk2(s[4 * 33], s[5 * 33]); o.w = pk2(s[6 * 33], s[7 * 33]);
    const int ng = n0 + nn; const int drow = (d.mode == 0) ? ng : ((ng >> 7) * 256 + (ng & 127) + (d.mode == 2 ? 128 : 0));
    *(u32x4*)(d.WT + (size_t)drow * d.K + k0 + 8 * c) = o; }
  asm volatile("s_waitcnt lgkmcnt(0)" ::: "memory");
}
DI void rms_row_to_bf16(const float* xrow, bf16_t* orow, int lane) {
  const f32x4* xr = (const f32x4*)xrow + lane;
  f32x4 v[4]; float s = 0.f;
#pragma unroll
  for (int j = 0; j < 4; ++j) { v[j] = xr[64 * j]; s += (v[j].x * v[j].x + v[j].y * v[j].y) + (v[j].z * v[j].z + v[j].w * v[j].w); }
  const float rstd = 1.0f / sqrtf(wave_sum(s) * (1.f / DM) + NORM_EPS);
  unsigned long long* o8 = (unsigned long long*)orow + lane;
#pragma unroll
  for (int j = 0; j < 4; ++j) o8[64 * j] = (unsigned long long)pk2(v[j].x * rstd, v[j].y * rstd) | ((unsigned long long)pk2(v[j].z * rstd, v[j].w * rstd) << 32);
}
DI void p0_prologue(const Ctx& F, const Params& P) {
  unsigned char* ws = P.ws; const int lane = lane_id_v(); const int tid = F.wave * 64 + lane;
  LAS float* scr = (LAS float*)(F.lds + F.wave * 16384);
  constexpr int I_IN0 = 16 * 80, I_OUT = 16 * 32, I_GU = 32 * 16 * 16, I_DN = 32 * 8 * 32, I_IN1 = 16 * 48;
  constexpr int PER_LAYER0 = I_IN0 + I_OUT + 2 * I_GU + I_DN, PER_LAYER1 = I_IN1 + I_OUT + 2 * I_GU + I_DN;
  auto mkdesc = [&](int it) {
    TrDesc d; int r = it; const int L = (r >= PER_LAYER0) ? 1 : 0; if (L) r -= PER_LAYER0;
    const int i_in = L ? I_IN1 : I_IN0;
    const float* anorm = P.in[L ? I_ANORM1 : I_ANORM0]; const float* fnorm = P.in[L ? I_FNORM1 : I_FNORM0];
    if (r < i_in) { d.W = P.in[L ? I_WIN1 : I_WIN0]; d.gain = anorm; d.WT = (bf16_t*)(ws + (L ? WS_WIN1 : WS_WIN0)); d.K = 1024; d.N = L ? W1 : W0V; d.nvalid = d.N; d.mode = 0; d.nblk = L ? 48 : 80; d.item = r; return d; }
    r -= i_in;
    if (r < I_OUT) { d.W = P.in[L ? I_WOUT1 : I_WOUT0]; d.gain = nullptr; d.WT = (bf16_t*)(ws + (L ? WS_WOUT1 : WS_WOUT0)); d.K = 1024; d.N = 1024; d.nvalid = 1024; d.mode = 0; d.nblk = 32; d.item = r; return d; }
    r -= I_OUT;
    if (r < 2 * I_GU) { const int up = r >= I_GU; if (up) r -= I_GU; const int e = r >> 8;
      d.W = P.in[up ? (L ? I_WU1 : I_WU0) : (L ? I_WG1 : I_WG0)] + (size_t)e * 1024 * 512; d.gain = fnorm; d.WT = (bf16_t*)(ws + (L ? WS_WGU1 : WS_WGU0)) + (size_t)e * 1024 * 1024;
      d.K = 1024; d.N = 512; d.nvalid = 512; d.mode = up ? 2 : 1; d.nblk = 16; d.item = r & 255; return d; }
    r -= 2 * I_GU;
    { const int e = r >> 8; d.W = P.in[L ? I_WD1 : I_WD0] + (size_t)e * 512 * 1024; d.gain = nullptr; d.WT = (bf16_t*)(ws + (L ? WS_WD1 : WS_WD0)) + (size_t)e * 1024 * 512; d.K = 512; d.N = 1024; d.nvalid = 1024; d.mode = 0; d.nblk = 32; d.item = r & 255; return d; }
  };
  {
    const int NIT = PER_LAYER0 + PER_LAYER1;
    int it = F.gw;
    f32x4 ra[8], rb[8];
    TrDesc da, db;
    if (it < NIT) { da = mkdesc(it); tr_load(da, lane, ra); }
    while (it < NIT) {
      const int itn = it + F.NGW;
      if (itn < NIT) { db = mkdesc(itn); tr_load(db, lane, rb); }
      tr_finish(da, lane, ra, scr);
      if (itn >= NIT) break;
      const int itn2 = itn + F.NGW;
      if (itn2 < NIT) { da = mkdesc(itn2); tr_load(da, lane, ra); }
      tr_finish(db, lane, rb, scr);
      it = itn2;
    }
  }
  for (int m = F.gw; m < NTOK; m += F.NGW) rms_row_to_bf16(P.in[I_X] + (size_t)m * DM, (bf16_t*)(ws + WS_XN) + (size_t)m * DM, lane);
  const int gt = blockIdx.x * 512 + tid, NGT = F.G * 512;
  for (int i = gt; i < 512; i += NGT) ((unsigned*)(ws + WS_XN + (size_t)NTOK * DM * 2))[i] = 0u;
  for (int i = gt; i < 128; i += NGT) ((int*)(ws + WS_CTL))[i] = 0;
  for (int i = gt; i < SEQ * 32; i += NGT) {
    const int t = i >> 5, k = i & 31;
    const float inv = (float)exp2(-(double)k * (13.287712379549449 / 32.0));
    const float ang = (float)t * inv;
    const double rev = (double)ang * 0.15915494309189535; const float fr = (float)(rev - rint(rev));
    ((float*)(ws + WS_ROPE))[i] = __builtin_amdgcn_cosf(fr); ((float*)(ws + WS_ROPE))[SEQ * 32 + i] = __builtin_amdgcn_sinf(fr);
  }
  for (int i = gt; i < 2 * 36 * 1024; i += NGT) {
    const int L = i / (36 * 1024), r = i % (36 * 1024), j = r >> 10, k = r & 1023;
    const float g = P.in[L ? I_FNORM1 : I_FNORM0][k];
    float w; if (j < 4) w = P.in[L ? I_WRG1 : I_WRG0][k * 4 + j]; else { const int gg = (j - 4) >> 3, e = (j - 4) & 7; w = P.in[L ? I_WRE1 : I_WRE0][((size_t)gg * 1024 + k) * 8 + e]; }
    ((float*)(ws + (L ? WS_WR1 : WS_WR0)))[r] = w * g;
  }
  for (int i = gt; i < 2 * 36; i += NGT) { const int L = i / 36, j = i % 36; ((float*)(ws + (L ? WS_WR1 : WS_WR0)))[36 * 1024 + j] = (j < 4) ? P.in[L ? I_BRG1 : I_BRG0][j] : P.in[L ? I_BRE1 : I_BRE0][j - 4]; }
}

DI u32x4 normrope8(const u32x4 w, const float (&gv)[8], bool do_norm, const f32x4 (&cs)[2], const f32x4 (&sn)[2], int sub, float oscale) {
  float v[8] = {bflo(w.x), bfhi(w.x), bflo(w.y), bfhi(w.y), bflo(w.z), bfhi(w.z), bflo(w.w), bfhi(w.w)};
  if (do_norm) {
    float s = 0.f;
#pragma unroll
    for (int j = 0; j < 8; ++j) s += v[j] * v[j];
    s += __shfl_xor(s, 1); s += __shfl_xor(s, 2); s += __shfl_xor(s, 4);
    const float rstd = 1.0f / sqrtf(s * (1.f / 64.f) + NORM_EPS);
#pragma unroll
    for (int j = 0; j < 8; ++j) v[j] = v[j] * rstd * gv[j];
  }
  const float sg = (sub & 4) ? 1.f : -1.f;
  const float cv[8] = {cs[0].x, cs[0].y, cs[0].z, cs[0].w, cs[1].x, cs[1].y, cs[1].z, cs[1].w};
  const float sv[8] = {sn[0].x, sn[0].y, sn[0].z, sn[0].w, sn[1].x, sn[1].y, sn[1].z, sn[1].w};
  float o[8];
#pragma unroll
  for (int j = 0; j < 8; ++j) { const float pr = __shfl_xor(v[j], 4); o[j] = (v[j] * cv[j] + sg * pr * sv[j]) * oscale; }
  u32x4 r; r.x = pk2(o[0], o[1]); r.y = pk2(o[2], o[3]); r.z = pk2(o[4], o[5]); r.w = pk2(o[6], o[7]);
  return r;
}
struct Tok0 { u32x4 q, pb, cb, cc[3], ch[3]; f32x4 cs[2], sn[2]; bf16_t v; };
DI void p1b_transform0(const Ctx& F, const Params& P) {
  bf16_t* PROJ = (bf16_t*)(P.ws + WS_PROJ); bf16_t* MIX = (bf16_t*)(P.ws + WS_MIX);
  const float* cosT = (const float*)(P.ws + WS_ROPE); const float* sinT = cosT + SEQ * 32;
  const int lane = lane_id_v(), sub = lane & 7, grp = lane >> 3;
  const int g2 = grp < 6 ? grp : 5;
  const int pbcol = (g2 == 0 ? C_K : (g2 <= 4 ? C_IQ + (g2 - 1) * 64 : C_IK)) + sub * 8;
  float gq[8], gk[8], cw[8][3];
#pragma unroll
  for (int j = 0; j < 8; ++j) { gq[j] = P.in[I_QN0][8 * sub + j]; gk[j] = P.in[I_KN0][8 * sub + j]; }
#pragma unroll
  for (int j = 0; j < 8; ++j) { const float* w = P.in[I_CONVW] + (8 * lane + j) * 3; cw[j][0] = w[0]; cw[j][1] = w[1]; cw[j][2] = w[2]; }
  auto load = [&](Tok0& T, int m) {
    const int t = m & (SEQ - 1); const bf16_t* row = PROJ + (size_t)m * W0P;
    T.q = *(const u32x4*)(row + C_Q + grp * 64 + sub * 8); T.pb = *(const u32x4*)(row + pbcol); T.cb = *(const u32x4*)(row + C_CB + 8 * lane); T.v = row[C_V + lane];
#pragma unroll
    for (int d = 0; d < 3; ++d) { const int back = 2 - d; const bf16_t* r2 = row - (size_t)(t >= back ? back : 0) * W0P; T.cc[d] = *(const u32x4*)(r2 + C_CC + 8 * lane); T.ch[d] = *(const u32x4*)(r2 + C_CH + 8 * lane); }
    const f32x4* cp = (const f32x4*)(cosT + t * 32 + 8 * (sub & 3)); const f32x4* sp = (const f32x4*)(sinT + t * 32 + 8 * (sub & 3));
    T.cs[0] = cp[0]; T.cs[1] = cp[1]; T.sn[0] = sp[0]; T.sn[1] = sp[1];
  };
  auto process = [&](const Tok0& T, int m) {
    const int t = m & (SEQ - 1); bf16_t* row = PROJ + (size_t)m * W0P;
    *(u32x4*)(row + C_Q + grp * 64 + sub * 8) = normrope8(T.q, gq, true, T.cs, T.sn, sub, 1.f);
    { const u32x4 r = normrope8(T.pb, gk, g2 == 0, T.cs, T.sn, sub, 1.f);
      const size_t fo = ((((size_t)(m >> 12) * 128 + (t >> 5)) * 4 + (sub >> 1)) * 64 + (sub & 1) * 32 + (t & 31)) * 8;
      if (grp < 6) { bf16_t* dst = g2 == 0 ? (bf16_t*)(P.ws + WS_KF) + fo : (g2 == 5 ? (bf16_t*)(P.ws + WS_IKF) + fo : row + pbcol); *(u32x4*)dst = r; } }
    { const int kk = t & 31, st = kk >> 4, rem = kk & 15, hf = (rem >> 2) & 1, j = 4 * (rem >> 3) + (rem & 3);
      const size_t vo = (((((size_t)(m >> 12) * 128 + (t >> 5)) * 2 + st) * 2 + (lane >> 5)) * 64 + hf * 32 + (lane & 31)) * 8 + j;
      ((bf16_t*)(P.ws + WS_VTF))[vo] = T.v; }
    { float u[3][8];
#pragma unroll
      for (int d = 0; d < 3; ++d) { const bool okd = t >= 2 - d; const u32x4 a = T.cc[d], b = T.ch[d];
        u[d][0] = okd ? bflo(a.x) * bflo(b.x) : 0.f; u[d][1] = okd ? bfhi(a.x) * bfhi(b.x) : 0.f; u[d][2] = okd ? bflo(a.y) * bflo(b.y) : 0.f; u[d][3] = okd ? bfhi(a.y) * bfhi(b.y) : 0.f;
        u[d][4] = okd ? bflo(a.z) * bflo(b.z) : 0.f; u[d][5] = okd ? bfhi(a.z) * bfhi(b.z) : 0.f; u[d][6] = okd ? bflo(a.w) * bflo(b.w) : 0.f; u[d][7] = okd ? bfhi(a.w) * bfhi(b.w) : 0.f; }
      const u32x4 cb = T.cb;
      const float cbv[8] = {bflo(cb.x), bfhi(cb.x), bflo(cb.y), bfhi(cb.y), bflo(cb.z), bfhi(cb.z), bflo(cb.w), bfhi(cb.w)};
      float o[8];
#pragma unroll
      for (int j = 0; j < 8; ++j) o[j] = cbv[j] * (u[0][j] * cw[j][0] + u[1][j] * cw[j][1] + u[2][j] * cw[j][2]);
      u32x4 r; r.x = pk2(o[0], o[1]); r.y = pk2(o[2], o[3]); r.z = pk2(o[4], o[5]); r.w = pk2(o[6], o[7]);
      *(u32x4*)(MIX + (size_t)m * DM + 8 * lane) = r; }
  };
  Tok0 A, B;
  int m = F.gw;
  if (m < NTOK) load(A, m);
  while (m < NTOK) {
    const int m1 = m + F.NGW;
    if (m1 < NTOK) load(B, m1);
    process(A, m);
    if (m1 >= NTOK) break;
    const int m2 = m1 + F.NGW;
    if (m2 < NTOK) load(A, m2);
    process(B, m1);
    m = m2;
  }
}

DI unsigned f2key(float f) { const unsigned b = __float_as_uint(f); return b ^ ((unsigned)((int)b >> 31) | 0x80000000u); }
DI s16x4 tr_read(LAS unsigned char* p) { typedef short v4i16_t __attribute__((ext_vector_type(4))); return __builtin_bit_cast(s16x4, __builtin_amdgcn_ds_read_tr16_b64_v4i16((LAS v4i16_t*)p)); }
#define DPP_U(v, ctrl) ((unsigned)__builtin_amdgcn_update_dpp(0, (int)(v), (ctrl), 0xF, 0xF, true))
DI unsigned wave_total_u(unsigned v) {
  v += DPP_U(v, 0xB1); v += DPP_U(v, 0x4E); v += DPP_U(v, 0x124); v += DPP_U(v, 0x128);
  return (unsigned)__builtin_amdgcn_readlane((int)v, 0) + (unsigned)__builtin_amdgcn_readlane((int)v, 16) + (unsigned)__builtin_amdgcn_readlane((int)v, 32) + (unsigned)__builtin_amdgcn_readlane((int)v, 48);
}
DI unsigned wave_maxall_u(unsigned v) {
  v = max(v, DPP_U(v, 0xB1)); v = max(v, DPP_U(v, 0x4E)); v = max(v, DPP_U(v, 0x124)); v = max(v, DPP_U(v, 0x128));
  const unsigned a = (unsigned)__builtin_amdgcn_readlane((int)v, 0), b = (unsigned)__builtin_amdgcn_readlane((int)v, 16), c = (unsigned)__builtin_amdgcn_readlane((int)v, 32), d = (unsigned)__builtin_amdgcn_readlane((int)v, 48);
  return max(max(a, b), max(c, d));
}
DI unsigned lane_prefix(unsigned long long m) { return __builtin_amdgcn_mbcnt_hi((unsigned)(m >> 32), __builtin_amdgcn_mbcnt_lo((unsigned)m, 0u)); }

DI void dsa_phase(const Ctx& F, const Params& P) {
  const bf16_t* PROJ = (const bf16_t*)(P.ws + WS_PROJ); bf16_t* MIX = (bf16_t*)(P.ws + WS_MIX);
  const bf16_t* IKF = (const bf16_t*)(P.ws + WS_IKF); const bf16_t* KF = (const bf16_t*)(P.ws + WS_KF); const bf16_t* VTF = (const bf16_t*)(P.ws + WS_VTF);
  LAS unsigned* sc = (LAS unsigned*)F.lds;
  LAS unsigned* msk32 = (LAS unsigned*)(F.lds + LDS_LIST);
  LAS float* part = (LAS float*)F.lds;
  const int w = F.wave;
  float cshift; { const int l0 = lane_id_v(); cshift = 8.f * wave_max(fabsf(P.in[I_QN0][l0])) * wave_max(fabsf(P.in[I_KN0][l0])) * 1.02f; }
  const float c1 = 0.125f * LOG2E, c2 = __builtin_amdgcn_readfirstlane(__float_as_int(cshift * LOG2E)) == 0 ? 0.f : __int_as_float(__builtin_amdgcn_readfirstlane(__float_as_int(cshift * LOG2E)));
#ifdef TIMEDSA
  unsigned long long tacc = 0ull, tmark = 0ull;
#define DSA_T0(n) if (TIMEDSA == (n)) tmark = __builtin_amdgcn_s_memrealtime();
#define DSA_T1(n) if (TIMEDSA == (n)) tacc += __builtin_amdgcn_s_memrealtime() - tmark;
#else
#define DSA_T0(n)
#define DSA_T1(n)
#endif
  for (int v = blockIdx.x; v < 8192; v += gridDim.x) {
    const int cidx = v & 255, jj = v >> 8, b = jj >> 1, tb = (jj & 1) ? (511 - cidx) : cidx;
    const int t0 = tb * 8; const size_t rb = (size_t)b * SEQ;
    const int ntile = (t0 + 8 + 31) >> 5;
    const int lane = lane_id_v();
    const int c = lane & 31, half = lane >> 5, qc = c >> 2, hx = c & 3;
    DSA_T0(1)
    {
      bf16x8 af[4];
      { const bf16_t* ap = PROJ + (rb + t0 + qc) * W0P + C_IQ + hx * 64 + 8 * half;
#pragma unroll
        for (int ks = 0; ks < 4; ++ks) af[ks] = *(const bf16x8*)(ap + 16 * ks); }
      float wq[4][4];
#pragma unroll
      for (int g = 0; g < 4; ++g) { const u32x2 ww = *(const u32x2*)(PROJ + (rb + t0 + 2 * g + half) * W0P + C_IW);
        wq[g][0] = bflo(ww.x) * 0.0625f; wq[g][1] = bfhi(ww.x) * 0.0625f; wq[g][2] = bflo(ww.y) * 0.0625f; wq[g][3] = bfhi(ww.y) * 0.0625f; }
      const bf16_t* fb = IKF + ((size_t)b * 128 * 4 * 64 + lane) * 8;
      const int Tlast = ntile - 1;
      auto ld1 = [&](bf16x8 (&d)[4], int T) { const int Tc = T < Tlast ? T : Tlast;
#pragma unroll
        for (int ks = 0; ks < 4; ++ks) d[ks] = *(const bf16x8*)(fb + (size_t)(Tc * 4 + ks) * 512); };
      auto cp1 = [&](const bf16x8 (&bfr)[4], int T) {
        f32x16 acc;
#pragma unroll
        for (int i = 0; i < 16; ++i) acc[i] = 0.f;
#pragma unroll
        for (int ks = 0; ks < 4; ++ks) acc = __builtin_amdgcn_mfma_f32_32x32x16_bf16(af[ks], bfr[ks], acc, 0, 0, 0);
        const int s = 32 * T + c;
#pragma unroll
        for (int g = 0; g < 4; ++g) {
          float sv = (wq[g][0] * fmaxf(acc[4 * g], 0.f) + wq[g][1] * fmaxf(acc[4 * g + 1], 0.f)) + (wq[g][2] * fmaxf(acc[4 * g + 2], 0.f) + wq[g][3] * fmaxf(acc[4 * g + 3], 0.f));
          sv = (sv == 0.f) ? 0.f : sv;
          const int ql = 2 * g + half;
          sc[ql * 4096 + s] = (s <= t0 + ql) ? f2key(sv) : 0u;
        } };
      bf16x8 r0[4], r1[4], r2[4], r3[4];
      if (w < ntile) { ld1(r0, w); ld1(r1, w + 8); ld1(r2, w + 16); ld1(r3, w + 24); }
      for (int T = w; T < ntile; T += 32) {
        cp1(r0, T); ld1(r0, T + 32); __builtin_amdgcn_sched_barrier(0);
        if (T + 8 < ntile) { cp1(r1, T + 8); ld1(r1, T + 40); __builtin_amdgcn_sched_barrier(0); }
        if (T + 16 < ntile) { cp1(r2, T + 16); ld1(r2, T + 48); __builtin_amdgcn_sched_barrier(0); }
        if (T + 24 < ntile) { cp1(r3, T + 24); ld1(r3, T + 56); __builtin_amdgcn_sched_barrier(0); }
      }
    }
    __syncthreads();
    asm volatile("" ::: "memory"); __builtin_amdgcn_sched_barrier(0);
    DSA_T1(1)
    DSA_T0(2)
    {
      const int lane = lane_id_v();
      {
        const int cq = lane & 31;
        const bf16_t* qp = PROJ + (rb + t0 + (cq >> 2)) * W0P + C_Q + (4 * (w >> 2) + (cq & 3)) * 64 + 16 * (w & 3) + 8 * (lane >> 5);
        *(LAS u32x4*)(F.lds + LDS_LIST + 4096 + (w * 64 + lane) * 16) = *(const u32x4*)qp;
      }
      const int t = t0 + w;
      const int nch = (t >> 10) + 1;
      unsigned u[64];
#pragma unroll
      for (int ch = 0; ch < 4; ++ch) {
        if (ch < nch) {
#pragma unroll
          for (int k2 = 0; k2 < 16; ++k2) { const int j = 16 * ch + k2; const unsigned x = sc[w * 4096 + 64 * j + lane]; u[j] = (lane <= t - 64 * j) ? x : 0u; }
        } else {
#pragma unroll
          for (int k2 = 0; k2 < 16; ++k2) u[16 * ch + k2] = 0u;
        }
      }
      unsigned thr = 0u; int sthr = -1;
      if (t >= 256) {
        unsigned prefix = 0u; bool exact = false; int startbit = 31;
        {
          unsigned mx = 0u;
#pragma unroll
          for (int ch = 0; ch < 4; ++ch) if (ch < nch) {
#pragma unroll
            for (int k2 = 0; k2 < 16; ++k2) mx = max(mx, u[16 * ch + k2]);
          }
          const unsigned trial = wave_maxall_u(mx) & 0xFF800000u;
          unsigned cnt = 0u;
#pragma unroll
          for (int ch = 0; ch < 4; ++ch) if (ch < nch) {
#pragma unroll
            for (int k2 = 0; k2 < 16; ++k2) cnt += (u[16 * ch + k2] >= trial) ? 1u : 0u;
          }
          cnt = wave_total_u(cnt);
          if (cnt >= 256u) { prefix = trial; startbit = 22; exact = (cnt == 256u); }
        }
        if (!exact) {
          for (int bit = startbit; bit >= 0; --bit) {
            const unsigned trial = prefix | (1u << bit);
            unsigned cnt = 0u;
#pragma unroll
            for (int ch = 0; ch < 4; ++ch) if (ch < nch) {
#pragma unroll
              for (int k2 = 0; k2 < 16; ++k2) cnt += (u[16 * ch + k2] >= trial) ? 1u : 0u;
            }
            cnt = wave_total_u(cnt);
            if (cnt >= 256u) prefix = trial;
            if (cnt == 256u) { exact = true; break; }
          }
        }
        if (exact) thr = prefix - 1u;
        else {
          thr = prefix; unsigned cgt = 0u;
#pragma unroll
          for (int j = 0; j < 64; ++j) cgt += (u[j] > thr) ? 1u : 0u;
          cgt = wave_total_u(cgt);
          const int need = 256 - (int)cgt;
          int tbf = 0;
#pragma unroll
          for (int ch = 0; ch < 4; ++ch) if (ch < nch) {
#pragma unroll
            for (int k2 = 0; k2 < 16; ++k2) { const int j = 16 * ch + k2; const bool eq = u[j] == thr; const unsigned long long m = __ballot(eq);
              const unsigned long long hit = __ballot(eq && (tbf + (int)lane_prefix(m) == need - 1));
              if (hit) sthr = 64 * j + __builtin_ctzll(hit);
              tbf += __builtin_popcountll(m); }
          }
        }
      }
#pragma unroll
      for (int ch = 0; ch < 4; ++ch) {
        if (ch < nch) {
#pragma unroll
          for (int k2 = 0; k2 < 16; ++k2) { const int j = 16 * ch + k2; const bool sel = (u[j] > thr) || (u[j] == thr && lane <= sthr - 64 * j); const unsigned long long m = __ballot(sel);
            if (lane == 0) *(LAS u32x2*)(msk32 + w * 128 + 2 * j) = (u32x2){(unsigned)m, (unsigned)(m >> 32)}; }
        } else if (lane < 16) *(LAS u32x2*)(msk32 + w * 128 + 2 * (16 * ch + lane)) = (u32x2){0u, 0u};
      }
    }
    __syncthreads();
    asm volatile("" ::: "memory"); __builtin_amdgcn_sched_barrier(0);
    DSA_T1(2)
    DSA_T0(3)
    {
      const int lane = lane_id_v(); const int c = lane & 31, half = lane >> 5, qc = c >> 2, hx = c & 3;
      const int tq = t0 + qc;
      const LAS unsigned char* qlds = F.lds + LDS_LIST + 4096 + lane * 16;
      f32x16 o00, o01, o10, o11;
#pragma unroll
      for (int i = 0; i < 16; ++i) { o00[i] = 0.f; o01[i] = 0.f; o10[i] = 0.f; o11[i] = 0.f; }
      float lsum0 = 0.f, lsum1 = 0.f;
      const bf16_t* kb = KF + ((size_t)b * 128 * 4 * 64 + lane) * 8;
      const bf16_t* vb = VTF + ((size_t)b * 128 * 4 * 64 + lane) * 8;
      const int Tlast = ntile - 1;
      auto ld2 = [&](bf16x8 (&kf)[4], bf16x8 (&vf)[4], int T) { const int Tc = T < Tlast ? T : Tlast;
#pragma unroll
        for (int ks = 0; ks < 4; ++ks) { kf[ks] = *(const bf16x8*)(kb + (size_t)(Tc * 4 + ks) * 512); vf[ks] = *(const bf16x8*)(vb + (size_t)(Tc * 4 + ks) * 512); } };
      auto cp2 = [&](const bf16x8 (&kf)[4], const bf16x8 (&vf)[4], int T) {
        const unsigned mw = msk32[qc * 128 + T] >> (4 * half);
#pragma unroll
        for (int cb = 0; cb < 2; ++cb) {
          bf16x8 qf[4];
#pragma unroll
          for (int ks = 0; ks < 4; ++ks) qf[ks] = *(const LAS bf16x8*)(qlds + (cb * 4 + ks) * 1024);
          f32x16 s;
#pragma unroll
          for (int i = 0; i < 16; ++i) s[i] = 0.f;
#pragma unroll
          for (int ks = 0; ks < 4; ++ks) s = __builtin_amdgcn_mfma_f32_32x32x16_bf16(kf[ks], qf[ks], s, 0, 0, 0);
          float ls = 0.f;
#pragma unroll
          for (int r = 0; r < 16; ++r) { const float p = ((mw >> ((r & 3) + 8 * (r >> 2))) & 1u) ? __builtin_amdgcn_exp2f(s[r] * c1 - c2) : 0.f; s[r] = p; ls += p; }
          if (cb == 0) lsum0 += ls; else lsum1 += ls;
#pragma unroll
          for (int st = 0; st < 2; ++st) {
            u32x4 pw; pw.x = pk2(s[8 * st], s[8 * st + 1]); pw.y = pk2(s[8 * st + 2], s[8 * st + 3]); pw.z = pk2(s[8 * st + 4], s[8 * st + 5]); pw.w = pk2(s[8 * st + 6], s[8 * st + 7]);
            const bf16x8 pf = __builtin_bit_cast(bf16x8, pw);
            if (cb == 0) { o00 = __builtin_amdgcn_mfma_f32_32x32x16_bf16(vf[2 * st], pf, o00, 0, 0, 0); o10 = __builtin_amdgcn_mfma_f32_32x32x16_bf16(vf[2 * st + 1], pf, o10, 0, 0, 0); }
            else { o01 = __builtin_amdgcn_mfma_f32_32x32x16_bf16(vf[2 * st], pf, o01, 0, 0, 0); o11 = __builtin_amdgcn_mfma_f32_32x32x16_bf16(vf[2 * st + 1], pf, o11, 0, 0, 0); }
          }
        } };
      bf16x8 ka[4], va[4], kb2[4], vb2[4];
      if (w < ntile) { ld2(ka, va, w); ld2(kb2, vb2, w + 8); }
      for (int T = w; T < ntile; T += 16) {
        cp2(ka, va, T); ld2(ka, va, T + 16); __builtin_amdgcn_sched_barrier(0);
        if (T + 8 < ntile) { cp2(kb2, vb2, T + 8); ld2(kb2, vb2, T + 24); __builtin_amdgcn_sched_barrier(0); }
      }
      lsum0 += __shfl_xor(lsum0, 32); lsum1 += __shfl_xor(lsum1, 32);
      bf16_t* opb = MIX + (rb + tq) * DM + 512 + hx * 64 + 32 * (w >> 2) + 8 * (w & 3) + 4 * half;
#pragma unroll
      for (int cb = 0; cb < 2; ++cb) {
        LAS float* pw_ = part + w * (33 * 64) + lane;
        if (cb == 1) __syncthreads();
#pragma unroll
        for (int i = 0; i < 16; ++i) { pw_[i * 64] = cb == 0 ? o00[i] : o01[i]; pw_[(16 + i) * 64] = cb == 0 ? o10[i] : o11[i]; }
        pw_[32 * 64] = cb == 0 ? lsum0 : lsum1;
        __syncthreads();
        float a4[4] = {0.f, 0.f, 0.f, 0.f}; float lt = 0.f;
#pragma unroll
        for (int k8 = 0; k8 < 8; ++k8) { const LAS float* pr = part + k8 * (33 * 64) + lane;
#pragma unroll
          for (int i = 0; i < 4; ++i) a4[i] += pr[(4 * w + i) * 64];
          lt += pr[32 * 64]; }
        const float inv = 1.0f / lt;
        u32x2 w0; w0.x = pk2(a4[0] * inv, a4[1] * inv); w0.y = pk2(a4[2] * inv, a4[3] * inv); *(u32x2*)(opb + cb * 256) = w0;
      }
    }
    __syncthreads();
    DSA_T1(3)
  }
#ifdef TIMEDSA
  if (blockIdx.x == 0 && w == 0 && lane_id_v() == 0) { unsigned long long* tsw = (unsigned long long*)(P.ws + WS_CTL + 4096); tsw[0] = 0ull; tsw[1] = tacc; }
#endif
}

DI float fswap32_add(float a, float b) { const auto r = __builtin_amdgcn_permlane32_swap(__float_as_uint(a), __float_as_uint(b), false, false); return __uint_as_float(r[0]) + __uint_as_float(r[1]); }
DI float fswap16_add(float a, float b) { const auto r = __builtin_amdgcn_permlane16_swap(__float_as_uint(a), __float_as_uint(b), false, false); return __uint_as_float(r[0]) + __uint_as_float(r[1]); }
DI void tred64(float (&v)[64], int lane) {
#pragma unroll
  for (int i = 0; i < 32; ++i) v[i] = fswap32_add(v[i], v[i + 32]);
#pragma unroll
  for (int i = 0; i < 16; ++i) v[i] = fswap16_add(v[i], v[i + 16]);
#pragma unroll
  for (int i = 0; i < 8; ++i) { const bool up = lane & 8; const float keep = up ? v[i + 8] : v[i], send = up ? v[i] : v[i + 8]; v[i] = keep + __shfl_xor(send, 8); }
#pragma unroll
  for (int i = 0; i < 4; ++i) { const bool up = lane & 4; const float keep = up ? v[i + 4] : v[i], send = up ? v[i] : v[i + 4]; v[i] = keep + __shfl_xor(send, 4); }
#pragma unroll
  for (int i = 0; i < 2; ++i) { const bool up = lane & 2; const float keep = up ? v[i + 2] : v[i], send = up ? v[i] : v[i + 2]; v[i] = keep + __shfl_xor(send, 2); }
  { const bool up = lane & 1; const float keep = up ? v[1] : v[0], send = up ? v[0] : v[1]; v[0] = keep + __shfl_xor(send, 1); }
}
DI void tred8(float (&v)[8], int lane) {
#pragma unroll
  for (int i = 0; i < 4; ++i) v[i] = fswap32_add(v[i], v[i + 4]);
#pragma unroll
  for (int i = 0; i < 2; ++i) v[i] = fswap16_add(v[i], v[i + 2]);
  { const bool up = lane & 8; const float keep = up ? v[1] : v[0], send = up ? v[0] : v[1]; v[0] = keep + __shfl_xor(send, 8); }
  v[0] += __shfl_xor(v[0], 4); v[0] += __shfl_xor(v[0], 2); v[0] += __shfl_xor(v[0], 1);
}
#define RDL(v, l) __int_as_float(__builtin_amdgcn_readlane(__float_as_int(v), (l)))
DI float wave_sum_dpp(float v) {
  v += __int_as_float(__builtin_amdgcn_update_dpp(0, __float_as_int(v), 0xB1, 0xF, 0xF, true));
  v += __int_as_float(__builtin_amdgcn_update_dpp(0, __float_as_int(v), 0x4E, 0xF, 0xF, true));
  v += __int_as_float(__builtin_amdgcn_update_dpp(0, __float_as_int(v), 0x124, 0xF, 0xF, true));
  v += __int_as_float(__builtin_amdgcn_update_dpp(0, __float_as_int(v), 0x128, 0xF, 0xF, true));
  return (RDL(v, 0) + RDL(v, 16)) + (RDL(v, 32) + RDL(v, 48));
}
DI void route_one(const float (&lg)[36], int& x0, int& x1, float& g0, float& g1) {
  int gs = 0; float gm = lg[0];
#pragma unroll
  for (int j = 1; j < 4; ++j) { const bool gt = lg[j] > gm; gm = gt ? lg[j] : gm; gs = gt ? j : gs; }
  gs = __builtin_amdgcn_readfirstlane(gs);
  float z = 0.f;
#pragma unroll
  for (int j = 0; j < 4; ++j) z += __expf(lg[j] - gm);
  const float pg = 1.0f / z;
  float le[8];
#pragma unroll
  for (int i = 0; i < 8; ++i) le[i] = gs == 0 ? lg[4 + i] : (gs == 1 ? lg[12 + i] : (gs == 2 ? lg[20 + i] : lg[28 + i]));
  int i0e = 0; float m0 = le[0];
#pragma unroll
  for (int i = 1; i < 8; ++i) { const bool gt = le[i] > m0; m0 = gt ? le[i] : m0; i0e = gt ? i : i0e; }
  i0e = __builtin_amdgcn_readfirstlane(i0e);
  int i1e = -1; float m1 = -INFINITY;
#pragma unroll
  for (int i = 0; i < 8; ++i) { const bool gt = (i != i0e) && (le[i] > m1); m1 = gt ? le[i] : m1; i1e = gt ? i : i1e; }
  i1e = __builtin_amdgcn_readfirstlane(i1e);
  const float e1 = __expf(m1 - m0);
  g0 = pg / (1.0f + e1); g1 = pg * e1 / (1.0f + e1);
  x0 = gs * 8 + i0e; x1 = gs * 8 + i1e;
}
DI void router_phase(const Ctx& F, const Params& P, int L) {
  unsigned char* ws = P.ws;
  LAS float* wl = (LAS float*)F.lds;
  LAS int* lcnt = (LAS int*)(F.lds + 147456);
  LAS int* lbase = lcnt + 32;
  LAS i32x4* lasg = (LAS i32x4*)(F.lds + 147456 + 256);
  const float* wrg = (const float*)(ws + (L ? WS_WR1 : WS_WR0));
  const int lane = lane_id_v(); const int tid = F.wave * 64 + lane;
  for (int i = tid; i < 36 * 1024 / 4; i += 512) ((LAS f32x4*)wl)[i] = ((const f32x4*)wrg)[i];
  int* cnt = (int*)(ws + WS_CTL) + L * 64; int* list = (int*)(ws + WS_LIST);
  int4* asg = (int4*)(ws + WS_ASG); float2* asgg = (float2*)(ws + WS_ASGG);
  bf16_t* XN = (bf16_t*)(ws + WS_XN);
  const int niter = (NTOK + F.NGW - 1) / F.NGW;
  for (int i0 = 0; i0 < niter; i0 += 32) {
    if (tid < 32) lcnt[tid] = 0;
    __syncthreads();
    for (int i2 = 0; i2 < 32; i2 += 2) {
      if (i0 + i2 >= niter) break;
      int mk[2]; bool okk[2];
#pragma unroll
      for (int k = 0; k < 2; ++k) { const int m = F.gw + (i0 + i2 + k) * F.NGW; okk[k] = (i0 + i2 + k < niter) && (m < NTOK); mk[k] = okk[k] ? m : F.gw; }
      f32x4 v[2][4]; float rstd[2];
#pragma unroll
      for (int k = 0; k < 2; ++k) { const f32x4* xr = (const f32x4*)(P.out + (size_t)mk[k] * DM) + lane; float ss = 0.f;
#pragma unroll
        for (int j = 0; j < 4; ++j) { v[k][j] = xr[64 * j]; ss += (v[k][j].x * v[k][j].x + v[k][j].y * v[k][j].y) + (v[k][j].z * v[k][j].z + v[k][j].w * v[k][j].w); }
        rstd[k] = 1.0f / sqrtf(wave_sum_dpp(ss) * (1.f / DM) + NORM_EPS); }
#pragma unroll
      for (int k = 0; k < 2; ++k) if (okk[k]) { unsigned long long* o8 = (unsigned long long*)(XN + (size_t)mk[k] * DM) + lane;
#pragma unroll
        for (int j = 0; j < 4; ++j) o8[64 * j] = (unsigned long long)pk2(v[k][j].x * rstd[k], v[k][j].y * rstd[k]) | ((unsigned long long)pk2(v[k][j].z * rstd[k], v[k][j].w * rstd[k]) << 32); }
      f32x2 vp[4][4];
#pragma unroll
      for (int j = 0; j < 4; ++j) { vp[j][0] = (f32x2){v[0][j].x, v[1][j].x}; vp[j][1] = (f32x2){v[0][j].y, v[1][j].y}; vp[j][2] = (f32x2){v[0][j].z, v[1][j].z}; vp[j][3] = (f32x2){v[0][j].w, v[1][j].w}; }
      float va[64], vb[8];
#pragma unroll
      for (int jc = 0; jc < 36; ++jc) {
        f32x4 w4[4];
#pragma unroll
        for (int j = 0; j < 4; ++j) w4[j] = *(const LAS f32x4*)(wl + jc * 1024 + 256 * j + 4 * lane);
        f32x2 a = {0.f, 0.f};
#pragma unroll
        for (int j = 0; j < 4; ++j) {
          a = __builtin_elementwise_fma(vp[j][0], (f32x2){w4[j].x, w4[j].x}, a); a = __builtin_elementwise_fma(vp[j][1], (f32x2){w4[j].y, w4[j].y}, a);
          a = __builtin_elementwise_fma(vp[j][2], (f32x2){w4[j].z, w4[j].z}, a); a = __builtin_elementwise_fma(vp[j][3], (f32x2){w4[j].w, w4[j].w}, a); }
        va[jc] = a.x;
        { const int idx = 36 + jc; if (idx < 64) va[idx] = a.y; else vb[idx - 64] = a.y; }
        if ((jc & 1) == 1) asm volatile("" ::: "memory");
      }
      tred64(va, lane); tred8(vb, lane);
      const int zv = opaque(0);
      float lg0[36], lg1[36];
#pragma unroll
      for (int jc = 0; jc < 36; ++jc) {
        const float bias = wrg[36 * 1024 + jc + zv];
        { float t = RDL(va[0], jc) * rstd[0] + bias; asm volatile("" : "+v"(t)); lg0[jc] = t; }
        { const int idx = 36 + jc; const float tot = idx < 64 ? RDL(va[0], idx < 64 ? idx : 0) : RDL(vb[0], idx >= 64 ? 8 * (idx - 64) : 0); float t = tot * rstd[1] + bias; asm volatile("" : "+v"(t)); lg1[jc] = t; }
      }
#define ROUTE_K(k, LG) { int x0, x1; float g0, g1; route_one(LG, x0, x1, g0, g1); \
        if (lane == 0 && okk[k]) { \
          const int r0 = __hip_atomic_fetch_add(lcnt + x0, 1, __ATOMIC_RELAXED, __HIP_MEMORY_SCOPE_WORKGROUP); \
          const int r1 = __hip_atomic_fetch_add(lcnt + x1, 1, __ATOMIC_RELAXED, __HIP_MEMORY_SCOPE_WORKGROUP); \
          lasg[(i2 + k) * 8 + F.wave] = (i32x4){x0, x1, r0, r1}; asgg[mk[k]] = make_float2(g0, g1); } }
      ROUTE_K(0, lg0) ROUTE_K(1, lg1)
#undef ROUTE_K
    }
    __syncthreads();
    if (tid < 32) lbase[tid] = atomicAdd(cnt + tid, lcnt[tid]);
    __syncthreads();
    if (tid < 256) {
      const int ii = tid >> 3, wv = tid & 7; const int m = (int)blockIdx.x * 8 + wv + (i0 + ii) * F.NGW;
      if (i0 + ii < niter && m < NTOK) {
        const i32x4 a = lasg[tid]; const int r0 = lbase[a.x] + a.z, r1 = lbase[a.y] + a.w;
        list[a.x * 65536 + r0] = m; list[a.y * 65536 + r1] = m; asg[m] = make_int4(a.x, a.y, r0, r1);
      }
    }
    __syncthreads();
  }
}
DI void moe_setup(const Ctx& F, const Params& P, int L) {
  LAS int* pb = (LAS int*)(F.lds + LDS_MISC); LAS int* cl = pb + 64;
  const int* cnt = (const int*)(P.ws + WS_CTL) + L * 64;
  const int tid = F.wave * 64 + lane_id_v();
  __syncthreads();
  if (tid < 32) cl[tid] = cnt[tid];
  __syncthreads();
  if (tid == 0) { int a = 0; for (int e = 0; e < NEXP; ++e) { pb[e] = a; a += (cl[e] + 255) >> 8; } pb[NEXP] = a; }
  __syncthreads();
}
DI void combine_phase(const Ctx& F, const Params& P, int L, bool with_norm) {
  unsigned char* ws = P.ws;
  moe_setup(F, P, L);
  const LAS int* pb = (const LAS int*)(F.lds + LDS_MISC);
  const int4* asg = (const int4*)(ws + WS_ASG); const float2* asgg = (const float2*)(ws + WS_ASGG);
  const bf16_t* Y = (const bf16_t*)(ws + WS_PROJ); bf16_t* XN = (bf16_t*)(ws + WS_XN);
  const int lane = lane_id_v();
  for (int m = F.gw; m < NTOK; m += F.NGW) {
    const int4 a = asg[m]; const float2 gg = asgg[m];
    const size_t row0 = (size_t)pb[a.x] * 256 + a.z, row1 = (size_t)pb[a.y] * 256 + a.w;
    f32x4* xr = (f32x4*)(P.out + (size_t)m * DM) + lane;
    const u32x2* y0 = (const u32x2*)(Y + row0 * DM) + lane; const u32x2* y1 = (const u32x2*)(Y + row1 * DM) + lane;
    f32x4 v[4]; float ss = 0.f;
#pragma unroll
    for (int j = 0; j < 4; ++j) { f32x4 x = xr[64 * j]; const u32x2 a0 = y0[64 * j], a1 = y1[64 * j];
      x.x += gg.x * bflo(a0.x) + gg.y * bflo(a1.x); x.y += gg.x * bfhi(a0.x) + gg.y * bfhi(a1.x); x.z += gg.x * bflo(a0.y) + gg.y * bflo(a1.y); x.w += gg.x * bfhi(a0.y) + gg.y * bfhi(a1.y);
      xr[64 * j] = x; v[j] = x; ss += (x.x * x.x + x.y * x.y) + (x.z * x.z + x.w * x.w); }
    if (with_norm) {
      const float rstd = 1.0f / sqrtf(wave_sum(ss) * (1.f / DM) + NORM_EPS);
      unsigned long long* o8 = (unsigned long long*)(XN + (size_t)m * DM) + lane;
#pragma unroll
      for (int j = 0; j < 4; ++j) o8[64 * j] = (unsigned long long)pk2(v[j].x * rstd, v[j].y * rstd) | ((unsigned long long)pk2(v[j].z * rstd, v[j].w * rstd) << 32);
    }
  }
}
template <class Bar> DI void moe_gemms(const Ctx& F, const Params& P, int L, const Bar& gbar) {
  unsigned char* ws = P.ws;
  const int vcu = (F.G % 8 == 0) ? ((int)(blockIdx.x % 8) * (F.G / 8) + (int)(blockIdx.x / 8)) : (int)blockIdx.x;
  moe_setup(F, P, L);
  {
    pg8::MoeSched<true> S{(const LAS int*)(F.lds + LDS_MISC), (const LAS int*)(F.lds + LDS_MISC) + 64, (const int*)(ws + WS_LIST), (const char*)(ws + (L ? WS_WGU1 : WS_WGU0)), F.G, vcu, 1024};
    pg8::EpiSwiGLU E{(bf16_t*)(ws + WS_H)};
    pg8::gemm_phase<pg8::EpiSwiGLU, pg8::MoeSched<true>, true>(F.lds, F.wave, (const char*)(ws + WS_XN), 1024, S, E);
  }
  xcd_barrier(gbar);
  {
    pg8::MoeSched<false> S{(const LAS int*)(F.lds + LDS_MISC), (const LAS int*)(F.lds + LDS_MISC) + 64, nullptr, (const char*)(ws + (L ? WS_WD1 : WS_WD0)), F.G, vcu, 512};
    pg8::EpiBf16 E{(bf16_t*)(ws + WS_PROJ), DM};
    pg8::gemm_phase<pg8::EpiBf16, pg8::MoeSched<false>, true>(F.lds, F.wave, (const char*)(ws + WS_H), 512, S, E);
  }
}

struct Tok1 { u32x4 q0, q1, k; f32x4 cs[2], sn[2]; };
DI void p8b_transform1(const Ctx& F, const Params& P) {
  bf16_t* QKV = (bf16_t*)(P.ws + WS_PROJ);
  const float* cosT = (const float*)(P.ws + WS_ROPE); const float* sinT = cosT + SEQ * 32;
  const int lane = lane_id_v(), sub = lane & 7, grp = lane >> 3;
  float gq[8], gk[8];
#pragma unroll
  for (int j = 0; j < 8; ++j) { gq[j] = P.in[I_QN1][8 * sub + j]; gk[j] = P.in[I_KN1][8 * sub + j]; }
  const int kcol = 1024 + (grp & 3) * 64 + sub * 8;
  auto load = [&](Tok1& T, int m) {
    const int t = m & (SEQ - 1); const bf16_t* row = QKV + (size_t)m * W1;
    T.q0 = *(const u32x4*)(row + grp * 64 + sub * 8); T.q1 = *(const u32x4*)(row + 512 + grp * 64 + sub * 8); T.k = *(const u32x4*)(row + kcol);
    const f32x4* cp = (const f32x4*)(cosT + t * 32 + 8 * (sub & 3)); const f32x4* sp = (const f32x4*)(sinT + t * 32 + 8 * (sub & 3));
    T.cs[0] = cp[0]; T.cs[1] = cp[1]; T.sn[0] = sp[0]; T.sn[1] = sp[1];
  };
  auto process = [&](const Tok1& T, int m) {
    bf16_t* row = QKV + (size_t)m * W1;
    *(u32x4*)(row + grp * 64 + sub * 8) = normrope8(T.q0, gq, true, T.cs, T.sn, sub, 0.125f * LOG2E);
    *(u32x4*)(row + 512 + grp * 64 + sub * 8) = normrope8(T.q1, gq, true, T.cs, T.sn, sub, 0.125f * LOG2E);
    const u32x4 r = normrope8(T.k, gk, true, T.cs, T.sn, sub, 1.f);
    if (grp < 4) *(u32x4*)(row + kcol) = r;
  };
  Tok1 A, B;
  int m = F.gw;
  if (m < NTOK) load(A, m);
  while (m < NTOK) {
    const int m1 = m + F.NGW;
    if (m1 < NTOK) load(B, m1);
    process(A, m);
    if (m1 >= NTOK) break;
    const int m2 = m1 + F.NGW;
    if (m2 < NTOK) load(A, m2);
    process(B, m1);
    m = m2;
  }
}

DI void dil_phase(const Ctx& F, const Params& P) {
  const bf16_t* QKV = (const bf16_t*)(P.ws + WS_PROJ); bf16_t* MIX = (bf16_t*)(P.ws + WS_MIX);
  LAS unsigned char* kst = F.lds + F.wave * 8192;
  LAS unsigned char* vst = kst + 4096;
  float cshift; { const int l0 = lane_id_v(); cshift = 8.f * wave_max(fabsf(P.in[I_QN1][l0])) * wave_max(fabsf(P.in[I_KN1][l0])) * 1.02f; }
  const float c1 = 0.125f * LOG2E, c2 = cshift * LOG2E;
  const int gwv = ((F.G % 8 == 0) ? ((int)(blockIdx.x % 8) * (F.G / 8) + (int)(blockIdx.x / 8)) : (int)blockIdx.x) * 8 + F.wave;
  for (int it = gwv; it < 32768; it += F.NGW) {
    const int lane = lane_id_v(), c = lane & 31, half = lane >> 5, qi = c >> 2, gq = c & 3;
    const int q4 = (lane & 15) >> 2, p4 = lane & 3, blk = (lane >> 4) & 1;
    const int lrow = lane >> 3, lch = lane & 7;
    const int r = it & 15, tile = (it >> 4) & 31, kh = (it >> 9) & 3, b = it >> 11;
    const size_t rb = (size_t)b * SEQ; const int tmax = tile * 128 + r + 112, tq = tile * 128 + r + 16 * qi;
    bf16x8 qf[4];
    { const bf16_t* qp = QKV + (rb + tq) * W1 + (4 * kh + gq) * 64 + 8 * half;
#pragma unroll
      for (int ks = 0; ks < 4; ++ks) qf[ks] = *(const bf16x8*)(qp + 16 * ks); }
    f32x16 o0, o1;
#pragma unroll
    for (int i = 0; i < 16; ++i) { o0[i] = 0.f; o1[i] = 0.f; }
    float lsum = 0.f;
    const bf16_t* gbase = QKV + rb * W1 + 1024 + kh * 64 + lch * 8;
    auto tile_sh = [](int ti) { return ti < 8 ? 0 : (ti < 13 ? 2 : 4); };
    auto tile_T = [](int ti) { return ti < 8 ? ti : (ti < 13 ? ti - 8 : ti - 13); };
    u32x4 gk[4], gv[4];
    auto issue = [&](int ti) { const int sh = tile_sh(ti), T = tile_T(ti);
#pragma unroll
      for (int i = 0; i < 4; ++i) { const int n = 32 * T + lrow + 8 * i; int pos = tmax - (n << sh); pos = pos < 0 ? 0 : pos;
        const bf16_t* rp = gbase + (size_t)pos * W1; gk[i] = *(const u32x4*)rp; gv[i] = *(const u32x4*)(rp + 256); } };
    issue(0);
#pragma unroll 1
    for (int ti = 0; ti < 18; ++ti) {
      const int sh = tile_sh(ti), T = tile_T(ti);
      const int ei = (16 >> sh) * (7 - qi);
#pragma unroll
      for (int i = 0; i < 4; ++i) { const int row = lrow + 8 * i; const int off = row * 128 + ((lch ^ (row & 7)) << 4);
        *(LAS u32x4*)(kst + off) = gk[i]; *(LAS u32x4*)(vst + off) = gv[i]; }
      if (ti + 1 < 18) issue(ti + 1);
      asm volatile("" ::: "memory");
      f32x16 s;
#pragma unroll
      for (int i = 0; i < 16; ++i) s[i] = -c2;
#pragma unroll
      for (int ks = 0; ks < 4; ++ks) { const bf16x8 kf = *(const LAS bf16x8*)(kst + c * 128 + (((2 * ks + half) ^ (c & 7)) << 4)); s = __builtin_amdgcn_mfma_f32_32x32x16_bf16(kf, qf[ks], s, 0, 0, 0); }
#pragma unroll
      for (int reg = 0; reg < 16; ++reg) { const int nn = 32 * T + (reg & 3) + 8 * (reg >> 2) + 4 * half; const int ps = tmax - (nn << sh);
        const bool ok = (nn >= ei) && (nn <= ei + 128) && (ps >= 0);
        const float p = ok ? __builtin_amdgcn_exp2f(s[reg]) : 0.f; s[reg] = p; lsum += p; }
#pragma unroll
      for (int st = 0; st < 2; ++st) {
        u32x4 pw; pw.x = pk2(s[8 * st], s[8 * st + 1]); pw.y = pk2(s[8 * st + 2], s[8 * st + 3]); pw.z = pk2(s[8 * st + 4], s[8 * st + 5]); pw.w = pk2(s[8 * st + 6], s[8 * st + 7]);
        const bf16x8 pf = __builtin_bit_cast(bf16x8, pw);
        const int r1 = 16 * st + 4 * half + q4, r2 = r1 + 8;
#pragma unroll
        for (int dblk = 0; dblk < 2; ++dblk) {
          const int ch = 4 * dblk + 2 * blk + (p4 >> 1), bo = (p4 & 1) * 8;
          const s16x4 lo = tr_read(vst + r1 * 128 + (((ch ^ (r1 & 7)) << 4) + bo)), hi = tr_read(vst + r2 * 128 + (((ch ^ (r2 & 7)) << 4) + bo));
          const bf16x8 vf = __builtin_shufflevector(lo, hi, 0, 1, 2, 3, 4, 5, 6, 7);
          if (dblk == 0) o0 = __builtin_amdgcn_mfma_f32_32x32x16_bf16(vf, pf, o0, 0, 0, 0); else o1 = __builtin_amdgcn_mfma_f32_32x32x16_bf16(vf, pf, o1, 0, 0, 0);
        }
      }
      asm volatile("" ::: "memory");
    }
    lsum += __shfl_xor(lsum, 32);
    const float inv = 1.0f / lsum;
    bf16_t* op = MIX + (rb + tq) * DM + (4 * kh + gq) * 64 + 4 * half;
#pragma unroll
    for (int gI = 0; gI < 4; ++gI) {
      u32x2 w0; w0.x = pk2(o0[4 * gI] * inv, o0[4 * gI + 1] * inv); w0.y = pk2(o0[4 * gI + 2] * inv, o0[4 * gI + 3] * inv); *(u32x2*)(op + 8 * gI) = w0;
      u32x2 w1; w1.x = pk2(o1[4 * gI] * inv, o1[4 * gI + 1] * inv); w1.y = pk2(o1[4 * gI + 2] * inv, o1[4 * gI + 3] * inv); *(u32x2*)(op + 32 + 8 * gI) = w1;
    }
  }
}

#define XB_TMO      128
#define XB_XCNT(j)  (256  + 64 * (j))
#define XB_XSUB(j)  (1280 + 64 * (j))
#define XB_XGEN(j)  (2304 + 64 * (j))
#define XB_TOP      3328
#define XB_TOPGEN   3392
#define XCD_BAR_WORDS 3456
#define XB_SPIN_CAP (1u << 18)

__device__ __forceinline__ unsigned xb_ld(unsigned* p)              { return __hip_atomic_load(p, __ATOMIC_RELAXED, __HIP_MEMORY_SCOPE_AGENT); }
__device__ __forceinline__ unsigned xb_add(unsigned* p, unsigned v) { return __hip_atomic_fetch_add(p, v, __ATOMIC_RELAXED, __HIP_MEMORY_SCOPE_AGENT); }
__device__ __forceinline__ unsigned xb_xcc_id() { return (unsigned)__builtin_amdgcn_s_getreg((3 << 11) | 20) & 0xFu; }
#define XB_SPIN(cond, bar) do { unsigned _sp = 0; while (cond) { __builtin_amdgcn_s_sleep(1); \
    if ((++_sp & 255u) == 0u) { if (xb_ld(&(bar)[XB_TMO])) break; if (_sp > XB_SPIN_CAP) { atomicAdd(&(bar)[XB_TMO], 1u); break; } } } } while (0)

struct XcdBarrier {
    unsigned* bar; unsigned x;
    volatile LAS unsigned* st;
};

__device__ __forceinline__ XcdBarrier xcd_barrier_post(unsigned* bar, volatile LAS unsigned* st) {
    XcdBarrier b; b.bar = bar; b.x = xb_xcc_id(); b.st = st;
    if (threadIdx.x == 0) (void)xb_add(&bar[XB_XCNT(b.x)], 1u);
    return b;
}
__device__ __forceinline__ void xcd_barrier_complete(unsigned* bar, unsigned x, unsigned& nloc, unsigned& nx) {
    const unsigned G = gridDim.x * gridDim.y * gridDim.z;
    unsigned sum, cnt, mine, sp = 0u;
    for (;;) {
        sum = 0u; cnt = 0u; mine = 0u;
#pragma unroll
        for (unsigned j = 0; j < 16; ++j) { const unsigned c = xb_ld(&bar[XB_XCNT(j)]); sum += c; cnt += (c > 0u) ? 1u : 0u; mine = (j == x) ? c : mine; }
        if (sum == G) break;
        __builtin_amdgcn_s_sleep(1);
        if ((++sp & 255u) == 0u) { if (xb_ld(&bar[XB_TMO])) break; if (sp > XB_SPIN_CAP) { atomicAdd(&bar[XB_TMO], 1u); break; } }
    }
    nloc = mine > 0u ? mine : 1u; nx = cnt > 0u ? cnt : 1u;
}

__device__ __forceinline__ void xcd_barrier(const XcdBarrier& b) {
    asm volatile("s_waitcnt vmcnt(0)" ::: "memory");
    __syncthreads();
    if (threadIdx.x == 0) {
        unsigned* bar = b.bar;
        __builtin_amdgcn_s_waitcnt(0);
        unsigned nloc = b.st[0], nx = b.st[1];
        if (nloc == 0u) { xcd_barrier_complete(bar, b.x, nloc, nx); b.st[0] = nloc; b.st[1] = nx; }
        const unsigned old = xb_add(&bar[XB_XSUB(b.x)], 1u);
        const unsigned gen = old / nloc;
        if (old + 1u == (gen + 1u) * nloc) {
            __builtin_amdgcn_fence(__ATOMIC_RELEASE, "agent");
            asm volatile("s_waitcnt vmcnt(0)" ::: "memory");
            const unsigned og = xb_add(&bar[XB_TOP], 1u);
            const unsigned tg = og / nx;
            if (og + 1u == (tg + 1u) * nx) xb_add(&bar[XB_TOPGEN], 1u);
            else XB_SPIN(xb_ld(&bar[XB_TOPGEN]) == tg, bar);
            __builtin_amdgcn_fence(__ATOMIC_ACQUIRE, "agent");
            xb_add(&bar[XB_XGEN(b.x)], 1u);
            asm volatile("s_waitcnt vmcnt(0)" ::: "memory");
        } else {
            XB_SPIN(xb_ld(&bar[XB_XGEN(b.x)]) == gen, bar);
            __builtin_amdgcn_fence(__ATOMIC_ACQUIRE, "agent");
            asm volatile("s_waitcnt vmcnt(0)" ::: "memory");
        }
    }
    __syncthreads();
}


__global__ void __launch_bounds__(512, 2) fwd_megakernel(Params P) {
  extern __shared__ __attribute__((aligned(16))) unsigned char lds_raw[];
  cg::grid_group grid = cg::this_grid();
  Ctx F; F.lds = (LAS unsigned char*)lds_raw; F.wave = __builtin_amdgcn_readfirstlane((int)threadIdx.x >> 6);
  F.G = gridDim.x; F.gw = blockIdx.x * 8 + F.wave; F.NGW = F.G * 8;
  unsigned char* ws = P.ws;
  volatile LAS unsigned* xst = (volatile LAS unsigned*)(F.lds + LDS_BYTES - 16);
  if (threadIdx.x < 2) xst[threadIdx.x] = 0u;
  unsigned* xbar_words = (unsigned*)(ws + WS_CTL + 65536);
  if (blockIdx.x == 0) for (int i = threadIdx.x; i < XCD_BAR_WORDS; i += 512) xbar_words[i] = 0u;
  __syncthreads();
  XcdBarrier xbar; xbar.bar = xbar_words; xbar.x = 0; xbar.st = xst;
#define GRID_BAR() xcd_barrier(xbar)

#ifndef PHMASK
#define PHMASK 0xFFFFFFFFu
#endif
#define PH(n) if ((PHMASK >> (n)) & 1u)
#if defined(TIMEDSA) && !defined(TIMEPH)
#define TIMEPH 99
#define TIMEN 1
#endif
#ifdef TIMEPH
  unsigned long long* tsw = (unsigned long long*)(ws + WS_CTL + 4096);
#define TS_BEGIN(n) if ((n) >= TIMEPH && (n) < TIMEPH + TIMEN && (n) == TIMEPH && blockIdx.x == 0 && threadIdx.x == 0) tsw[0] = __builtin_amdgcn_s_memrealtime();
#define TS_END(n) if ((n) == TIMEPH + TIMEN - 1 && blockIdx.x == 0 && threadIdx.x == 0) tsw[1] = __builtin_amdgcn_s_memrealtime();
#else
#define TS_BEGIN(n)
#define TS_END(n)
#endif
  TS_BEGIN(0)
  PH(0) p0_prologue(F, P);
  grid.sync();
  xbar = xcd_barrier_post(xbar_words, xst);
  TS_END(0)
  TS_BEGIN(1)
  PH(1) {
    pg8::DenseSched S; S.init(NTOK, W0P, 1024, ws + WS_WIN0, F.G, (int)blockIdx.x);
    pg8::EpiBf16 E{(bf16_t*)(ws + WS_PROJ), W0P};
    pg8::gemm_phase<pg8::EpiBf16, pg8::DenseSched, true>(F.lds, F.wave, (const char*)(ws + WS_XN), 1024, S, E);
  }
  GRID_BAR();
  TS_END(1)
  TS_BEGIN(2)
  PH(2) p1b_transform0(F, P);
  GRID_BAR();
  TS_END(2)
  TS_BEGIN(3)
  PH(3) dsa_phase(F, P);
  GRID_BAR();
  TS_END(3)
  TS_BEGIN(4)
  PH(4) {
    pg8::DenseSched S; S.init(NTOK, 1024, 1024, ws + WS_WOUT0, F.G, (int)blockIdx.x);
    pg8::EpiResF32 E{P.in[I_X], P.out, DM};
    pg8::gemm_phase<pg8::EpiResF32, pg8::DenseSched, true>(F.lds, F.wave, (const char*)(ws + WS_MIX), 1024, S, E);
  }
  GRID_BAR();
  TS_END(4)
  TS_BEGIN(5)
  PH(5) router_phase(F, P, 0);
  GRID_BAR();
  TS_END(5)
  TS_BEGIN(6)
  PH(6) moe_gemms(F, P, 0, xbar);
  GRID_BAR();
  TS_END(6)
  TS_BEGIN(7)
  PH(7) combine_phase(F, P, 0, true);
  GRID_BAR();
  TS_END(7)
  TS_BEGIN(8)
  PH(8) {
    pg8::DenseSched S; S.init(NTOK, W1, 1024, ws + WS_WIN1, F.G, (int)blockIdx.x);
    pg8::EpiBf16 E{(bf16_t*)(ws + WS_PROJ), W1};
    pg8::gemm_phase<pg8::EpiBf16, pg8::DenseSched, true>(F.lds, F.wave, (const char*)(ws + WS_XN), 1024, S, E);
  }
  GRID_BAR();
  TS_END(8)
  TS_BEGIN(9)
  PH(9) p8b_transform1(F, P);
  GRID_BAR();
  TS_END(9)
  TS_BEGIN(10)
  PH(10) dil_phase(F, P);
  GRID_BAR();
  TS_END(10)
  TS_BEGIN(11)
  PH(11) {
    pg8::DenseSched S; S.init(NTOK, 1024, 1024, ws + WS_WOUT1, F.G, (int)blockIdx.x);
    pg8::EpiResF32 E{P.out, P.out, DM};
    pg8::gemm_phase<pg8::EpiResF32, pg8::DenseSched, true>(F.lds, F.wave, (const char*)(ws + WS_MIX), 1024, S, E);
  }
  GRID_BAR();
  TS_END(11)
  TS_BEGIN(12)
  PH(12) router_phase(F, P, 1);
  GRID_BAR();
  TS_END(12)
  TS_BEGIN(13)
  PH(13) moe_gemms(F, P, 1, xbar);
  GRID_BAR();
  TS_END(13)
  TS_BEGIN(14)
  PH(14) combine_phase(F, P, 1, false);
#ifdef TIMEPH
  GRID_BAR();
  TS_END(14)
  GRID_BAR();
  { const unsigned long long dt = (tsw[1] - tsw[0]) * 4ull; const unsigned long long t0 = __builtin_amdgcn_s_memrealtime();
    while (__builtin_amdgcn_s_memrealtime() - t0 < dt) __builtin_amdgcn_s_sleep(32); }
#endif
}

extern "C" void kernel_launch(void* const* d_in, const int* in_sizes, int n_in, void* d_out, int out_size, void* d_ws, size_t ws_size, hipStream_t stream) {
  static int grid_blocks = 0;
  if (!grid_blocks) {
    if (n_in != 28 || out_size != NTOK * DM || ws_size < WS_END) { fprintf(stderr, "kernel_launch: unexpected shapes (n_in %d out %d ws %zu)\n", n_in, out_size, ws_size); grid_blocks = -1; return; }
    int dev = 0, cus = 0, per_cu = 0;
    (void)hipGetDevice(&dev);
    (void)hipDeviceGetAttribute(&cus, hipDeviceAttributeMultiprocessorCount, dev);
    (void)hipFuncSetAttribute((const void*)fwd_megakernel, hipFuncAttributeMaxDynamicSharedMemorySize, LDS_BYTES);
    (void)hipOccupancyMaxActiveBlocksPerMultiprocessor(&per_cu, (const void*)fwd_megakernel, 512, LDS_BYTES);
    if (per_cu < 1) per_cu = 1;
    grid_blocks = cus * per_cu;
  }
  if (grid_blocks < 0) return;
  Params p{};
  for (int i = 0; i < 28; ++i) p.in[i] = (const float*)d_in[i];
  p.out = (float*)d_out; p.ws = (unsigned char*)d_ws;
  void* args[] = {&p};
  hipError_t e = hipLaunchCooperativeKernel((const void*)fwd_megakernel, dim3(grid_blocks), dim3(512), args, LDS_BYTES, stream);
  if (e != hipSuccess) fprintf(stderr, "cooperative launch failed: %s (grid %d)\n", hipGetErrorString(e), grid_blocks);
}
```

```cpp
#include <hip/hip_runtime.h>
#include <hip/hip_cooperative_groups.h>
#include <cstdio>
#include <cstdint>
namespace cg = cooperative_groups;

#define LAS __attribute__((address_space(3)))
#define DI __device__ __forceinline__
typedef unsigned short bf16_t;
typedef short bf16x8 __attribute__((ext_vector_type(8)));
typedef short s16x4 __attribute__((ext_vector_type(4)));
typedef float f32x2 __attribute__((ext_vector_type(2)));
typedef float f32x4 __attribute__((ext_vector_type(4)));
typedef float f32x16 __attribute__((ext_vector_type(16)));
typedef unsigned u32x2 __attribute__((ext_vector_type(2)));
typedef unsigned u32x4 __attribute__((ext_vector_type(4)));
typedef int i32x4 __attribute__((ext_vector_type(4)));
typedef __bf16 bf16x2_t __attribute__((ext_vector_type(2)));

constexpr int NTOK = 65536, DM = 1024, SEQ = 4096, NBATCH = 16;
constexpr int W0P = 2560, W0V = 2500;
constexpr int W1 = 1536;
constexpr int C_CB = 0, C_CC = 512, C_CH = 1024, C_Q = 1536, C_K = 2048, C_V = 2112, C_IQ = 2176, C_IK = 2432, C_IW = 2496;
constexpr int NEXP = 32, DEXP = 512;
constexpr int MAXROWS = 139264;
constexpr float NORM_EPS = 1e-6f;
constexpr float LOG2E = 1.4426950408889634f;

constexpr size_t MiB = 1u << 20;
constexpr size_t WS_CTL = 0;
constexpr size_t WS_ROPE = 1 * MiB;
constexpr size_t WS_WR0 = 2 * MiB, WS_WR1 = 2 * MiB + 256 * 1024;
constexpr size_t WS_WIN0 = 3 * MiB, WS_WOUT0 = 8 * MiB, WS_WIN1 = 10 * MiB, WS_WOUT1 = 13 * MiB;
constexpr size_t WS_WGU0 = 16 * MiB, WS_WD0 = 80 * MiB, WS_WGU1 = 112 * MiB, WS_WD1 = 176 * MiB;
constexpr size_t WS_XN = 208 * MiB;
constexpr size_t WS_MIX = 337 * MiB;
constexpr size_t WS_H = 337 * MiB;
constexpr size_t WS_XB = 473 * MiB;
constexpr size_t WS_PROJ = 601 * MiB;
constexpr size_t WS_LIST = 921 * MiB;
constexpr size_t WS_ASG = 929 * MiB;
constexpr size_t WS_ASGG = 930 * MiB;
constexpr size_t WS_IKF = 931 * MiB, WS_KF = 939 * MiB, WS_VTF = 947 * MiB;
constexpr size_t WS_END = 955 * MiB;

constexpr int LDS_BYTES = 155648;
constexpr int LDS_LIST = 131072;
constexpr int LDS_MISC = 131072 + 16384;

DI unsigned pk2(float lo, float hi) { f32x2 v = {lo, hi}; bf16x2_t b = __builtin_convertvector(v, bf16x2_t); return __builtin_bit_cast(unsigned, b); }
DI float bflo(unsigned w) { return __uint_as_float(w << 16); }
DI float bfhi(unsigned w) { return __uint_as_float(w & 0xffff0000u); }
DI float bf1(bf16_t h) { return __uint_as_float((unsigned)h << 16); }
DI int opaque(int x) { asm volatile("" : "+v"(x)); return x; }
DI int lane_id_v() { int l; asm volatile("v_mbcnt_lo_u32_b32 %0, -1, 0\n\tv_mbcnt_hi_u32_b32 %0, -1, %0" : "=v"(l)); return l; }
DI float wave_sum(float v) {
#pragma unroll
  for (int o = 1; o < 64; o <<= 1) v += __shfl_xor(v, o);
  return v;
}
DI float wave_max(float v) {
#pragma unroll
  for (int o = 1; o < 64; o <<= 1) v = fmaxf(v, __shfl_xor(v, o));
  return v;
}
DI unsigned wave_sum_u(unsigned v) {
#pragma unroll
  for (int o = 1; o < 64; o <<= 1) v += (unsigned)__shfl_xor((int)v, o);
  return v;
}

namespace pg8 {
constexpr int BM = 256, BK = 64, HALF = 128, HTB = HALF * BK * 2, STAGE_BYTES = 8 * HTB, NXCD = 8, WGM = 8;
DI int lds_byte(int r, int c) { const int st = (r >> 4) * 2 + (c >> 5), rr = r & 15, cc = c & 31, ob = rr * 64 + cc * 2; return st * 1024 + (ob ^ (((ob >> 9) & 1) << 5)); }
DI void stage_rc(int b, int& R, int& C) { const int st = b / 1024, sb = b % 1024, swz = sb ^ (((sb >> 9) & 1) << 5); R = (st >> 1) * 16 + swz / 64; C = (st & 1) * 32 + (swz % 64) / 2; }
DI int perm32(int rho) { const int n = rho >> 4, i = rho & 15; return 8 * (i >> 2) + 4 * n + (i & 3); }

struct Unit { const char* b; int p0, p1, p2, p3; };

struct EpiBf16 {
  static constexpr bool PERM = true;
  bf16_t* O; int ldc;
  DI void operator()(const f32x4 (&acc)[2][2][4][2], const Unit& u, int wr, int wc, int fr, int fq) const {
    const int row0 = u.p0 + wr * 64 + fr, col0 = u.p1 + wc * 32 + 8 * fq;
#pragma unroll
    for (int ai = 0; ai < 2; ++ai)
#pragma unroll
      for (int m = 0; m < 4; ++m) { bf16_t* rowp = O + (size_t)(row0 + ai * HALF + m * 16) * ldc + col0;
#pragma unroll
        for (int bj = 0; bj < 2; ++bj) { const f32x4 v0 = acc[ai][bj][m][0], v1 = acc[ai][bj][m][1];
          u32x4 w; w.x = pk2(v0[0], v0[1]); w.y = pk2(v0[2], v0[3]); w.z = pk2(v1[0], v1[1]); w.w = pk2(v1[2], v1[3]);
          *(u32x4*)(rowp + bj * HALF) = w; } }
  }
};
template <bool BASE_F32> struct EpiResB {
  static constexpr bool PERM = true;
  const void* base; bf16_t* out; int ldc;
  DI void operator()(const f32x4 (&acc)[2][2][4][2], const Unit& u, int wr, int wc, int fr, int fq) const {
    const int row0 = u.p0 + wr * 64 + fr, col0 = u.p1 + wc * 32 + 8 * fq;
#pragma unroll
    for (int ai = 0; ai < 2; ++ai)
#pragma unroll
      for (int m = 0; m < 4; ++m) { const size_t off = (size_t)(row0 + ai * HALF + m * 16) * ldc + col0;
#pragma unroll
        for (int bj = 0; bj < 2; ++bj) { f32x4 v0 = acc[ai][bj][m][0], v1 = acc[ai][bj][m][1];
          if (BASE_F32) { const float* bp = (const float*)base + off + bj * HALF; v0 = v0 + *(const f32x4*)bp; v1 = v1 + *(const f32x4*)(bp + 4); }
          else { const u32x4 b = *(const u32x4*)((const bf16_t*)base + off + bj * HALF);
            v0 = v0 + (f32x4){bflo(b.x), bfhi(b.x), bflo(b.y), bfhi(b.y)}; v1 = v1 + (f32x4){bflo(b.z), bfhi(b.z), bflo(b.w), bfhi(b.w)}; }
          u32x4 w; w.x = pk2(v0[0], v0[1]); w.y = pk2(v0[2], v0[3]); w.z = pk2(v1[0], v1[1]); w.w = pk2(v1[2], v1[3]);
          *(u32x4*)(out + off + bj * HALF) = w; } }
  }
};
struct EpiQKV1 {
  static constexpr bool PERM = true;
  bf16_t* O; const float* qg; const float* kg; const float* cosT; const float* sinT;
  DI void operator()(const f32x4 (&acc)[2][2][4][2], const Unit& u, int wr, int wc, int fr, int fq) const {
    const int tilec = u.p1 >> 8;
    const int row0 = u.p0 + wr * 64 + fr, col0 = u.p1 + wc * 64 + 8 * fq;
    if (tilec == 5) {
#pragma unroll
      for (int ai = 0; ai < 2; ++ai)
#pragma unroll
        for (int m = 0; m < 4; ++m) { bf16_t* rowp = O + (size_t)(row0 + ai * HALF + m * 16) * W1 + col0;
#pragma unroll
          for (int bj = 0; bj < 2; ++bj) { const f32x4 v0 = acc[ai][bj][m][0], v1 = acc[ai][bj][m][1];
            u32x4 w; w.x = pk2(v0[0], v0[1]); w.y = pk2(v0[2], v0[3]); w.z = pk2(v1[0], v1[1]); w.w = pk2(v1[2], v1[3]); *(u32x4*)(rowp + 32 * bj) = w; } }
      return;
    }
    const float* gp = (tilec == 4 ? kg : qg) + 8 * fq; const float osc = tilec == 4 ? 1.f : 0.125f * LOG2E;
    float g0[8], g1[8];
#pragma unroll
    for (int i = 0; i < 8; ++i) { g0[i] = gp[i]; g1[i] = gp[32 + i]; }
#pragma unroll
    for (int ai = 0; ai < 2; ++ai)
#pragma unroll
      for (int m = 0; m < 4; ++m) {
        const int row = row0 + ai * HALF + m * 16; const int t = row & (SEQ - 1);
        const f32x4 a0 = acc[ai][0][m][0], a1 = acc[ai][0][m][1], b0 = acc[ai][1][m][0], b1 = acc[ai][1][m][1];
        float x1[8] = {a0[0], a0[1], a0[2], a0[3], a1[0], a1[1], a1[2], a1[3]}, x2[8] = {b0[0], b0[1], b0[2], b0[3], b1[0], b1[1], b1[2], b1[3]};
        float ss = 0.f;
#pragma unroll
        for (int i = 0; i < 8; ++i) ss += x1[i] * x1[i] + x2[i] * x2[i];
        ss += __shfl_xor(ss, 16); ss += __shfl_xor(ss, 32);
        const float rstd = 1.0f / sqrtf(ss * (1.f / 64.f) + NORM_EPS);
        const f32x4* cp = (const f32x4*)(cosT + t * 32 + 8 * fq); const f32x4* sp = (const f32x4*)(sinT + t * 32 + 8 * fq);
        const f32x4 c0 = cp[0], c1 = cp[1], s0 = sp[0], s1 = sp[1];
        const float cv[8] = {c0[0], c0[1], c0[2], c0[3], c1[0], c1[1], c1[2], c1[3]}, sv[8] = {s0[0], s0[1], s0[2], s0[3], s1[0], s1[1], s1[2], s1[3]};
        float o1[8], o2[8];
#pragma unroll
        for (int i = 0; i < 8; ++i) { const float y1 = x1[i] * rstd * g0[i], y2 = x2[i] * rstd * g1[i]; o1[i] = (y1 * cv[i] - y2 * sv[i]) * osc; o2[i] = (y1 * sv[i] + y2 * cv[i]) * osc; }
        bf16_t* rowp = O + (size_t)row * W1 + col0;
        u32x4 w; w.x = pk2(o1[0], o1[1]); w.y = pk2(o1[2], o1[3]); w.z = pk2(o1[4], o1[5]); w.w = pk2(o1[6], o1[7]); *(u32x4*)rowp = w;
        w.x = pk2(o2[0], o2[1]); w.y = pk2(o2[2], o2[3]); w.z = pk2(o2[4], o2[5]); w.w = pk2(o2[6], o2[7]); *(u32x4*)(rowp + 32) = w;
      }
  }
};
struct EpiProj0 {
  static constexpr bool PERM = true;
  bf16_t* O; bf16_t* KFo; bf16_t* IKFo; const float* qg; const float* kg; const float* cosT; const float* sinT;
  DI void operator()(const f32x4 (&acc)[2][2][4][2], const Unit& u, int wr, int wc, int fr, int fq) const {
    const int grp64 = (u.p1 >> 6) + wc;
    const int row0 = u.p0 + wr * 64 + fr, col0 = u.p1 + wc * 64 + 8 * fq;
    const bool rope = (grp64 >= 24 && grp64 <= 32) || (grp64 >= 34 && grp64 <= 38);
    if (!rope) {
#pragma unroll
      for (int ai = 0; ai < 2; ++ai)
#pragma unroll
        for (int m = 0; m < 4; ++m) { bf16_t* rowp = O + (size_t)(row0 + ai * HALF + m * 16) * W0P + col0;
#pragma unroll
          for (int bj = 0; bj < 2; ++bj) { const f32x4 v0 = acc[ai][bj][m][0], v1 = acc[ai][bj][m][1];
            u32x4 w; w.x = pk2(v0[0], v0[1]); w.y = pk2(v0[2], v0[3]); w.z = pk2(v1[0], v1[1]); w.w = pk2(v1[2], v1[3]); *(u32x4*)(rowp + 32 * bj) = w; } }
      return;
    }
    const bool norm = grp64 <= 32;
    const float* gp = (grp64 == 32 ? kg : qg) + 8 * fq;
    float g0[8], g1[8];
#pragma unroll
    for (int i = 0; i < 8; ++i) { g0[i] = norm ? gp[i] : 1.f; g1[i] = norm ? gp[32 + i] : 1.f; }
    bf16_t* frag = grp64 == 32 ? KFo : (grp64 == 38 ? IKFo : nullptr);
#pragma unroll
    for (int ai = 0; ai < 2; ++ai)
#pragma unroll
      for (int m = 0; m < 4; ++m) {
        const int row = row0 + ai * HALF + m * 16; const int t = row & (SEQ - 1);
        const f32x4 a0 = acc[ai][0][m][0], a1 = acc[ai][0][m][1], b0 = acc[ai][1][m][0], b1 = acc[ai][1][m][1];
        float x1[8] = {a0[0], a0[1], a0[2], a0[3], a1[0], a1[1], a1[2], a1[3]}, x2[8] = {b0[0], b0[1], b0[2], b0[3], b1[0], b1[1], b1[2], b1[3]};
        float ss = 0.f;
#pragma unroll
        for (int i = 0; i < 8; ++i) ss += x1[i] * x1[i] + x2[i] * x2[i];
        ss += __shfl_xor(ss, 16); ss += __shfl_xor(ss, 32);
        const float rstd = norm ? 1.0f / sqrtf(ss * (1.f / 64.f) + NORM_EPS) : 1.f;
        const f32x4* cp = (const f32x4*)(cosT + t * 32 + 8 * fq); const f32x4* sp = (const f32x4*)(sinT + t * 32 + 8 * fq);
        const f32x4 c0 = cp[0], c1 = cp[1], s0 = sp[0], s1 = sp[1];
        const float cv[8] = {c0[0], c0[1], c0[2], c0[3], c1[0], c1[1], c1[2], c1[3]}, sv[8] = {s0[0], s0[1], s0[2], s0[3], s1[0], s1[1], s1[2], s1[3]};
        float o1[8], o2[8];
#pragma unroll
        for (int i = 0; i < 8; ++i) { const float y1 = x1[i] * rstd * g0[i], y2 = x2[i] * rstd * g1[i]; o1[i] = y1 * cv[i] - y2 * sv[i]; o2[i] = y1 * sv[i] + y2 * cv[i]; }
        u32x4 w1, w2; w1.x = pk2(o1[0], o1[1]); w1.y = pk2(o1[2], o1[3]); w1.z = pk2(o1[4], o1[5]); w1.w = pk2(o1[6], o1[7]);
        w2.x = pk2(o2[0], o2[1]); w2.y = pk2(o2[2], o2[3]); w2.z = pk2(o2[4], o2[5]); w2.w = pk2(o2[6], o2[7]);
        if (frag) {
          const size_t fo = ((((size_t)(row >> 12) * 128 + (t >> 5)) * 4 + (fq >> 1)) * 64 + (fq & 1) * 32 + (t & 31)) * 8;
          *(u32x4*)(frag + fo) = w1; *(u32x4*)(frag + fo + 2 * 64 * 8) = w2;
        } else { bf16_t* rowp = O + (size_t)row * W0P + col0; *(u32x4*)rowp = w1; *(u32x4*)(rowp + 32) = w2; }
      }
  }
};
struct EpiResF32 {
  static constexpr bool PERM = false;
  const float* base; float* out; int ldc;
  DI void operator()(const f32x4 (&acc)[2][2][4][2], const Unit& u, int wr, int wc, int fr, int fq) const {
    const int row0 = u.p0 + wr * 64 + fr, col0 = u.p1 + wc * 32 + 4 * fq;
#pragma unroll
    for (int ai = 0; ai < 2; ++ai)
#pragma unroll
      for (int m = 0; m < 4; ++m) { const size_t off = (size_t)(row0 + ai * HALF + m * 16) * ldc + col0;
#pragma unroll
        for (int bj = 0; bj < 2; ++bj)
#pragma unroll
          for (int n = 0; n < 2; ++n) { const f32x4 bs = *(const f32x4*)(base + off + bj * HALF + n * 16); *(f32x4*)(out + off + bj * HALF + n * 16) = bs + acc[ai][bj][m][n]; } }
  }
};
DI float silu_mul(float g, float u) { return g * u * __builtin_amdgcn_rcpf(1.0f + __builtin_amdgcn_exp2f(-g * LOG2E)); }
struct EpiSwiGLU {
  static constexpr bool PERM = true;
  bf16_t* H;
  DI void operator()(const f32x4 (&acc)[2][2][4][2], const Unit& u, int wr, int wc, int fr, int fq) const {
    const int row0 = u.p0 + wr * 64 + fr, col0 = u.p1 + wc * 32 + 8 * fq;
#pragma unroll
    for (int ai = 0; ai < 2; ++ai)
#pragma unroll
      for (int m = 0; m < 4; ++m) { bf16_t* rowp = H + (size_t)(row0 + ai * HALF + m * 16) * DEXP + col0;
        const f32x4 g0 = acc[ai][0][m][0], g1 = acc[ai][0][m][1], u0 = acc[ai][1][m][0], u1 = acc[ai][1][m][1];
        u32x4 w; w.x = pk2(silu_mul(g0[0], u0[0]), silu_mul(g0[1], u0[1])); w.y = pk2(silu_mul(g0[2], u0[2]), silu_mul(g0[3], u0[3]));
        w.z = pk2(silu_mul(g1[0], u1[0]), silu_mul(g1[1], u1[1])); w.w = pk2(silu_mul(g1[2], u1[2]), silu_mul(g1[3], u1[3]));
        *(u32x4*)rowp = w; }
  }
};

struct DenseSched {
  static constexpr bool NEXT_IN_LDS = false;
  int nM, nN, nwg, G, c, K; const char* Bt;
  DI void init(int M, int N, int K_, const void* Bt_, int G_, int c_) { nM = M / BM; nN = N / BM; nwg = nM * nN; G = G_; c = c_; K = K_; Bt = (const char*)Bt_; }
  DI bool next(int i, Unit& u) const {
    const long L = (long)i * G + c; if (L >= nwg) return false;
    int wgid = (int)L; { const int q = nwg / NXCD, r = nwg % NXCD, xcd = wgid % NXCD, off = wgid / NXCD; wgid = (xcd < r ? xcd * (q + 1) : r * (q + 1) + (xcd - r) * q) + off; }
    const int nig = WGM * nN, gid = wgid / nig, fm = gid * WGM, gsz = (nM - fm) < WGM ? (nM - fm) : WGM;
    const int pm = fm + ((wgid % nig) % gsz), pn = (wgid % nig) / gsz;
    u.p0 = pm * BM; u.p1 = pn * BM; u.p2 = 0; u.p3 = 0; u.b = Bt + (size_t)pn * BM * K * 2; return true;
  }
  DI void a_off(const Unit& u, const int (&R)[2], const int (&C)[2], unsigned (&o)[2][2]) const {
#pragma unroll
    for (int h = 0; h < 2; ++h)
#pragma unroll
      for (int i = 0; i < 2; ++i) o[h][i] = (unsigned)((u.p0 + h * HALF + R[i]) * K + C[i]) * 2u;
  }
};
template <bool GATHER> struct MoeSched {
  static constexpr bool NEXT_IN_LDS = GATHER;
  const LAS int* pb; const LAS int* cnt; const int* list; const char* W; int G, c, K;
  DI bool next(int i, Unit& u) const {
    const int L = i * G + c; const int total = __builtin_amdgcn_readfirstlane(pb[NEXP]) * 4; if (L >= total) return false;
    const int rbg = L >> 2, pn = L & 3; int e = 0;
    for (int j = 1; j < NEXP; ++j) e = (__builtin_amdgcn_readfirstlane(pb[j]) <= rbg) ? j : e;
    u.p0 = rbg * BM; u.p1 = pn * (GATHER ? 128 : 256); u.p2 = e; u.p3 = rbg - __builtin_amdgcn_readfirstlane(pb[e]);
    u.b = W + (size_t)(e * 1024 + pn * 256) * K * 2; return true;
  }
  DI void a_off(const Unit& u, const int (&R)[2], const int (&C)[2], unsigned (&o)[2][2]) const {
    if (GATHER) {
      const int ce = __builtin_amdgcn_readfirstlane(cnt[u.p2]);
#pragma unroll
      for (int h = 0; h < 2; ++h)
#pragma unroll
        for (int i = 0; i < 2; ++i) { const int row = u.p3 * BM + h * HALF + R[i]; const int tok = (row < ce) ? list[u.p2 * 65536 + row] : NTOK; o[h][i] = (unsigned)(tok * K + C[i]) * 2u; }
    } else {
#pragma unroll
      for (int h = 0; h < 2; ++h)
#pragma unroll
        for (int i = 0; i < 2; ++i) o[h][i] = (unsigned)((u.p0 + h * HALF + R[i]) * K + C[i]) * 2u;
    }
  }
};

template <class Epi, class Sched, bool ALIGN_EPI>
DI void gemm_phase(LAS unsigned char* lds, const int wave_id, const char* gA, const int K, const Sched& S, const Epi& E) {
  const int lane = lane_id_v(), wid = wave_id, tid = wid * 64 + lane, wr = wid >> 2, wc = wid & 3, fr = lane & 15, fq = lane >> 4;
  const int nt = K / BK;
  unsigned voffB[2];
  { int R, C; stage_rc(tid * 16, R, C);
    const int Rb = Epi::PERM ? ((R & ~31) + perm32(R & 31)) : R; voffB[0] = (unsigned)(Rb * K + C) * 2u; voffB[1] = voffB[0] + (unsigned)(64 * K * 2); }
#define PG8_RC(Rp, Cp) int Rp[2], Cp[2]; { int R_, C_; stage_rc(opaque(tid) * 16, R_, C_); Rp[0] = R_; Cp[0] = C_; Rp[1] = R_ + 64; Cp[1] = C_; }
  const size_t kstep = (size_t)(BK * 2);
  const size_t hstep = (size_t)HALF * K * 2;
  const unsigned ldsw = (unsigned)wid * 1024u;
  const int aoff = lds_byte(wr * 64 + fr, fq * 8), boff = lds_byte(wc * 32 + fr, fq * 8);
#define PG8_SA(b, h) (((b) * 2 + (h)) * HTB)
#define PG8_SB(b, h) ((4 + (b) * 2 + (h)) * HTB)
#define PG8_STAGE_B(bufoff, gbase) do { _Pragma("unroll") for (int _i = 0; _i < 2; ++_i) \
    __builtin_amdgcn_global_load_lds((const unsigned*)((const char*)(gbase) + voffB[_i]), (LAS unsigned*)(lds + (bufoff) + ldsw + _i * 8192), 16, 0, 0); } while (0)
#define PG8_STAGE_A(bufoff, kb, offs) do { _Pragma("unroll") for (int _i = 0; _i < 2; ++_i) \
    __builtin_amdgcn_global_load_lds((const unsigned*)(gA + (size_t)(kb) + (offs)[_i]), (LAS unsigned*)(lds + (bufoff) + ldsw + _i * 8192), 16, 0, 0); } while (0)
#define PG8_LDA(dst, b, h) do { _Pragma("unroll") for (int m = 0; m < 4; ++m) _Pragma("unroll") for (int k = 0; k < 2; ++k) dst[m][k] = *(const LAS bf16x8*)(lds + PG8_SA(b, h) + aoff + m * 2048 + k * 1024); } while (0)
#define PG8_LDB(dst, b, h) do { _Pragma("unroll") for (int n = 0; n < 2; ++n) _Pragma("unroll") for (int k = 0; k < 2; ++k) dst[n][k] = *(const LAS bf16x8*)(lds + PG8_SB(b, h) + boff + n * 2048 + k * 1024); } while (0)
#define PG8_MMA(ai, bj, At, Bt) do { __builtin_amdgcn_s_setprio(1); _Pragma("unroll") for (int m = 0; m < 4; ++m) _Pragma("unroll") for (int n = 0; n < 2; ++n) _Pragma("unroll") for (int k = 0; k < 2; ++k) \
    acc[ai][bj][m][n] = __builtin_amdgcn_mfma_f32_16x16x32_bf16(Bt[n][k], At[m][k], acc[ai][bj][m][n], 0, 0, 0); __builtin_amdgcn_s_setprio(0); } while (0)
#define PG8_WAIT_V(n) asm volatile("s_waitcnt vmcnt(" #n ")" ::: "memory")
#define PG8_WAIT_L(n) asm volatile("s_waitcnt lgkmcnt(" #n ")" ::: "memory")
#define PG8_BAR __builtin_amdgcn_s_barrier()
#define PG8_SCHED __builtin_amdgcn_sched_barrier(0)
  Unit cur, nxt; int ui = 0;
  if (!S.next(0, cur)) return;
  unsigned ca[2][2];
  { PG8_RC(Rp, Cp) S.a_off(cur, Rp, Cp, ca); }
  f32x4 acc[2][2][4][2];
#pragma unroll
  for (int a = 0; a < 2; ++a)
#pragma unroll
    for (int b = 0; b < 2; ++b)
#pragma unroll
      for (int m = 0; m < 4; ++m)
#pragma unroll
        for (int n = 0; n < 2; ++n) acc[a][b][m][n] = (f32x4){0.f, 0.f, 0.f, 0.f};
  bf16x8 At[4][2], B0[2][2], B1[2][2];
  const char* cB = cur.b;
  PG8_STAGE_B(PG8_SB(0, 0), cB); PG8_STAGE_B(PG8_SB(0, 1), cB + hstep); PG8_STAGE_A(PG8_SA(0, 0), 0, ca[0]); PG8_STAGE_A(PG8_SA(0, 1), 0, ca[1]);
  if (wr == 1) PG8_BAR;
  PG8_WAIT_V(2); PG8_BAR;
  PG8_STAGE_B(PG8_SB(1, 0), cB + kstep); PG8_STAGE_A(PG8_SA(1, 0), kstep, ca[0]); PG8_STAGE_B(PG8_SB(1, 1), cB + hstep + kstep);
  PG8_WAIT_V(6); PG8_BAR;
  for (;;) {
    const bool has_next = S.next(ui + 1, nxt);
    if (Sched::NEXT_IN_LDS) {
      unsigned na[2][2];
      if (has_next) { PG8_RC(Rp, Cp) S.a_off(nxt, Rp, Cp, na); }
      else {
#pragma unroll
        for (int h = 0; h < 2; ++h)
#pragma unroll
          for (int i = 0; i < 2; ++i) na[h][i] = ca[h][i];
      }
      *(LAS u32x4*)(lds + STAGE_BYTES + 8192 + tid * 16) = (u32x4){na[0][0], na[0][1], na[1][0], na[1][1]};
    }
    const char* nB = has_next ? nxt.b : cB;
    for (int t = 0; t < nt; t += 2) {
      const bool last = (t == nt - 2);
      PG8_LDB(B0, 0, 0); PG8_LDB(B1, 0, 1); PG8_SCHED; PG8_LDA(At, 0, 0); PG8_STAGE_A(PG8_SA(1, 1), (size_t)(t + 1) * kstep, ca[1]);
      PG8_WAIT_V(8); PG8_WAIT_L(0); PG8_BAR; PG8_MMA(0, 0, At, B0); PG8_MMA(0, 1, At, B1); PG8_BAR; PG8_SCHED;
      const size_t kb2 = last ? 0 : (size_t)(t + 2) * kstep;
      const char* b2 = last ? nB : cB + (size_t)(t + 2) * kstep;
      if (last) {
        if (Sched::NEXT_IN_LDS) { const u32x4 v = *(const LAS u32x4*)(lds + STAGE_BYTES + 8192 + tid * 16); ca[0][0] = v.x; ca[0][1] = v.y; ca[1][0] = v.z; ca[1][1] = v.w; }
        else if (has_next) { PG8_RC(Rp, Cp) S.a_off(nxt, Rp, Cp, ca); }
      }
      PG8_LDA(At, 0, 1); PG8_STAGE_B(PG8_SB(0, 0), b2); PG8_STAGE_B(PG8_SB(0, 1), b2 + hstep); PG8_STAGE_A(PG8_SA(0, 0), kb2, ca[0]);
      PG8_WAIT_V(8); PG8_WAIT_L(0); PG8_BAR; PG8_MMA(1, 0, At, B0); PG8_MMA(1, 1, At, B1); PG8_BAR; PG8_SCHED;
      PG8_LDB(B0, 1, 0); PG8_LDB(B1, 1, 1); PG8_SCHED; PG8_LDA(At, 1, 0); PG8_STAGE_A(PG8_SA(0, 1), kb2, ca[1]);
      PG8_WAIT_V(8); PG8_WAIT_L(0); PG8_BAR; PG8_MMA(0, 0, At, B0); PG8_MMA(0, 1, At, B1); PG8_BAR; PG8_SCHED;
      PG8_LDA(At, 1, 1); PG8_STAGE_B(PG8_SB(1, 0), b2 + kstep); PG8_STAGE_B(PG8_SB(1, 1), b2 + kstep + hstep); PG8_STAGE_A(PG8_SA(1, 0), kb2 + kstep, ca[0]);
      PG8_WAIT_V(8); PG8_WAIT_L(0); PG8_BAR; PG8_MMA(1, 0, At, B0); PG8_MMA(1, 1, At, B1); PG8_BAR; PG8_SCHED;
    }
    if constexpr (ALIGN_EPI) { if (wr == 0) PG8_BAR; }
    E(acc, cur, wr, wc, fr, fq);
    if (!has_next) break;
#pragma unroll
    for (int a = 0; a < 2; ++a)
#pragma unroll
      for (int b = 0; b < 2; ++b)
#pragma unroll
        for (int m = 0; m < 4; ++m)
#pragma unroll
          for (int n = 0; n < 2; ++n) acc[a][b][m][n] = (f32x4){0.f, 0.f, 0.f, 0.f};
    cur = nxt; cB = nB; ++ui;
    if constexpr (ALIGN_EPI) { if (wr == 1) PG8_BAR; }
  }
  PG8_WAIT_V(0);
  if constexpr (!ALIGN_EPI) { if (wr == 0) PG8_BAR; }
  PG8_BAR;
#undef PG8_RC
#undef PG8_SA
#undef PG8_SB
#undef PG8_STAGE_A
#undef PG8_STAGE_B
#undef PG8_LDA
#undef PG8_LDB
#undef PG8_MMA
#undef PG8_WAIT_V
#undef PG8_WAIT_L
#undef PG8_BAR
#undef PG8_SCHED
}
}

struct Params { const float* in[28]; float* out; unsigned char* ws; };
enum { I_X = 0, I_ANORM0, I_WIN0, I_CONVW, I_QN0, I_KN0, I_WOUT0, I_FNORM0, I_WRG0, I_BRG0, I_WRE0, I_BRE0, I_WG0, I_WU0, I_WD0,
       I_ANORM1, I_WIN1, I_QN1, I_KN1, I_WOUT1, I_FNORM1, I_WRG1, I_BRG1, I_WRE1, I_BRE1, I_WG1, I_WU1, I_WD1 };

struct Ctx { LAS unsigned char* lds; int wave, G, gw, NGW; };

struct TrDesc { const float* W; const float* gain; bf16_t* WT; int K, N, nvalid, mode, nblk, item; };
DI void tr_load(const TrDesc& d, int lane, f32x4 (&r)[8]) {
  const int kb = d.item / d.nblk, nb = d.item % d.nblk, k0 = 64 * kb, n = 32 * nb + 4 * (lane & 7);
#pragma unroll
  for (int i = 0; i < 8; ++i) { const int kk = 8 * i + (lane >> 3); r[i] = (n < d.nvalid) ? *(const f32x4*)(d.W + (size_t)(k0 + kk) * d.N + n) : (f32x4){0.f, 0.f, 0.f, 0.f}; }
}
DI void tr_finish(const TrDesc& d, int lane, const f32x4 (&r)[8], LAS float* scr) {
  const int kb = d.item / d.nblk, nb = d.item % d.nblk, k0 = 64 * kb, n0 = 32 * nb;
#pragma unroll
  for (int i = 0; i < 8; ++i) { const int kk = 8 * i + (lane >> 3); const float g = d.gain ? d.gain[k0 + kk] : 1.f; LAS float* s = scr + kk * 33 + 4 * (lane & 7);
    s[0] = r[i].x * g; s[1] = r[i].y * g; s[2] = r[i].z * g; s[3] = r[i].w * g; }
  asm volatile("s_waitcnt lgkmcnt(0)" ::: "memory");
  const int c = lane & 7;
#pragma unroll
  for (int j = 0; j < 4; ++j) { const int nn = (lane >> 3) + 8 * j; const LAS float* s = scr + (8 * c) * 33 + nn;
    u32x4 o; o.x = pk2(s[0 * 33], s[1 * 33]); o.y = pk2(s[2 * 33], s[3 * 33]); o.z = pk2(s[4 * 33], s[5 * 33]); o.w = pk2(s[6 * 33], s[7 * 33]);
    const int ng = n0 + nn; const int drow = (d.mode == 0) ? ng : (d.mode == 3 ? ((ng & ~255) + 128 * ((ng >> 5) & 1) + 32 * ((ng >> 6) & 3) + (ng & 31)) : ((ng >> 7) * 256 + (ng & 127) + (d.mode == 2 ? 128 : 0)));
    *(u32x4*)(d.WT + (size_t)drow * d.K + k0 + 8 * c) = o; }
  asm volatile("s_waitcnt lgkmcnt(0)" ::: "memory");
}
DI void rms_row_to_bf16(const float* xrow, bf16_t* orow, int lane) {
  const f32x4* xr = (const f32x4*)xrow + lane;
  f32x4 v[4]; float s = 0.f;
#pragma unroll
  for (int j = 0; j < 4; ++j) { v[j] = xr[64 * j]; s += (v[j].x * v[j].x + v[j].y * v[j].y) + (v[j].z * v[j].z + v[j].w * v[j].w); }
  const float rstd = 1.0f / sqrtf(wave_sum(s) * (1.f / DM) + NORM_EPS);
  unsigned long long* o8 = (unsigned long long*)orow + lane;
#pragma unroll
  for (int j = 0; j < 4; ++j) o8[64 * j] = (unsigned long long)pk2(v[j].x * rstd, v[j].y * rstd) | ((unsigned long long)pk2(v[j].z * rstd, v[j].w * rstd) << 32);
}
DI void p0_prologue(const Ctx& F, const Params& P) {
  unsigned char* ws = P.ws; const int lane = lane_id_v(); const int tid = F.wave * 64 + lane;
  LAS float* scr = (LAS float*)(F.lds + F.wave * 16384);
  constexpr int I_IN0 = 16 * 80, I_OUT = 16 * 32, I_GU = 32 * 16 * 16, I_DN = 32 * 8 * 32, I_IN1 = 16 * 48;
  constexpr int PER_LAYER0 = I_IN0 + I_OUT + 2 * I_GU + I_DN, PER_LAYER1 = I_IN1 + I_OUT + 2 * I_GU + I_DN;
  auto mkdesc = [&](int it) {
    TrDesc d; int r = it; const int L = (r >= PER_LAYER0) ? 1 : 0; if (L) r -= PER_LAYER0;
    const int i_in = L ? I_IN1 : I_IN0;
    const float* anorm = P.in[L ? I_ANORM1 : I_ANORM0]; const float* fnorm = P.in[L ? I_FNORM1 : I_FNORM0];
    if (r < i_in) { d.W = P.in[L ? I_WIN1 : I_WIN0]; d.gain = anorm; d.WT = (bf16_t*)(ws + (L ? WS_WIN1 : WS_WIN0)); d.K = 1024; d.N = L ? W1 : W0V; d.nvalid = d.N; d.mode = 3; d.nblk = L ? 48 : 80; d.item = r; return d; }
    r -= i_in;
    if (r < I_OUT) { d.W = P.in[L ? I_WOUT1 : I_WOUT0]; d.gain = nullptr; d.WT = (bf16_t*)(ws + (L ? WS_WOUT1 : WS_WOUT0)); d.K = 1024; d.N = 1024; d.nvalid = 1024; d.mode = 0; d.nblk = 32; d.item = r; return d; }
    r -= I_OUT;
    if (r < 2 * I_GU) { const int up = r >= I_GU; if (up) r -= I_GU; const int e = r >> 8;
      d.W = P.in[up ? (L ? I_WU1 : I_WU0) : (L ? I_WG1 : I_WG0)] + (size_t)e * 1024 * 512; d.gain = fnorm; d.WT = (bf16_t*)(ws + (L ? WS_WGU1 : WS_WGU0)) + (size_t)e * 1024 * 1024;
      d.K = 1024; d.N = 512; d.nvalid = 512; d.mode = up ? 2 : 1; d.nblk = 16; d.item = r & 255; return d; }
    r -= 2 * I_GU;
    { const int e = r >> 8; d.W = P.in[L ? I_WD1 : I_WD0] + (size_t)e * 512 * 1024; d.gain = nullptr; d.WT = (bf16_t*)(ws + (L ? WS_WD1 : WS_WD0)) + (size_t)e * 1024 * 512; d.K = 512; d.N = 1024; d.nvalid = 1024; d.mode = 0; d.nblk = 32; d.item = r & 255; return d; }
  };
  {
    const int NIT = PER_LAYER0 + PER_LAYER1;
    int it = F.gw;
    f32x4 ra[8], rb[8];
    TrDesc da, db;
    if (it < NIT) { da = mkdesc(it); tr_load(da, lane, ra); }
    while (it < NIT) {
      const int itn = it + F.NGW;
      if (itn < NIT) { db = mkdesc(itn); tr_load(db, lane, rb); }
      tr_finish(da, lane, ra, scr);
      if (itn >= NIT) break;
      const int itn2 = itn + F.NGW;
      if (itn2 < NIT) { da = mkdesc(itn2); tr_load(da, lane, ra); }
      tr_finish(db, lane, rb, scr);
      it = itn2;
    }
  }
  for (int m = F.gw; m < NTOK; m += F.NGW) rms_row_to_bf16(P.in[I_X] + (size_t)m * DM, (bf16_t*)(ws + WS_XN) + (size_t)m * DM, lane);
  const int gt = blockIdx.x * 512 + tid, NGT = F.G * 512;
  for (int i = gt; i < 512; i += NGT) ((unsigned*)(ws + WS_XN + (size_t)NTOK * DM * 2))[i] = 0u;
  for (int i = gt; i < 128; i += NGT) ((int*)(ws + WS_CTL))[i] = 0;
  for (int i = gt; i < SEQ * 32; i += NGT) {
    const int t = i >> 5, k = i & 31;
    const float inv = (float)exp2(-(double)k * (13.287712379549449 / 32.0));
    const float ang = (float)t * inv;
    const double rev = (double)ang * 0.15915494309189535; const float fr = (float)(rev - rint(rev));
    ((float*)(ws + WS_ROPE))[i] = __builtin_amdgcn_cosf(fr); ((float*)(ws + WS_ROPE))[SEQ * 32 + i] = __builtin_amdgcn_sinf(fr);
  }
  for (int i = gt; i < 2 * 36 * 1024; i += NGT) {
    const int L = i / (36 * 1024), r = i % (36 * 1024), j = r >> 10, k = r & 1023;
    const float g = P.in[L ? I_FNORM1 : I_FNORM0][k];
    float w; if (j < 4) w = P.in[L ? I_WRG1 : I_WRG0][k * 4 + j]; else { const int gg = (j - 4) >> 3, e = (j - 4) & 7; w = P.in[L ? I_WRE1 : I_WRE0][((size_t)gg * 1024 + k) * 8 + e]; }
    ((float*)(ws + (L ? WS_WR1 : WS_WR0)))[r] = w * g;
  }
  for (int i = gt; i < 2 * 36; i += NGT) { const int L = i / 36, j = i % 36; ((float*)(ws + (L ? WS_WR1 : WS_WR0)))[36 * 1024 + j] = (j < 4) ? P.in[L ? I_BRG1 : I_BRG0][j] : P.in[L ? I_BRE1 : I_BRE0][j - 4]; }
}

DI u32x4 normrope8(const u32x4 w, const float (&gv)[8], bool do_norm, const f32x4 (&cs)[2], const f32x4 (&sn)[2], int sub, float oscale) {
  float v[8] = {bflo(w.x), bfhi(w.x), bflo(w.y), bfhi(w.y), bflo(w.z), bfhi(w.z), bflo(w.w), bfhi(w.w)};
  if (do_norm) {
    float s = 0.f;
#pragma unroll
    for (int j = 0; j < 8; ++j) s += v[j] * v[j];
    s += __shfl_xor(s, 1); s += __shfl_xor(s, 2); s += __shfl_xor(s, 4);
    const float rstd = 1.0f / sqrtf(s * (1.f / 64.f) + NORM_EPS);
#pragma unroll
    for (int j = 0; j < 8; ++j) v[j] = v[j] * rstd * gv[j];
  }
  const float sg = (sub & 4) ? 1.f : -1.f;
  const float cv[8] = {cs[0].x, cs[0].y, cs[0].z, cs[0].w, cs[1].x, cs[1].y, cs[1].z, cs[1].w};
  const float sv[8] = {sn[0].x, sn[0].y, sn[0].z, sn[0].w, sn[1].x, sn[1].y, sn[1].z, sn[1].w};
  float o[8];
#pragma unroll
  for (int j = 0; j < 8; ++j) { const float pr = __shfl_xor(v[j], 4); o[j] = (v[j] * cv[j] + sg * pr * sv[j]) * oscale; }
  u32x4 r; r.x = pk2(o[0], o[1]); r.y = pk2(o[2], o[3]); r.z = pk2(o[4], o[5]); r.w = pk2(o[6], o[7]);
  return r;
}
struct Tok0 { u32x4 cb, cc[3], ch[3]; bf16_t v; };
DI void p1b_transform0(const Ctx& F, const Params& P) {
  bf16_t* PROJ = (bf16_t*)(P.ws + WS_PROJ); bf16_t* MIX = (bf16_t*)(P.ws + WS_MIX);
  const int lane = lane_id_v();
  float cw[8][3];
#pragma unroll
  for (int j = 0; j < 8; ++j) { const float* w = P.in[I_CONVW] + (8 * lane + j) * 3; cw[j][0] = w[0]; cw[j][1] = w[1]; cw[j][2] = w[2]; }
  auto load = [&](Tok0& T, int m) {
    const int t = m & (SEQ - 1); const bf16_t* row = PROJ + (size_t)m * W0P;
    T.cb = *(const u32x4*)(row + C_CB + 8 * lane); T.v = row[C_V + lane];
#pragma unroll
    for (int d = 0; d < 3; ++d) { const int back = 2 - d; const bf16_t* r2 = row - (size_t)(t >= back ? back : 0) * W0P; T.cc[d] = *(const u32x4*)(r2 + C_CC + 8 * lane); T.ch[d] = *(const u32x4*)(r2 + C_CH + 8 * lane); }
  };
  auto process = [&](const Tok0& T, int m) {
    const int t = m & (SEQ - 1);
    { const int kk = t & 31, st = kk >> 4, rem = kk & 15, hf = (rem >> 2) & 1, j = 4 * (rem >> 3) + (rem & 3);
      const size_t vo = (((((size_t)(m >> 12) * 128 + (t >> 5)) * 2 + st) * 2 + (lane >> 5)) * 64 + hf * 32 + (lane & 31)) * 8 + j;
      ((bf16_t*)(P.ws + WS_VTF))[vo] = T.v; }
    { float u[3][8];
#pragma unroll
      for (int d = 0; d < 3; ++d) { const bool okd = t >= 2 - d; const u32x4 a = T.cc[d], b = T.ch[d];
        u[d][0] = okd ? bflo(a.x) * bflo(b.x) : 0.f; u[d][1] = okd ? bfhi(a.x) * bfhi(b.x) : 0.f; u[d][2] = okd ? bflo(a.y) * bflo(b.y) : 0.f; u[d][3] = okd ? bfhi(a.y) * bfhi(b.y) : 0.f;
        u[d][4] = okd ? bflo(a.z) * bflo(b.z) : 0.f; u[d][5] = okd ? bfhi(a.z) * bfhi(b.z) : 0.f; u[d][6] = okd ? bflo(a.w) * bflo(b.w) : 0.f; u[d][7] = okd ? bfhi(a.w) * bfhi(b.w) : 0.f; }
      const u32x4 cb = T.cb;
      const float cbv[8] = {bflo(cb.x), bfhi(cb.x), bflo(cb.y), bfhi(cb.y), bflo(cb.z), bfhi(cb.z), bflo(cb.w), bfhi(cb.w)};
      float o[8];
#pragma unroll
      for (int j = 0; j < 8; ++j) o[j] = cbv[j] * (u[0][j] * cw[j][0] + u[1][j] * cw[j][1] + u[2][j] * cw[j][2]);
      u32x4 r; r.x = pk2(o[0], o[1]); r.y = pk2(o[2], o[3]); r.z = pk2(o[4], o[5]); r.w = pk2(o[6], o[7]);
      *(u32x4*)(MIX + (size_t)m * DM + 8 * lane) = r; }
  };
  Tok0 A, B;
  int m = F.gw;
  if (m < NTOK) load(A, m);
  while (m < NTOK) {
    const int m1 = m + F.NGW;
    if (m1 < NTOK) load(B, m1);
    process(A, m);
    if (m1 >= NTOK) break;
    const int m2 = m1 + F.NGW;
    if (m2 < NTOK) load(A, m2);
    process(B, m1);
    m = m2;
  }
}

DI unsigned f2key(float f) { const unsigned b = __float_as_uint(f); return b ^ ((unsigned)((int)b >> 31) | 0x80000000u); }
DI s16x4 tr_read(LAS unsigned char* p) { typedef short v4i16_t __attribute__((ext_vector_type(4))); return __builtin_bit_cast(s16x4, __builtin_amdgcn_ds_read_tr16_b64_v4i16((LAS v4i16_t*)p)); }
#define DPP_U(v, ctrl) ((unsigned)__builtin_amdgcn_update_dpp(0, (int)(v), (ctrl), 0xF, 0xF, true))
DI unsigned wave_total_u(unsigned v) {
  v += DPP_U(v, 0xB1); v += DPP_U(v, 0x4E); v += DPP_U(v, 0x124); v += DPP_U(v, 0x128);
  return (unsigned)__builtin_amdgcn_readlane((int)v, 0) + (unsigned)__builtin_amdgcn_readlane((int)v, 16) + (unsigned)__builtin_amdgcn_readlane((int)v, 32) + (unsigned)__builtin_amdgcn_readlane((int)v, 48);
}
DI unsigned wave_maxall_u(unsigned v) {
  v = max(v, DPP_U(v, 0xB1)); v = max(v, DPP_U(v, 0x4E)); v = max(v, DPP_U(v, 0x124)); v = max(v, DPP_U(v, 0x128));
  const unsigned a = (unsigned)__builtin_amdgcn_readlane((int)v, 0), b = (unsigned)__builtin_amdgcn_readlane((int)v, 16), c = (unsigned)__builtin_amdgcn_readlane((int)v, 32), d = (unsigned)__builtin_amdgcn_readlane((int)v, 48);
  return max(max(a, b), max(c, d));
}
DI unsigned lane_prefix(unsigned long long m) { return __builtin_amdgcn_mbcnt_hi((unsigned)(m >> 32), __builtin_amdgcn_mbcnt_lo((unsigned)m, 0u)); }

DI void dsa_phase(const Ctx& F, const Params& P) {
  const bf16_t* PROJ = (const bf16_t*)(P.ws + WS_PROJ); bf16_t* MIX = (bf16_t*)(P.ws + WS_MIX);
  const bf16_t* IKF = (const bf16_t*)(P.ws + WS_IKF); const bf16_t* KF = (const bf16_t*)(P.ws + WS_KF); const bf16_t* VTF = (const bf16_t*)(P.ws + WS_VTF);
  LAS unsigned* sc = (LAS unsigned*)F.lds;
  LAS unsigned* msk32 = (LAS unsigned*)(F.lds + LDS_LIST);
  LAS float* part = (LAS float*)F.lds;
  const int w = F.wave;
  float cshift; { const int l0 = lane_id_v(); cshift = 8.f * wave_max(fabsf(P.in[I_QN0][l0])) * wave_max(fabsf(P.in[I_KN0][l0])) * 1.02f; }
  const float c1 = 0.125f * LOG2E, c2 = __builtin_amdgcn_readfirstlane(__float_as_int(cshift * LOG2E)) == 0 ? 0.f : __int_as_float(__builtin_amdgcn_readfirstlane(__float_as_int(cshift * LOG2E)));
#ifdef TIMEDSA
  unsigned long long tacc = 0ull, tmark = 0ull;
#define DSA_T0(n) if (TIMEDSA == (n)) tmark = __builtin_amdgcn_s_memrealtime();
#define DSA_T1(n) if (TIMEDSA == (n)) tacc += __builtin_amdgcn_s_memrealtime() - tmark;
#else
#define DSA_T0(n)
#define DSA_T1(n)
#endif
  for (int v = blockIdx.x; v < 8192; v += gridDim.x) {
    const int cidx = v & 255, jj = v >> 8, b = jj >> 1, tb = (jj & 1) ? (511 - cidx) : cidx;
    const int t0 = tb * 8; const size_t rb = (size_t)b * SEQ;
    const int ntile = (t0 + 8 + 31) >> 5;
    const int lane = lane_id_v();
    const int c = lane & 31, half = lane >> 5, qc = c >> 2, hx = c & 3;
    DSA_T0(1)
    {
      bf16x8 af[4];
      { const bf16_t* ap = PROJ + (rb + t0 + qc) * W0P + C_IQ + hx * 64 + 8 * half;
#pragma unroll
        for (int ks = 0; ks < 4; ++ks) af[ks] = *(const bf16x8*)(ap + 16 * ks); }
      float wq[4][4];
#pragma unroll
      for (int g = 0; g < 4; ++g) { const u32x2 ww = *(const u32x2*)(PROJ + (rb + t0 + 2 * g + half) * W0P + C_IW);
        wq[g][0] = bflo(ww.x) * 0.0625f; wq[g][1] = bfhi(ww.x) * 0.0625f; wq[g][2] = bflo(ww.y) * 0.0625f; wq[g][3] = bfhi(ww.y) * 0.0625f; }
      const bf16_t* fb = IKF + ((size_t)b * 128 * 4 * 64 + lane) * 8;
      const int Tlast = ntile - 1;
      auto ld1 = [&](bf16x8 (&d)[4], int T) { const int Tc = T < Tlast ? T : Tlast;
#pragma unroll
        for (int ks = 0; ks < 4; ++ks) d[ks] = *(const bf16x8*)(fb + (size_t)(Tc * 4 + ks) * 512); };
      auto cp1 = [&](const bf16x8 (&bfr)[4], int T) {
        f32x16 acc;
#pragma unroll
        for (int i = 0; i < 16; ++i) acc[i] = 0.f;
#pragma unroll
        for (int ks = 0; ks < 4; ++ks) acc = __builtin_amdgcn_mfma_f32_32x32x16_bf16(af[ks], bfr[ks], acc, 0, 0, 0);
        const int s = 32 * T + c;
#pragma unroll
        for (int g = 0; g < 4; ++g) {
          float sv = (wq[g][0] * fmaxf(acc[4 * g], 0.f) + wq[g][1] * fmaxf(acc[4 * g + 1], 0.f)) + (wq[g][2] * fmaxf(acc[4 * g + 2], 0.f) + wq[g][3] * fmaxf(acc[4 * g + 3], 0.f));
          sv = (sv == 0.f) ? 0.f : sv;
          const int ql = 2 * g + half;
          sc[ql * 4096 + s] = (s <= t0 + ql) ? f2key(sv) : 0u;
        } };
      bf16x8 r0[4], r1[4], r2[4], r3[4];
      if (w < ntile) { ld1(r0, w); ld1(r1, w + 8); ld1(r2, w + 16); ld1(r3, w + 24); }
      for (int T = w; T < ntile; T += 32) {
        cp1(r0, T); ld1(r0, T + 32); __builtin_amdgcn_sched_barrier(0);
        if (T + 8 < ntile) { cp1(r1, T + 8); ld1(r1, T + 40); __builtin_amdgcn_sched_barrier(0); }
        if (T + 16 < ntile) { cp1(r2, T + 16); ld1(r2, T + 48); __builtin_amdgcn_sched_barrier(0); }
        if (T + 24 < ntile) { cp1(r3, T + 24); ld1(r3, T + 56); __builtin_amdgcn_sched_barrier(0); }
      }
    }
    __syncthreads();
    asm volatile("" ::: "memory"); __builtin_amdgcn_sched_barrier(0);
    DSA_T1(1)
    DSA_T0(2)
    {
      const int lane = lane_id_v();
      {
        const int cq = lane & 31;
        const bf16_t* qp = PROJ + (rb + t0 + (cq >> 2)) * W0P + C_Q + (4 * (w >> 2) + (cq & 3)) * 64 + 16 * (w & 3) + 8 * (lane >> 5);
        *(LAS u32x4*)(F.lds + LDS_LIST + 4096 + (w * 64 + lane) * 16) = *(const u32x4*)qp;
      }
      const int t = t0 + w;
      const int nch = (t >> 10) + 1;
      unsigned u[64];
#pragma unroll
      for (int ch = 0; ch < 4; ++ch) {
        if (ch < nch) {
#pragma unroll
          for (int k2 = 0; k2 < 16; ++k2) { const int j = 16 * ch + k2; const unsigned x = sc[w * 4096 + 64 * j + lane]; u[j] = (lane <= t - 64 * j) ? x : 0u; }
        } else {
#pragma unroll
          for (int k2 = 0; k2 < 16; ++k2) u[16 * ch + k2] = 0u;
        }
      }
      unsigned thr = 0u; int sthr = -1;
      if (t >= 256) {
        unsigned prefix = 0u; bool exact = false; int startbit = 31;
        {
          unsigned mx = 0u;
#pragma unroll
          for (int ch = 0; ch < 4; ++ch) if (ch < nch) {
#pragma unroll
            for (int k2 = 0; k2 < 16; ++k2) mx = max(mx, u[16 * ch + k2]);
          }
          const unsigned trial = wave_maxall_u(mx) & 0xFF800000u;
          unsigned cnt = 0u;
#pragma unroll
          for (int ch = 0; ch < 4; ++ch) if (ch < nch) {
#pragma unroll
            for (int k2 = 0; k2 < 16; ++k2) cnt += (u[16 * ch + k2] >= trial) ? 1u : 0u;
          }
          cnt = wave_total_u(cnt);
          if (cnt >= 256u) { prefix = trial; startbit = 22; exact = (cnt == 256u); }
        }
        if (!exact) {
          for (int bit = startbit; bit >= 0; --bit) {
            const unsigned trial = prefix | (1u << bit);
            unsigned cnt = 0u;
#pragma unroll
            for (int ch = 0; ch < 4; ++ch) if (ch < nch) {
#pragma unroll
              for (int k2 = 0; k2 < 16; ++k2) cnt += (u[16 * ch + k2] >= trial) ? 1u : 0u;
            }
            cnt = wave_total_u(cnt);
            if (cnt >= 256u) prefix = trial;
            if (cnt == 256u) { exact = true; break; }
          }
        }
        if (exact) thr = prefix - 1u;
        else {
          thr = prefix; unsigned cgt = 0u;
#pragma unroll
          for (int j = 0; j < 64; ++j) cgt += (u[j] > thr) ? 1u : 0u;
          cgt = wave_total_u(cgt);
          const int need = 256 - (int)cgt;
          int tbf = 0;
#pragma unroll
          for (int ch = 0; ch < 4; ++ch) if (ch < nch) {
#pragma unroll
            for (int k2 = 0; k2 < 16; ++k2) { const int j = 16 * ch + k2; const bool eq = u[j] == thr; const unsigned long long m = __ballot(eq);
              const unsigned long long hit = __ballot(eq && (tbf + (int)lane_prefix(m) == need - 1));
              if (hit) sthr = 64 * j + __builtin_ctzll(hit);
              tbf += __builtin_popcountll(m); }
          }
        }
      }
#pragma unroll
      for (int ch = 0; ch < 4; ++ch) {
        if (ch < nch) {
#pragma unroll
          for (int k2 = 0; k2 < 16; ++k2) { const int j = 16 * ch + k2; const bool sel = (u[j] > thr) || (u[j] == thr && lane <= sthr - 64 * j); const unsigned long long m = __ballot(sel);
            if (lane == 0) *(LAS u32x2*)(msk32 + w * 128 + 2 * j) = (u32x2){(unsigned)m, (unsigned)(m >> 32)}; }
        } else if (lane < 16) *(LAS u32x2*)(msk32 + w * 128 + 2 * (16 * ch + lane)) = (u32x2){0u, 0u};
      }
    }
    __syncthreads();
    asm volatile("" ::: "memory"); __builtin_amdgcn_sched_barrier(0);
    DSA_T1(2)
    DSA_T0(3)
    {
      const int lane = lane_id_v(); const int c = lane & 31, half = lane >> 5, qc = c >> 2, hx = c & 3;
      const int tq = t0 + qc;
      const LAS unsigned char* qlds = F.lds + LDS_LIST + 4096 + lane * 16;
      f32x16 o00, o01, o10, o11;
#pragma unroll
      for (int i = 0; i < 16; ++i) { o00[i] = 0.f; o01[i] = 0.f; o10[i] = 0.f; o11[i] = 0.f; }
      float lsum0 = 0.f, lsum1 = 0.f;
      const bf16_t* kb = KF + ((size_t)b * 128 * 4 * 64 + lane) * 8;
      const bf16_t* vb = VTF + ((size_t)b * 128 * 4 * 64 + lane) * 8;
      const int Tlast = ntile - 1;
      auto ld2 = [&](bf16x8 (&kf)[4], bf16x8 (&vf)[4], int T) { const int Tc = T < Tlast ? T : Tlast;
#pragma unroll
        for (int ks = 0; ks < 4; ++ks) { kf[ks] = *(const bf16x8*)(kb + (size_t)(Tc * 4 + ks) * 512); vf[ks] = *(const bf16x8*)(vb + (size_t)(Tc * 4 + ks) * 512); } };
      auto cp2 = [&](const bf16x8 (&kf)[4], const bf16x8 (&vf)[4], int T) {
        const unsigned mw = msk32[qc * 128 + T] >> (4 * half);
#pragma unroll
        for (int cb = 0; cb < 2; ++cb) {
          bf16x8 qf[4];
#pragma unroll
          for (int ks = 0; ks < 4; ++ks) qf[ks] = *(const LAS bf16x8*)(qlds + (cb * 4 + ks) * 1024);
          f32x16 s;
#pragma unroll
          for (int i = 0; i < 16; ++i) s[i] = 0.f;
#pragma unroll
          for (int ks = 0; ks < 4; ++ks) s = __builtin_amdgcn_mfma_f32_32x32x16_bf16(kf[ks], qf[ks], s, 0, 0, 0);
          float ls = 0.f;
#pragma unroll
          for (int r = 0; r < 16; ++r) { const float p = ((mw >> ((r & 3) + 8 * (r >> 2))) & 1u) ? __builtin_amdgcn_exp2f(s[r] * c1 - c2) : 0.f; s[r] = p; ls += p; }
          if (cb == 0) lsum0 += ls; else lsum1 += ls;
#pragma unroll
          for (int st = 0; st < 2; ++st) {
            u32x4 pw; pw.x = pk2(s[8 * st], s[8 * st + 1]); pw.y = pk2(s[8 * st + 2], s[8 * st + 3]); pw.z = pk2(s[8 * st + 4], s[8 * st + 5]); pw.w = pk2(s[8 * st + 6], s[8 * st + 7]);
            const bf16x8 pf = __builtin_bit_cast(bf16x8, pw);
            if (cb == 0) { o00 = __builtin_amdgcn_mfma_f32_32x32x16_bf16(vf[2 * st], pf, o00, 0, 0, 0); o10 = __builtin_amdgcn_mfma_f32_32x32x16_bf16(vf[2 * st + 1], pf, o10, 0, 0, 0); }
            else { o01 = __builtin_amdgcn_mfma_f32_32x32x16_bf16(vf[2 * st], pf, o01, 0, 0, 0); o11 = __builtin_amdgcn_mfma_f32_32x32x16_bf16(vf[2 * st + 1], pf, o11, 0, 0, 0); }
          }
        } };
      bf16x8 ka[4], va[4], kb2[4], vb2[4];
      if (w < ntile) { ld2(ka, va, w); ld2(kb2, vb2, w + 8); }
      for (int T = w; T < ntile; T += 16) {
        cp2(ka, va, T); ld2(ka, va, T + 16); __builtin_amdgcn_sched_barrier(0);
        if (T + 8 < ntile) { cp2(kb2, vb2, T + 8); ld2(kb2, vb2, T + 24); __builtin_amdgcn_sched_barrier(0); }
      }
      lsum0 += __shfl_xor(lsum0, 32); lsum1 += __shfl_xor(lsum1, 32);
      bf16_t* opb = MIX + (rb + tq) * DM + 512 + hx * 64 + 32 * (w >> 2) + 8 * (w & 3) + 4 * half;
#pragma unroll
      for (int cb = 0; cb < 2; ++cb) {
        LAS float* pw_ = part + w * (33 * 64) + lane;
        if (cb == 1) __syncthreads();
#pragma unroll
        for (int i = 0; i < 16; ++i) { pw_[i * 64] = cb == 0 ? o00[i] : o01[i]; pw_[(16 + i) * 64] = cb == 0 ? o10[i] : o11[i]; }
        pw_[32 * 64] = cb == 0 ? lsum0 : lsum1;
        __syncthreads();
        float a4[4] = {0.f, 0.f, 0.f, 0.f}; float lt = 0.f;
#pragma unroll
        for (int k8 = 0; k8 < 8; ++k8) { const LAS float* pr = part + k8 * (33 * 64) + lane;
#pragma unroll
          for (int i = 0; i < 4; ++i) a4[i] += pr[(4 * w + i) * 64];
          lt += pr[32 * 64]; }
        const float inv = 1.0f / lt;
        u32x2 w0; w0.x = pk2(a4[0] * inv, a4[1] * inv); w0.y = pk2(a4[2] * inv, a4[3] * inv); *(u32x2*)(opb + cb * 256) = w0;
      }
    }
    __syncthreads();
    DSA_T1(3)
  }
#ifdef TIMEDSA
  if (blockIdx.x == 0 && w == 0 && lane_id_v() == 0) { unsigned long long* tsw = (unsigned long long*)(P.ws + WS_CTL + 4096); tsw[0] = 0ull; tsw[1] = tacc; }
#endif
}

DI float fswap32_add(float a, float b) { const auto r = __builtin_amdgcn_permlane32_swap(__float_as_uint(a), __float_as_uint(b), false, false); return __uint_as_float(r[0]) + __uint_as_float(r[1]); }
DI float fswap16_add(float a, float b) { const auto r = __builtin_amdgcn_permlane16_swap(__float_as_uint(a), __float_as_uint(b), false, false); return __uint_as_float(r[0]) + __uint_as_float(r[1]); }
DI void tred64(float (&v)[64], int lane) {
#pragma unroll
  for (int i = 0; i < 32; ++i) v[i] = fswap32_add(v[i], v[i + 32]);
#pragma unroll
  for (int i = 0; i < 16; ++i) v[i] = fswap16_add(v[i], v[i + 16]);
#pragma unroll
  for (int i = 0; i < 8; ++i) { const bool up = lane & 8; const float keep = up ? v[i + 8] : v[i], send = up ? v[i] : v[i + 8]; v[i] = keep + __shfl_xor(send, 8); }
#pragma unroll
  for (int i = 0; i < 4; ++i) { const bool up = lane & 4; const float keep = up ? v[i + 4] : v[i], send = up ? v[i] : v[i + 4]; v[i] = keep + __shfl_xor(send, 4); }
#pragma unroll
  for (int i = 0; i < 2; ++i) { const bool up = lane & 2; const float keep = up ? v[i + 2] : v[i], send = up ? v[i] : v[i + 2]; v[i] = keep + __shfl_xor(send, 2); }
  { const bool up = lane & 1; const float keep = up ? v[1] : v[0], send = up ? v[0] : v[1]; v[0] = keep + __shfl_xor(send, 1); }
}
DI void tred8(float (&v)[8], int lane) {
#pragma unroll
  for (int i = 0; i < 4; ++i) v[i] = fswap32_add(v[i], v[i + 4]);
#pragma unroll
  for (int i = 0; i < 2; ++i) v[i] = fswap16_add(v[i], v[i + 2]);
  { const bool up = lane & 8; const float keep = up ? v[1] : v[0], send = up ? v[0] : v[1]; v[0] = keep + __shfl_xor(send, 8); }
  v[0] += __shfl_xor(v[0], 4); v[0] += __shfl_xor(v[0], 2); v[0] += __shfl_xor(v[0], 1);
}
#define RDL(v, l) __int_as_float(__builtin_amdgcn_readlane(__float_as_int(v), (l)))
DI float wave_sum_dpp(float v) {
  v += __int_as_float(__builtin_amdgcn_update_dpp(0, __float_as_int(v), 0xB1, 0xF, 0xF, true));
  v += __int_as_float(__builtin_amdgcn_update_dpp(0, __float_as_int(v), 0x4E, 0xF, 0xF, true));
  v += __int_as_float(__builtin_amdgcn_update_dpp(0, __float_as_int(v), 0x124, 0xF, 0xF, true));
  v += __int_as_float(__builtin_amdgcn_update_dpp(0, __float_as_int(v), 0x128, 0xF, 0xF, true));
  return (RDL(v, 0) + RDL(v, 16)) + (RDL(v, 32) + RDL(v, 48));
}
DI void route_one(const float (&lg)[36], int& x0, int& x1, float& g0, float& g1) {
  int gs = 0; float gm = lg[0];
#pragma unroll
  for (int j = 1; j < 4; ++j) { const bool gt = lg[j] > gm; gm = gt ? lg[j] : gm; gs = gt ? j : gs; }
  gs = __builtin_amdgcn_readfirstlane(gs);
  float z = 0.f;
#pragma unroll
  for (int j = 0; j < 4; ++j) z += __expf(lg[j] - gm);
  const float pg = 1.0f / z;
  float le[8];
#pragma unroll
  for (int i = 0; i < 8; ++i) le[i] = gs == 0 ? lg[4 + i] : (gs == 1 ? lg[12 + i] : (gs == 2 ? lg[20 + i] : lg[28 + i]));
  int i0e = 0; float m0 = le[0];
#pragma unroll
  for (int i = 1; i < 8; ++i) { const bool gt = le[i] > m0; m0 = gt ? le[i] : m0; i0e = gt ? i : i0e; }
  i0e = __builtin_amdgcn_readfirstlane(i0e);
  int i1e = -1; float m1 = -INFINITY;
#pragma unroll
  for (int i = 0; i < 8; ++i) { const bool gt = (i != i0e) && (le[i] > m1); m1 = gt ? le[i] : m1; i1e = gt ? i : i1e; }
  i1e = __builtin_amdgcn_readfirstlane(i1e);
  const float e1 = __expf(m1 - m0);
  g0 = pg / (1.0f + e1); g1 = pg * e1 / (1.0f + e1);
  x0 = gs * 8 + i0e; x1 = gs * 8 + i1e;
}
DI void router_phase(const Ctx& F, const Params& P, int L) {
  unsigned char* ws = P.ws;
  LAS float* wl = (LAS float*)F.lds;
  LAS int* lcnt = (LAS int*)(F.lds + 147456);
  LAS int* lbase = lcnt + 32;
  LAS i32x4* lasg = (LAS i32x4*)(F.lds + 147456 + 256);
  const float* wrg = (const float*)(ws + (L ? WS_WR1 : WS_WR0));
  const int lane = lane_id_v(); const int tid = F.wave * 64 + lane;
  for (int i = tid; i < 36 * 1024 / 4; i += 512) ((LAS f32x4*)wl)[i] = ((const f32x4*)wrg)[i];
  int* cnt = (int*)(ws + WS_CTL) + L * 64; int* list = (int*)(ws + WS_LIST);
  int4* asg = (int4*)(ws + WS_ASG); float2* asgg = (float2*)(ws + WS_ASGG);
  bf16_t* XN = (bf16_t*)(ws + WS_XN);
  const int niter = (NTOK + F.NGW - 1) / F.NGW;
  for (int i0 = 0; i0 < niter; i0 += 32) {
    if (tid < 32) lcnt[tid] = 0;
    __syncthreads();
    for (int i2 = 0; i2 < 32; i2 += 2) {
      if (i0 + i2 >= niter) break;
      int mk[2]; bool okk[2];
#pragma unroll
      for (int k = 0; k < 2; ++k) { const int m = F.gw + (i0 + i2 + k) * F.NGW; okk[k] = (i0 + i2 + k < niter) && (m < NTOK); mk[k] = okk[k] ? m : F.gw; }
      f32x4 v[2][4]; float rstd[2];
#pragma unroll
      for (int k = 0; k < 2; ++k) { const u32x2* xr = (const u32x2*)((const bf16_t*)(ws + WS_XB) + (size_t)mk[k] * DM) + lane; float ss = 0.f;
#pragma unroll
        for (int j = 0; j < 4; ++j) { const u32x2 xb = xr[64 * j]; v[k][j] = (f32x4){bflo(xb.x), bfhi(xb.x), bflo(xb.y), bfhi(xb.y)}; ss += (v[k][j].x * v[k][j].x + v[k][j].y * v[k][j].y) + (v[k][j].z * v[k][j].z + v[k][j].w * v[k][j].w); }
        rstd[k] = 1.0f / sqrtf(wave_sum_dpp(ss) * (1.f / DM) + NORM_EPS); }
#pragma unroll
      for (int k = 0; k < 2; ++k) if (okk[k]) { unsigned long long* o8 = (unsigned long long*)(XN + (size_t)mk[k] * DM) + lane;
#pragma unroll
        for (int j = 0; j < 4; ++j) o8[64 * j] = (unsigned long long)pk2(v[k][j].x * rstd[k], v[k][j].y * rstd[k]) | ((unsigned long long)pk2(v[k][j].z * rstd[k], v[k][j].w * rstd[k]) << 32); }
      f32x2 vp[4][4];
#pragma unroll
      for (int j = 0; j < 4; ++j) { vp[j][0] = (f32x2){v[0][j].x, v[1][j].x}; vp[j][1] = (f32x2){v[0][j].y, v[1][j].y}; vp[j][2] = (f32x2){v[0][j].z, v[1][j].z}; vp[j][3] = (f32x2){v[0][j].w, v[1][j].w}; }
      float va[64], vb[8];
#pragma unroll
      for (int jc = 0; jc < 36; ++jc) {
        f32x4 w4[4];
#pragma unroll
        for (int j = 0; j < 4; ++j) w4[j] = *(const LAS f32x4*)(wl + jc * 1024 + 256 * j + 4 * lane);
        f32x2 a = {0.f, 0.f};
#pragma unroll
        for (int j = 0; j < 4; ++j) {
          a = __builtin_elementwise_fma(vp[j][0], (f32x2){w4[j].x, w4[j].x}, a); a = __builtin_elementwise_fma(vp[j][1], (f32x2){w4[j].y, w4[j].y}, a);
          a = __builtin_elementwise_fma(vp[j][2], (f32x2){w4[j].z, w4[j].z}, a); a = __builtin_elementwise_fma(vp[j][3], (f32x2){w4[j].w, w4[j].w}, a); }
        va[jc] = a.x;
        { const int idx = 36 + jc; if (idx < 64) va[idx] = a.y; else vb[idx - 64] = a.y; }
        if ((jc & 1) == 1) asm volatile("" ::: "memory");
      }
      tred64(va, lane); tred8(vb, lane);
      const int zv = opaque(0);
      float lg0[36], lg1[36];
#pragma unroll
      for (int jc = 0; jc < 36; ++jc) {
        const float bias = wrg[36 * 1024 + jc + zv];
        { float t = RDL(va[0], jc) * rstd[0] + bias; asm volatile("" : "+v"(t)); lg0[jc] = t; }
        { const int idx = 36 + jc; const float tot = idx < 64 ? RDL(va[0], idx < 64 ? idx : 0) : RDL(vb[0], idx >= 64 ? 8 * (idx - 64) : 0); float t = tot * rstd[1] + bias; asm volatile("" : "+v"(t)); lg1[jc] = t; }
      }
#define ROUTE_K(k, LG) { int x0, x1; float g0, g1; route_one(LG, x0, x1, g0, g1); \
        if (lane == 0 && okk[k]) { \
          const int r0 = __hip_atomic_fetch_add(lcnt + x0, 1, __ATOMIC_RELAXED, __HIP_MEMORY_SCOPE_WORKGROUP); \
          const int r1 = __hip_atomic_fetch_add(lcnt + x1, 1, __ATOMIC_RELAXED, __HIP_MEMORY_SCOPE_WORKGROUP); \
          lasg[(i2 + k) * 8 + F.wave] = (i32x4){x0, x1, r0, r1}; asgg[mk[k]] = make_float2(g0, g1); } }
      ROUTE_K(0, lg0) ROUTE_K(1, lg1)
#undef ROUTE_K
    }
    __syncthreads();
    if (tid < 32) lbase[tid] = atomicAdd(cnt + tid, lcnt[tid]);
    __syncthreads();
    if (tid < 256) {
      const int ii = tid >> 3, wv = tid & 7; const int m = (int)blockIdx.x * 8 + wv + (i0 + ii) * F.NGW;
      if (i0 + ii < niter && m < NTOK) {
        const i32x4 a = lasg[tid]; const int r0 = lbase[a.x] + a.z, r1 = lbase[a.y] + a.w;
        list[a.x * 65536 + r0] = m; list[a.y * 65536 + r1] = m; asg[m] = make_int4(a.x, a.y, r0, r1);
      }
    }
    __syncthreads();
  }
}
DI void moe_setup(const Ctx& F, const Params& P, int L) {
  LAS int* pb = (LAS int*)(F.lds + LDS_MISC); LAS int* cl = pb + 64;
  const int* cnt = (const int*)(P.ws + WS_CTL) + L * 64;
  const int tid = F.wave * 64 + lane_id_v();
  __syncthreads();
  if (tid < 32) cl[tid] = cnt[tid];
  __syncthreads();
  if (tid == 0) { int a = 0; for (int e = 0; e < NEXP; ++e) { pb[e] = a; a += (cl[e] + 255) >> 8; } pb[NEXP] = a; }
  __syncthreads();
}
DI void combine_phase(const Ctx& F, const Params& P, int L, bool with_norm) {
  unsigned char* ws = P.ws;
  moe_setup(F, P, L);
  const LAS int* pb = (const LAS int*)(F.lds + LDS_MISC);
  const int4* asg = (const int4*)(ws + WS_ASG); const float2* asgg = (const float2*)(ws + WS_ASGG);
  const bf16_t* Y = (const bf16_t*)(ws + WS_PROJ); bf16_t* XN = (bf16_t*)(ws + WS_XN);
  const int lane = lane_id_v();
  for (int m = F.gw; m < NTOK; m += F.NGW) {
    const int4 a = asg[m]; const float2 gg = asgg[m];
    const size_t row0 = (size_t)pb[a.x] * 256 + a.z, row1 = (size_t)pb[a.y] * 256 + a.w;
    u32x2* xr = (u32x2*)((bf16_t*)(ws + WS_XB) + (size_t)m * DM) + lane;
    f32x4* orow = (f32x4*)(P.out + (size_t)m * DM) + lane;
    const u32x2* y0 = (const u32x2*)(Y + row0 * DM) + lane; const u32x2* y1 = (const u32x2*)(Y + row1 * DM) + lane;
    f32x4 v[4]; float ss = 0.f;
#pragma unroll
    for (int j = 0; j < 4; ++j) { const u32x2 xb = xr[64 * j]; f32x4 x = (f32x4){bflo(xb.x), bfhi(xb.x), bflo(xb.y), bfhi(xb.y)}; const u32x2 a0 = y0[64 * j], a1 = y1[64 * j];
      x.x += gg.x * bflo(a0.x) + gg.y * bflo(a1.x); x.y += gg.x * bfhi(a0.x) + gg.y * bfhi(a1.x); x.z += gg.x * bflo(a0.y) + gg.y * bflo(a1.y); x.w += gg.x * bfhi(a0.y) + gg.y * bfhi(a1.y);
      if (with_norm) { u32x2 o; o.x = pk2(x.x, x.y); o.y = pk2(x.z, x.w); xr[64 * j] = o; } else orow[64 * j] = x;
      v[j] = x; ss += (x.x * x.x + x.y * x.y) + (x.z * x.z + x.w * x.w); }
    if (with_norm) {
      const float rstd = 1.0f / sqrtf(wave_sum(ss) * (1.f / DM) + NORM_EPS);
      unsigned long long* o8 = (unsigned long long*)(XN + (size_t)m * DM) + lane;
#pragma unroll
      for (int j = 0; j < 4; ++j) o8[64 * j] = (unsigned long long)pk2(v[j].x * rstd, v[j].y * rstd) | ((unsigned long long)pk2(v[j].z * rstd, v[j].w * rstd) << 32);
    }
  }
}
template <class Bar> DI void moe_gemms(const Ctx& F, const Params& P, int L, const Bar& gbar) {
  unsigned char* ws = P.ws;
  const int vcu = (F.G % 8 == 0) ? ((int)(blockIdx.x % 8) * (F.G / 8) + (int)(blockIdx.x / 8)) : (int)blockIdx.x;
  moe_setup(F, P, L);
  {
    pg8::MoeSched<true> S{(const LAS int*)(F.lds + LDS_MISC), (const LAS int*)(F.lds + LDS_MISC) + 64, (const int*)(ws + WS_LIST), (const char*)(ws + (L ? WS_WGU1 : WS_WGU0)), F.G, vcu, 1024};
    pg8::EpiSwiGLU E{(bf16_t*)(ws + WS_H)};
    pg8::gemm_phase<pg8::EpiSwiGLU, pg8::MoeSched<true>, true>(F.lds, F.wave, (const char*)(ws + WS_XN), 1024, S, E);
  }
  xcd_barrier(gbar);
  {
    pg8::MoeSched<false> S{(const LAS int*)(F.lds + LDS_MISC), (const LAS int*)(F.lds + LDS_MISC) + 64, nullptr, (const char*)(ws + (L ? WS_WD1 : WS_WD0)), F.G, vcu, 512};
    pg8::EpiBf16 E{(bf16_t*)(ws + WS_PROJ), DM};
    pg8::gemm_phase<pg8::EpiBf16, pg8::MoeSched<false>, true>(F.lds, F.wave, (const char*)(ws + WS_H), 512, S, E);
  }
}

struct Tok1 { u32x4 q0, q1, k; f32x4 cs[2], sn[2]; };
DI void p8b_transform1(const Ctx& F, const Params& P) {
  bf16_t* QKV = (bf16_t*)(P.ws + WS_PROJ);
  const float* cosT = (const float*)(P.ws + WS_ROPE); const float* sinT = cosT + SEQ * 32;
  const int lane = lane_id_v(), sub = lane & 7, grp = lane >> 3;
  float gq[8], gk[8];
#pragma unroll
  for (int j = 0; j < 8; ++j) { gq[j] = P.in[I_QN1][8 * sub + j]; gk[j] = P.in[I_KN1][8 * sub + j]; }
  const int kcol = 1024 + (grp & 3) * 64 + sub * 8;
  auto load = [&](Tok1& T, int m) {
    const int t = m & (SEQ - 1); const bf16_t* row = QKV + (size_t)m * W1;
    T.q0 = *(const u32x4*)(row + grp * 64 + sub * 8); T.q1 = *(const u32x4*)(row + 512 + grp * 64 + sub * 8); T.k = *(const u32x4*)(row + kcol);
    const f32x4* cp = (const f32x4*)(cosT + t * 32 + 8 * (sub & 3)); const f32x4* sp = (const f32x4*)(sinT + t * 32 + 8 * (sub & 3));
    T.cs[0] = cp[0]; T.cs[1] = cp[1]; T.sn[0] = sp[0]; T.sn[1] = sp[1];
  };
  auto process = [&](const Tok1& T, int m) {
    bf16_t* row = QKV + (size_t)m * W1;
    *(u32x4*)(row + grp * 64 + sub * 8) = normrope8(T.q0, gq, true, T.cs, T.sn, sub, 0.125f * LOG2E);
    *(u32x4*)(row + 512 + grp * 64 + sub * 8) = normrope8(T.q1, gq, true, T.cs, T.sn, sub, 0.125f * LOG2E);
    const u32x4 r = normrope8(T.k, gk, true, T.cs, T.sn, sub, 1.f);
    if (grp < 4) *(u32x4*)(row + kcol) = r;
  };
  Tok1 A, B;
  int m = F.gw;
  if (m < NTOK) load(A, m);
  while (m < NTOK) {
    const int m1 = m + F.NGW;
    if (m1 < NTOK) load(B, m1);
    process(A, m);
    if (m1 >= NTOK) break;
    const int m2 = m1 + F.NGW;
    if (m2 < NTOK) load(A, m2);
    process(B, m1);
    m = m2;
  }
}

DI void dil_phase(const Ctx& F, const Params& P) {
  const bf16_t* QKV = (const bf16_t*)(P.ws + WS_PROJ); bf16_t* MIX = (bf16_t*)(P.ws + WS_MIX);
  LAS unsigned char* kst = F.lds + F.wave * 8192;
  LAS unsigned char* vst = kst + 4096;
  float cshift; { const int l0 = lane_id_v(); cshift = 8.f * wave_max(fabsf(P.in[I_QN1][l0])) * wave_max(fabsf(P.in[I_KN1][l0])) * 1.02f; }
  const float c1 = 0.125f * LOG2E, c2 = cshift * LOG2E;
  const int gwv = ((F.G % 8 == 0) ? ((int)(blockIdx.x % 8) * (F.G / 8) + (int)(blockIdx.x / 8)) : (int)blockIdx.x) * 8 + F.wave;
  for (int it = gwv; it < 32768; it += F.NGW) {
    const int lane = lane_id_v(), c = lane & 31, half = lane >> 5, qi = c >> 2, gq = c & 3;
    const int q4 = (lane & 15) >> 2, p4 = lane & 3, blk = (lane >> 4) & 1;
    const int lrow = lane >> 3, lch = lane & 7;
    const int r = it & 15, tile = (it >> 4) & 31, kh = (it >> 9) & 3, b = it >> 11;
    const size_t rb = (size_t)b * SEQ; const int tmax = tile * 128 + r + 112, tq = tile * 128 + r + 16 * qi;
    bf16x8 qf[4];
    { const bf16_t* qp = QKV + (rb + tq) * W1 + (4 * kh + gq) * 64 + 8 * half;
#pragma unroll
      for (int ks = 0; ks < 4; ++ks) qf[ks] = *(const bf16x8*)(qp + 16 * ks); }
    f32x16 o0, o1;
#pragma unroll
    for (int i = 0; i < 16; ++i) { o0[i] = 0.f; o1[i] = 0.f; }
    float lsum = 0.f;
    const bf16_t* gbase = QKV + rb * W1 + 1024 + kh * 64 + lch * 8;
    auto tile_sh = [](int ti) { return ti < 8 ? 0 : (ti < 13 ? 2 : 4); };
    auto tile_T = [](int ti) { return ti < 8 ? ti : (ti < 13 ? ti - 8 : ti - 13); };
    u32x4 gk[4], gv[4];
    auto issue = [&](int ti) { const int sh = tile_sh(ti), T = tile_T(ti);
#pragma unroll
      for (int i = 0; i < 4; ++i) { const int n = 32 * T + lrow + 8 * i; int pos = tmax - (n << sh); pos = pos < 0 ? 0 : pos;
        const bf16_t* rp = gbase + (size_t)pos * W1; gk[i] = *(const u32x4*)rp; gv[i] = *(const u32x4*)(rp + 256); } };
    issue(0);
#pragma unroll 1
    for (int ti = 0; ti < 18; ++ti) {
      const int sh = tile_sh(ti), T = tile_T(ti);
      const int ei = (16 >> sh) * (7 - qi);
#pragma unroll
      for (int i = 0; i < 4; ++i) { const int row = lrow + 8 * i; const int off = row * 128 + ((lch ^ (row & 7)) << 4);
        *(LAS u32x4*)(kst + off) = gk[i]; *(LAS u32x4*)(vst + off) = gv[i]; }
      if (ti + 1 < 18) issue(ti + 1);
      asm volatile("" ::: "memory");
      f32x16 s;
#pragma unroll
      for (int i = 0; i < 16; ++i) s[i] = -c2;
#pragma unroll
      for (int ks = 0; ks < 4; ++ks) { const bf16x8 kf = *(const LAS bf16x8*)(kst + c * 128 + (((2 * ks + half) ^ (c & 7)) << 4)); s = __builtin_amdgcn_mfma_f32_32x32x16_bf16(kf, qf[ks], s, 0, 0, 0); }
#pragma unroll
      for (int reg = 0; reg < 16; ++reg) { const int nn = 32 * T + (reg & 3) + 8 * (reg >> 2) + 4 * half; const int ps = tmax - (nn << sh);
        const bool ok = (nn >= ei) && (nn <= ei + 128) && (ps >= 0);
        const float p = ok ? __builtin_amdgcn_exp2f(s[reg]) : 0.f; s[reg] = p; lsum += p; }
#pragma unroll
      for (int st = 0; st < 2; ++st) {
        u32x4 pw; pw.x = pk2(s[8 * st], s[8 * st + 1]); pw.y = pk2(s[8 * st + 2], s[8 * st + 3]); pw.z = pk2(s[8 * st + 4], s[8 * st + 5]); pw.w = pk2(s[8 * st + 6], s[8 * st + 7]);
        const bf16x8 pf = __builtin_bit_cast(bf16x8, pw);
        const int r1 = 16 * st + 4 * half + q4, r2 = r1 + 8;
#pragma unroll
        for (int dblk = 0; dblk < 2; ++dblk) {
          const int ch = 4 * dblk + 2 * blk + (p4 >> 1), bo = (p4 & 1) * 8;
          const s16x4 lo = tr_read(vst + r1 * 128 + (((ch ^ (r1 & 7)) << 4) + bo)), hi = tr_read(vst + r2 * 128 + (((ch ^ (r2 & 7)) << 4) + bo));
          const bf16x8 vf = __builtin_shufflevector(lo, hi, 0, 1, 2, 3, 4, 5, 6, 7);
          if (dblk == 0) o0 = __builtin_amdgcn_mfma_f32_32x32x16_bf16(vf, pf, o0, 0, 0, 0); else o1 = __builtin_amdgcn_mfma_f32_32x32x16_bf16(vf, pf, o1, 0, 0, 0);
        }
      }
      asm volatile("" ::: "memory");
    }
    lsum += __shfl_xor(lsum, 32);
    const float inv = 1.0f / lsum;
    bf16_t* op = MIX + (rb + tq) * DM + (4 * kh + gq) * 64 + 4 * half;
#pragma unroll
    for (int gI = 0; gI < 4; ++gI) {
      u32x2 w0; w0.x = pk2(o0[4 * gI] * inv, o0[4 * gI + 1] * inv); w0.y = pk2(o0[4 * gI + 2] * inv, o0[4 * gI + 3] * inv); *(u32x2*)(op + 8 * gI) = w0;
      u32x2 w1; w1.x = pk2(o1[4 * gI] * inv, o1[4 * gI + 1] * inv); w1.y = pk2(o1[4 * gI + 2] * inv, o1[4 * gI + 3] * inv); *(u32x2*)(op + 32 + 8 * gI) = w1;
    }
  }
}

#define XB_TMO      128
#define XB_XCNT(j)  (256  + 64 * (j))
#define XB_XSUB(j)  (1280 + 64 * (j))
#define XB_XGEN(j)  (2304 + 64 * (j))
#define XB_TOP      3328
#define XB_TOPGEN   3392
#define XCD_BAR_WORDS 3456
#define XB_SPIN_CAP (1u << 18)

__device__ __forceinline__ unsigned xb_ld(unsigned* p)              { return __hip_atomic_load(p, __ATOMIC_RELAXED, __HIP_MEMORY_SCOPE_AGENT); }
__device__ __forceinline__ unsigned xb_add(unsigned* p, unsigned v) { return __hip_atomic_fetch_add(p, v, __ATOMIC_RELAXED, __HIP_MEMORY_SCOPE_AGENT); }
__device__ __forceinline__ unsigned xb_xcc_id() { return (unsigned)__builtin_amdgcn_s_getreg((3 << 11) | 20) & 0xFu; }
#define XB_SPIN(cond, bar) do { unsigned _sp = 0; while (cond) { __builtin_amdgcn_s_sleep(1); \
    if ((++_sp & 255u) == 0u) { if (xb_ld(&(bar)[XB_TMO])) break; if (_sp > XB_SPIN_CAP) { atomicAdd(&(bar)[XB_TMO], 1u); break; } } } } while (0)

struct XcdBarrier {
    unsigned* bar; unsigned x;
    volatile LAS unsigned* st;
};

__device__ __forceinline__ XcdBarrier xcd_barrier_post(unsigned* bar, volatile LAS unsigned* st) {
    XcdBarrier b; b.bar = bar; b.x = xb_xcc_id(); b.st = st;
    if (threadIdx.x == 0) (void)xb_add(&bar[XB_XCNT(b.x)], 1u);
    return b;
}
__device__ __forceinline__ void xcd_barrier_complete(unsigned* bar, unsigned x, unsigned& nloc, unsigned& nx) {
    const unsigned G = gridDim.x * gridDim.y * gridDim.z;
    unsigned sum, cnt, mine, sp = 0u;
    for (;;) {
        sum = 0u; cnt = 0u; mine = 0u;
#pragma unroll
        for (unsigned j = 0; j < 16; ++j) { const unsigned c = xb_ld(&bar[XB_XCNT(j)]); sum += c; cnt += (c > 0u) ? 1u : 0u; mine = (j == x) ? c : mine; }
        if (sum == G) break;
        __builtin_amdgcn_s_sleep(1);
        if ((++sp & 255u) == 0u) { if (xb_ld(&bar[XB_TMO])) break; if (sp > XB_SPIN_CAP) { atomicAdd(&bar[XB_TMO], 1u); break; } }
    }
    nloc = mine > 0u ? mine : 1u; nx = cnt > 0u ? cnt : 1u;
}

__device__ __forceinline__ void xcd_barrier(const XcdBarrier& b) {
    asm volatile("s_waitcnt vmcnt(0)" ::: "memory");
    __syncthreads();
    if (threadIdx.x == 0) {
        unsigned* bar = b.bar;
        __builtin_amdgcn_s_waitcnt(0);
        unsigned nloc = b.st[0], nx = b.st[1];
        if (nloc == 0u) { xcd_barrier_complete(bar, b.x, nloc, nx); b.st[0] = nloc; b.st[1] = nx; }
        const unsigned old = xb_add(&bar[XB_XSUB(b.x)], 1u);
        const unsigned gen = old / nloc;
        if (old + 1u == (gen + 1u) * nloc) {
            __builtin_amdgcn_fence(__ATOMIC_RELEASE, "agent");
            asm volatile("s_waitcnt vmcnt(0)" ::: "memory");
            const unsigned og = xb_add(&bar[XB_TOP], 1u);
            const unsigned tg = og / nx;
            if (og + 1u == (tg + 1u) * nx) xb_add(&bar[XB_TOPGEN], 1u);
            else XB_SPIN(xb_ld(&bar[XB_TOPGEN]) == tg, bar);
            __builtin_amdgcn_fence(__ATOMIC_ACQUIRE, "agent");
            xb_add(&bar[XB_XGEN(b.x)], 1u);
            asm volatile("s_waitcnt vmcnt(0)" ::: "memory");
        } else {
            XB_SPIN(xb_ld(&bar[XB_XGEN(b.x)]) == gen, bar);
            __builtin_amdgcn_fence(__ATOMIC_ACQUIRE, "agent");
            asm volatile("s_waitcnt vmcnt(0)" ::: "memory");
        }
    }
    __syncthreads();
}


__global__ void __launch_bounds__(512, 2) fwd_megakernel(Params P) {
  extern __shared__ __attribute__((aligned(16))) unsigned char lds_raw[];
  cg::grid_group grid = cg::this_grid();
  Ctx F; F.lds = (LAS unsigned char*)lds_raw; F.wave = __builtin_amdgcn_readfirstlane((int)threadIdx.x >> 6);
  F.G = gridDim.x; F.gw = blockIdx.x * 8 + F.wave; F.NGW = F.G * 8;
  unsigned char* ws = P.ws;
  volatile LAS unsigned* xst = (volatile LAS unsigned*)(F.lds + LDS_BYTES - 16);
  if (threadIdx.x < 2) xst[threadIdx.x] = 0u;
  unsigned* xbar_words = (unsigned*)(ws + WS_CTL + 65536);
  __syncthreads();
  XcdBarrier xbar = xcd_barrier_post(xbar_words, xst);
#define GRID_BAR() xcd_barrier(xbar)

#ifndef PHMASK
#define PHMASK 0xFFFFFFFFu
#endif
#define PH(n) if ((PHMASK >> (n)) & 1u)
#if defined(TIMEDSA) && !defined(TIMEPH)
#define TIMEPH 99
#define TIMEN 1
#endif
#ifdef TIMEPH
  unsigned long long* tsw = (unsigned long long*)(ws + WS_CTL + 4096);
#define TS_BEGIN(n) if ((n) >= TIMEPH && (n) < TIMEPH + TIMEN && (n) == TIMEPH && blockIdx.x == 0 && threadIdx.x == 0) tsw[0] = __builtin_amdgcn_s_memrealtime();
#define TS_END(n) if ((n) == TIMEPH + TIMEN - 1 && blockIdx.x == 0 && threadIdx.x == 0) tsw[1] = __builtin_amdgcn_s_memrealtime();
#else
#define TS_BEGIN(n)
#define TS_END(n)
#endif
  TS_BEGIN(0)
  PH(0) p0_prologue(F, P);
  if (P.ws == nullptr) grid.sync();
  GRID_BAR();
  TS_END(0)
  TS_BEGIN(1)
  PH(1) {
    pg8::DenseSched S; S.init(NTOK, W0P, 1024, ws + WS_WIN0, F.G, (int)blockIdx.x);
    pg8::EpiProj0 E{(bf16_t*)(ws + WS_PROJ), (bf16_t*)(ws + WS_KF), (bf16_t*)(ws + WS_IKF), P.in[I_QN0], P.in[I_KN0], (const float*)(ws + WS_ROPE), (const float*)(ws + WS_ROPE) + SEQ * 32};
    pg8::gemm_phase<pg8::EpiProj0, pg8::DenseSched, true>(F.lds, F.wave, (const char*)(ws + WS_XN), 1024, S, E);
  }
  GRID_BAR();
  TS_END(1)
  TS_BEGIN(2)
  PH(2) p1b_transform0(F, P);
  GRID_BAR();
  TS_END(2)
  TS_BEGIN(3)
  PH(3) dsa_phase(F, P);
  GRID_BAR();
  TS_END(3)
  TS_BEGIN(4)
  PH(4) {
    pg8::DenseSched S; S.init(NTOK, 1024, 1024, ws + WS_WOUT0, F.G, (int)blockIdx.x);
    pg8::EpiResB<true> E{P.in[I_X], (bf16_t*)(ws + WS_XB), DM};
    pg8::gemm_phase<pg8::EpiResB<true>, pg8::DenseSched, true>(F.lds, F.wave, (const char*)(ws + WS_MIX), 1024, S, E);
  }
  GRID_BAR();
  TS_END(4)
  TS_BEGIN(5)
  PH(5) router_phase(F, P, 0);
  GRID_BAR();
  TS_END(5)
  TS_BEGIN(6)
  PH(6) moe_gemms(F, P, 0, xbar);
  GRID_BAR();
  TS_END(6)
  TS_BEGIN(7)
  PH(7) combine_phase(F, P, 0, true);
  GRID_BAR();
  TS_END(7)
  TS_BEGIN(8)
  PH(8) {
    pg8::DenseSched S; S.init(NTOK, W1, 1024, ws + WS_WIN1, F.G, (int)blockIdx.x);
    pg8::EpiQKV1 E{(bf16_t*)(ws + WS_PROJ), P.in[I_QN1], P.in[I_KN1], (const float*)(ws + WS_ROPE), (const float*)(ws + WS_ROPE) + SEQ * 32};
    pg8::gemm_phase<pg8::EpiQKV1, pg8::DenseSched, true>(F.lds, F.wave, (const char*)(ws + WS_XN), 1024, S, E);
  }
  GRID_BAR();
  TS_END(8)
  TS_BEGIN(10)
  PH(10) dil_phase(F, P);
  GRID_BAR();
  TS_END(10)
  TS_BEGIN(11)
  PH(11) {
    pg8::DenseSched S; S.init(NTOK, 1024, 1024, ws + WS_WOUT1, F.G, (int)blockIdx.x);
    pg8::EpiResB<false> E{ws + WS_XB, (bf16_t*)(ws + WS_XB), DM};
    pg8::gemm_phase<pg8::EpiResB<false>, pg8::DenseSched, true>(F.lds, F.wave, (const char*)(ws + WS_MIX), 1024, S, E);
  }
  GRID_BAR();
  TS_END(11)
  TS_BEGIN(12)
  PH(12) router_phase(F, P, 1);
  GRID_BAR();
  TS_END(12)
  TS_BEGIN(13)
  PH(13) moe_gemms(F, P, 1, xbar);
  GRID_BAR();
  TS_END(13)
  TS_BEGIN(14)
  PH(14) combine_phase(F, P, 1, false);
#ifdef TIMEPH
  GRID_BAR();
  TS_END(14)
  GRID_BAR();
  { const unsigned long long dt = (tsw[1] - tsw[0]) * 4ull; const unsigned long long t0 = __builtin_amdgcn_s_memrealtime();
    while (__builtin_amdgcn_s_memrealtime() - t0 < dt) __builtin_amdgcn_s_sleep(32); }
#endif
}

extern "C" void kernel_launch(void* const* d_in, const int* in_sizes, int n_in, void* d_out, int out_size, void* d_ws, size_t ws_size, hipStream_t stream) {
  static int grid_blocks = 0;
  if (!grid_blocks) {
    if (n_in != 28 || out_size != NTOK * DM || ws_size < WS_END) { fprintf(stderr, "kernel_launch: unexpected shapes (n_in %d out %d ws %zu)\n", n_in, out_size, ws_size); grid_blocks = -1; return; }
    int dev = 0, cus = 0, per_cu = 0;
    (void)hipGetDevice(&dev);
    (void)hipDeviceGetAttribute(&cus, hipDeviceAttributeMultiprocessorCount, dev);
    (void)hipFuncSetAttribute((const void*)fwd_megakernel, hipFuncAttributeMaxDynamicSharedMemorySize, LDS_BYTES);
    (void)hipOccupancyMaxActiveBlocksPerMultiprocessor(&per_cu, (const void*)fwd_megakernel, 512, LDS_BYTES);
    if (per_cu < 1) per_cu = 1;
    grid_blocks = cus * per_cu;
  }
  if (grid_blocks < 0) return;
  Params p{};
  for (int i = 0; i < 28; ++i) p.in[i] = (const float*)d_in[i];
  p.out = (float*)d_out; p.ws = (unsigned char*)d_ws;
  (void)hipMemsetAsync((unsigned char*)d_ws + WS_CTL + 65536, 0, XCD_BAR_WORDS * 4, stream);
  void* args[] = {&p};
  hipError_t e = hipLaunchCooperativeKernel((const void*)fwd_megakernel, dim3(grid_blocks), dim3(512), args, LDS_BYTES, stream);
  if (e != hipSuccess) fprintf(stderr, "cooperative launch failed: %s (grid %d)\n", hipGetErrorString(e), grid_blocks);
}
```

```cpp
#include <hip/hip_runtime.h>
#include <hip/hip_cooperative_groups.h>
#include <cstdio>
#include <cstdint>
namespace cg = cooperative_groups;

#define LAS __attribute__((address_space(3)))
#define DI __device__ __forceinline__
typedef unsigned short bf16_t;
typedef short bf16x8 __attribute__((ext_vector_type(8)));
typedef short s16x4 __attribute__((ext_vector_type(4)));
typedef float f32x2 __attribute__((ext_vector_type(2)));
typedef float f32x4 __attribute__((ext_vector_type(4)));
typedef float f32x16 __attribute__((ext_vector_type(16)));
typedef unsigned u32x2 __attribute__((ext_vector_type(2)));
typedef unsigned u32x4 __attribute__((ext_vector_type(4)));
typedef int i32x4 __attribute__((ext_vector_type(4)));
typedef __bf16 bf16x2_t __attribute__((ext_vector_type(2)));

constexpr int NTOK = 65536, DM = 1024, SEQ = 4096, NBATCH = 16;
constexpr int W0P = 2560, W0V = 2500;
constexpr int W1 = 1536;
constexpr int C_CB = 0, C_CC = 512, C_CH = 1024, C_Q = 1536, C_K = 2048, C_V = 2112, C_IQ = 2176, C_IK = 2432, C_IW = 2496;
constexpr int NEXP = 32, DEXP = 512;
constexpr int MAXROWS = 139264;
constexpr float NORM_EPS = 1e-6f;
constexpr float LOG2E = 1.4426950408889634f;

constexpr size_t MiB = 1u << 20;
constexpr size_t WS_CTL = 0;
constexpr size_t WS_ROPE = 1 * MiB;
constexpr size_t WS_WR0 = 2 * MiB, WS_WR1 = 2 * MiB + 256 * 1024;
constexpr size_t WS_WIN0 = 3 * MiB, WS_WOUT0 = 8 * MiB, WS_WIN1 = 10 * MiB, WS_WOUT1 = 13 * MiB;
constexpr size_t WS_WGU0 = 16 * MiB, WS_WD0 = 80 * MiB, WS_WGU1 = 112 * MiB, WS_WD1 = 176 * MiB;
constexpr size_t WS_XN = 208 * MiB;
constexpr size_t WS_MIX = 337 * MiB;
constexpr size_t WS_H = 337 * MiB;
constexpr size_t WS_XB = 473 * MiB;
constexpr size_t WS_PROJ = 601 * MiB;
constexpr size_t WS_LIST = 921 * MiB;
constexpr size_t WS_ASG = 929 * MiB;
constexpr size_t WS_ASGG = 930 * MiB;
constexpr size_t WS_IKF = 931 * MiB, WS_KF = 939 * MiB, WS_VTF = 947 * MiB;
constexpr size_t WS_RSL = 955 * MiB;
constexpr size_t WS_END = 963 * MiB;

constexpr int LDS_BYTES = 155648;
constexpr int LDS_LIST = 131072;
constexpr int LDS_MISC = 131072 + 16384;

DI unsigned pk2(float lo, float hi) { f32x2 v = {lo, hi}; bf16x2_t b = __builtin_convertvector(v, bf16x2_t); return __builtin_bit_cast(unsigned, b); }
DI float bflo(unsigned w) { return __uint_as_float(w << 16); }
DI float bfhi(unsigned w) { return __uint_as_float(w & 0xffff0000u); }
DI float bf1(bf16_t h) { return __uint_as_float((unsigned)h << 16); }
DI int opaque(int x) { asm volatile("" : "+v"(x)); return x; }
DI int lane_id_v() { int l; asm volatile("v_mbcnt_lo_u32_b32 %0, -1, 0\n\tv_mbcnt_hi_u32_b32 %0, -1, %0" : "=v"(l)); return l; }
DI float wave_sum(float v) {
#pragma unroll
  for (int o = 1; o < 64; o <<= 1) v += __shfl_xor(v, o);
  return v;
}
DI float wave_max(float v) {
#pragma unroll
  for (int o = 1; o < 64; o <<= 1) v = fmaxf(v, __shfl_xor(v, o));
  return v;
}
DI unsigned wave_sum_u(unsigned v) {
#pragma unroll
  for (int o = 1; o < 64; o <<= 1) v += (unsigned)__shfl_xor((int)v, o);
  return v;
}

namespace pg8 {
constexpr int BM = 256, BK = 64, HALF = 128, HTB = HALF * BK * 2, STAGE_BYTES = 8 * HTB, NXCD = 8, WGM = 8;
DI int lds_byte(int r, int c) { const int st = (r >> 4) * 2 + (c >> 5), rr = r & 15, cc = c & 31, ob = rr * 64 + cc * 2; return st * 1024 + (ob ^ (((ob >> 9) & 1) << 5)); }
DI void stage_rc(int b, int& R, int& C) { const int st = b / 1024, sb = b % 1024, swz = sb ^ (((sb >> 9) & 1) << 5); R = (st >> 1) * 16 + swz / 64; C = (st & 1) * 32 + (swz % 64) / 2; }
DI int perm32(int rho) { const int n = rho >> 4, i = rho & 15; return 8 * (i >> 2) + 4 * n + (i & 3); }

struct Unit { const char* b; int p0, p1, p2, p3; };

struct EpiBf16 {
  static constexpr bool PERM = true;
  bf16_t* O; int ldc;
  DI void operator()(const f32x4 (&acc)[2][2][4][2], const Unit& u, int wr, int wc, int fr, int fq) const {
    const int row0 = u.p0 + wr * 64 + fr, col0 = u.p1 + wc * 32 + 8 * fq;
#pragma unroll
    for (int ai = 0; ai < 2; ++ai)
#pragma unroll
      for (int m = 0; m < 4; ++m) { bf16_t* rowp = O + (size_t)(row0 + ai * HALF + m * 16) * ldc + col0;
#pragma unroll
        for (int bj = 0; bj < 2; ++bj) { const f32x4 v0 = acc[ai][bj][m][0], v1 = acc[ai][bj][m][1];
          u32x4 w; w.x = pk2(v0[0], v0[1]); w.y = pk2(v0[2], v0[3]); w.z = pk2(v1[0], v1[1]); w.w = pk2(v1[2], v1[3]);
          *(u32x4*)(rowp + bj * HALF) = w; } }
  }
};
template <bool BASE_F32> struct EpiResB {
  static constexpr bool PERM = true;
  const void* base; bf16_t* out; int ldc;
  DI void operator()(const f32x4 (&acc)[2][2][4][2], const Unit& u, int wr, int wc, int fr, int fq) const {
    const int row0 = u.p0 + wr * 64 + fr, col0 = u.p1 + wc * 32 + 8 * fq;
#pragma unroll
    for (int ai = 0; ai < 2; ++ai)
#pragma unroll
      for (int m = 0; m < 4; ++m) { const size_t off = (size_t)(row0 + ai * HALF + m * 16) * ldc + col0;
#pragma unroll
        for (int bj = 0; bj < 2; ++bj) { f32x4 v0 = acc[ai][bj][m][0], v1 = acc[ai][bj][m][1];
          if (BASE_F32) { const float* bp = (const float*)base + off + bj * HALF; v0 = v0 + *(const f32x4*)bp; v1 = v1 + *(const f32x4*)(bp + 4); }
          else { const u32x4 b = *(const u32x4*)((const bf16_t*)base + off + bj * HALF);
            v0 = v0 + (f32x4){bflo(b.x), bfhi(b.x), bflo(b.y), bfhi(b.y)}; v1 = v1 + (f32x4){bflo(b.z), bfhi(b.z), bflo(b.w), bfhi(b.w)}; }
          u32x4 w; w.x = pk2(v0[0], v0[1]); w.y = pk2(v0[2], v0[3]); w.z = pk2(v1[0], v1[1]); w.w = pk2(v1[2], v1[3]);
          *(u32x4*)(out + off + bj * HALF) = w; } }
  }
};
struct EpiQKV1 {
  static constexpr bool PERM = true;
  bf16_t* O; const float* qg; const float* kg; const float* cosT; const float* sinT;
  DI void operator()(const f32x4 (&acc)[2][2][4][2], const Unit& u, int wr, int wc, int fr, int fq) const {
    const int tilec = u.p1 >> 8;
    const int row0 = u.p0 + wr * 64 + fr, col0 = u.p1 + wc * 64 + 8 * fq;
    if (tilec == 5) {
#pragma unroll
      for (int ai = 0; ai < 2; ++ai)
#pragma unroll
        for (int m = 0; m < 4; ++m) { bf16_t* rowp = O + (size_t)(row0 + ai * HALF + m * 16) * W1 + col0;
#pragma unroll
          for (int bj = 0; bj < 2; ++bj) { const f32x4 v0 = acc[ai][bj][m][0], v1 = acc[ai][bj][m][1];
            u32x4 w; w.x = pk2(v0[0], v0[1]); w.y = pk2(v0[2], v0[3]); w.z = pk2(v1[0], v1[1]); w.w = pk2(v1[2], v1[3]); *(u32x4*)(rowp + 32 * bj) = w; } }
      return;
    }
    const float* gp = (tilec == 4 ? kg : qg) + 8 * fq; const float osc = tilec == 4 ? 1.f : 0.125f * LOG2E;
    float g0[8], g1[8];
#pragma unroll
    for (int i = 0; i < 8; ++i) { g0[i] = gp[i]; g1[i] = gp[32 + i]; }
#pragma unroll
    for (int ai = 0; ai < 2; ++ai)
#pragma unroll
      for (int m = 0; m < 4; ++m) {
        const int row = row0 + ai * HALF + m * 16; const int t = row & (SEQ - 1);
        const f32x4 a0 = acc[ai][0][m][0], a1 = acc[ai][0][m][1], b0 = acc[ai][1][m][0], b1 = acc[ai][1][m][1];
        float x1[8] = {a0[0], a0[1], a0[2], a0[3], a1[0], a1[1], a1[2], a1[3]}, x2[8] = {b0[0], b0[1], b0[2], b0[3], b1[0], b1[1], b1[2], b1[3]};
        float ss = 0.f;
#pragma unroll
        for (int i = 0; i < 8; ++i) ss += x1[i] * x1[i] + x2[i] * x2[i];
        ss += __shfl_xor(ss, 16); ss += __shfl_xor(ss, 32);
        const float rstd = 1.0f / sqrtf(ss * (1.f / 64.f) + NORM_EPS);
        const f32x4* cp = (const f32x4*)(cosT + t * 32 + 8 * fq); const f32x4* sp = (const f32x4*)(sinT + t * 32 + 8 * fq);
        const f32x4 c0 = cp[0], c1 = cp[1], s0 = sp[0], s1 = sp[1];
        const float cv[8] = {c0[0], c0[1], c0[2], c0[3], c1[0], c1[1], c1[2], c1[3]}, sv[8] = {s0[0], s0[1], s0[2], s0[3], s1[0], s1[1], s1[2], s1[3]};
        float o1[8], o2[8];
#pragma unroll
        for (int i = 0; i < 8; ++i) { const float y1 = x1[i] * rstd * g0[i], y2 = x2[i] * rstd * g1[i]; o1[i] = (y1 * cv[i] - y2 * sv[i]) * osc; o2[i] = (y1 * sv[i] + y2 * cv[i]) * osc; }
        bf16_t* rowp = O + (size_t)row * W1 + col0;
        u32x4 w; w.x = pk2(o1[0], o1[1]); w.y = pk2(o1[2], o1[3]); w.z = pk2(o1[4], o1[5]); w.w = pk2(o1[6], o1[7]); *(u32x4*)rowp = w;
        w.x = pk2(o2[0], o2[1]); w.y = pk2(o2[2], o2[3]); w.z = pk2(o2[4], o2[5]); w.w = pk2(o2[6], o2[7]); *(u32x4*)(rowp + 32) = w;
      }
  }
};
struct EpiProj0 {
  static constexpr bool PERM = true;
  bf16_t* O; bf16_t* KFo; bf16_t* IKFo; const float* qg; const float* kg; const float* cosT; const float* sinT;
  DI void operator()(const f32x4 (&acc)[2][2][4][2], const Unit& u, int wr, int wc, int fr, int fq) const {
    const int grp64 = (u.p1 >> 6) + wc;
    const int row0 = u.p0 + wr * 64 + fr, col0 = u.p1 + wc * 64 + 8 * fq;
    const bool rope = (grp64 >= 24 && grp64 <= 32) || (grp64 >= 34 && grp64 <= 38);
    if (!rope) {
#pragma unroll
      for (int ai = 0; ai < 2; ++ai)
#pragma unroll
        for (int m = 0; m < 4; ++m) { bf16_t* rowp = O + (size_t)(row0 + ai * HALF + m * 16) * W0P + col0;
#pragma unroll
          for (int bj = 0; bj < 2; ++bj) { const f32x4 v0 = acc[ai][bj][m][0], v1 = acc[ai][bj][m][1];
            u32x4 w; w.x = pk2(v0[0], v0[1]); w.y = pk2(v0[2], v0[3]); w.z = pk2(v1[0], v1[1]); w.w = pk2(v1[2], v1[3]); *(u32x4*)(rowp + 32 * bj) = w; } }
      return;
    }
    const bool norm = grp64 <= 32;
    const float* gp = (grp64 == 32 ? kg : qg) + 8 * fq;
    float g0[8], g1[8];
#pragma unroll
    for (int i = 0; i < 8; ++i) { g0[i] = norm ? gp[i] : 1.f; g1[i] = norm ? gp[32 + i] : 1.f; }
    bf16_t* frag = grp64 == 32 ? KFo : (grp64 == 38 ? IKFo : nullptr);
#pragma unroll
    for (int ai = 0; ai < 2; ++ai)
#pragma unroll
      for (int m = 0; m < 4; ++m) {
        const int row = row0 + ai * HALF + m * 16; const int t = row & (SEQ - 1);
        const f32x4 a0 = acc[ai][0][m][0], a1 = acc[ai][0][m][1], b0 = acc[ai][1][m][0], b1 = acc[ai][1][m][1];
        float x1[8] = {a0[0], a0[1], a0[2], a0[3], a1[0], a1[1], a1[2], a1[3]}, x2[8] = {b0[0], b0[1], b0[2], b0[3], b1[0], b1[1], b1[2], b1[3]};
        float ss = 0.f;
#pragma unroll
        for (int i = 0; i < 8; ++i) ss += x1[i] * x1[i] + x2[i] * x2[i];
        ss += __shfl_xor(ss, 16); ss += __shfl_xor(ss, 32);
        const float rstd = norm ? 1.0f / sqrtf(ss * (1.f / 64.f) + NORM_EPS) : 1.f;
        const f32x4* cp = (const f32x4*)(cosT + t * 32 + 8 * fq); const f32x4* sp = (const f32x4*)(sinT + t * 32 + 8 * fq);
        const f32x4 c0 = cp[0], c1 = cp[1], s0 = sp[0], s1 = sp[1];
        const float cv[8] = {c0[0], c0[1], c0[2], c0[3], c1[0], c1[1], c1[2], c1[3]}, sv[8] = {s0[0], s0[1], s0[2], s0[3], s1[0], s1[1], s1[2], s1[3]};
        float o1[8], o2[8];
#pragma unroll
        for (int i = 0; i < 8; ++i) { const float y1 = x1[i] * rstd * g0[i], y2 = x2[i] * rstd * g1[i]; o1[i] = y1 * cv[i] - y2 * sv[i]; o2[i] = y1 * sv[i] + y2 * cv[i]; }
        u32x4 w1, w2; w1.x = pk2(o1[0], o1[1]); w1.y = pk2(o1[2], o1[3]); w1.z = pk2(o1[4], o1[5]); w1.w = pk2(o1[6], o1[7]);
        w2.x = pk2(o2[0], o2[1]); w2.y = pk2(o2[2], o2[3]); w2.z = pk2(o2[4], o2[5]); w2.w = pk2(o2[6], o2[7]);
        if (frag) {
          const size_t fo = ((((size_t)(row >> 12) * 128 + (t >> 5)) * 4 + (fq >> 1)) * 64 + (fq & 1) * 32 + (t & 31)) * 8;
          *(u32x4*)(frag + fo) = w1; *(u32x4*)(frag + fo + 2 * 64 * 8) = w2;
        } else { bf16_t* rowp = O + (size_t)row * W0P + col0; *(u32x4*)rowp = w1; *(u32x4*)(rowp + 32) = w2; }
      }
  }
};
struct EpiResF32 {
  static constexpr bool PERM = false;
  const float* base; float* out; int ldc;
  DI void operator()(const f32x4 (&acc)[2][2][4][2], const Unit& u, int wr, int wc, int fr, int fq) const {
    const int row0 = u.p0 + wr * 64 + fr, col0 = u.p1 + wc * 32 + 4 * fq;
#pragma unroll
    for (int ai = 0; ai < 2; ++ai)
#pragma unroll
      for (int m = 0; m < 4; ++m) { const size_t off = (size_t)(row0 + ai * HALF + m * 16) * ldc + col0;
#pragma unroll
        for (int bj = 0; bj < 2; ++bj)
#pragma unroll
          for (int n = 0; n < 2; ++n) { const f32x4 bs = *(const f32x4*)(base + off + bj * HALF + n * 16); *(f32x4*)(out + off + bj * HALF + n * 16) = bs + acc[ai][bj][m][n]; } }
  }
};
DI float silu_mul(float g, float u) { return g * u * __builtin_amdgcn_rcpf(1.0f + __builtin_amdgcn_exp2f(-g * LOG2E)); }
struct EpiSwiGLU {
  static constexpr bool PERM = true;
  bf16_t* H; const float* RSL; const LAS int* cnt;
  DI void operator()(const f32x4 (&acc)[2][2][4][2], const Unit& u, int wr, int wc, int fr, int fq) const {
    const int row0 = u.p0 + wr * 64 + fr, col0 = u.p1 + wc * 32 + 8 * fq; const int ce = __builtin_amdgcn_readfirstlane(cnt[u.p2]);
#pragma unroll
    for (int ai = 0; ai < 2; ++ai)
#pragma unroll
      for (int m = 0; m < 4; ++m) { bf16_t* rowp = H + (size_t)(row0 + ai * HALF + m * 16) * DEXP + col0;
        const int lrow = u.p3 * BM + wr * 64 + fr + ai * HALF + m * 16; const float rs = (lrow < ce) ? RSL[u.p2 * 65536 + lrow] : 0.f;
        const f32x4 g0 = acc[ai][0][m][0] * rs, g1 = acc[ai][0][m][1] * rs, u0 = acc[ai][1][m][0] * rs, u1 = acc[ai][1][m][1] * rs;
        u32x4 w; w.x = pk2(silu_mul(g0[0], u0[0]), silu_mul(g0[1], u0[1])); w.y = pk2(silu_mul(g0[2], u0[2]), silu_mul(g0[3], u0[3]));
        w.z = pk2(silu_mul(g1[0], u1[0]), silu_mul(g1[1], u1[1])); w.w = pk2(silu_mul(g1[2], u1[2]), silu_mul(g1[3], u1[3]));
        *(u32x4*)rowp = w; }
  }
};

struct DenseSched {
  static constexpr bool NEXT_IN_LDS = false;
  int nM, nN, nwg, G, c, K; const char* Bt;
  DI void init(int M, int N, int K_, const void* Bt_, int G_, int c_) { nM = M / BM; nN = N / BM; nwg = nM * nN; G = G_; c = c_; K = K_; Bt = (const char*)Bt_; }
  DI bool next(int i, Unit& u) const {
    const long L = (long)i * G + c; if (L >= nwg) return false;
    int wgid = (int)L; { const int q = nwg / NXCD, r = nwg % NXCD, xcd = wgid % NXCD, off = wgid / NXCD; wgid = (xcd < r ? xcd * (q + 1) : r * (q + 1) + (xcd - r) * q) + off; }
    const int nig = WGM * nN, gid = wgid / nig, fm = gid * WGM, gsz = (nM - fm) < WGM ? (nM - fm) : WGM;
    const int pm = fm + ((wgid % nig) % gsz), pn = (wgid % nig) / gsz;
    u.p0 = pm * BM; u.p1 = pn * BM; u.p2 = 0; u.p3 = 0; u.b = Bt + (size_t)pn * BM * K * 2; return true;
  }
  DI void a_off(const Unit& u, const int (&R)[2], const int (&C)[2], unsigned (&o)[2][2]) const {
#pragma unroll
    for (int h = 0; h < 2; ++h)
#pragma unroll
      for (int i = 0; i < 2; ++i) o[h][i] = (unsigned)((u.p0 + h * HALF + R[i]) * K + C[i]) * 2u;
  }
};
template <bool GATHER> struct MoeSched {
  static constexpr bool NEXT_IN_LDS = GATHER;
  const LAS int* pb; const LAS int* cnt; const int* list; const char* W; int G, c, K;
  DI bool next(int i, Unit& u) const {
    const int L = i * G + c; const int total = __builtin_amdgcn_readfirstlane(pb[NEXP]) * 4; if (L >= total) return false;
    const int rbg = L >> 2, pn = L & 3; int e = 0;
    for (int j = 1; j < NEXP; ++j) e = (__builtin_amdgcn_readfirstlane(pb[j]) <= rbg) ? j : e;
    u.p0 = rbg * BM; u.p1 = pn * (GATHER ? 128 : 256); u.p2 = e; u.p3 = rbg - __builtin_amdgcn_readfirstlane(pb[e]);
    u.b = W + (size_t)(e * 1024 + pn * 256) * K * 2; return true;
  }
  DI void a_off(const Unit& u, const int (&R)[2], const int (&C)[2], unsigned (&o)[2][2]) const {
    if (GATHER) {
      const int ce = __builtin_amdgcn_readfirstlane(cnt[u.p2]);
#pragma unroll
      for (int h = 0; h < 2; ++h)
#pragma unroll
        for (int i = 0; i < 2; ++i) { const int row = u.p3 * BM + h * HALF + R[i]; const int tok = (row < ce) ? list[u.p2 * 65536 + row] : 0; o[h][i] = (unsigned)(tok * K + C[i]) * 2u; }
    } else {
#pragma unroll
      for (int h = 0; h < 2; ++h)
#pragma unroll
        for (int i = 0; i < 2; ++i) o[h][i] = (unsigned)((u.p0 + h * HALF + R[i]) * K + C[i]) * 2u;
    }
  }
};

template <class Epi, class Sched, bool ALIGN_EPI>
DI void gemm_phase(LAS unsigned char* lds, const int wave_id, const char* gA, const int K, const Sched& S, const Epi& E) {
  const int lane = lane_id_v(), wid = wave_id, tid = wid * 64 + lane, wr = wid >> 2, wc = wid & 3, fr = lane & 15, fq = lane >> 4;
  const int nt = K / BK;
  unsigned voffB[2];
  { int R, C; stage_rc(tid * 16, R, C);
    const int Rb = Epi::PERM ? ((R & ~31) + perm32(R & 31)) : R; voffB[0] = (unsigned)(Rb * K + C) * 2u; voffB[1] = voffB[0] + (unsigned)(64 * K * 2); }
#define PG8_RC(Rp, Cp) int Rp[2], Cp[2]; { int R_, C_; stage_rc(opaque(tid) * 16, R_, C_); Rp[0] = R_; Cp[0] = C_; Rp[1] = R_ + 64; Cp[1] = C_; }
  const size_t kstep = (size_t)(BK * 2);
  const size_t hstep = (size_t)HALF * K * 2;
  const unsigned ldsw = (unsigned)wid * 1024u;
  const int aoff = lds_byte(wr * 64 + fr, fq * 8), boff = lds_byte(wc * 32 + fr, fq * 8);
#define PG8_SA(b, h) (((b) * 2 + (h)) * HTB)
#define PG8_SB(b, h) ((4 + (b) * 2 + (h)) * HTB)
#define PG8_STAGE_B(bufoff, gbase) do { _Pragma("unroll") for (int _i = 0; _i < 2; ++_i) \
    __builtin_amdgcn_global_load_lds((const unsigned*)((const char*)(gbase) + voffB[_i]), (LAS unsigned*)(lds + (bufoff) + ldsw + _i * 8192), 16, 0, 0); } while (0)
#define PG8_STAGE_A(bufoff, kb, offs) do { _Pragma("unroll") for (int _i = 0; _i < 2; ++_i) \
    __builtin_amdgcn_global_load_lds((const unsigned*)(gA + (size_t)(kb) + (offs)[_i]), (LAS unsigned*)(lds + (bufoff) + ldsw + _i * 8192), 16, 0, 0); } while (0)
#define PG8_LDA(dst, b, h) do { _Pragma("unroll") for (int m = 0; m < 4; ++m) _Pragma("unroll") for (int k = 0; k < 2; ++k) dst[m][k] = *(const LAS bf16x8*)(lds + PG8_SA(b, h) + aoff + m * 2048 + k * 1024); } while (0)
#define PG8_LDB(dst, b, h) do { _Pragma("unroll") for (int n = 0; n < 2; ++n) _Pragma("unroll") for (int k = 0; k < 2; ++k) dst[n][k] = *(const LAS bf16x8*)(lds + PG8_SB(b, h) + boff + n * 2048 + k * 1024); } while (0)
#define PG8_MMA(ai, bj, At, Bt) do { __builtin_amdgcn_s_setprio(1); _Pragma("unroll") for (int m = 0; m < 4; ++m) _Pragma("unroll") for (int n = 0; n < 2; ++n) _Pragma("unroll") for (int k = 0; k < 2; ++k) \
    acc[ai][bj][m][n] = __builtin_amdgcn_mfma_f32_16x16x32_bf16(Bt[n][k], At[m][k], acc[ai][bj][m][n], 0, 0, 0); __builtin_amdgcn_s_setprio(0); } while (0)
#define PG8_WAIT_V(n) asm volatile("s_waitcnt vmcnt(" #n ")" ::: "memory")
#define PG8_WAIT_L(n) asm volatile("s_waitcnt lgkmcnt(" #n ")" ::: "memory")
#define PG8_BAR __builtin_amdgcn_s_barrier()
#define PG8_SCHED __builtin_amdgcn_sched_barrier(0)
  Unit cur, nxt; int ui = 0;
  if (!S.next(0, cur)) return;
  unsigned ca[2][2];
  { PG8_RC(Rp, Cp) S.a_off(cur, Rp, Cp, ca); }
  f32x4 acc[2][2][4][2];
#pragma unroll
  for (int a = 0; a < 2; ++a)
#pragma unroll
    for (int b = 0; b < 2; ++b)
#pragma unroll
      for (int m = 0; m < 4; ++m)
#pragma unroll
        for (int n = 0; n < 2; ++n) acc[a][b][m][n] = (f32x4){0.f, 0.f, 0.f, 0.f};
  bf16x8 At[4][2], B0[2][2], B1[2][2];
  const char* cB = cur.b;
  PG8_STAGE_B(PG8_SB(0, 0), cB); PG8_STAGE_B(PG8_SB(0, 1), cB + hstep); PG8_STAGE_A(PG8_SA(0, 0), 0, ca[0]); PG8_STAGE_A(PG8_SA(0, 1), 0, ca[1]);
  if (wr == 1) PG8_BAR;
  PG8_WAIT_V(2); PG8_BAR;
  PG8_STAGE_B(PG8_SB(1, 0), cB + kstep); PG8_STAGE_A(PG8_SA(1, 0), kstep, ca[0]); PG8_STAGE_B(PG8_SB(1, 1), cB + hstep + kstep);
  PG8_WAIT_V(6); PG8_BAR;
  for (;;) {
    const bool has_next = S.next(ui + 1, nxt);
    if (Sched::NEXT_IN_LDS) {
      unsigned na[2][2];
      if (has_next) { PG8_RC(Rp, Cp) S.a_off(nxt, Rp, Cp, na); }
      else {
#pragma unroll
        for (int h = 0; h < 2; ++h)
#pragma unroll
          for (int i = 0; i < 2; ++i) na[h][i] = ca[h][i];
      }
      *(LAS u32x4*)(lds + STAGE_BYTES + 8192 + tid * 16) = (u32x4){na[0][0], na[0][1], na[1][0], na[1][1]};
    }
    const char* nB = has_next ? nxt.b : cB;
    for (int t = 0; t < nt; t += 2) {
      const bool last = (t == nt - 2);
      PG8_LDB(B0, 0, 0); PG8_LDB(B1, 0, 1); PG8_SCHED; PG8_LDA(At, 0, 0); PG8_STAGE_A(PG8_SA(1, 1), (size_t)(t + 1) * kstep, ca[1]);
      PG8_WAIT_V(8); PG8_WAIT_L(0); PG8_BAR; PG8_MMA(0, 0, At, B0); PG8_MMA(0, 1, At, B1); PG8_BAR; PG8_SCHED;
      const size_t kb2 = last ? 0 : (size_t)(t + 2) * kstep;
      const char* b2 = last ? nB : cB + (size_t)(t + 2) * kstep;
      if (last) {
        if (Sched::NEXT_IN_LDS) { const u32x4 v = *(const LAS u32x4*)(lds + STAGE_BYTES + 8192 + tid * 16); ca[0][0] = v.x; ca[0][1] = v.y; ca[1][0] = v.z; ca[1][1] = v.w; }
        else if (has_next) { PG8_RC(Rp, Cp) S.a_off(nxt, Rp, Cp, ca); }
      }
      PG8_LDA(At, 0, 1); PG8_STAGE_B(PG8_SB(0, 0), b2); PG8_STAGE_B(PG8_SB(0, 1), b2 + hstep); PG8_STAGE_A(PG8_SA(0, 0), kb2, ca[0]);
      PG8_WAIT_V(8); PG8_WAIT_L(0); PG8_BAR; PG8_MMA(1, 0, At, B0); PG8_MMA(1, 1, At, B1); PG8_BAR; PG8_SCHED;
      PG8_LDB(B0, 1, 0); PG8_LDB(B1, 1, 1); PG8_SCHED; PG8_LDA(At, 1, 0); PG8_STAGE_A(PG8_SA(0, 1), kb2, ca[1]);
      PG8_WAIT_V(8); PG8_WAIT_L(0); PG8_BAR; PG8_MMA(0, 0, At, B0); PG8_MMA(0, 1, At, B1); PG8_BAR; PG8_SCHED;
      PG8_LDA(At, 1, 1); PG8_STAGE_B(PG8_SB(1, 0), b2 + kstep); PG8_STAGE_B(PG8_SB(1, 1), b2 + kstep + hstep); PG8_STAGE_A(PG8_SA(1, 0), kb2 + kstep, ca[0]);
      PG8_WAIT_V(8); PG8_WAIT_L(0); PG8_BAR; PG8_MMA(1, 0, At, B0); PG8_MMA(1, 1, At, B1); PG8_BAR; PG8_SCHED;
    }
    if constexpr (ALIGN_EPI) { if (wr == 0) PG8_BAR; }
    E(acc, cur, wr, wc, fr, fq);
    if (!has_next) break;
#pragma unroll
    for (int a = 0; a < 2; ++a)
#pragma unroll
      for (int b = 0; b < 2; ++b)
#pragma unroll
        for (int m = 0; m < 4; ++m)
#pragma unroll
          for (int n = 0; n < 2; ++n) acc[a][b][m][n] = (f32x4){0.f, 0.f, 0.f, 0.f};
    cur = nxt; cB = nB; ++ui;
    if constexpr (ALIGN_EPI) { if (wr == 1) PG8_BAR; }
  }
  PG8_WAIT_V(0);
  if constexpr (!ALIGN_EPI) { if (wr == 0) PG8_BAR; }
  PG8_BAR;
#undef PG8_RC
#undef PG8_SA
#undef PG8_SB
#undef PG8_STAGE_A
#undef PG8_STAGE_B
#undef PG8_LDA
#undef PG8_LDB
#undef PG8_MMA
#undef PG8_WAIT_V
#undef PG8_WAIT_L
#undef PG8_BAR
#undef PG8_SCHED
}
}

struct Params { const float* in[28]; float* out; unsigned char* ws; };
enum { I_X = 0, I_ANORM0, I_WIN0, I_CONVW, I_QN0, I_KN0, I_WOUT0, I_FNORM0, I_WRG0, I_BRG0, I_WRE0, I_BRE0, I_WG0, I_WU0, I_WD0,
       I_ANORM1, I_WIN1, I_QN1, I_KN1, I_WOUT1, I_FNORM1, I_WRG1, I_BRG1, I_WRE1, I_BRE1, I_WG1, I_WU1, I_WD1 };

struct Ctx { LAS unsigned char* lds; int wave, G, gw, NGW; };

struct TrDesc { const float* W; const float* gain; bf16_t* WT; int K, N, nvalid, mode, nblk, item; };
DI void tr_load(const TrDesc& d, int lane, f32x4 (&r)[8]) {
  const int kb = d.item / d.nblk, nb = d.item % d.nblk, k0 = 64 * kb, n = 32 * nb + 4 * (lane & 7);
#pragma unroll
  for (int i = 0; i < 8; ++i) { const int kk = 8 * i + (lane >> 3); r[i] = (n < d.nvalid) ? *(const f32x4*)(d.W + (size_t)(k0 + kk) * d.N + n) : (f32x4){0.f, 0.f, 0.f, 0.f}; }
}
DI void tr_finish(const TrDesc& d, int lane, const f32x4 (&r)[8], LAS float* scr) {
  const int kb = d.item / d.nblk, nb = d.item % d.nblk, k0 = 64 * kb, n0 = 32 * nb;
#pragma unroll
  for (int i = 0; i < 8; ++i) { const int kk = 8 * i + (lane >> 3); const float g = d.gain ? d.gain[k0 + kk] : 1.f; LAS float* s = scr + kk * 33 + 4 * (lane & 7);
    s[0] = r[i].x * g; s[1] = r[i].y * g; s[2] = r[i].z * g; s[3] = r[i].w * g; }
  asm volatile("s_waitcnt lgkmcnt(0)" ::: "memory");
  const int c = lane & 7;
#pragma unroll
  for (int j = 0; j < 4; ++j) { const int nn = (lane >> 3) + 8 * j; const LAS float* s = scr + (8 * c) * 33 + nn;
    u32x4 o; o.x = pk2(s[0 * 33], s[1 * 33]); o.y = pk2(s[2 * 33], s[3 * 33]); o.z = pk2(s[4 * 33], s[5 * 33]); o.w = pk2(s[6 * 33], s[7 * 33]);
    const int ng = n0 + nn; const int drow = (d.mode == 0) ? ng : (d.mode == 3 ? ((ng & ~255) + 128 * ((ng >> 5) & 1) + 32 * ((ng >> 6) & 3) + (ng & 31)) : ((ng >> 7) * 256 + (ng & 127) + (d.mode == 2 ? 128 : 0)));
    *(u32x4*)(d.WT + (size_t)drow * d.K + k0 + 8 * c) = o; }
  asm volatile("s_waitcnt lgkmcnt(0)" ::: "memory");
}
DI void rms_row_to_bf16(const float* xrow, bf16_t* orow, int lane) {
  const f32x4* xr = (const f32x4*)xrow + lane;
  f32x4 v[4]; float s = 0.f;
#pragma unroll
  for (int j = 0; j < 4; ++j) { v[j] = xr[64 * j]; s += (v[j].x * v[j].x + v[j].y * v[j].y) + (v[j].z * v[j].z + v[j].w * v[j].w); }
  const float rstd = 1.0f / sqrtf(wave_sum(s) * (1.f / DM) + NORM_EPS);
  unsigned long long* o8 = (unsigned long long*)orow + lane;
#pragma unroll
  for (int j = 0; j < 4; ++j) o8[64 * j] = (unsigned long long)pk2(v[j].x * rstd, v[j].y * rstd) | ((unsigned long long)pk2(v[j].z * rstd, v[j].w * rstd) << 32);
}
DI void p0_prologue(const Ctx& F, const Params& P) {
  unsigned char* ws = P.ws; const int lane = lane_id_v(); const int tid = F.wave * 64 + lane;
  LAS float* scr = (LAS float*)(F.lds + F.wave * 16384);
  constexpr int I_IN0 = 16 * 80, I_OUT = 16 * 32, I_GU = 32 * 16 * 16, I_DN = 32 * 8 * 32, I_IN1 = 16 * 48;
  constexpr int PER_LAYER0 = I_IN0 + I_OUT + 2 * I_GU + I_DN, PER_LAYER1 = I_IN1 + I_OUT + 2 * I_GU + I_DN;
  auto mkdesc = [&](int it) {
    TrDesc d; int r = it; const int L = (r >= PER_LAYER0) ? 1 : 0; if (L) r -= PER_LAYER0;
    const int i_in = L ? I_IN1 : I_IN0;
    const float* anorm = P.in[L ? I_ANORM1 : I_ANORM0]; const float* fnorm = P.in[L ? I_FNORM1 : I_FNORM0];
    if (r < i_in) { d.W = P.in[L ? I_WIN1 : I_WIN0]; d.gain = anorm; d.WT = (bf16_t*)(ws + (L ? WS_WIN1 : WS_WIN0)); d.K = 1024; d.N = L ? W1 : W0V; d.nvalid = d.N; d.mode = 3; d.nblk = L ? 48 : 80; d.item = r; return d; }
    r -= i_in;
    if (r < I_OUT) { d.W = P.in[L ? I_WOUT1 : I_WOUT0]; d.gain = nullptr; d.WT = (bf16_t*)(ws + (L ? WS_WOUT1 : WS_WOUT0)); d.K = 1024; d.N = 1024; d.nvalid = 1024; d.mode = 0; d.nblk = 32; d.item = r; return d; }
    r -= I_OUT;
    if (r < 2 * I_GU) { const int up = r >= I_GU; if (up) r -= I_GU; const int e = r >> 8;
      d.W = P.in[up ? (L ? I_WU1 : I_WU0) : (L ? I_WG1 : I_WG0)] + (size_t)e * 1024 * 512; d.gain = fnorm; d.WT = (bf16_t*)(ws + (L ? WS_WGU1 : WS_WGU0)) + (size_t)e * 1024 * 1024;
      d.K = 1024; d.N = 512; d.nvalid = 512; d.mode = up ? 2 : 1; d.nblk = 16; d.item = r & 255; return d; }
    r -= 2 * I_GU;
    { const int e = r >> 8; d.W = P.in[L ? I_WD1 : I_WD0] + (size_t)e * 512 * 1024; d.gain = nullptr; d.WT = (bf16_t*)(ws + (L ? WS_WD1 : WS_WD0)) + (size_t)e * 1024 * 512; d.K = 512; d.N = 1024; d.nvalid = 1024; d.mode = 0; d.nblk = 32; d.item = r & 255; return d; }
  };
  {
    const int NIT = PER_LAYER0 + PER_LAYER1;
    int it = F.gw;
    f32x4 ra[8], rb[8];
    TrDesc da, db;
    if (it < NIT) { da = mkdesc(it); tr_load(da, lane, ra); }
    while (it < NIT) {
      const int itn = it + F.NGW;
      if (itn < NIT) { db = mkdesc(itn); tr_load(db, lane, rb); }
      tr_finish(da, lane, ra, scr);
      if (itn >= NIT) break;
      const int itn2 = itn + F.NGW;
      if (itn2 < NIT) { da = mkdesc(itn2); tr_load(da, lane, ra); }
      tr_finish(db, lane, rb, scr);
      it = itn2;
    }
  }
  for (int m = F.gw; m < NTOK; m += F.NGW) rms_row_to_bf16(P.in[I_X] + (size_t)m * DM, (bf16_t*)(ws + WS_XN) + (size_t)m * DM, lane);
  const int gt = blockIdx.x * 512 + tid, NGT = F.G * 512;
  for (int i = gt; i < 512; i += NGT) ((unsigned*)(ws + WS_XN + (size_t)NTOK * DM * 2))[i] = 0u;
  for (int i = gt; i < 128; i += NGT) ((int*)(ws + WS_CTL))[i] = 0;
  for (int i = gt; i < SEQ * 32; i += NGT) {
    const int t = i >> 5, k = i & 31;
    const float inv = (float)exp2(-(double)k * (13.287712379549449 / 32.0));
    const float ang = (float)t * inv;
    const double rev = (double)ang * 0.15915494309189535; const float fr = (float)(rev - rint(rev));
    ((float*)(ws + WS_ROPE))[i] = __builtin_amdgcn_cosf(fr); ((float*)(ws + WS_ROPE))[SEQ * 32 + i] = __builtin_amdgcn_sinf(fr);
  }
  for (int i = gt; i < 2 * 36 * 1024; i += NGT) {
    const int L = i / (36 * 1024), r = i % (36 * 1024), j = r >> 10, k = r & 1023;
    const float g = P.in[L ? I_FNORM1 : I_FNORM0][k];
    float w; if (j < 4) w = P.in[L ? I_WRG1 : I_WRG0][k * 4 + j]; else { const int gg = (j - 4) >> 3, e = (j - 4) & 7; w = P.in[L ? I_WRE1 : I_WRE0][((size_t)gg * 1024 + k) * 8 + e]; }
    w *= g;
    const unsigned hi = pk2(w, 0.f) & 0xffffu; const float lo = w - __uint_as_float(hi << 16);
    bf16_t* base = (bf16_t*)(ws + (L ? WS_WR1 : WS_WR0));
    base[r] = (bf16_t)hi; base[36 * 1024 + r] = (bf16_t)(pk2(lo, 0.f) & 0xffffu);
  }
  for (int i = gt; i < 2 * 36; i += NGT) { const int L = i / 36, j = i % 36; ((float*)(ws + (L ? WS_WR1 : WS_WR0) + 147456))[j] = (j < 4) ? P.in[L ? I_BRG1 : I_BRG0][j] : P.in[L ? I_BRE1 : I_BRE0][j - 4]; }
}

DI u32x4 normrope8(const u32x4 w, const float (&gv)[8], bool do_norm, const f32x4 (&cs)[2], const f32x4 (&sn)[2], int sub, float oscale) {
  float v[8] = {bflo(w.x), bfhi(w.x), bflo(w.y), bfhi(w.y), bflo(w.z), bfhi(w.z), bflo(w.w), bfhi(w.w)};
  if (do_norm) {
    float s = 0.f;
#pragma unroll
    for (int j = 0; j < 8; ++j) s += v[j] * v[j];
    s += __shfl_xor(s, 1); s += __shfl_xor(s, 2); s += __shfl_xor(s, 4);
    const float rstd = 1.0f / sqrtf(s * (1.f / 64.f) + NORM_EPS);
#pragma unroll
    for (int j = 0; j < 8; ++j) v[j] = v[j] * rstd * gv[j];
  }
  const float sg = (sub & 4) ? 1.f : -1.f;
  const float cv[8] = {cs[0].x, cs[0].y, cs[0].z, cs[0].w, cs[1].x, cs[1].y, cs[1].z, cs[1].w};
  const float sv[8] = {sn[0].x, sn[0].y, sn[0].z, sn[0].w, sn[1].x, sn[1].y, sn[1].z, sn[1].w};
  float o[8];
#pragma unroll
  for (int j = 0; j < 8; ++j) { const float pr = __shfl_xor(v[j], 4); o[j] = (v[j] * cv[j] + sg * pr * sv[j]) * oscale; }
  u32x4 r; r.x = pk2(o[0], o[1]); r.y = pk2(o[2], o[3]); r.z = pk2(o[4], o[5]); r.w = pk2(o[6], o[7]);
  return r;
}
struct Tok0 { u32x4 cb, cc[3], ch[3]; bf16_t v; };
DI void p1b_transform0(const Ctx& F, const Params& P) {
  bf16_t* PROJ = (bf16_t*)(P.ws + WS_PROJ); bf16_t* MIX = (bf16_t*)(P.ws + WS_MIX);
  const int lane = lane_id_v();
  float cw[8][3];
#pragma unroll
  for (int j = 0; j < 8; ++j) { const float* w = P.in[I_CONVW] + (8 * lane + j) * 3; cw[j][0] = w[0]; cw[j][1] = w[1]; cw[j][2] = w[2]; }
  auto load = [&](Tok0& T, int m) {
    const int t = m & (SEQ - 1); const bf16_t* row = PROJ + (size_t)m * W0P;
    T.cb = *(const u32x4*)(row + C_CB + 8 * lane); T.v = row[C_V + lane];
#pragma unroll
    for (int d = 0; d < 3; ++d) { const int back = 2 - d; const bf16_t* r2 = row - (size_t)(t >= back ? back : 0) * W0P; T.cc[d] = *(const u32x4*)(r2 + C_CC + 8 * lane); T.ch[d] = *(const u32x4*)(r2 + C_CH + 8 * lane); }
  };
  auto process = [&](const Tok0& T, int m) {
    const int t = m & (SEQ - 1);
    { const int kk = t & 31, st = kk >> 4, rem = kk & 15, hf = (rem >> 2) & 1, j = 4 * (rem >> 3) + (rem & 3);
      const size_t vo = (((((size_t)(m >> 12) * 128 + (t >> 5)) * 2 + st) * 2 + (lane >> 5)) * 64 + hf * 32 + (lane & 31)) * 8 + j;
      ((bf16_t*)(P.ws + WS_VTF))[vo] = T.v; }
    { float u[3][8];
#pragma unroll
      for (int d = 0; d < 3; ++d) { const bool okd = t >= 2 - d; const u32x4 a = T.cc[d], b = T.ch[d];
        u[d][0] = okd ? bflo(a.x) * bflo(b.x) : 0.f; u[d][1] = okd ? bfhi(a.x) * bfhi(b.x) : 0.f; u[d][2] = okd ? bflo(a.y) * bflo(b.y) : 0.f; u[d][3] = okd ? bfhi(a.y) * bfhi(b.y) : 0.f;
        u[d][4] = okd ? bflo(a.z) * bflo(b.z) : 0.f; u[d][5] = okd ? bfhi(a.z) * bfhi(b.z) : 0.f; u[d][6] = okd ? bflo(a.w) * bflo(b.w) : 0.f; u[d][7] = okd ? bfhi(a.w) * bfhi(b.w) : 0.f; }
      const u32x4 cb = T.cb;
      const float cbv[8] = {bflo(cb.x), bfhi(cb.x), bflo(cb.y), bfhi(cb.y), bflo(cb.z), bfhi(cb.z), bflo(cb.w), bfhi(cb.w)};
      float o[8];
#pragma unroll
      for (int j = 0; j < 8; ++j) o[j] = cbv[j] * (u[0][j] * cw[j][0] + u[1][j] * cw[j][1] + u[2][j] * cw[j][2]);
      u32x4 r; r.x = pk2(o[0], o[1]); r.y = pk2(o[2], o[3]); r.z = pk2(o[4], o[5]); r.w = pk2(o[6], o[7]);
      *(u32x4*)(MIX + (size_t)m * DM + 8 * lane) = r; }
  };
  Tok0 A, B;
  int m = F.gw;
  if (m < NTOK) load(A, m);
  while (m < NTOK) {
    const int m1 = m + F.NGW;
    if (m1 < NTOK) load(B, m1);
    process(A, m);
    if (m1 >= NTOK) break;
    const int m2 = m1 + F.NGW;
    if (m2 < NTOK) load(A, m2);
    process(B, m1);
    m = m2;
  }
}

DI unsigned f2key(float f) { const unsigned b = __float_as_uint(f); return b ^ ((unsigned)((int)b >> 31) | 0x80000000u); }
DI s16x4 tr_read(LAS unsigned char* p) { typedef short v4i16_t __attribute__((ext_vector_type(4))); return __builtin_bit_cast(s16x4, __builtin_amdgcn_ds_read_tr16_b64_v4i16((LAS v4i16_t*)p)); }
#define DPP_U(v, ctrl) ((unsigned)__builtin_amdgcn_update_dpp(0, (int)(v), (ctrl), 0xF, 0xF, true))
DI unsigned wave_total_u(unsigned v) {
  v += DPP_U(v, 0xB1); v += DPP_U(v, 0x4E); v += DPP_U(v, 0x124); v += DPP_U(v, 0x128);
  return (unsigned)__builtin_amdgcn_readlane((int)v, 0) + (unsigned)__builtin_amdgcn_readlane((int)v, 16) + (unsigned)__builtin_amdgcn_readlane((int)v, 32) + (unsigned)__builtin_amdgcn_readlane((int)v, 48);
}
DI unsigned wave_maxall_u(unsigned v) {
  v = max(v, DPP_U(v, 0xB1)); v = max(v, DPP_U(v, 0x4E)); v = max(v, DPP_U(v, 0x124)); v = max(v, DPP_U(v, 0x128));
  const unsigned a = (unsigned)__builtin_amdgcn_readlane((int)v, 0), b = (unsigned)__builtin_amdgcn_readlane((int)v, 16), c = (unsigned)__builtin_amdgcn_readlane((int)v, 32), d = (unsigned)__builtin_amdgcn_readlane((int)v, 48);
  return max(max(a, b), max(c, d));
}
DI unsigned lane_prefix(unsigned long long m) { return __builtin_amdgcn_mbcnt_hi((unsigned)(m >> 32), __builtin_amdgcn_mbcnt_lo((unsigned)m, 0u)); }

DI void dsa_phase(const Ctx& F, const Params& P) {
  const bf16_t* PROJ = (const bf16_t*)(P.ws + WS_PROJ); bf16_t* MIX = (bf16_t*)(P.ws + WS_MIX);
  const bf16_t* IKF = (const bf16_t*)(P.ws + WS_IKF); const bf16_t* KF = (const bf16_t*)(P.ws + WS_KF); const bf16_t* VTF = (const bf16_t*)(P.ws + WS_VTF);
  LAS unsigned* sc = (LAS unsigned*)F.lds;
  LAS unsigned* msk32 = (LAS unsigned*)(F.lds + LDS_LIST);
  LAS float* part = (LAS float*)F.lds;
  const int w = F.wave;
  float cshift; { const int l0 = lane_id_v(); cshift = 8.f * wave_max(fabsf(P.in[I_QN0][l0])) * wave_max(fabsf(P.in[I_KN0][l0])) * 1.02f; }
  const float c1 = 0.125f * LOG2E, c2 = __builtin_amdgcn_readfirstlane(__float_as_int(cshift * LOG2E)) == 0 ? 0.f : __int_as_float(__builtin_amdgcn_readfirstlane(__float_as_int(cshift * LOG2E)));
#ifdef TIMEDSA
  unsigned long long tacc = 0ull, tmark = 0ull;
#define DSA_T0(n) if (TIMEDSA == (n)) tmark = __builtin_amdgcn_s_memrealtime();
#define DSA_T1(n) if (TIMEDSA == (n)) tacc += __builtin_amdgcn_s_memrealtime() - tmark;
#else
#define DSA_T0(n)
#define DSA_T1(n)
#endif
  for (int v = blockIdx.x; v < 8192; v += gridDim.x) {
    const int cidx = v & 255, jj = v >> 8, b = jj >> 1, tb = (jj & 1) ? (511 - cidx) : cidx;
    const int t0 = tb * 8; const size_t rb = (size_t)b * SEQ;
    const int ntile = (t0 + 8 + 31) >> 5;
    const int lane = lane_id_v();
    const int c = lane & 31, half = lane >> 5, qc = c >> 2, hx = c & 3;
    DSA_T0(1)
    {
      bf16x8 af[4];
      { const bf16_t* ap = PROJ + (rb + t0 + qc) * W0P + C_IQ + hx * 64 + 8 * half;
#pragma unroll
        for (int ks = 0; ks < 4; ++ks) af[ks] = *(const bf16x8*)(ap + 16 * ks); }
      float wq[4][4];
#pragma unroll
      for (int g = 0; g < 4; ++g) { const u32x2 ww = *(const u32x2*)(PROJ + (rb + t0 + 2 * g + half) * W0P + C_IW);
        wq[g][0] = bflo(ww.x) * 0.0625f; wq[g][1] = bfhi(ww.x) * 0.0625f; wq[g][2] = bflo(ww.y) * 0.0625f; wq[g][3] = bfhi(ww.y) * 0.0625f; }
      const bf16_t* fb = IKF + ((size_t)b * 128 * 4 * 64 + lane) * 8;
      const int Tlast = ntile - 1;
      auto ld1 = [&](bf16x8 (&d)[4], int T) { const int Tc = T < Tlast ? T : Tlast;
#pragma unroll
        for (int ks = 0; ks < 4; ++ks) d[ks] = *(const bf16x8*)(fb + (size_t)(Tc * 4 + ks) * 512); };
      auto cp1 = [&](const bf16x8 (&bfr)[4], int T) {
        f32x16 acc;
#pragma unroll
        for (int i = 0; i < 16; ++i) acc[i] = 0.f;
#pragma unroll
        for (int ks = 0; ks < 4; ++ks) acc = __builtin_amdgcn_mfma_f32_32x32x16_bf16(af[ks], bfr[ks], acc, 0, 0, 0);
        const int s = 32 * T + c;
        const bool edge = 32 * T + 31 > t0;
#pragma unroll
        for (int g = 0; g < 4; ++g) {
          float sv = __builtin_fmaf(wq[g][3], fmaxf(acc[4 * g + 3], 0.f), __builtin_fmaf(wq[g][2], fmaxf(acc[4 * g + 2], 0.f), __builtin_fmaf(wq[g][1], fmaxf(acc[4 * g + 1], 0.f), __builtin_fmaf(wq[g][0], fmaxf(acc[4 * g], 0.f), 0.f))));
          const int ql = 2 * g + half;
          unsigned key = f2key(sv);
          if (edge) key = (s <= t0 + ql) ? key : 0u;
          sc[ql * 4096 + s] = key;
        } };
      bf16x8 r0[4], r1[4], r2[4], r3[4];
      if (w < ntile) { ld1(r0, w); ld1(r1, w + 8); ld1(r2, w + 16); ld1(r3, w + 24); }
      for (int T = w; T < ntile; T += 32) {
        cp1(r0, T); ld1(r0, T + 32); __builtin_amdgcn_sched_barrier(0);
        if (T + 8 < ntile) { cp1(r1, T + 8); ld1(r1, T + 40); __builtin_amdgcn_sched_barrier(0); }
        if (T + 16 < ntile) { cp1(r2, T + 16); ld1(r2, T + 48); __builtin_amdgcn_sched_barrier(0); }
        if (T + 24 < ntile) { cp1(r3, T + 24); ld1(r3, T + 56); __builtin_amdgcn_sched_barrier(0); }
      }
    }
    __syncthreads();
    asm volatile("" ::: "memory"); __builtin_amdgcn_sched_barrier(0);
    DSA_T1(1)
    DSA_T0(2)
    {
      const int lane = lane_id_v();
      const int t = t0 + w;
      const int nch = (t >> 10) + 1;
      unsigned u[64];
#pragma unroll
      for (int ch = 0; ch < 4; ++ch) {
        if (ch < nch) {
#pragma unroll
          for (int k2 = 0; k2 < 16; ++k2) { const int j = 16 * ch + k2; const unsigned x = sc[w * 4096 + 64 * j + lane]; u[j] = (lane <= t - 64 * j) ? x : 0u; }
        } else {
#pragma unroll
          for (int k2 = 0; k2 < 16; ++k2) u[16 * ch + k2] = 0u;
        }
      }
      unsigned thr = 0u; int sthr = -1;
      if (t >= 256) {
        unsigned prefix = 0u; bool exact = false; int startbit = 31;
        {
          unsigned mx = 0u;
#pragma unroll
          for (int ch = 0; ch < 4; ++ch) if (ch < nch) {
#pragma unroll
            for (int k2 = 0; k2 < 16; ++k2) mx = max(mx, u[16 * ch + k2]);
          }
          const unsigned trial = wave_maxall_u(mx) & 0xFF800000u;
          unsigned cnt = 0u;
#pragma unroll
          for (int ch = 0; ch < 4; ++ch) if (ch < nch) {
#pragma unroll
            for (int k2 = 0; k2 < 16; ++k2) cnt += (u[16 * ch + k2] >= trial) ? 1u : 0u;
          }
          cnt = wave_total_u(cnt);
          if (cnt >= 256u) { prefix = trial; startbit = 22; exact = (cnt == 256u); }
        }
        if (!exact) {
          for (int bit = startbit; bit >= 0; --bit) {
            const unsigned trial = prefix | (1u << bit);
            unsigned cnt = 0u;
#pragma unroll
            for (int ch = 0; ch < 4; ++ch) if (ch < nch) {
#pragma unroll
              for (int k2 = 0; k2 < 16; ++k2) cnt += (u[16 * ch + k2] >= trial) ? 1u : 0u;
            }
            cnt = wave_total_u(cnt);
            if (cnt >= 256u) prefix = trial;
            if (cnt == 256u) { exact = true; break; }
          }
        }
        if (exact) thr = prefix - 1u;
        else {
          thr = prefix; unsigned cgt = 0u;
#pragma unroll
          for (int j = 0; j < 64; ++j) cgt += (u[j] > thr) ? 1u : 0u;
          cgt = wave_total_u(cgt);
          const int need = 256 - (int)cgt;
          int tbf = 0;
#pragma unroll
          for (int ch = 0; ch < 4; ++ch) if (ch < nch) {
#pragma unroll
            for (int k2 = 0; k2 < 16; ++k2) { const int j = 16 * ch + k2; const bool eq = u[j] == thr; const unsigned long long m = __ballot(eq);
              const unsigned long long hit = __ballot(eq && (tbf + (int)lane_prefix(m) == need - 1));
              if (hit) sthr = 64 * j + __builtin_ctzll(hit);
              tbf += __builtin_popcountll(m); }
          }
        }
      }
#pragma unroll
      for (int ch = 0; ch < 4; ++ch) {
        if (ch < nch) {
#pragma unroll
          for (int k2 = 0; k2 < 16; ++k2) { const int j = 16 * ch + k2; const bool sel = (u[j] > thr) || (u[j] == thr && lane <= sthr - 64 * j); const unsigned long long m = __ballot(sel);
            if (lane == 0) *(LAS u32x2*)(msk32 + w * 128 + 2 * j) = (u32x2){(unsigned)m, (unsigned)(m >> 32)}; }
        } else if (lane < 16) *(LAS u32x2*)(msk32 + w * 128 + 2 * (16 * ch + lane)) = (u32x2){0u, 0u};
      }
    }
    __syncthreads();
    asm volatile("" ::: "memory"); __builtin_amdgcn_sched_barrier(0);
    DSA_T1(2)
    DSA_T0(3)
    {
      const int lane = lane_id_v(); const int c = lane & 31, half = lane >> 5, qc = c >> 2, hx = c & 3;
      const int cbw = w & 1, kq = w >> 1;
      const int tq = t0 + qc;
      bf16x8 qf[4];
      { const bf16_t* qp = PROJ + (rb + tq) * W0P + C_Q + (4 * cbw + hx) * 64 + 8 * half; const float qs = 0.125f * LOG2E;
#pragma unroll
        for (int ks = 0; ks < 4; ++ks) { const u32x4 qv = *(const u32x4*)(qp + 16 * ks);
          u32x4 qo; qo.x = pk2(bflo(qv.x) * qs, bfhi(qv.x) * qs); qo.y = pk2(bflo(qv.y) * qs, bfhi(qv.y) * qs); qo.z = pk2(bflo(qv.z) * qs, bfhi(qv.z) * qs); qo.w = pk2(bflo(qv.w) * qs, bfhi(qv.w) * qs);
          qf[ks] = __builtin_bit_cast(bf16x8, qo); } }
      f32x16 o0, o1;
#pragma unroll
      for (int i = 0; i < 16; ++i) { o0[i] = 0.f; o1[i] = 0.f; }
      float lsum = 0.f;
      const bf16_t* kb = KF + ((size_t)b * 128 * 4 * 64 + lane) * 8;
      const bf16_t* vb = VTF + ((size_t)b * 128 * 4 * 64 + lane) * 8;
      const int Tlast = ntile - 1;
      auto ld2 = [&](bf16x8 (&kf)[4], bf16x8 (&vf)[4], int T) { const int Tc = T < Tlast ? T : Tlast;
#pragma unroll
        for (int ks = 0; ks < 4; ++ks) { kf[ks] = *(const bf16x8*)(kb + (size_t)(Tc * 4 + ks) * 512); vf[ks] = *(const bf16x8*)(vb + (size_t)(Tc * 4 + ks) * 512); } };
      auto cp2 = [&](const bf16x8 (&kf)[4], const bf16x8 (&vf)[4], int T) {
        const unsigned mw = msk32[qc * 128 + T] >> (4 * half);
        f32x16 s;
#pragma unroll
        for (int i = 0; i < 16; ++i) s[i] = -c2;
#pragma unroll
        for (int ks = 0; ks < 4; ++ks) s = __builtin_amdgcn_mfma_f32_32x32x16_bf16(kf[ks], qf[ks], s, 0, 0, 0);
#pragma unroll
        for (int r = 0; r < 16; ++r) {
          int mb; asm("v_bfe_i32 %0, %1, %2, 1" : "=v"(mb) : "v"(mw), "n"((r & 3) + 8 * (r >> 2)));
          const float p = __int_as_float(__float_as_int(__builtin_amdgcn_exp2f(s[r])) & mb); s[r] = p; lsum += p; }
#pragma unroll
        for (int st = 0; st < 2; ++st) {
          u32x4 pw; pw.x = pk2(s[8 * st], s[8 * st + 1]); pw.y = pk2(s[8 * st + 2], s[8 * st + 3]); pw.z = pk2(s[8 * st + 4], s[8 * st + 5]); pw.w = pk2(s[8 * st + 6], s[8 * st + 7]);
          const bf16x8 pf = __builtin_bit_cast(bf16x8, pw);
          o0 = __builtin_amdgcn_mfma_f32_32x32x16_bf16(vf[2 * st], pf, o0, 0, 0, 0);
          o1 = __builtin_amdgcn_mfma_f32_32x32x16_bf16(vf[2 * st + 1], pf, o1, 0, 0, 0);
        } };
      bf16x8 ka[4], va[4], kb2[4], vb2[4];
      if (kq < ntile) { ld2(ka, va, kq); ld2(kb2, vb2, kq + 4); }
      for (int T = kq; T < ntile; T += 8) {
        cp2(ka, va, T); ld2(ka, va, T + 8); __builtin_amdgcn_sched_barrier(0);
        if (T + 4 < ntile) { cp2(kb2, vb2, T + 4); ld2(kb2, vb2, T + 12); __builtin_amdgcn_sched_barrier(0); }
      }
      lsum += __shfl_xor(lsum, 32);
      LAS float* pw_ = part + w * (33 * 64) + lane;
#pragma unroll
      for (int i = 0; i < 16; ++i) { pw_[i * 64] = o0[i]; pw_[(16 + i) * 64] = o1[i]; }
      pw_[32 * 64] = lsum;
      __syncthreads();
      float acc8[8]; float lt = 0.f;
#pragma unroll
      for (int i = 0; i < 8; ++i) acc8[i] = 0.f;
#pragma unroll
      for (int k4 = 0; k4 < 4; ++k4) { const LAS float* pr = part + (2 * k4 + cbw) * (33 * 64) + lane;
#pragma unroll
        for (int i = 0; i < 8; ++i) acc8[i] += pr[(8 * kq + i) * 64];
        lt += pr[32 * 64]; }
      const float inv = 1.0f / lt;
      bf16_t* op = MIX + (rb + tq) * DM + 512 + (4 * cbw + hx) * 64 + 32 * (kq >> 1) + 16 * (kq & 1) + 4 * half;
      u32x2 w0; w0.x = pk2(acc8[0] * inv, acc8[1] * inv); w0.y = pk2(acc8[2] * inv, acc8[3] * inv); *(u32x2*)op = w0;
      u32x2 w1; w1.x = pk2(acc8[4] * inv, acc8[5] * inv); w1.y = pk2(acc8[6] * inv, acc8[7] * inv); *(u32x2*)(op + 8) = w1;
    }
    __syncthreads();
    DSA_T1(3)
  }
#ifdef TIMEDSA
  if (blockIdx.x == 0 && w == 0 && lane_id_v() == 0) { unsigned long long* tsw = (unsigned long long*)(P.ws + WS_CTL + 4096); tsw[0] = 0ull; tsw[1] = tacc; }
#endif
}

DI void route_lane(const float (&lg)[36], int& x0, int& x1, float& g0, float& g1) {
  int gs = 0; float gm = lg[0];
#pragma unroll
  for (int j = 1; j < 4; ++j) { const bool gt = lg[j] > gm; gm = gt ? lg[j] : gm; gs = gt ? j : gs; }
  float z = 0.f;
#pragma unroll
  for (int j = 0; j < 4; ++j) z += __expf(lg[j] - gm);
  const float pg = 1.0f / z;
  float le[8];
#pragma unroll
  for (int i = 0; i < 8; ++i) le[i] = gs == 0 ? lg[4 + i] : (gs == 1 ? lg[12 + i] : (gs == 2 ? lg[20 + i] : lg[28 + i]));
  int i0e = 0; float m0 = le[0];
#pragma unroll
  for (int i = 1; i < 8; ++i) { const bool gt = le[i] > m0; m0 = gt ? le[i] : m0; i0e = gt ? i : i0e; }
  int i1e = -1; float m1 = -INFINITY;
#pragma unroll
  for (int i = 0; i < 8; ++i) { const bool gt = (i != i0e) && (le[i] > m1); m1 = gt ? le[i] : m1; i1e = gt ? i : i1e; }
  const float e1 = __expf(m1 - m0);
  g0 = pg / (1.0f + e1); g1 = pg * e1 / (1.0f + e1);
  x0 = gs * 8 + i0e; x1 = gs * 8 + i1e;
}
DI void router_phase(const Ctx& F, const Params& P, int L) {
  unsigned char* ws = P.ws;
  constexpr int WSTR = 2064;
  constexpr int L_WH = 0, L_WL = 36 * WSTR, L_ZERO = 2 * 36 * WSTR, L_CNT = L_ZERO + WSTR, L_ASG = L_CNT + 256, L_RS = L_ASG + 4096;
  static_assert(L_ASG + 4096 <= LDS_BYTES - 16, "router LDS map");
  LAS unsigned char* lds = F.lds;
  LAS int* lcnt = (LAS int*)(lds + L_CNT); LAS int* lbase = lcnt + 32;
  LAS i32x4* lasg = (LAS i32x4*)(lds + L_ASG);
  const bf16_t* wsrc = (const bf16_t*)(ws + (L ? WS_WR1 : WS_WR0));
  const float* bias = (const float*)(ws + (L ? WS_WR1 : WS_WR0) + 147456);
  const int lane = lane_id_v(); const int w = F.wave; const int tid = w * 64 + lane;
  int* cnt = (int*)(ws + WS_CTL) + L * 64; int* list = (int*)(ws + WS_LIST); float* RSL = (float*)(ws + WS_RSL);
  int4* asg = (int4*)(ws + WS_ASG); float2* asgg = (float2*)(ws + WS_ASGG);
  const bf16_t* XB = (const bf16_t*)(ws + WS_XB);
  const int niter = (NTOK + F.NGW - 1) / F.NGW;
  for (int i0 = 0; i0 < niter; i0 += 32) {
    for (int i = tid; i < 2 * 36 * 128; i += 512) { const int row = i >> 7, ch = i & 127; *(LAS u32x4*)(lds + row * WSTR + ch * 16) = *(const u32x4*)(wsrc + row * 1024 + ch * 8); }
    for (int i = tid; i < 128; i += 512) *(LAS u32x4*)(lds + L_ZERO + i * 16) = (u32x4){0u, 0u, 0u, 0u};
    if (tid < 32) lcnt[tid] = 0;
    __syncthreads();
    const int c = lane & 31, half = lane >> 5;
    const int it_r = i0 + c; const int m_r = F.gw + it_r * F.NGW; const bool ok_r = (it_r < niter) && (m_r < NTOK);
    const bf16_t* arow = XB + (size_t)(ok_r ? m_r : F.gw) * DM + 8 * half;
    const int b0off = c * WSTR + 16 * half;
    const int b1off = (c < 4 ? (32 + c) * WSTR : (L_ZERO - L_WH)) + 16 * half;
    f32x16 d0, d1, dx;
#pragma unroll
    for (int i = 0; i < 16; ++i) { d0[i] = 0.f; d1[i] = 0.f; dx[i] = 0.f; }
    bf16x8 ar[8];
#pragma unroll
    for (int j = 0; j < 8; ++j) ar[j] = *(const bf16x8*)(arow + 16 * j);
    for (int k8 = 0; k8 < 64; k8 += 8) {
#pragma unroll
      for (int j = 0; j < 8; ++j) {
        const int ks = k8 + j;
        const bf16x8 a_cur = ar[j];
        const bf16x8 h0 = *(const LAS bf16x8*)(lds + L_WH + b0off + 32 * ks), l0 = *(const LAS bf16x8*)(lds + L_WL + b0off + 32 * ks);
        const bf16x8 h1 = *(const LAS bf16x8*)(lds + L_WH + b1off + 32 * ks), l1 = *(const LAS bf16x8*)(lds + (c < 4 ? L_WL : L_WH) + b1off + 32 * ks);
        d0 = __builtin_amdgcn_mfma_f32_32x32x16_bf16(a_cur, h0, d0, 0, 0, 0); d0 = __builtin_amdgcn_mfma_f32_32x32x16_bf16(a_cur, l0, d0, 0, 0, 0);
        d1 = __builtin_amdgcn_mfma_f32_32x32x16_bf16(a_cur, h1, d1, 0, 0, 0); d1 = __builtin_amdgcn_mfma_f32_32x32x16_bf16(a_cur, l1, d1, 0, 0, 0);
        dx = __builtin_amdgcn_mfma_f32_32x32x16_bf16(a_cur, a_cur, dx, 0, 0, 0);
        if (k8 + 8 < 64) ar[j] = *(const bf16x8*)(arow + 16 * (ks + 8));
      }
    }
    __syncthreads();
    LAS float* tw = (LAS float*)(lds + w * 8192);
#pragma unroll
    for (int i = 0; i < 16; ++i) { const int row = (i & 3) + 8 * (i >> 2) + 4 * half; tw[row * 40 + c] = d0[i]; if (c < 4) tw[row * 40 + 32 + c] = d1[i]; if (row == c) tw[row * 40 + 36] = dx[i]; }
    asm volatile("s_waitcnt lgkmcnt(0)" ::: "memory");
    if (lane < 32) {
      const int it_t = i0 + lane; const int m = F.gw + it_t * F.NGW;
      if (it_t < niter && m < NTOK) {
        const LAS f32x4* tr4 = (const LAS f32x4*)(tw + lane * 40);
        float raw[40];
#pragma unroll
        for (int q = 0; q < 10; ++q) { const f32x4 v4 = tr4[q]; raw[4 * q] = v4.x; raw[4 * q + 1] = v4.y; raw[4 * q + 2] = v4.z; raw[4 * q + 3] = v4.w; }
        const float rstd = 1.0f / sqrtf(raw[36] * (1.f / DM) + NORM_EPS);
        float lg[36];
#pragma unroll
        for (int j = 0; j < 36; ++j) lg[j] = raw[j] * rstd + bias[j];
        int x0, x1; float g0, g1; route_lane(lg, x0, x1, g0, g1);
        const int r0 = __hip_atomic_fetch_add(lcnt + x0, 1, __ATOMIC_RELAXED, __HIP_MEMORY_SCOPE_WORKGROUP);
        const int r1 = __hip_atomic_fetch_add(lcnt + x1, 1, __ATOMIC_RELAXED, __HIP_MEMORY_SCOPE_WORKGROUP);
        lasg[lane * 8 + w] = (i32x4){x0, x1, r0, r1}; asgg[m] = make_float2(g0, g1);
        tw[lane * 40 + 37] = rstd;
      }
    }
    __syncthreads();
    if (tid < 32) lbase[tid] = atomicAdd(cnt + tid, lcnt[tid]);
    __syncthreads();
    if (tid < 256) {
      const int ii = tid >> 3, wv = tid & 7; const int m = (int)blockIdx.x * 8 + wv + (i0 + ii) * F.NGW;
      if (i0 + ii < niter && m < NTOK) {
        const i32x4 a = lasg[tid]; const int r0 = lbase[a.x] + a.z, r1 = lbase[a.y] + a.w;
        const float rs = ((const LAS float*)(lds + wv * 8192))[ii * 40 + 37];
        list[a.x * 65536 + r0] = m; list[a.y * 65536 + r1] = m; asg[m] = make_int4(a.x, a.y, r0, r1);
        RSL[a.x * 65536 + r0] = rs; RSL[a.y * 65536 + r1] = rs;
      }
    }
    __syncthreads();
  }
}
DI void moe_setup(const Ctx& F, const Params& P, int L) {
  LAS int* pb = (LAS int*)(F.lds + LDS_MISC); LAS int* cl = pb + 64;
  const int* cnt = (const int*)(P.ws + WS_CTL) + L * 64;
  const int tid = F.wave * 64 + lane_id_v();
  __syncthreads();
  if (tid < 32) cl[tid] = cnt[tid];
  __syncthreads();
  if (tid == 0) { int a = 0; for (int e = 0; e < NEXP; ++e) { pb[e] = a; a += (cl[e] + 255) >> 8; } pb[NEXP] = a; }
  __syncthreads();
}
DI void combine_phase(const Ctx& F, const Params& P, int L, bool with_norm) {
  unsigned char* ws = P.ws;
  moe_setup(F, P, L);
  const LAS int* pb = (const LAS int*)(F.lds + LDS_MISC);
  const int4* asg = (const int4*)(ws + WS_ASG); const float2* asgg = (const float2*)(ws + WS_ASGG);
  const bf16_t* Y = (const bf16_t*)(ws + WS_PROJ); bf16_t* XN = (bf16_t*)(ws + WS_XN);
  const int lane = lane_id_v();
  for (int m = F.gw; m < NTOK; m += F.NGW) {
    const int4 a = asg[m]; const float2 gg = asgg[m];
    const size_t row0 = (size_t)pb[a.x] * 256 + a.z, row1 = (size_t)pb[a.y] * 256 + a.w;
    u32x2* xr = (u32x2*)((bf16_t*)(ws + WS_XB) + (size_t)m * DM) + lane;
    f32x4* orow = (f32x4*)(P.out + (size_t)m * DM) + lane;
    const u32x2* y0 = (const u32x2*)(Y + row0 * DM) + lane; const u32x2* y1 = (const u32x2*)(Y + row1 * DM) + lane;
    f32x4 v[4]; float ss = 0.f;
#pragma unroll
    for (int j = 0; j < 4; ++j) { const u32x2 xb = xr[64 * j]; f32x4 x = (f32x4){bflo(xb.x), bfhi(xb.x), bflo(xb.y), bfhi(xb.y)}; const u32x2 a0 = y0[64 * j], a1 = y1[64 * j];
      x.x += gg.x * bflo(a0.x) + gg.y * bflo(a1.x); x.y += gg.x * bfhi(a0.x) + gg.y * bfhi(a1.x); x.z += gg.x * bflo(a0.y) + gg.y * bflo(a1.y); x.w += gg.x * bfhi(a0.y) + gg.y * bfhi(a1.y);
      if (with_norm) { u32x2 o; o.x = pk2(x.x, x.y); o.y = pk2(x.z, x.w); xr[64 * j] = o; } else orow[64 * j] = x;
      v[j] = x; ss += (x.x * x.x + x.y * x.y) + (x.z * x.z + x.w * x.w); }
    if (with_norm) {
      const float rstd = 1.0f / sqrtf(wave_sum(ss) * (1.f / DM) + NORM_EPS);
      unsigned long long* o8 = (unsigned long long*)(XN + (size_t)m * DM) + lane;
#pragma unroll
      for (int j = 0; j < 4; ++j) o8[64 * j] = (unsigned long long)pk2(v[j].x * rstd, v[j].y * rstd) | ((unsigned long long)pk2(v[j].z * rstd, v[j].w * rstd) << 32);
    }
  }
}
template <class Bar> DI void moe_gemms(const Ctx& F, const Params& P, int L, const Bar& gbar) {
  unsigned char* ws = P.ws;
  const int vcu = (F.G % 8 == 0) ? ((int)(blockIdx.x % 8) * (F.G / 8) + (int)(blockIdx.x / 8)) : (int)blockIdx.x;
  moe_setup(F, P, L);
  {
    pg8::MoeSched<true> S{(const LAS int*)(F.lds + LDS_MISC), (const LAS int*)(F.lds + LDS_MISC) + 64, (const int*)(ws + WS_LIST), (const char*)(ws + (L ? WS_WGU1 : WS_WGU0)), F.G, vcu, 1024};
    pg8::EpiSwiGLU E{(bf16_t*)(ws + WS_H), (const float*)(ws + WS_RSL), (const LAS int*)(F.lds + LDS_MISC) + 64};
    pg8::gemm_phase<pg8::EpiSwiGLU, pg8::MoeSched<true>, true>(F.lds, F.wave, (const char*)(ws + WS_XB), 1024, S, E);
  }
  xcd_barrier(gbar);
  {
    pg8::MoeSched<false> S{(const LAS int*)(F.lds + LDS_MISC), (const LAS int*)(F.lds + LDS_MISC) + 64, nullptr, (const char*)(ws + (L ? WS_WD1 : WS_WD0)), F.G, vcu, 512};
    pg8::EpiBf16 E{(bf16_t*)(ws + WS_PROJ), DM};
    pg8::gemm_phase<pg8::EpiBf16, pg8::MoeSched<false>, true>(F.lds, F.wave, (const char*)(ws + WS_H), 512, S, E);
  }
}

struct Tok1 { u32x4 q0, q1, k; f32x4 cs[2], sn[2]; };
DI void p8b_transform1(const Ctx& F, const Params& P) {
  bf16_t* QKV = (bf16_t*)(P.ws + WS_PROJ);
  const float* cosT = (const float*)(P.ws + WS_ROPE); const float* sinT = cosT + SEQ * 32;
  const int lane = lane_id_v(), sub = lane & 7, grp = lane >> 3;
  float gq[8], gk[8];
#pragma unroll
  for (int j = 0; j < 8; ++j) { gq[j] = P.in[I_QN1][8 * sub + j]; gk[j] = P.in[I_KN1][8 * sub + j]; }
  const int kcol = 1024 + (grp & 3) * 64 + sub * 8;
  auto load = [&](Tok1& T, int m) {
    const int t = m & (SEQ - 1); const bf16_t* row = QKV + (size_t)m * W1;
    T.q0 = *(const u32x4*)(row + grp * 64 + sub * 8); T.q1 = *(const u32x4*)(row + 512 + grp * 64 + sub * 8); T.k = *(const u32x4*)(row + kcol);
    const f32x4* cp = (const f32x4*)(cosT + t * 32 + 8 * (sub & 3)); const f32x4* sp = (const f32x4*)(sinT + t * 32 + 8 * (sub & 3));
    T.cs[0] = cp[0]; T.cs[1] = cp[1]; T.sn[0] = sp[0]; T.sn[1] = sp[1];
  };
  auto process = [&](const Tok1& T, int m) {
    bf16_t* row = QKV + (size_t)m * W1;
    *(u32x4*)(row + grp * 64 + sub * 8) = normrope8(T.q0, gq, true, T.cs, T.sn, sub, 0.125f * LOG2E);
    *(u32x4*)(row + 512 + grp * 64 + sub * 8) = normrope8(T.q1, gq, true, T.cs, T.sn, sub, 0.125f * LOG2E);
    const u32x4 r = normrope8(T.k, gk, true, T.cs, T.sn, sub, 1.f);
    if (grp < 4) *(u32x4*)(row + kcol) = r;
  };
  Tok1 A, B;
  int m = F.gw;
  if (m < NTOK) load(A, m);
  while (m < NTOK) {
    const int m1 = m + F.NGW;
    if (m1 < NTOK) load(B, m1);
    process(A, m);
    if (m1 >= NTOK) break;
    const int m2 = m1 + F.NGW;
    if (m2 < NTOK) load(A, m2);
    process(B, m1);
    m = m2;
  }
}

DI void dil_phase(const Ctx& F, const Params& P) {
  const bf16_t* QKV = (const bf16_t*)(P.ws + WS_PROJ); bf16_t* MIX = (bf16_t*)(P.ws + WS_MIX);
  LAS unsigned char* kst = F.lds + F.wave * 8192;
  LAS unsigned char* vst = kst + 4096;
  float cshift; { const int l0 = lane_id_v(); cshift = 8.f * wave_max(fabsf(P.in[I_QN1][l0])) * wave_max(fabsf(P.in[I_KN1][l0])) * 1.02f; }
  const float c2 = cshift * LOG2E;
  const int gwv = ((F.G % 8 == 0) ? ((int)(blockIdx.x % 8) * (F.G / 8) + (int)(blockIdx.x / 8)) : (int)blockIdx.x) * 8 + F.wave;
  const int lane = lane_id_v(), c = lane & 31, half = lane >> 5, qi = c >> 2, gq = c & 3;
  const int q4 = (lane & 15) >> 2, p4 = lane & 3, blk = (lane >> 4) & 1;
  const int lrow = lane >> 3, lch = lane & 7;
  const int woff = lrow * 128 + ((lch ^ (lrow & 7)) << 4);
  const int kra = c * 128 + ((half ^ (c & 7)) << 4);
  const int r1 = 4 * half + q4;
  const int tra0 = r1 * 128 + (((2 * blk + (p4 >> 1)) ^ (r1 & 7)) << 4) + (p4 & 1) * 8;
  for (int it = gwv; it < 32768; it += F.NGW) {
    const int r = it & 15, tile = (it >> 4) & 31, kh = (it >> 9) & 3, b = it >> 11;
    const size_t rb = (size_t)b * SEQ; const int tmax = tile * 128 + r + 112, tq = tile * 128 + r + 16 * qi;
    bf16x8 qf[4];
    { const bf16_t* qp = QKV + (rb + tq) * W1 + (4 * kh + gq) * 64 + 8 * half;
#pragma unroll
      for (int ks = 0; ks < 4; ++ks) qf[ks] = *(const bf16x8*)(qp + 16 * ks); }
    f32x16 o0, o1;
#pragma unroll
    for (int i = 0; i < 16; ++i) { o0[i] = 0.f; o1[i] = 0.f; }
    float lsum = 0.f;
    const char* sbase = (const char*)(QKV + rb * W1 + 1024 + kh * 64) ;
    constexpr int RP = W1 * 2;
    u32x4 gk[4], gv[4];
    auto issue = [&](int ti) { const int sh = ti < 8 ? 0 : (ti < 13 ? 2 : 4), T = ti < 8 ? ti : (ti < 13 ? ti - 8 : ti - 13);
      const int v0 = (tmax - ((32 * T + lrow) << sh)) * RP + lch * 16; const int dv = (8 << sh) * RP;
#pragma unroll
      for (int i = 0; i < 4; ++i) { int vo = v0 - i * dv; vo = vo < lch * 16 ? lch * 16 : vo;
        const char* rp = sbase + (unsigned)vo; gk[i] = *(const u32x4*)rp; gv[i] = *(const u32x4*)(rp + 512); } };
    issue(0);
#pragma unroll 1
    for (int ti = 0; ti < 18; ++ti) {
      const int sh = ti < 8 ? 0 : (ti < 13 ? 2 : 4), T = ti < 8 ? ti : (ti < 13 ? ti - 8 : ti - 13);
#pragma unroll
      for (int i = 0; i < 4; ++i) { *(LAS u32x4*)(kst + woff + i * 1024) = gk[i]; *(LAS u32x4*)(vst + woff + i * 1024) = gv[i]; }
      if (ti + 1 < 18) issue(ti + 1);
      asm volatile("" ::: "memory");
      f32x16 s;
#pragma unroll
      for (int i = 0; i < 16; ++i) s[i] = -c2;
#pragma unroll
      for (int ks = 0; ks < 4; ++ks) { const bf16x8 kf = *(const LAS bf16x8*)(kst + (kra ^ (ks << 5))); s = __builtin_amdgcn_mfma_f32_32x32x16_bf16(kf, qf[ks], s, 0, 0, 0); }
      unsigned m32;
      { const int ei = (16 >> sh) * (7 - qi); const int nmax = tmax >> sh; const int hn = (ei + 128 < nmax) ? ei + 128 : nmax;
        const int lo = ei - 32 * T - 4 * half, hi = hn - 32 * T - 4 * half;
        const int loc = lo < 0 ? 0 : lo, hic = hi > 31 ? 31 : hi;
        m32 = (loc <= hic) ? ((0xFFFFFFFFu >> (31 - hic)) & (0xFFFFFFFFu << loc)) : 0u; }
#pragma unroll
      for (int reg = 0; reg < 16; ++reg) { const int mb = __builtin_amdgcn_sbfe((int)m32, (reg & 3) + 8 * (reg >> 2), 1);
        const float p = __int_as_float(__float_as_int(__builtin_amdgcn_exp2f(s[reg])) & mb); s[reg] = p; lsum += p; }
#pragma unroll
      for (int st = 0; st < 2; ++st) {
        u32x4 pw; pw.x = pk2(s[8 * st], s[8 * st + 1]); pw.y = pk2(s[8 * st + 2], s[8 * st + 3]); pw.z = pk2(s[8 * st + 4], s[8 * st + 5]); pw.w = pk2(s[8 * st + 6], s[8 * st + 7]);
        const bf16x8 pf = __builtin_bit_cast(bf16x8, pw);
#pragma unroll
        for (int dblk = 0; dblk < 2; ++dblk) {
          const int ta = (tra0 ^ (dblk << 6)) + st * 2048;
          const s16x4 lo4 = tr_read(vst + ta), hi4 = tr_read(vst + ta + 1024);
          const bf16x8 vf = __builtin_shufflevector(lo4, hi4, 0, 1, 2, 3, 4, 5, 6, 7);
          if (dblk == 0) o0 = __builtin_amdgcn_mfma_f32_32x32x16_bf16(vf, pf, o0, 0, 0, 0); else o1 = __builtin_amdgcn_mfma_f32_32x32x16_bf16(vf, pf, o1, 0, 0, 0);
        }
      }
      asm volatile("" ::: "memory");
    }
    lsum += __shfl_xor(lsum, 32);
    const float inv = 1.0f / lsum;
    bf16_t* op = MIX + (rb + tq) * DM + (4 * kh + gq) * 64 + 4 * half;
#pragma unroll
    for (int gI = 0; gI < 4; ++gI) {
      u32x2 w0; w0.x = pk2(o0[4 * gI] * inv, o0[4 * gI + 1] * inv); w0.y = pk2(o0[4 * gI + 2] * inv, o0[4 * gI + 3] * inv); *(u32x2*)(op + 8 * gI) = w0;
      u32x2 w1; w1.x = pk2(o1[4 * gI] * inv, o1[4 * gI + 1] * inv); w1.y = pk2(o1[4 * gI + 2] * inv, o1[4 * gI + 3] * inv); *(u32x2*)(op + 32 + 8 * gI) = w1;
    }
  }
}

#define XB_TMO      128
#define XB_XCNT(j)  (256  + 64 * (j))
#define XB_XSUB(j)  (1280 + 64 * (j))
#define XB_XGEN(j)  (2304 + 64 * (j))
#define XB_TOP      3328
#define XB_TOPGEN   3392
#define XCD_BAR_WORDS 3456
#define XB_SPIN_CAP (1u << 18)

__device__ __forceinline__ unsigned xb_ld(unsigned* p)              { return __hip_atomic_load(p, __ATOMIC_RELAXED, __HIP_MEMORY_SCOPE_AGENT); }
__device__ __forceinline__ unsigned xb_add(unsigned* p, unsigned v) { return __hip_atomic_fetch_add(p, v, __ATOMIC_RELAXED, __HIP_MEMORY_SCOPE_AGENT); }
__device__ __forceinline__ unsigned xb_xcc_id() { return (unsigned)__builtin_amdgcn_s_getreg((3 << 11) | 20) & 0xFu; }
#define XB_SPIN(cond, bar) do { unsigned _sp = 0; while (cond) { __builtin_amdgcn_s_sleep(1); \
    if ((++_sp & 255u) == 0u) { if (xb_ld(&(bar)[XB_TMO])) break; if (_sp > XB_SPIN_CAP) { atomicAdd(&(bar)[XB_TMO], 1u); break; } } } } while (0)

struct XcdBarrier {
    unsigned* bar; unsigned x;
    volatile LAS unsigned* st;
};

__device__ __forceinline__ XcdBarrier xcd_barrier_post(unsigned* bar, volatile LAS unsigned* st) {
    XcdBarrier b; b.bar = bar; b.x = xb_xcc_id(); b.st = st;
    if (threadIdx.x == 0) (void)xb_add(&bar[XB_XCNT(b.x)], 1u);
    return b;
}
__device__ __forceinline__ void xcd_barrier_complete(unsigned* bar, unsigned x, unsigned& nloc, unsigned& nx) {
    const unsigned G = gridDim.x * gridDim.y * gridDim.z;
    unsigned sum, cnt, mine, sp = 0u;
    for (;;) {
        sum = 0u; cnt = 0u; mine = 0u;
#pragma unroll
        for (unsigned j = 0; j < 16; ++j) { const unsigned c = xb_ld(&bar[XB_XCNT(j)]); sum += c; cnt += (c > 0u) ? 1u : 0u; mine = (j == x) ? c : mine; }
        if (sum == G) break;
        __builtin_amdgcn_s_sleep(1);
        if ((++sp & 255u) == 0u) { if (xb_ld(&bar[XB_TMO])) break; if (sp > XB_SPIN_CAP) { atomicAdd(&bar[XB_TMO], 1u); break; } }
    }
    nloc = mine > 0u ? mine : 1u; nx = cnt > 0u ? cnt : 1u;
}

__device__ __forceinline__ void xcd_barrier(const XcdBarrier& b) {
    asm volatile("s_waitcnt vmcnt(0)" ::: "memory");
    __syncthreads();
    if (threadIdx.x == 0) {
        unsigned* bar = b.bar;
        __builtin_amdgcn_s_waitcnt(0);
        unsigned nloc = b.st[0], nx = b.st[1];
        if (nloc == 0u) { xcd_barrier_complete(bar, b.x, nloc, nx); b.st[0] = nloc; b.st[1] = nx; }
        const unsigned old = xb_add(&bar[XB_XSUB(b.x)], 1u);
        const unsigned gen = old / nloc;
        if (old + 1u == (gen + 1u) * nloc) {
            __builtin_amdgcn_fence(__ATOMIC_RELEASE, "agent");
            asm volatile("s_waitcnt vmcnt(0)" ::: "memory");
            const unsigned og = xb_add(&bar[XB_TOP], 1u);
            const unsigned tg = og / nx;
            if (og + 1u == (tg + 1u) * nx) xb_add(&bar[XB_TOPGEN], 1u);
            else XB_SPIN(xb_ld(&bar[XB_TOPGEN]) == tg, bar);
            __builtin_amdgcn_fence(__ATOMIC_ACQUIRE, "agent");
            xb_add(&bar[XB_XGEN(b.x)], 1u);
            asm volatile("s_waitcnt vmcnt(0)" ::: "memory");
        } else {
            XB_SPIN(xb_ld(&bar[XB_XGEN(b.x)]) == gen, bar);
            __builtin_amdgcn_fence(__ATOMIC_ACQUIRE, "agent");
            asm volatile("s_waitcnt vmcnt(0)" ::: "memory");
        }
    }
    __syncthreads();
}


__global__ void __launch_bounds__(512, 2) fwd_megakernel(Params P) {
  extern __shared__ __attribute__((aligned(16))) unsigned char lds_raw[];
  cg::grid_group grid = cg::this_grid();
  Ctx F; F.lds = (LAS unsigned char*)lds_raw; F.wave = __builtin_amdgcn_readfirstlane((int)threadIdx.x >> 6);
  F.G = gridDim.x; F.gw = blockIdx.x * 8 + F.wave; F.NGW = F.G * 8;
  unsigned char* ws = P.ws;
  volatile LAS unsigned* xst = (volatile LAS unsigned*)(F.lds + LDS_BYTES - 16);
  if (threadIdx.x < 2) xst[threadIdx.x] = 0u;
  unsigned* xbar_words = (unsigned*)(ws + WS_CTL + 65536);
  __syncthreads();
  XcdBarrier xbar = xcd_barrier_post(xbar_words, xst);
#define GRID_BAR() xcd_barrier(xbar)

#ifndef PHMASK
#define PHMASK 0xFFFFFFFFu
#endif
#define PH(n) if ((PHMASK >> (n)) & 1u)
#if defined(TIMEDSA) && !defined(TIMEPH)
#define TIMEPH 99
#define TIMEN 1
#endif
#ifdef TIMEPH
  unsigned long long* tsw = (unsigned long long*)(ws + WS_CTL + 4096);
#define TS_BEGIN(n) if ((n) >= TIMEPH && (n) < TIMEPH + TIMEN && (n) == TIMEPH && blockIdx.x == 0 && threadIdx.x == 0) tsw[0] = __builtin_amdgcn_s_memrealtime();
#define TS_END(n) if ((n) == TIMEPH + TIMEN - 1 && blockIdx.x == 0 && threadIdx.x == 0) tsw[1] = __builtin_amdgcn_s_memrealtime();
#else
#define TS_BEGIN(n)
#define TS_END(n)
#endif
  TS_BEGIN(0)
  PH(0) p0_prologue(F, P);
  if (P.ws == nullptr) grid.sync();
  GRID_BAR();
  TS_END(0)
  TS_BEGIN(1)
  PH(1) {
    pg8::DenseSched S; S.init(NTOK, W0P, 1024, ws + WS_WIN0, F.G, (int)blockIdx.x);
    pg8::EpiProj0 E{(bf16_t*)(ws + WS_PROJ), (bf16_t*)(ws + WS_KF), (bf16_t*)(ws + WS_IKF), P.in[I_QN0], P.in[I_KN0], (const float*)(ws + WS_ROPE), (const float*)(ws + WS_ROPE) + SEQ * 32};
    pg8::gemm_phase<pg8::EpiProj0, pg8::DenseSched, true>(F.lds, F.wave, (const char*)(ws + WS_XN), 1024, S, E);
  }
  GRID_BAR();
  TS_END(1)
  TS_BEGIN(2)
  PH(2) p1b_transform0(F, P);
  GRID_BAR();
  TS_END(2)
  TS_BEGIN(3)
  PH(3) dsa_phase(F, P);
  GRID_BAR();
  TS_END(3)
  TS_BEGIN(4)
  PH(4) {
    pg8::DenseSched S; S.init(NTOK, 1024, 1024, ws + WS_WOUT0, F.G, (int)blockIdx.x);
    pg8::EpiResB<true> E{P.in[I_X], (bf16_t*)(ws + WS_XB), DM};
    pg8::gemm_phase<pg8::EpiResB<true>, pg8::DenseSched, true>(F.lds, F.wave, (const char*)(ws + WS_MIX), 1024, S, E);
  }
  GRID_BAR();
  TS_END(4)
  TS_BEGIN(5)
  PH(5) router_phase(F, P, 0);
  GRID_BAR();
  TS_END(5)
  TS_BEGIN(6)
  PH(6) moe_gemms(F, P, 0, xbar);
  GRID_BAR();
  TS_END(6)
  TS_BEGIN(7)
  PH(7) combine_phase(F, P, 0, true);
  GRID_BAR();
  TS_END(7)
  TS_BEGIN(8)
  PH(8) {
    pg8::DenseSched S; S.init(NTOK, W1, 1024, ws + WS_WIN1, F.G, (int)blockIdx.x);
    pg8::EpiQKV1 E{(bf16_t*)(ws + WS_PROJ), P.in[I_QN1], P.in[I_KN1], (const float*)(ws + WS_ROPE), (const float*)(ws + WS_ROPE) + SEQ * 32};
    pg8::gemm_phase<pg8::EpiQKV1, pg8::DenseSched, true>(F.lds, F.wave, (const char*)(ws + WS_XN), 1024, S, E);
  }
  GRID_BAR();
  TS_END(8)
  TS_BEGIN(10)
  PH(10) dil_phase(F, P);
  GRID_BAR();
  TS_END(10)
  TS_BEGIN(11)
  PH(11) {
    pg8::DenseSched S; S.init(NTOK, 1024, 1024, ws + WS_WOUT1, F.G, (int)blockIdx.x);
    pg8::EpiResB<false> E{ws + WS_XB, (bf16_t*)(ws + WS_XB), DM};
    pg8::gemm_phase<pg8::EpiResB<false>, pg8::DenseSched, true>(F.lds, F.wave, (const char*)(ws + WS_MIX), 1024, S, E);
  }
  GRID_BAR();
  TS_END(11)
  TS_BEGIN(12)
  PH(12) router_phase(F, P, 1);
  GRID_BAR();
  TS_END(12)
  TS_BEGIN(13)
  PH(13) moe_gemms(F, P, 1, xbar);
  GRID_BAR();
  TS_END(13)
  TS_BEGIN(14)
  PH(14) combine_phase(F, P, 1, false);
#ifdef TIMEPH
  GRID_BAR();
  TS_END(14)
  GRID_BAR();
  { const unsigned long long dt = (tsw[1] - tsw[0]) * 4ull; const unsigned long long t0 = __builtin_amdgcn_s_memrealtime();
    while (__builtin_amdgcn_s_memrealtime() - t0 < dt) __builtin_amdgcn_s_sleep(32); }
#endif
}

extern "C" void kernel_launch(void* const* d_in, const int* in_sizes, int n_in, void* d_out, int out_size, void* d_ws, size_t ws_size, hipStream_t stream) {
  static int grid_blocks = 0;
  if (!grid_blocks) {
    if (n_in != 28 || out_size != NTOK * DM || ws_size < WS_END) { fprintf(stderr, "kernel_launch: unexpected shapes (n_in %d out %d ws %zu)\n", n_in, out_size, ws_size); grid_blocks = -1; return; }
    int dev = 0, cus = 0, per_cu = 0;
    (void)hipGetDevice(&dev);
    (void)hipDeviceGetAttribute(&cus, hipDeviceAttributeMultiprocessorCount, dev);
    (void)hipFuncSetAttribute((const void*)fwd_megakernel, hipFuncAttributeMaxDynamicSharedMemorySize, LDS_BYTES);
    (void)hipOccupancyMaxActiveBlocksPerMultiprocessor(&per_cu, (const void*)fwd_megakernel, 512, LDS_BYTES);
    if (per_cu < 1) per_cu = 1;
    grid_blocks = cus * per_cu;
  }
  if (grid_blocks < 0) return;
  Params p{};
  for (int i = 0; i < 28; ++i) p.in[i] = (const float*)d_in[i];
  p.out = (float*)d_out; p.ws = (unsigned char*)d_ws;
  (void)hipMemsetAsync((unsigned char*)d_ws + WS_CTL + 65536, 0, XCD_BAR_WORDS * 4, stream);
  void* args[] = {&p};
  hipError_t e = hipLaunchCooperativeKernel((const void*)fwd_megakernel, dim3(grid_blocks), dim3(512), args, LDS_BYTES, stream);
  if (e != hipSuccess) fprintf(stderr, "cooperative launch failed: %s (grid %d)\n", hipGetErrorString(e), grid_blocks);
}
```

```cpp
#include <hip/hip_runtime.h>
#include <hip/hip_cooperative_groups.h>
#include <cstdio>
#include <cstdint>
namespace cg = cooperative_groups;

#define LAS __attribute__((address_space(3)))
#define DI __device__ __forceinline__
typedef unsigned short bf16_t;
typedef short bf16x8 __attribute__((ext_vector_type(8)));
typedef short s16x4 __attribute__((ext_vector_type(4)));
typedef float f32x2 __attribute__((ext_vector_type(2)));
typedef float f32x4 __attribute__((ext_vector_type(4)));
typedef float f32x16 __attribute__((ext_vector_type(16)));
typedef unsigned u32x2 __attribute__((ext_vector_type(2)));
typedef unsigned u32x4 __attribute__((ext_vector_type(4)));
typedef int i32x4 __attribute__((ext_vector_type(4)));
typedef __bf16 bf16x2_t __attribute__((ext_vector_type(2)));

constexpr int NTOK = 65536, DM = 1024, SEQ = 4096, NBATCH = 16;
constexpr int W0P = 2560, W0V = 2500;
constexpr int W1 = 1536;
constexpr int C_CB = 0, C_CC = 512, C_CH = 1024, C_Q = 1536, C_K = 2048, C_V = 2112, C_IQ = 2176, C_IK = 2432, C_IW = 2496;
constexpr int NEXP = 32, DEXP = 512;
constexpr int MAXROWS = 139264;
constexpr float NORM_EPS = 1e-6f;
constexpr float LOG2E = 1.4426950408889634f;

constexpr size_t MiB = 1u << 20;
constexpr size_t WS_CTL = 0;
constexpr size_t WS_ROPE = 1 * MiB;
constexpr size_t WS_WR0 = 2 * MiB, WS_WR1 = 2 * MiB + 256 * 1024;
constexpr size_t WS_WIN0 = 3 * MiB, WS_WOUT0 = 8 * MiB, WS_WIN1 = 10 * MiB, WS_WOUT1 = 13 * MiB;
constexpr size_t WS_WGU0 = 16 * MiB, WS_WD0 = 80 * MiB, WS_WGU1 = 112 * MiB, WS_WD1 = 176 * MiB;
constexpr size_t WS_XN = 208 * MiB;
constexpr size_t WS_MIX = 337 * MiB;
constexpr size_t WS_H = 337 * MiB;
constexpr size_t WS_XB = 473 * MiB;
constexpr size_t WS_PROJ = 601 * MiB;
constexpr size_t WS_LIST = 921 * MiB;
constexpr size_t WS_ASG = 929 * MiB;
constexpr size_t WS_ASGG = 930 * MiB;
constexpr size_t WS_IKF = 931 * MiB, WS_KF = 939 * MiB, WS_VTF = 947 * MiB;
constexpr size_t WS_RSL = 955 * MiB;
constexpr size_t WS_END = 963 * MiB;

constexpr int LDS_BYTES = 155648;
constexpr int LDS_LIST = 131072;
constexpr int LDS_MISC = 131072 + 16384;

DI unsigned pk2(float lo, float hi) { f32x2 v = {lo, hi}; bf16x2_t b = __builtin_convertvector(v, bf16x2_t); return __builtin_bit_cast(unsigned, b); }
DI float bflo(unsigned w) { return __uint_as_float(w << 16); }
DI float bfhi(unsigned w) { return __uint_as_float(w & 0xffff0000u); }
DI float bf1(bf16_t h) { return __uint_as_float((unsigned)h << 16); }
DI int opaque(int x) { asm volatile("" : "+v"(x)); return x; }
DI int lane_id_v() { int l; asm volatile("v_mbcnt_lo_u32_b32 %0, -1, 0\n\tv_mbcnt_hi_u32_b32 %0, -1, %0" : "=v"(l)); return l; }
DI float wave_sum(float v) {
#pragma unroll
  for (int o = 1; o < 64; o <<= 1) v += __shfl_xor(v, o);
  return v;
}
DI float wave_max(float v) {
#pragma unroll
  for (int o = 1; o < 64; o <<= 1) v = fmaxf(v, __shfl_xor(v, o));
  return v;
}
DI unsigned wave_sum_u(unsigned v) {
#pragma unroll
  for (int o = 1; o < 64; o <<= 1) v += (unsigned)__shfl_xor((int)v, o);
  return v;
}

namespace pg8 {
constexpr int BM = 256, BK = 64, HALF = 128, HTB = HALF * BK * 2, STAGE_BYTES = 8 * HTB, NXCD = 8, WGM = 8;
DI int lds_byte(int r, int c) { const int st = (r >> 4) * 2 + (c >> 5), rr = r & 15, cc = c & 31, ob = rr * 64 + cc * 2; return st * 1024 + (ob ^ (((ob >> 9) & 1) << 5)); }
DI void stage_rc(int b, int& R, int& C) { const int st = b / 1024, sb = b % 1024, swz = sb ^ (((sb >> 9) & 1) << 5); R = (st >> 1) * 16 + swz / 64; C = (st & 1) * 32 + (swz % 64) / 2; }
DI int perm32(int rho) { const int n = rho >> 4, i = rho & 15; return 8 * (i >> 2) + 4 * n + (i & 3); }

struct Unit { const char* b; int p0, p1, p2, p3; };

struct EpiBf16 {
  static constexpr bool PERM = true;
  bf16_t* O; int ldc;
  DI void operator()(const f32x4 (&acc)[2][2][4][2], const Unit& u, int wr, int wc, int fr, int fq) const {
    const int row0 = u.p0 + wr * 64 + fr, col0 = u.p1 + wc * 32 + 8 * fq;
#pragma unroll
    for (int ai = 0; ai < 2; ++ai)
#pragma unroll
      for (int m = 0; m < 4; ++m) { bf16_t* rowp = O + (size_t)(row0 + ai * HALF + m * 16) * ldc + col0;
#pragma unroll
        for (int bj = 0; bj < 2; ++bj) { const f32x4 v0 = acc[ai][bj][m][0], v1 = acc[ai][bj][m][1];
          u32x4 w; w.x = pk2(v0[0], v0[1]); w.y = pk2(v0[2], v0[3]); w.z = pk2(v1[0], v1[1]); w.w = pk2(v1[2], v1[3]);
          *(u32x4*)(rowp + bj * HALF) = w; } }
  }
};
template <bool BASE_F32> struct EpiResB {
  static constexpr bool PERM = true;
  const void* base; bf16_t* out; int ldc;
  DI void operator()(const f32x4 (&acc)[2][2][4][2], const Unit& u, int wr, int wc, int fr, int fq) const {
    const int row0 = u.p0 + wr * 64 + fr, col0 = u.p1 + wc * 32 + 8 * fq;
#pragma unroll
    for (int ai = 0; ai < 2; ++ai)
#pragma unroll
      for (int m = 0; m < 4; ++m) { const size_t off = (size_t)(row0 + ai * HALF + m * 16) * ldc + col0;
#pragma unroll
        for (int bj = 0; bj < 2; ++bj) { f32x4 v0 = acc[ai][bj][m][0], v1 = acc[ai][bj][m][1];
          if (BASE_F32) { const float* bp = (const float*)base + off + bj * HALF; v0 = v0 + *(const f32x4*)bp; v1 = v1 + *(const f32x4*)(bp + 4); }
          else { const u32x4 b = *(const u32x4*)((const bf16_t*)base + off + bj * HALF);
            v0 = v0 + (f32x4){bflo(b.x), bfhi(b.x), bflo(b.y), bfhi(b.y)}; v1 = v1 + (f32x4){bflo(b.z), bfhi(b.z), bflo(b.w), bfhi(b.w)}; }
          u32x4 w; w.x = pk2(v0[0], v0[1]); w.y = pk2(v0[2], v0[3]); w.z = pk2(v1[0], v1[1]); w.w = pk2(v1[2], v1[3]);
          *(u32x4*)(out + off + bj * HALF) = w; } }
  }
};
struct EpiQKV1 {
  static constexpr bool PERM = true;
  bf16_t* O; const float* qg; const float* kg; const float* cosT; const float* sinT;
  DI void operator()(const f32x4 (&acc)[2][2][4][2], const Unit& u, int wr, int wc, int fr, int fq) const {
    const int tilec = u.p1 >> 8;
    const int row0 = u.p0 + wr * 64 + fr, col0 = u.p1 + wc * 64 + 8 * fq;
    if (tilec == 5) {
#pragma unroll
      for (int ai = 0; ai < 2; ++ai)
#pragma unroll
        for (int m = 0; m < 4; ++m) { bf16_t* rowp = O + (size_t)(row0 + ai * HALF + m * 16) * W1 + col0;
#pragma unroll
          for (int bj = 0; bj < 2; ++bj) { const f32x4 v0 = acc[ai][bj][m][0], v1 = acc[ai][bj][m][1];
            u32x4 w; w.x = pk2(v0[0], v0[1]); w.y = pk2(v0[2], v0[3]); w.z = pk2(v1[0], v1[1]); w.w = pk2(v1[2], v1[3]); *(u32x4*)(rowp + 32 * bj) = w; } }
      return;
    }
    const float* gp = (tilec == 4 ? kg : qg) + 8 * fq; const float osc = tilec == 4 ? 1.f : 0.125f * LOG2E;
    float g0[8], g1[8];
#pragma unroll
    for (int i = 0; i < 8; ++i) { g0[i] = gp[i]; g1[i] = gp[32 + i]; }
#pragma unroll
    for (int ai = 0; ai < 2; ++ai)
#pragma unroll
      for (int m = 0; m < 4; ++m) {
        const int row = row0 + ai * HALF + m * 16; const int t = row & (SEQ - 1);
        const f32x4 a0 = acc[ai][0][m][0], a1 = acc[ai][0][m][1], b0 = acc[ai][1][m][0], b1 = acc[ai][1][m][1];
        float x1[8] = {a0[0], a0[1], a0[2], a0[3], a1[0], a1[1], a1[2], a1[3]}, x2[8] = {b0[0], b0[1], b0[2], b0[3], b1[0], b1[1], b1[2], b1[3]};
        float ss = 0.f;
#pragma unroll
        for (int i = 0; i < 8; ++i) ss += x1[i] * x1[i] + x2[i] * x2[i];
        ss += __shfl_xor(ss, 16); ss += __shfl_xor(ss, 32);
        const float rstd = 1.0f / sqrtf(ss * (1.f / 64.f) + NORM_EPS);
        const f32x4* cp = (const f32x4*)(cosT + t * 32 + 8 * fq); const f32x4* sp = (const f32x4*)(sinT + t * 32 + 8 * fq);
        const f32x4 c0 = cp[0], c1 = cp[1], s0 = sp[0], s1 = sp[1];
        const float cv[8] = {c0[0], c0[1], c0[2], c0[3], c1[0], c1[1], c1[2], c1[3]}, sv[8] = {s0[0], s0[1], s0[2], s0[3], s1[0], s1[1], s1[2], s1[3]};
        float o1[8], o2[8];
#pragma unroll
        for (int i = 0; i < 8; ++i) { const float y1 = x1[i] * rstd * g0[i], y2 = x2[i] * rstd * g1[i]; o1[i] = (y1 * cv[i] - y2 * sv[i]) * osc; o2[i] = (y1 * sv[i] + y2 * cv[i]) * osc; }
        bf16_t* rowp = O + (size_t)row * W1 + col0;
        u32x4 w; w.x = pk2(o1[0], o1[1]); w.y = pk2(o1[2], o1[3]); w.z = pk2(o1[4], o1[5]); w.w = pk2(o1[6], o1[7]); *(u32x4*)rowp = w;
        w.x = pk2(o2[0], o2[1]); w.y = pk2(o2[2], o2[3]); w.z = pk2(o2[4], o2[5]); w.w = pk2(o2[6], o2[7]); *(u32x4*)(rowp + 32) = w;
      }
  }
};
struct EpiProj0 {
  static constexpr bool PERM = true;
  bf16_t* O; bf16_t* KFo; bf16_t* IKFo; const float* qg; const float* kg; const float* cosT; const float* sinT;
  DI void operator()(const f32x4 (&acc)[2][2][4][2], const Unit& u, int wr, int wc, int fr, int fq) const {
    const int grp64 = (u.p1 >> 6) + wc;
    const int row0 = u.p0 + wr * 64 + fr, col0 = u.p1 + wc * 64 + 8 * fq;
    const bool rope = (grp64 >= 24 && grp64 <= 32) || (grp64 >= 34 && grp64 <= 38);
    if (!rope) {
#pragma unroll
      for (int ai = 0; ai < 2; ++ai)
#pragma unroll
        for (int m = 0; m < 4; ++m) { bf16_t* rowp = O + (size_t)(row0 + ai * HALF + m * 16) * W0P + col0;
#pragma unroll
          for (int bj = 0; bj < 2; ++bj) { const f32x4 v0 = acc[ai][bj][m][0], v1 = acc[ai][bj][m][1];
            u32x4 w; w.x = pk2(v0[0], v0[1]); w.y = pk2(v0[2], v0[3]); w.z = pk2(v1[0], v1[1]); w.w = pk2(v1[2], v1[3]); *(u32x4*)(rowp + 32 * bj) = w; } }
      return;
    }
    const bool norm = grp64 <= 32;
    const float* gp = (grp64 == 32 ? kg : qg) + 8 * fq;
    float g0[8], g1[8];
#pragma unroll
    for (int i = 0; i < 8; ++i) { g0[i] = norm ? gp[i] : 1.f; g1[i] = norm ? gp[32 + i] : 1.f; }
    bf16_t* frag = grp64 == 32 ? KFo : (grp64 == 38 ? IKFo : nullptr);
#pragma unroll
    for (int ai = 0; ai < 2; ++ai)
#pragma unroll
      for (int m = 0; m < 4; ++m) {
        const int row = row0 + ai * HALF + m * 16; const int t = row & (SEQ - 1);
        const f32x4 a0 = acc[ai][0][m][0], a1 = acc[ai][0][m][1], b0 = acc[ai][1][m][0], b1 = acc[ai][1][m][1];
        float x1[8] = {a0[0], a0[1], a0[2], a0[3], a1[0], a1[1], a1[2], a1[3]}, x2[8] = {b0[0], b0[1], b0[2], b0[3], b1[0], b1[1], b1[2], b1[3]};
        float ss = 0.f;
#pragma unroll
        for (int i = 0; i < 8; ++i) ss += x1[i] * x1[i] + x2[i] * x2[i];
        ss += __shfl_xor(ss, 16); ss += __shfl_xor(ss, 32);
        const float rstd = norm ? 1.0f / sqrtf(ss * (1.f / 64.f) + NORM_EPS) : 1.f;
        const f32x4* cp = (const f32x4*)(cosT + t * 32 + 8 * fq); const f32x4* sp = (const f32x4*)(sinT + t * 32 + 8 * fq);
        const f32x4 c0 = cp[0], c1 = cp[1], s0 = sp[0], s1 = sp[1];
        const float cv[8] = {c0[0], c0[1], c0[2], c0[3], c1[0], c1[1], c1[2], c1[3]}, sv[8] = {s0[0], s0[1], s0[2], s0[3], s1[0], s1[1], s1[2], s1[3]};
        float o1[8], o2[8];
#pragma unroll
        for (int i = 0; i < 8; ++i) { const float y1 = x1[i] * rstd * g0[i], y2 = x2[i] * rstd * g1[i]; o1[i] = y1 * cv[i] - y2 * sv[i]; o2[i] = y1 * sv[i] + y2 * cv[i]; }
        u32x4 w1, w2; w1.x = pk2(o1[0], o1[1]); w1.y = pk2(o1[2], o1[3]); w1.z = pk2(o1[4], o1[5]); w1.w = pk2(o1[6], o1[7]);
        w2.x = pk2(o2[0], o2[1]); w2.y = pk2(o2[2], o2[3]); w2.z = pk2(o2[4], o2[5]); w2.w = pk2(o2[6], o2[7]);
        if (frag) {
          const size_t fo = ((((size_t)(row >> 12) * 128 + (t >> 5)) * 4 + (fq >> 1)) * 64 + (fq & 1) * 32 + (t & 31)) * 8;
          *(u32x4*)(frag + fo) = w1; *(u32x4*)(frag + fo + 2 * 64 * 8) = w2;
        } else { bf16_t* rowp = O + (size_t)row * W0P + col0; *(u32x4*)rowp = w1; *(u32x4*)(rowp + 32) = w2; }
      }
  }
};
struct EpiResF32 {
  static constexpr bool PERM = false;
  const float* base; float* out; int ldc;
  DI void operator()(const f32x4 (&acc)[2][2][4][2], const Unit& u, int wr, int wc, int fr, int fq) const {
    const int row0 = u.p0 + wr * 64 + fr, col0 = u.p1 + wc * 32 + 4 * fq;
#pragma unroll
    for (int ai = 0; ai < 2; ++ai)
#pragma unroll
      for (int m = 0; m < 4; ++m) { const size_t off = (size_t)(row0 + ai * HALF + m * 16) * ldc + col0;
#pragma unroll
        for (int bj = 0; bj < 2; ++bj)
#pragma unroll
          for (int n = 0; n < 2; ++n) { const f32x4 bs = *(const f32x4*)(base + off + bj * HALF + n * 16); *(f32x4*)(out + off + bj * HALF + n * 16) = bs + acc[ai][bj][m][n]; } }
  }
};
DI float silu_mul(float g, float u) { return g * u * __builtin_amdgcn_rcpf(1.0f + __builtin_amdgcn_exp2f(-g * LOG2E)); }
struct EpiSwiGLU {
  static constexpr bool PERM = true;
  bf16_t* H; const float* RSL; const LAS int* cnt;
  DI void operator()(const f32x4 (&acc)[2][2][4][2], const Unit& u, int wr, int wc, int fr, int fq) const {
    const int row0 = u.p0 + wr * 64 + fr, col0 = u.p1 + wc * 32 + 8 * fq; const int ce = __builtin_amdgcn_readfirstlane(cnt[u.p2]);
#pragma unroll
    for (int ai = 0; ai < 2; ++ai)
#pragma unroll
      for (int m = 0; m < 4; ++m) { bf16_t* rowp = H + (size_t)(row0 + ai * HALF + m * 16) * DEXP + col0;
        const int lrow = u.p3 * BM + wr * 64 + fr + ai * HALF + m * 16; const float rs = (lrow < ce) ? RSL[u.p2 * 65536 + lrow] : 0.f;
        const f32x4 g0 = acc[ai][0][m][0] * rs, g1 = acc[ai][0][m][1] * rs, u0 = acc[ai][1][m][0] * rs, u1 = acc[ai][1][m][1] * rs;
        u32x4 w; w.x = pk2(silu_mul(g0[0], u0[0]), silu_mul(g0[1], u0[1])); w.y = pk2(silu_mul(g0[2], u0[2]), silu_mul(g0[3], u0[3]));
        w.z = pk2(silu_mul(g1[0], u1[0]), silu_mul(g1[1], u1[1])); w.w = pk2(silu_mul(g1[2], u1[2]), silu_mul(g1[3], u1[3]));
        *(u32x4*)rowp = w; }
  }
};

struct DenseSched {
  static constexpr bool NEXT_IN_LDS = false;
  int nM, nN, nwg, G, c, K; const char* Bt;
  DI void init(int M, int N, int K_, const void* Bt_, int G_, int c_) { nM = M / BM; nN = N / BM; nwg = nM * nN; G = G_; c = c_; K = K_; Bt = (const char*)Bt_; }
  DI bool next(int i, Unit& u) const {
    const long L = (long)i * G + c; if (L >= nwg) return false;
    int wgid = (int)L; { const int q = nwg / NXCD, r = nwg % NXCD, xcd = wgid % NXCD, off = wgid / NXCD; wgid = (xcd < r ? xcd * (q + 1) : r * (q + 1) + (xcd - r) * q) + off; }
    const int nig = WGM * nN, gid = wgid / nig, fm = gid * WGM, gsz = (nM - fm) < WGM ? (nM - fm) : WGM;
    const int pm = fm + ((wgid % nig) % gsz), pn = (wgid % nig) / gsz;
    u.p0 = pm * BM; u.p1 = pn * BM; u.p2 = 0; u.p3 = 0; u.b = Bt + (size_t)pn * BM * K * 2; return true;
  }
  DI void a_off(const Unit& u, const int (&R)[2], const int (&C)[2], unsigned (&o)[2][2]) const {
#pragma unroll
    for (int h = 0; h < 2; ++h)
#pragma unroll
      for (int i = 0; i < 2; ++i) o[h][i] = (unsigned)((u.p0 + h * HALF + R[i]) * K + C[i]) * 2u;
  }
};
template <bool GATHER> struct MoeSched {
  static constexpr bool NEXT_IN_LDS = GATHER;
  const LAS int* pb; const LAS int* cnt; const int* list; const char* W; int G, c, K;
  DI bool next(int i, Unit& u) const {
    const int L = i * G + c; const int total = __builtin_amdgcn_readfirstlane(pb[NEXP]) * 4; if (L >= total) return false;
    const int rbg = L >> 2, pn = L & 3; int e = 0;
    for (int j = 1; j < NEXP; ++j) e = (__builtin_amdgcn_readfirstlane(pb[j]) <= rbg) ? j : e;
    u.p0 = rbg * BM; u.p1 = pn * (GATHER ? 128 : 256); u.p2 = e; u.p3 = rbg - __builtin_amdgcn_readfirstlane(pb[e]);
    u.b = W + (size_t)(e * 1024 + pn * 256) * K * 2; return true;
  }
  DI void a_off(const Unit& u, const int (&R)[2], const int (&C)[2], unsigned (&o)[2][2]) const {
    if (GATHER) {
      const int ce = __builtin_amdgcn_readfirstlane(cnt[u.p2]);
#pragma unroll
      for (int h = 0; h < 2; ++h)
#pragma unroll
        for (int i = 0; i < 2; ++i) { const int row = u.p3 * BM + h * HALF + R[i]; const int tok = (row < ce) ? list[u.p2 * 65536 + row] : 0; o[h][i] = (unsigned)(tok * K + C[i]) * 2u; }
    } else {
#pragma unroll
      for (int h = 0; h < 2; ++h)
#pragma unroll
        for (int i = 0; i < 2; ++i) o[h][i] = (unsigned)((u.p0 + h * HALF + R[i]) * K + C[i]) * 2u;
    }
  }
};

template <class Epi, class Sched, bool ALIGN_EPI>
DI void gemm_phase(LAS unsigned char* lds, const int wave_id, const char* gA, const int K, const Sched& S, const Epi& E) {
  const int lane = lane_id_v(), wid = wave_id, tid = wid * 64 + lane, wr = wid >> 2, wc = wid & 3, fr = lane & 15, fq = lane >> 4;
  const int nt = K / BK;
  unsigned voffB[2];
  { int R, C; stage_rc(tid * 16, R, C);
    const int Rb = Epi::PERM ? ((R & ~31) + perm32(R & 31)) : R; voffB[0] = (unsigned)(Rb * K + C) * 2u; voffB[1] = voffB[0] + (unsigned)(64 * K * 2); }
#define PG8_RC(Rp, Cp) int Rp[2], Cp[2]; { int R_, C_; stage_rc(opaque(tid) * 16, R_, C_); Rp[0] = R_; Cp[0] = C_; Rp[1] = R_ + 64; Cp[1] = C_; }
  const size_t kstep = (size_t)(BK * 2);
  const size_t hstep = (size_t)HALF * K * 2;
  const unsigned ldsw = (unsigned)wid * 1024u;
  const int aoff = lds_byte(wr * 64 + fr, fq * 8), boff = lds_byte(wc * 32 + fr, fq * 8);
#define PG8_SA(b, h) (((b) * 2 + (h)) * HTB)
#define PG8_SB(b, h) ((4 + (b) * 2 + (h)) * HTB)
#define PG8_STAGE_B(bufoff, gbase) do { _Pragma("unroll") for (int _i = 0; _i < 2; ++_i) \
    __builtin_amdgcn_global_load_lds((const unsigned*)((const char*)(gbase) + voffB[_i]), (LAS unsigned*)(lds + (bufoff) + ldsw + _i * 8192), 16, 0, 0); } while (0)
#define PG8_STAGE_A(bufoff, kb, offs) do { _Pragma("unroll") for (int _i = 0; _i < 2; ++_i) \
    __builtin_amdgcn_global_load_lds((const unsigned*)(gA + (size_t)(kb) + (offs)[_i]), (LAS unsigned*)(lds + (bufoff) + ldsw + _i * 8192), 16, 0, 0); } while (0)
#define PG8_LDA(dst, b, h) do { _Pragma("unroll") for (int m = 0; m < 4; ++m) _Pragma("unroll") for (int k = 0; k < 2; ++k) dst[m][k] = *(const LAS bf16x8*)(lds + PG8_SA(b, h) + aoff + m * 2048 + k * 1024); } while (0)
#define PG8_LDB(dst, b, h) do { _Pragma("unroll") for (int n = 0; n < 2; ++n) _Pragma("unroll") for (int k = 0; k < 2; ++k) dst[n][k] = *(const LAS bf16x8*)(lds + PG8_SB(b, h) + boff + n * 2048 + k * 1024); } while (0)
#define PG8_MMA(ai, bj, At, Bt) do { __builtin_amdgcn_s_setprio(1); _Pragma("unroll") for (int m = 0; m < 4; ++m) _Pragma("unroll") for (int n = 0; n < 2; ++n) _Pragma("unroll") for (int k = 0; k < 2; ++k) \
    acc[ai][bj][m][n] = __builtin_amdgcn_mfma_f32_16x16x32_bf16(Bt[n][k], At[m][k], acc[ai][bj][m][n], 0, 0, 0); __builtin_amdgcn_s_setprio(0); } while (0)
#define PG8_WAIT_V(n) asm volatile("s_waitcnt vmcnt(" #n ")" ::: "memory")
#define PG8_WAIT_L(n) asm volatile("s_waitcnt lgkmcnt(" #n ")" ::: "memory")
#define PG8_BAR __builtin_amdgcn_s_barrier()
#define PG8_SCHED __builtin_amdgcn_sched_barrier(0)
  Unit cur, nxt; int ui = 0;
  if (!S.next(0, cur)) return;
  unsigned ca[2][2];
  { PG8_RC(Rp, Cp) S.a_off(cur, Rp, Cp, ca); }
  f32x4 acc[2][2][4][2];
#pragma unroll
  for (int a = 0; a < 2; ++a)
#pragma unroll
    for (int b = 0; b < 2; ++b)
#pragma unroll
      for (int m = 0; m < 4; ++m)
#pragma unroll
        for (int n = 0; n < 2; ++n) acc[a][b][m][n] = (f32x4){0.f, 0.f, 0.f, 0.f};
  bf16x8 At[4][2], B0[2][2], B1[2][2];
  const char* cB = cur.b;
  PG8_STAGE_B(PG8_SB(0, 0), cB); PG8_STAGE_B(PG8_SB(0, 1), cB + hstep); PG8_STAGE_A(PG8_SA(0, 0), 0, ca[0]); PG8_STAGE_A(PG8_SA(0, 1), 0, ca[1]);
  if (wr == 1) PG8_BAR;
  PG8_WAIT_V(2); PG8_BAR;
  PG8_STAGE_B(PG8_SB(1, 0), cB + kstep); PG8_STAGE_A(PG8_SA(1, 0), kstep, ca[0]); PG8_STAGE_B(PG8_SB(1, 1), cB + hstep + kstep);
  PG8_WAIT_V(6); PG8_BAR;
  for (;;) {
    const bool has_next = S.next(ui + 1, nxt);
    if (Sched::NEXT_IN_LDS) {
      unsigned na[2][2];
      if (has_next) { PG8_RC(Rp, Cp) S.a_off(nxt, Rp, Cp, na); }
      else {
#pragma unroll
        for (int h = 0; h < 2; ++h)
#pragma unroll
          for (int i = 0; i < 2; ++i) na[h][i] = ca[h][i];
      }
      *(LAS u32x4*)(lds + STAGE_BYTES + 8192 + tid * 16) = (u32x4){na[0][0], na[0][1], na[1][0], na[1][1]};
    }
    const char* nB = has_next ? nxt.b : cB;
    for (int t = 0; t < nt; t += 2) {
      const bool last = (t == nt - 2);
      PG8_LDB(B0, 0, 0); PG8_LDB(B1, 0, 1); PG8_SCHED; PG8_LDA(At, 0, 0); PG8_STAGE_A(PG8_SA(1, 1), (size_t)(t + 1) * kstep, ca[1]);
      PG8_WAIT_V(8); PG8_WAIT_L(0); PG8_BAR; PG8_MMA(0, 0, At, B0); PG8_MMA(0, 1, At, B1); PG8_BAR; PG8_SCHED;
      const size_t kb2 = last ? 0 : (size_t)(t + 2) * kstep;
      const char* b2 = last ? nB : cB + (size_t)(t + 2) * kstep;
      if (last) {
        if (Sched::NEXT_IN_LDS) { const u32x4 v = *(const LAS u32x4*)(lds + STAGE_BYTES + 8192 + tid * 16); ca[0][0] = v.x; ca[0][1] = v.y; ca[1][0] = v.z; ca[1][1] = v.w; }
        else if (has_next) { PG8_RC(Rp, Cp) S.a_off(nxt, Rp, Cp, ca); }
      }
      PG8_LDA(At, 0, 1); PG8_STAGE_B(PG8_SB(0, 0), b2); PG8_STAGE_B(PG8_SB(0, 1), b2 + hstep); PG8_STAGE_A(PG8_SA(0, 0), kb2, ca[0]);
      PG8_WAIT_V(8); PG8_WAIT_L(0); PG8_BAR; PG8_MMA(1, 0, At, B0); PG8_MMA(1, 1, At, B1); PG8_BAR; PG8_SCHED;
      PG8_LDB(B0, 1, 0); PG8_LDB(B1, 1, 1); PG8_SCHED; PG8_LDA(At, 1, 0); PG8_STAGE_A(PG8_SA(0, 1), kb2, ca[1]);
      PG8_WAIT_V(8); PG8_WAIT_L(0); PG8_BAR; PG8_MMA(0, 0, At, B0); PG8_MMA(0, 1, At, B1); PG8_BAR; PG8_SCHED;
      PG8_LDA(At, 1, 1); PG8_STAGE_B(PG8_SB(1, 0), b2 + kstep); PG8_STAGE_B(PG8_SB(1, 1), b2 + kstep + hstep); PG8_STAGE_A(PG8_SA(1, 0), kb2 + kstep, ca[0]);
      PG8_WAIT_V(8); PG8_WAIT_L(0); PG8_BAR; PG8_MMA(1, 0, At, B0); PG8_MMA(1, 1, At, B1); PG8_BAR; PG8_SCHED;
    }
    if constexpr (ALIGN_EPI) { if (wr == 0) PG8_BAR; }
    E(acc, cur, wr, wc, fr, fq);
    if (!has_next) break;
#pragma unroll
    for (int a = 0; a < 2; ++a)
#pragma unroll
      for (int b = 0; b < 2; ++b)
#pragma unroll
        for (int m = 0; m < 4; ++m)
#pragma unroll
          for (int n = 0; n < 2; ++n) acc[a][b][m][n] = (f32x4){0.f, 0.f, 0.f, 0.f};
    cur = nxt; cB = nB; ++ui;
    if constexpr (ALIGN_EPI) { if (wr == 1) PG8_BAR; }
  }
  PG8_WAIT_V(0);
  if constexpr (!ALIGN_EPI) { if (wr == 0) PG8_BAR; }
  PG8_BAR;
#undef PG8_RC
#undef PG8_SA
#undef PG8_SB
#undef PG8_STAGE_A
#undef PG8_STAGE_B
#undef PG8_LDA
#undef PG8_LDB
#undef PG8_MMA
#undef PG8_WAIT_V
#undef PG8_WAIT_L
#undef PG8_BAR
#undef PG8_SCHED
}
}

struct Params { const float* in[28]; float* out; unsigned char* ws; };
enum { I_X = 0, I_ANORM0, I_WIN0, I_CONVW, I_QN0, I_KN0, I_WOUT0, I_FNORM0, I_WRG0, I_BRG0, I_WRE0, I_BRE0, I_WG0, I_WU0, I_WD0,
       I_ANORM1, I_WIN1, I_QN1, I_KN1, I_WOUT1, I_FNORM1, I_WRG1, I_BRG1, I_WRE1, I_BRE1, I_WG1, I_WU1, I_WD1 };

struct Ctx { LAS unsigned char* lds; int wave, G, gw, NGW; };

struct TrDesc { const float* W; const float* gain; bf16_t* WT; int K, N, nvalid, mode, nblk, item; };
DI void tr_load(const TrDesc& d, int lane, f32x4 (&r)[8]) {
  const int kb = d.item / d.nblk, nb = d.item % d.nblk, k0 = 64 * kb, n = 32 * nb + 4 * (lane & 7);
#pragma unroll
  for (int i = 0; i < 8; ++i) { const int kk = 8 * i + (lane >> 3); r[i] = (n < d.nvalid) ? *(const f32x4*)(d.W + (size_t)(k0 + kk) * d.N + n) : (f32x4){0.f, 0.f, 0.f, 0.f}; }
}
DI void tr_finish(const TrDesc& d, int lane, const f32x4 (&r)[8], LAS float* scr) {
  const int kb = d.item / d.nblk, nb = d.item % d.nblk, k0 = 64 * kb, n0 = 32 * nb;
#pragma unroll
  for (int i = 0; i < 8; ++i) { const int kk = 8 * i + (lane >> 3); const float g = d.gain ? d.gain[k0 + kk] : 1.f; LAS float* s = scr + kk * 33 + 4 * (lane & 7);
    s[0] = r[i].x * g; s[1] = r[i].y * g; s[2] = r[i].z * g; s[3] = r[i].w * g; }
  asm volatile("s_waitcnt lgkmcnt(0)" ::: "memory");
  const int c = lane & 7;
#pragma unroll
  for (int j = 0; j < 4; ++j) { const int nn = (lane >> 3) + 8 * j; const LAS float* s = scr + (8 * c) * 33 + nn;
    u32x4 o; o.x = pk2(s[0 * 33], s[1 * 33]); o.y = pk2(s[2 * 33], s[3 * 33]); o.z = pk2(s[4 * 33], s[5 * 33]); o.w = pk2(s[6 * 33], s[7 * 33]);
    const int ng = n0 + nn; const int drow = (d.mode == 0) ? ng : (d.mode == 3 ? ((ng & ~255) + 128 * ((ng >> 5) & 1) + 32 * ((ng >> 6) & 3) + (ng & 31)) : ((ng >> 7) * 256 + (ng & 127) + (d.mode == 2 ? 128 : 0)));
    *(u32x4*)(d.WT + (size_t)drow * d.K + k0 + 8 * c) = o; }
  asm volatile("s_waitcnt lgkmcnt(0)" ::: "memory");
}
constexpr int TR_I_IN0 = 16 * 80, TR_I_OUT = 16 * 32, TR_I_GU = 32 * 16 * 16, TR_I_DN = 32 * 8 * 32, TR_I_IN1 = 16 * 48;
constexpr int TR_EARLY = TR_I_IN0 + TR_I_OUT, TR_MOE = 2 * TR_I_GU + TR_I_DN, TR_TOTAL = TR_EARLY + TR_MOE + TR_I_IN1 + TR_I_OUT + TR_MOE;
DI TrDesc tr_desc(const Params& P, int it) {
  unsigned char* ws = P.ws; TrDesc d; int r = it;
  if (r < TR_I_IN0) { d.W = P.in[I_WIN0]; d.gain = P.in[I_ANORM0]; d.WT = (bf16_t*)(ws + WS_WIN0); d.K = 1024; d.N = W0V; d.nvalid = W0V; d.mode = 3; d.nblk = 80; d.item = r; return d; }
  r -= TR_I_IN0;
  if (r < TR_I_OUT) { d.W = P.in[I_WOUT0]; d.gain = nullptr; d.WT = (bf16_t*)(ws + WS_WOUT0); d.K = 1024; d.N = 1024; d.nvalid = 1024; d.mode = 0; d.nblk = 32; d.item = r; return d; }
  r -= TR_I_OUT;
  int L = 0;
  if (r >= TR_MOE) { r -= TR_MOE;
    if (r < TR_I_IN1) { d.W = P.in[I_WIN1]; d.gain = P.in[I_ANORM1]; d.WT = (bf16_t*)(ws + WS_WIN1); d.K = 1024; d.N = W1; d.nvalid = W1; d.mode = 3; d.nblk = 48; d.item = r; return d; }
    r -= TR_I_IN1;
    if (r < TR_I_OUT) { d.W = P.in[I_WOUT1]; d.gain = nullptr; d.WT = (bf16_t*)(ws + WS_WOUT1); d.K = 1024; d.N = 1024; d.nvalid = 1024; d.mode = 0; d.nblk = 32; d.item = r; return d; }
    r -= TR_I_OUT; L = 1; }
  const float* fnorm = P.in[L ? I_FNORM1 : I_FNORM0];
  if (r < 2 * TR_I_GU) { const int up = r >= TR_I_GU; if (up) r -= TR_I_GU; const int e = r >> 8;
    d.W = P.in[up ? (L ? I_WU1 : I_WU0) : (L ? I_WG1 : I_WG0)] + (size_t)e * 1024 * 512; d.gain = fnorm; d.WT = (bf16_t*)(ws + (L ? WS_WGU1 : WS_WGU0)) + (size_t)e * 1024 * 1024;
    d.K = 1024; d.N = 512; d.nvalid = 512; d.mode = up ? 2 : 1; d.nblk = 16; d.item = r & 255; return d; }
  r -= 2 * TR_I_GU;
  { const int e = r >> 8; d.W = P.in[L ? I_WD1 : I_WD0] + (size_t)e * 512 * 1024; d.gain = nullptr; d.WT = (bf16_t*)(ws + (L ? WS_WD1 : WS_WD0)) + (size_t)e * 1024 * 512; d.K = 512; d.N = 1024; d.nvalid = 1024; d.mode = 0; d.nblk = 32; d.item = r & 255; return d; }
}
DI void rms_row_to_bf16(const float* xrow, bf16_t* orow, int lane) {
  const f32x4* xr = (const f32x4*)xrow + lane;
  f32x4 v[4]; float s = 0.f;
#pragma unroll
  for (int j = 0; j < 4; ++j) { v[j] = xr[64 * j]; s += (v[j].x * v[j].x + v[j].y * v[j].y) + (v[j].z * v[j].z + v[j].w * v[j].w); }
  const float rstd = 1.0f / sqrtf(wave_sum(s) * (1.f / DM) + NORM_EPS);
  unsigned long long* o8 = (unsigned long long*)orow + lane;
#pragma unroll
  for (int j = 0; j < 4; ++j) o8[64 * j] = (unsigned long long)pk2(v[j].x * rstd, v[j].y * rstd) | ((unsigned long long)pk2(v[j].z * rstd, v[j].w * rstd) << 32);
}
DI void p0_prologue(const Ctx& F, const Params& P) {
  unsigned char* ws = P.ws; const int lane = lane_id_v(); const int tid = F.wave * 64 + lane;
  LAS float* scr = (LAS float*)(F.lds + F.wave * 16384);
  {
    const int NIT = TR_EARLY;
    int it = F.gw;
    f32x4 ra[8], rb[8];
    TrDesc da, db;
    if (it < NIT) { da = tr_desc(P, it); tr_load(da, lane, ra); }
    while (it < NIT) {
      const int itn = it + F.NGW;
      if (itn < NIT) { db = tr_desc(P, itn); tr_load(db, lane, rb); }
      tr_finish(da, lane, ra, scr);
      if (itn >= NIT) break;
      const int itn2 = itn + F.NGW;
      if (itn2 < NIT) { da = tr_desc(P, itn2); tr_load(da, lane, ra); }
      tr_finish(db, lane, rb, scr);
      it = itn2;
    }
  }
  for (int m = F.gw; m < NTOK; m += F.NGW) rms_row_to_bf16(P.in[I_X] + (size_t)m * DM, (bf16_t*)(ws + WS_XN) + (size_t)m * DM, lane);
  const int gt = blockIdx.x * 512 + tid, NGT = F.G * 512;
  for (int i = gt; i < 512; i += NGT) ((unsigned*)(ws + WS_XN + (size_t)NTOK * DM * 2))[i] = 0u;
  for (int i = gt; i < 128; i += NGT) ((int*)(ws + WS_CTL))[i] = 0;
  for (int i = gt; i < SEQ * 32; i += NGT) {
    const int t = i >> 5, k = i & 31;
    const float inv = (float)exp2(-(double)k * (13.287712379549449 / 32.0));
    const float ang = (float)t * inv;
    const double rev = (double)ang * 0.15915494309189535; const float fr = (float)(rev - rint(rev));
    ((float*)(ws + WS_ROPE))[i] = __builtin_amdgcn_cosf(fr); ((float*)(ws + WS_ROPE))[SEQ * 32 + i] = __builtin_amdgcn_sinf(fr);
  }
  for (int i = gt; i < 2 * 36 * 1024; i += NGT) {
    const int L = i / (36 * 1024), r = i % (36 * 1024), j = r >> 10, k = r & 1023;
    const float g = P.in[L ? I_FNORM1 : I_FNORM0][k];
    float w; if (j < 4) w = P.in[L ? I_WRG1 : I_WRG0][k * 4 + j]; else { const int gg = (j - 4) >> 3, e = (j - 4) & 7; w = P.in[L ? I_WRE1 : I_WRE0][((size_t)gg * 1024 + k) * 8 + e]; }
    w *= g;
    const unsigned hi = pk2(w, 0.f) & 0xffffu; const float lo = w - __uint_as_float(hi << 16);
    bf16_t* base = (bf16_t*)(ws + (L ? WS_WR1 : WS_WR0));
    base[r] = (bf16_t)hi; base[36 * 1024 + r] = (bf16_t)(pk2(lo, 0.f) & 0xffffu);
  }
  for (int i = gt; i < 2 * 36; i += NGT) { const int L = i / 36, j = i % 36; ((float*)(ws + (L ? WS_WR1 : WS_WR0) + 147456))[j] = (j < 4) ? P.in[L ? I_BRG1 : I_BRG0][j] : P.in[L ? I_BRE1 : I_BRE0][j - 4]; }
}

DI u32x4 normrope8(const u32x4 w, const float (&gv)[8], bool do_norm, const f32x4 (&cs)[2], const f32x4 (&sn)[2], int sub, float oscale) {
  float v[8] = {bflo(w.x), bfhi(w.x), bflo(w.y), bfhi(w.y), bflo(w.z), bfhi(w.z), bflo(w.w), bfhi(w.w)};
  if (do_norm) {
    float s = 0.f;
#pragma unroll
    for (int j = 0; j < 8; ++j) s += v[j] * v[j];
    s += __shfl_xor(s, 1); s += __shfl_xor(s, 2); s += __shfl_xor(s, 4);
    const float rstd = 1.0f / sqrtf(s * (1.f / 64.f) + NORM_EPS);
#pragma unroll
    for (int j = 0; j < 8; ++j) v[j] = v[j] * rstd * gv[j];
  }
  const float sg = (sub & 4) ? 1.f : -1.f;
  const float cv[8] = {cs[0].x, cs[0].y, cs[0].z, cs[0].w, cs[1].x, cs[1].y, cs[1].z, cs[1].w};
  const float sv[8] = {sn[0].x, sn[0].y, sn[0].z, sn[0].w, sn[1].x, sn[1].y, sn[1].z, sn[1].w};
  float o[8];
#pragma unroll
  for (int j = 0; j < 8; ++j) { const float pr = __shfl_xor(v[j], 4); o[j] = (v[j] * cv[j] + sg * pr * sv[j]) * oscale; }
  u32x4 r; r.x = pk2(o[0], o[1]); r.y = pk2(o[2], o[3]); r.z = pk2(o[4], o[5]); r.w = pk2(o[6], o[7]);
  return r;
}
struct Tok0 { u32x4 cb, cc[3], ch[3]; bf16_t v; };
DI void p1b_transform0(const Ctx& F, const Params& P) {
  bf16_t* PROJ = (bf16_t*)(P.ws + WS_PROJ); bf16_t* MIX = (bf16_t*)(P.ws + WS_MIX);
  const int lane = lane_id_v();
  float cw[8][3];
#pragma unroll
  for (int j = 0; j < 8; ++j) { const float* w = P.in[I_CONVW] + (8 * lane + j) * 3; cw[j][0] = w[0]; cw[j][1] = w[1]; cw[j][2] = w[2]; }
  auto load = [&](Tok0& T, int m) {
    const int t = m & (SEQ - 1); const bf16_t* row = PROJ + (size_t)m * W0P;
    T.cb = *(const u32x4*)(row + C_CB + 8 * lane); T.v = row[C_V + lane];
#pragma unroll
    for (int d = 0; d < 3; ++d) { const int back = 2 - d; const bf16_t* r2 = row - (size_t)(t >= back ? back : 0) * W0P; T.cc[d] = *(const u32x4*)(r2 + C_CC + 8 * lane); T.ch[d] = *(const u32x4*)(r2 + C_CH + 8 * lane); }
  };
  auto process = [&](const Tok0& T, int m) {
    const int t = m & (SEQ - 1);
    { const int kk = t & 31, st = kk >> 4, rem = kk & 15, hf = (rem >> 2) & 1, j = 4 * (rem >> 3) + (rem & 3);
      const size_t vo = (((((size_t)(m >> 12) * 128 + (t >> 5)) * 2 + st) * 2 + (lane >> 5)) * 64 + hf * 32 + (lane & 31)) * 8 + j;
      ((bf16_t*)(P.ws + WS_VTF))[vo] = T.v; }
    { float u[3][8];
#pragma unroll
      for (int d = 0; d < 3; ++d) { const bool okd = t >= 2 - d; const u32x4 a = T.cc[d], b = T.ch[d];
        u[d][0] = okd ? bflo(a.x) * bflo(b.x) : 0.f; u[d][1] = okd ? bfhi(a.x) * bfhi(b.x) : 0.f; u[d][2] = okd ? bflo(a.y) * bflo(b.y) : 0.f; u[d][3] = okd ? bfhi(a.y) * bfhi(b.y) : 0.f;
        u[d][4] = okd ? bflo(a.z) * bflo(b.z) : 0.f; u[d][5] = okd ? bfhi(a.z) * bfhi(b.z) : 0.f; u[d][6] = okd ? bflo(a.w) * bflo(b.w) : 0.f; u[d][7] = okd ? bfhi(a.w) * bfhi(b.w) : 0.f; }
      const u32x4 cb = T.cb;
      const float cbv[8] = {bflo(cb.x), bfhi(cb.x), bflo(cb.y), bfhi(cb.y), bflo(cb.z), bfhi(cb.z), bflo(cb.w), bfhi(cb.w)};
      float o[8];
#pragma unroll
      for (int j = 0; j < 8; ++j) o[j] = cbv[j] * (u[0][j] * cw[j][0] + u[1][j] * cw[j][1] + u[2][j] * cw[j][2]);
      u32x4 r; r.x = pk2(o[0], o[1]); r.y = pk2(o[2], o[3]); r.z = pk2(o[4], o[5]); r.w = pk2(o[6], o[7]);
      *(u32x4*)(MIX + (size_t)m * DM + 8 * lane) = r; }
  };
  Tok0 A, B;
  int m = F.gw;
  if (m < NTOK) load(A, m);
  while (m < NTOK) {
    const int m1 = m + F.NGW;
    if (m1 < NTOK) load(B, m1);
    process(A, m);
    if (m1 >= NTOK) break;
    const int m2 = m1 + F.NGW;
    if (m2 < NTOK) load(A, m2);
    process(B, m1);
    m = m2;
  }
}

DI unsigned f2key(float f) { const unsigned b = __float_as_uint(f); return b ^ ((unsigned)((int)b >> 31) | 0x80000000u); }
DI s16x4 tr_read(LAS unsigned char* p) { typedef short v4i16_t __attribute__((ext_vector_type(4))); return __builtin_bit_cast(s16x4, __builtin_amdgcn_ds_read_tr16_b64_v4i16((LAS v4i16_t*)p)); }
#define DPP_U(v, ctrl) ((unsigned)__builtin_amdgcn_update_dpp(0, (int)(v), (ctrl), 0xF, 0xF, true))
DI unsigned wave_total_u(unsigned v) {
  v += DPP_U(v, 0xB1); v += DPP_U(v, 0x4E); v += DPP_U(v, 0x124); v += DPP_U(v, 0x128);
  return (unsigned)__builtin_amdgcn_readlane((int)v, 0) + (unsigned)__builtin_amdgcn_readlane((int)v, 16) + (unsigned)__builtin_amdgcn_readlane((int)v, 32) + (unsigned)__builtin_amdgcn_readlane((int)v, 48);
}
DI unsigned wave_maxall_u(unsigned v) {
  v = max(v, DPP_U(v, 0xB1)); v = max(v, DPP_U(v, 0x4E)); v = max(v, DPP_U(v, 0x124)); v = max(v, DPP_U(v, 0x128));
  const unsigned a = (unsigned)__builtin_amdgcn_readlane((int)v, 0), b = (unsigned)__builtin_amdgcn_readlane((int)v, 16), c = (unsigned)__builtin_amdgcn_readlane((int)v, 32), d = (unsigned)__builtin_amdgcn_readlane((int)v, 48);
  return max(max(a, b), max(c, d));
}
DI unsigned lane_prefix(unsigned long long m) { return __builtin_amdgcn_mbcnt_hi((unsigned)(m >> 32), __builtin_amdgcn_mbcnt_lo((unsigned)m, 0u)); }

DI void dsa_phase(const Ctx& F, const Params& P) {
  const bf16_t* PROJ = (const bf16_t*)(P.ws + WS_PROJ); bf16_t* MIX = (bf16_t*)(P.ws + WS_MIX);
  const bf16_t* IKF = (const bf16_t*)(P.ws + WS_IKF); const bf16_t* KF = (const bf16_t*)(P.ws + WS_KF); const bf16_t* VTF = (const bf16_t*)(P.ws + WS_VTF);
  LAS unsigned* sc = (LAS unsigned*)F.lds;
  LAS unsigned* msk32 = (LAS unsigned*)(F.lds + LDS_MISC);
  LAS float* trscr = (LAS float*)(F.lds + 67584 + F.wave * 8448);
  int trk = 0;
  LAS float* part = (LAS float*)F.lds;
  const int w = F.wave;
  float cshift; { const int l0 = lane_id_v(); cshift = 8.f * wave_max(fabsf(P.in[I_QN0][l0])) * wave_max(fabsf(P.in[I_KN0][l0])) * 1.02f; }
  const float c1 = 0.125f * LOG2E, c2 = __builtin_amdgcn_readfirstlane(__float_as_int(cshift * LOG2E)) == 0 ? 0.f : __int_as_float(__builtin_amdgcn_readfirstlane(__float_as_int(cshift * LOG2E)));
#ifdef TIMEDSA
  unsigned long long tacc = 0ull, tmark = 0ull;
#define DSA_T0(n) if (TIMEDSA == (n)) tmark = __builtin_amdgcn_s_memrealtime();
#define DSA_T1(n) if (TIMEDSA == (n)) tacc += __builtin_amdgcn_s_memrealtime() - tmark;
#else
#define DSA_T0(n)
#define DSA_T1(n)
#endif
  for (int v = blockIdx.x; v < 8192; v += gridDim.x) {
    const int cidx = v & 255, jj = v >> 8, b = jj >> 1, tb = (jj & 1) ? (511 - cidx) : cidx;
    const int t0 = tb * 8; const size_t rb = (size_t)b * SEQ;
    const int ntile = (t0 + 8 + 31) >> 5;
    const int lane = lane_id_v();
    const int c = lane & 31, half = lane >> 5, qc = c >> 2, hx = c & 3;
    DSA_T0(1)
    {
      bf16x8 af[4];
      { const bf16_t* ap = PROJ + (rb + t0 + qc) * W0P + C_IQ + hx * 64 + 8 * half;
#pragma unroll
        for (int ks = 0; ks < 4; ++ks) af[ks] = *(const bf16x8*)(ap + 16 * ks); }
      float wq[4][4];
#pragma unroll
      for (int g = 0; g < 4; ++g) { const u32x2 ww = *(const u32x2*)(PROJ + (rb + t0 + 2 * g + half) * W0P + C_IW);
        wq[g][0] = bflo(ww.x) * 0.0625f; wq[g][1] = bfhi(ww.x) * 0.0625f; wq[g][2] = bflo(ww.y) * 0.0625f; wq[g][3] = bfhi(ww.y) * 0.0625f; }
      const bf16_t* fb = IKF + ((size_t)b * 128 * 4 * 64 + lane) * 8;
      const int Tlast = ntile - 1;
      auto ld1 = [&](bf16x8 (&d)[4], int T) { const int Tc = T < Tlast ? T : Tlast;
#pragma unroll
        for (int ks = 0; ks < 4; ++ks) d[ks] = *(const bf16x8*)(fb + (size_t)(Tc * 4 + ks) * 512); };
      auto cp1 = [&](const bf16x8 (&bfr)[4], int T) {
        f32x16 acc;
#pragma unroll
        for (int i = 0; i < 16; ++i) acc[i] = 0.f;
#pragma unroll
        for (int ks = 0; ks < 4; ++ks) acc = __builtin_amdgcn_mfma_f32_32x32x16_bf16(af[ks], bfr[ks], acc, 0, 0, 0);
        const int s = 32 * T + c;
        const bool edge = 32 * T + 31 > t0;
#pragma unroll
        for (int g = 0; g < 4; ++g) {
          float sv = __builtin_fmaf(wq[g][3], fmaxf(acc[4 * g + 3], 0.f), __builtin_fmaf(wq[g][2], fmaxf(acc[4 * g + 2], 0.f), __builtin_fmaf(wq[g][1], fmaxf(acc[4 * g + 1], 0.f), __builtin_fmaf(wq[g][0], fmaxf(acc[4 * g], 0.f), 0.f))));
          const int ql = 2 * g + half;
          unsigned key = f2key(sv);
          if (edge) key = (s <= t0 + ql) ? key : 0u;
          sc[ql * 4096 + s] = key;
        } };
      bf16x8 r0[4], r1[4], r2[4], r3[4];
      if (w < ntile) { ld1(r0, w); ld1(r1, w + 8); ld1(r2, w + 16); ld1(r3, w + 24); }
      for (int T = w; T < ntile; T += 32) {
        cp1(r0, T); ld1(r0, T + 32); __builtin_amdgcn_sched_barrier(0);
        if (T + 8 < ntile) { cp1(r1, T + 8); ld1(r1, T + 40); __builtin_amdgcn_sched_barrier(0); }
        if (T + 16 < ntile) { cp1(r2, T + 16); ld1(r2, T + 48); __builtin_amdgcn_sched_barrier(0); }
        if (T + 24 < ntile) { cp1(r3, T + 24); ld1(r3, T + 56); __builtin_amdgcn_sched_barrier(0); }
      }
    }
    __syncthreads();
    asm volatile("" ::: "memory"); __builtin_amdgcn_sched_barrier(0);
    DSA_T1(1)
    DSA_T0(2)
    {
      const int lane = lane_id_v();
      const int t = t0 + w;
      const int nch = (t >> 10) + 1;
      unsigned u[64];
#pragma unroll
      for (int ch = 0; ch < 4; ++ch) {
        if (ch < nch) {
#pragma unroll
          for (int k2 = 0; k2 < 16; ++k2) { const int j = 16 * ch + k2; const unsigned x = sc[w * 4096 + 64 * j + lane]; u[j] = (lane <= t - 64 * j) ? x : 0u; }
        } else {
#pragma unroll
          for (int k2 = 0; k2 < 16; ++k2) u[16 * ch + k2] = 0u;
        }
      }
      unsigned thr = 0u; int sthr = -1;
      if (t >= 256) {
        unsigned prefix = 0u; bool exact = false; int startbit = 31;
        {
          unsigned mx = 0u;
#pragma unroll
          for (int ch = 0; ch < 4; ++ch) if (ch < nch) {
#pragma unroll
            for (int k2 = 0; k2 < 16; ++k2) mx = max(mx, u[16 * ch + k2]);
          }
          const unsigned trial = wave_maxall_u(mx) & 0xFF800000u;
          unsigned cnt = 0u;
#pragma unroll
          for (int ch = 0; ch < 4; ++ch) if (ch < nch) {
#pragma unroll
            for (int k2 = 0; k2 < 16; ++k2) cnt += (u[16 * ch + k2] >= trial) ? 1u : 0u;
          }
          cnt = wave_total_u(cnt);
          if (cnt >= 256u) { prefix = trial; startbit = 22; exact = (cnt == 256u); }
        }
        if (!exact) {
          for (int bit = startbit; bit >= 0; --bit) {
            const unsigned trial = prefix | (1u << bit);
            unsigned cnt = 0u;
#pragma unroll
            for (int ch = 0; ch < 4; ++ch) if (ch < nch) {
#pragma unroll
              for (int k2 = 0; k2 < 16; ++k2) cnt += (u[16 * ch + k2] >= trial) ? 1u : 0u;
            }
            cnt = wave_total_u(cnt);
            if (cnt >= 256u) prefix = trial;
            if (cnt == 256u) { exact = true; break; }
          }
        }
        if (exact) thr = prefix - 1u;
        else {
          thr = prefix; unsigned cgt = 0u;
#pragma unroll
          for (int j = 0; j < 64; ++j) cgt += (u[j] > thr) ? 1u : 0u;
          cgt = wave_total_u(cgt);
          const int need = 256 - (int)cgt;
          int tbf = 0;
#pragma unroll
          for (int ch = 0; ch < 4; ++ch) if (ch < nch) {
#pragma unroll
            for (int k2 = 0; k2 < 16; ++k2) { const int j = 16 * ch + k2; const bool eq = u[j] == thr; const unsigned long long m = __ballot(eq);
              const unsigned long long hit = __ballot(eq && (tbf + (int)lane_prefix(m) == need - 1));
              if (hit) sthr = 64 * j + __builtin_ctzll(hit);
              tbf += __builtin_popcountll(m); }
          }
        }
      }
#pragma unroll
      for (int ch = 0; ch < 4; ++ch) {
        if (ch < nch) {
#pragma unroll
          for (int k2 = 0; k2 < 16; ++k2) { const int j = 16 * ch + k2; const bool sel = (u[j] > thr) || (u[j] == thr && lane <= sthr - 64 * j); const unsigned long long m = __ballot(sel);
            if (lane == 0) *(LAS u32x2*)(msk32 + w * 128 + 2 * j) = (u32x2){(unsigned)m, (unsigned)(m >> 32)}; }
        } else if (lane < 16) *(LAS u32x2*)(msk32 + w * 128 + 2 * (16 * ch + lane)) = (u32x2){0u, 0u};
      }
    }
    __syncthreads();
    asm volatile("" ::: "memory"); __builtin_amdgcn_sched_barrier(0);
    DSA_T1(2)
    {
      const int tit = TR_EARLY + F.gw + trk * F.NGW;
      if (tit < TR_TOTAL) { const int tl = lane_id_v(); const TrDesc td = tr_desc(P, tit); f32x4 tr8[8]; tr_load(td, tl, tr8); tr_finish(td, tl, tr8, trscr); }
      ++trk;
    }
    asm volatile("" ::: "memory"); __builtin_amdgcn_sched_barrier(0);
    DSA_T0(3)
    {
      const int lane = lane_id_v(); const int c = lane & 31, half = lane >> 5, qc = c >> 2, hx = c & 3;
      const int cbw = w & 1, kq = w >> 1;
      const int tq = t0 + qc;
      bf16x8 qf[4];
      { const bf16_t* qp = PROJ + (rb + tq) * W0P + C_Q + (4 * cbw + hx) * 64 + 8 * half; const float qs = 0.125f * LOG2E;
#pragma unroll
        for (int ks = 0; ks < 4; ++ks) { const u32x4 qv = *(const u32x4*)(qp + 16 * ks);
          u32x4 qo; qo.x = pk2(bflo(qv.x) * qs, bfhi(qv.x) * qs); qo.y = pk2(bflo(qv.y) * qs, bfhi(qv.y) * qs); qo.z = pk2(bflo(qv.z) * qs, bfhi(qv.z) * qs); qo.w = pk2(bflo(qv.w) * qs, bfhi(qv.w) * qs);
          qf[ks] = __builtin_bit_cast(bf16x8, qo); } }
      f32x16 o0, o1;
#pragma unroll
      for (int i = 0; i < 16; ++i) { o0[i] = 0.f; o1[i] = 0.f; }
      float lsum = 0.f;
      const bf16_t* kb = KF + ((size_t)b * 128 * 4 * 64 + lane) * 8;
      const bf16_t* vb = VTF + ((size_t)b * 128 * 4 * 64 + lane) * 8;
      const int Tlast = ntile - 1;
      auto ld2 = [&](bf16x8 (&kf)[4], bf16x8 (&vf)[4], int T) { const int Tc = T < Tlast ? T : Tlast;
#pragma unroll
        for (int ks = 0; ks < 4; ++ks) { kf[ks] = *(const bf16x8*)(kb + (size_t)(Tc * 4 + ks) * 512); vf[ks] = *(const bf16x8*)(vb + (size_t)(Tc * 4 + ks) * 512); } };
      auto cp2 = [&](const bf16x8 (&kf)[4], const bf16x8 (&vf)[4], int T) {
        const unsigned mw = msk32[qc * 128 + T] >> (4 * half);
        f32x16 s;
#pragma unroll
        for (int i = 0; i < 16; ++i) s[i] = -c2;
#pragma unroll
        for (int ks = 0; ks < 4; ++ks) s = __builtin_amdgcn_mfma_f32_32x32x16_bf16(kf[ks], qf[ks], s, 0, 0, 0);
#pragma unroll
        for (int r = 0; r < 16; ++r) {
          int mb; asm("v_bfe_i32 %0, %1, %2, 1" : "=v"(mb) : "v"(mw), "n"((r & 3) + 8 * (r >> 2)));
          const float p = __int_as_float(__float_as_int(__builtin_amdgcn_exp2f(s[r])) & mb); s[r] = p; lsum += p; }
#pragma unroll
        for (int st = 0; st < 2; ++st) {
          u32x4 pw; pw.x = pk2(s[8 * st], s[8 * st + 1]); pw.y = pk2(s[8 * st + 2], s[8 * st + 3]); pw.z = pk2(s[8 * st + 4], s[8 * st + 5]); pw.w = pk2(s[8 * st + 6], s[8 * st + 7]);
          const bf16x8 pf = __builtin_bit_cast(bf16x8, pw);
          o0 = __builtin_amdgcn_mfma_f32_32x32x16_bf16(vf[2 * st], pf, o0, 0, 0, 0);
          o1 = __builtin_amdgcn_mfma_f32_32x32x16_bf16(vf[2 * st + 1], pf, o1, 0, 0, 0);
        } };
      bf16x8 ka[4], va[4], kb2[4], vb2[4];
      if (kq < ntile) { ld2(ka, va, kq); ld2(kb2, vb2, kq + 4); }
      for (int T = kq; T < ntile; T += 8) {
        cp2(ka, va, T); ld2(ka, va, T + 8); __builtin_amdgcn_sched_barrier(0);
        if (T + 4 < ntile) { cp2(kb2, vb2, T + 4); ld2(kb2, vb2, T + 12); __builtin_amdgcn_sched_barrier(0); }
      }
      lsum += __shfl_xor(lsum, 32);
      LAS float* pw_ = part + w * (33 * 64) + lane;
#pragma unroll
      for (int i = 0; i < 16; ++i) { pw_[i * 64] = o0[i]; pw_[(16 + i) * 64] = o1[i]; }
      pw_[32 * 64] = lsum;
      __syncthreads();
      float acc8[8]; float lt = 0.f;
#pragma unroll
      for (int i = 0; i < 8; ++i) acc8[i] = 0.f;
#pragma unroll
      for (int k4 = 0; k4 < 4; ++k4) { const LAS float* pr = part + (2 * k4 + cbw) * (33 * 64) + lane;
#pragma unroll
        for (int i = 0; i < 8; ++i) acc8[i] += pr[(8 * kq + i) * 64];
        lt += pr[32 * 64]; }
      const float inv = 1.0f / lt;
      bf16_t* op = MIX + (rb + tq) * DM + 512 + (4 * cbw + hx) * 64 + 32 * (kq >> 1) + 16 * (kq & 1) + 4 * half;
      u32x2 w0; w0.x = pk2(acc8[0] * inv, acc8[1] * inv); w0.y = pk2(acc8[2] * inv, acc8[3] * inv); *(u32x2*)op = w0;
      u32x2 w1; w1.x = pk2(acc8[4] * inv, acc8[5] * inv); w1.y = pk2(acc8[6] * inv, acc8[7] * inv); *(u32x2*)(op + 8) = w1;
    }
    __syncthreads();
    DSA_T1(3)
  }
  for (;; ++trk) { const int tit = TR_EARLY + F.gw + trk * F.NGW; if (tit >= TR_TOTAL) break; const int tl = lane_id_v(); const TrDesc td = tr_desc(P, tit); f32x4 tr8[8]; tr_load(td, tl, tr8); tr_finish(td, tl, tr8, trscr); }
#ifdef TIMEDSA
  if (blockIdx.x == 0 && w == 0 && lane_id_v() == 0) { unsigned long long* tsw = (unsigned long long*)(P.ws + WS_CTL + 4096); tsw[0] = 0ull; tsw[1] = tacc; }
#endif
}

DI void route_lane(const float (&lg)[36], int& x0, int& x1, float& g0, float& g1) {
  int gs = 0; float gm = lg[0];
#pragma unroll
  for (int j = 1; j < 4; ++j) { const bool gt = lg[j] > gm; gm = gt ? lg[j] : gm; gs = gt ? j : gs; }
  float z = 0.f;
#pragma unroll
  for (int j = 0; j < 4; ++j) z += __expf(lg[j] - gm);
  const float pg = 1.0f / z;
  float le[8];
#pragma unroll
  for (int i = 0; i < 8; ++i) le[i] = gs == 0 ? lg[4 + i] : (gs == 1 ? lg[12 + i] : (gs == 2 ? lg[20 + i] : lg[28 + i]));
  int i0e = 0; float m0 = le[0];
#pragma unroll
  for (int i = 1; i < 8; ++i) { const bool gt = le[i] > m0; m0 = gt ? le[i] : m0; i0e = gt ? i : i0e; }
  int i1e = -1; float m1 = -INFINITY;
#pragma unroll
  for (int i = 0; i < 8; ++i) { const bool gt = (i != i0e) && (le[i] > m1); m1 = gt ? le[i] : m1; i1e = gt ? i : i1e; }
  const float e1 = __expf(m1 - m0);
  g0 = pg / (1.0f + e1); g1 = pg * e1 / (1.0f + e1);
  x0 = gs * 8 + i0e; x1 = gs * 8 + i1e;
}
DI void router_phase(const Ctx& F, const Params& P, int L) {
  unsigned char* ws = P.ws;
  constexpr int WSTR = 2064;
  constexpr int L_WH = 0, L_WL = 36 * WSTR, L_ZERO = 2 * 36 * WSTR, L_CNT = L_ZERO + WSTR, L_ASG = L_CNT + 256, L_RS = L_ASG + 4096;
  static_assert(L_ASG + 4096 <= LDS_BYTES - 16, "router LDS map");
  LAS unsigned char* lds = F.lds;
  LAS int* lcnt = (LAS int*)(lds + L_CNT); LAS int* lbase = lcnt + 32;
  LAS i32x4* lasg = (LAS i32x4*)(lds + L_ASG);
  const bf16_t* wsrc = (const bf16_t*)(ws + (L ? WS_WR1 : WS_WR0));
  const float* bias = (const float*)(ws + (L ? WS_WR1 : WS_WR0) + 147456);
  const int lane = lane_id_v(); const int w = F.wave; const int tid = w * 64 + lane;
  int* cnt = (int*)(ws + WS_CTL) + L * 64; int* list = (int*)(ws + WS_LIST); float* RSL = (float*)(ws + WS_RSL);
  int4* asg = (int4*)(ws + WS_ASG); float2* asgg = (float2*)(ws + WS_ASGG);
  const bf16_t* XB = (const bf16_t*)(ws + WS_XB);
  const int niter = (NTOK + F.NGW - 1) / F.NGW;
  for (int i0 = 0; i0 < niter; i0 += 32) {
    for (int i = tid; i < 2 * 36 * 128; i += 512) { const int row = i >> 7, ch = i & 127; *(LAS u32x4*)(lds + row * WSTR + ch * 16) = *(const u32x4*)(wsrc + row * 1024 + ch * 8); }
    for (int i = tid; i < 128; i += 512) *(LAS u32x4*)(lds + L_ZERO + i * 16) = (u32x4){0u, 0u, 0u, 0u};
    if (tid < 32) lcnt[tid] = 0;
    __syncthreads();
    const int c = lane & 31, half = lane >> 5;
    const int it_r = i0 + c; const int m_r = F.gw + it_r * F.NGW; const bool ok_r = (it_r < niter) && (m_r < NTOK);
    const bf16_t* arow = XB + (size_t)(ok_r ? m_r : F.gw) * DM + 8 * half;
    const int b0off = c * WSTR + 16 * half;
    const int b1off = (c < 4 ? (32 + c) * WSTR : (L_ZERO - L_WH)) + 16 * half;
    f32x16 d0, d1, dx;
#pragma unroll
    for (int i = 0; i < 16; ++i) { d0[i] = 0.f; d1[i] = 0.f; dx[i] = 0.f; }
    bf16x8 ar[8];
#pragma unroll
    for (int j = 0; j < 8; ++j) ar[j] = *(const bf16x8*)(arow + 16 * j);
    for (int k8 = 0; k8 < 64; k8 += 8) {
#pragma unroll
      for (int j = 0; j < 8; ++j) {
        const int ks = k8 + j;
        const bf16x8 a_cur = ar[j];
        const bf16x8 h0 = *(const LAS bf16x8*)(lds + L_WH + b0off + 32 * ks), l0 = *(const LAS bf16x8*)(lds + L_WL + b0off + 32 * ks);
        const bf16x8 h1 = *(const LAS bf16x8*)(lds + L_WH + b1off + 32 * ks), l1 = *(const LAS bf16x8*)(lds + (c < 4 ? L_WL : L_WH) + b1off + 32 * ks);
        d0 = __builtin_amdgcn_mfma_f32_32x32x16_bf16(a_cur, h0, d0, 0, 0, 0); d0 = __builtin_amdgcn_mfma_f32_32x32x16_bf16(a_cur, l0, d0, 0, 0, 0);
        d1 = __builtin_amdgcn_mfma_f32_32x32x16_bf16(a_cur, h1, d1, 0, 0, 0); d1 = __builtin_amdgcn_mfma_f32_32x32x16_bf16(a_cur, l1, d1, 0, 0, 0);
        dx = __builtin_amdgcn_mfma_f32_32x32x16_bf16(a_cur, a_cur, dx, 0, 0, 0);
        if (k8 + 8 < 64) ar[j] = *(const bf16x8*)(arow + 16 * (ks + 8));
      }
    }
    __syncthreads();
    LAS float* tw = (LAS float*)(lds + w * 8192);
#pragma unroll
    for (int i = 0; i < 16; ++i) { const int row = (i & 3) + 8 * (i >> 2) + 4 * half; tw[row * 40 + c] = d0[i]; if (c < 4) tw[row * 40 + 32 + c] = d1[i]; if (row == c) tw[row * 40 + 36] = dx[i]; }
    asm volatile("s_waitcnt lgkmcnt(0)" ::: "memory");
    if (lane < 32) {
      const int it_t = i0 + lane; const int m = F.gw + it_t * F.NGW;
      if (it_t < niter && m < NTOK) {
        const LAS f32x4* tr4 = (const LAS f32x4*)(tw + lane * 40);
        float raw[40];
#pragma unroll
        for (int q = 0; q < 10; ++q) { const f32x4 v4 = tr4[q]; raw[4 * q] = v4.x; raw[4 * q + 1] = v4.y; raw[4 * q + 2] = v4.z; raw[4 * q + 3] = v4.w; }
        const float rstd = 1.0f / sqrtf(raw[36] * (1.f / DM) + NORM_EPS);
        float lg[36];
#pragma unroll
        for (int j = 0; j < 36; ++j) lg[j] = raw[j] * rstd + bias[j];
        int x0, x1; float g0, g1; route_lane(lg, x0, x1, g0, g1);
        const int r0 = __hip_atomic_fetch_add(lcnt + x0, 1, __ATOMIC_RELAXED, __HIP_MEMORY_SCOPE_WORKGROUP);
        const int r1 = __hip_atomic_fetch_add(lcnt + x1, 1, __ATOMIC_RELAXED, __HIP_MEMORY_SCOPE_WORKGROUP);
        lasg[lane * 8 + w] = (i32x4){x0, x1, r0, r1}; asgg[m] = make_float2(g0, g1);
        tw[lane * 40 + 37] = rstd;
      }
    }
    __syncthreads();
    if (tid < 32) lbase[tid] = atomicAdd(cnt + tid, lcnt[tid]);
    __syncthreads();
    if (tid < 256) {
      const int ii = tid >> 3, wv = tid & 7; const int m = (int)blockIdx.x * 8 + wv + (i0 + ii) * F.NGW;
      if (i0 + ii < niter && m < NTOK) {
        const i32x4 a = lasg[tid]; const int r0 = lbase[a.x] + a.z, r1 = lbase[a.y] + a.w;
        const float rs = ((const LAS float*)(lds + wv * 8192))[ii * 40 + 37];
        list[a.x * 65536 + r0] = m; list[a.y * 65536 + r1] = m; asg[m] = make_int4(a.x, a.y, r0, r1);
        RSL[a.x * 65536 + r0] = rs; RSL[a.y * 65536 + r1] = rs;
      }
    }
    __syncthreads();
  }
}
DI void moe_setup(const Ctx& F, const Params& P, int L) {
  LAS int* pb = (LAS int*)(F.lds + LDS_MISC); LAS int* cl = pb + 64;
  const int* cnt = (const int*)(P.ws + WS_CTL) + L * 64;
  const int tid = F.wave * 64 + lane_id_v();
  __syncthreads();
  if (tid < 32) cl[tid] = cnt[tid];
  __syncthreads();
  if (tid == 0) { int a = 0; for (int e = 0; e < NEXP; ++e) { pb[e] = a; a += (cl[e] + 255) >> 8; } pb[NEXP] = a; }
  __syncthreads();
}
DI void combine_phase(const Ctx& F, const Params& P, int L, bool with_norm) {
  unsigned char* ws = P.ws;
  moe_setup(F, P, L);
  const LAS int* pb = (const LAS int*)(F.lds + LDS_MISC);
  const int4* asg = (const int4*)(ws + WS_ASG); const float2* asgg = (const float2*)(ws + WS_ASGG);
  const bf16_t* Y = (const bf16_t*)(ws + WS_PROJ); bf16_t* XN = (bf16_t*)(ws + WS_XN);
  const int lane = lane_id_v();
  for (int m = F.gw; m < NTOK; m += F.NGW) {
    const int4 a = asg[m]; const float2 gg = asgg[m];
    const size_t row0 = (size_t)pb[a.x] * 256 + a.z, row1 = (size_t)pb[a.y] * 256 + a.w;
    u32x2* xr = (u32x2*)((bf16_t*)(ws + WS_XB) + (size_t)m * DM) + lane;
    f32x4* orow = (f32x4*)(P.out + (size_t)m * DM) + lane;
    const u32x2* y0 = (const u32x2*)(Y + row0 * DM) + lane; const u32x2* y1 = (const u32x2*)(Y + row1 * DM) + lane;
    f32x4 v[4]; float ss = 0.f;
#pragma unroll
    for (int j = 0; j < 4; ++j) { const u32x2 xb = xr[64 * j]; f32x4 x = (f32x4){bflo(xb.x), bfhi(xb.x), bflo(xb.y), bfhi(xb.y)}; const u32x2 a0 = y0[64 * j], a1 = y1[64 * j];
      x.x += gg.x * bflo(a0.x) + gg.y * bflo(a1.x); x.y += gg.x * bfhi(a0.x) + gg.y * bfhi(a1.x); x.z += gg.x * bflo(a0.y) + gg.y * bflo(a1.y); x.w += gg.x * bfhi(a0.y) + gg.y * bfhi(a1.y);
      if (with_norm) { u32x2 o; o.x = pk2(x.x, x.y); o.y = pk2(x.z, x.w); xr[64 * j] = o; } else orow[64 * j] = x;
      v[j] = x; ss += (x.x * x.x + x.y * x.y) + (x.z * x.z + x.w * x.w); }
    if (with_norm) {
      const float rstd = 1.0f / sqrtf(wave_sum(ss) * (1.f / DM) + NORM_EPS);
      unsigned long long* o8 = (unsigned long long*)(XN + (size_t)m * DM) + lane;
#pragma unroll
      for (int j = 0; j < 4; ++j) o8[64 * j] = (unsigned long long)pk2(v[j].x * rstd, v[j].y * rstd) | ((unsigned long long)pk2(v[j].z * rstd, v[j].w * rstd) << 32);
    }
  }
}
template <class Bar> DI void moe_gemms(const Ctx& F, const Params& P, int L, const Bar& gbar) {
  unsigned char* ws = P.ws;
  const int vcu = (F.G % 8 == 0) ? ((int)(blockIdx.x % 8) * (F.G / 8) + (int)(blockIdx.x / 8)) : (int)blockIdx.x;
  moe_setup(F, P, L);
  {
    pg8::MoeSched<true> S{(const LAS int*)(F.lds + LDS_MISC), (const LAS int*)(F.lds + LDS_MISC) + 64, (const int*)(ws + WS_LIST), (const char*)(ws + (L ? WS_WGU1 : WS_WGU0)), F.G, vcu, 1024};
    pg8::EpiSwiGLU E{(bf16_t*)(ws + WS_H), (const float*)(ws + WS_RSL), (const LAS int*)(F.lds + LDS_MISC) + 64};
    pg8::gemm_phase<pg8::EpiSwiGLU, pg8::MoeSched<true>, true>(F.lds, F.wave, (const char*)(ws + WS_XB), 1024, S, E);
  }
  xcd_barrier(gbar);
  {
    pg8::MoeSched<false> S{(const LAS int*)(F.lds + LDS_MISC), (const LAS int*)(F.lds + LDS_MISC) + 64, nullptr, (const char*)(ws + (L ? WS_WD1 : WS_WD0)), F.G, vcu, 512};
    pg8::EpiBf16 E{(bf16_t*)(ws + WS_PROJ), DM};
    pg8::gemm_phase<pg8::EpiBf16, pg8::MoeSched<false>, true>(F.lds, F.wave, (const char*)(ws + WS_H), 512, S, E);
  }
}

struct Tok1 { u32x4 q0, q1, k; f32x4 cs[2], sn[2]; };
DI void p8b_transform1(const Ctx& F, const Params& P) {
  bf16_t* QKV = (bf16_t*)(P.ws + WS_PROJ);
  const float* cosT = (const float*)(P.ws + WS_ROPE); const float* sinT = cosT + SEQ * 32;
  const int lane = lane_id_v(), sub = lane & 7, grp = lane >> 3;
  float gq[8], gk[8];
#pragma unroll
  for (int j = 0; j < 8; ++j) { gq[j] = P.in[I_QN1][8 * sub + j]; gk[j] = P.in[I_KN1][8 * sub + j]; }
  const int kcol = 1024 + (grp & 3) * 64 + sub * 8;
  auto load = [&](Tok1& T, int m) {
    const int t = m & (SEQ - 1); const bf16_t* row = QKV + (size_t)m * W1;
    T.q0 = *(const u32x4*)(row + grp * 64 + sub * 8); T.q1 = *(const u32x4*)(row + 512 + grp * 64 + sub * 8); T.k = *(const u32x4*)(row + kcol);
    const f32x4* cp = (const f32x4*)(cosT + t * 32 + 8 * (sub & 3)); const f32x4* sp = (const f32x4*)(sinT + t * 32 + 8 * (sub & 3));
    T.cs[0] = cp[0]; T.cs[1] = cp[1]; T.sn[0] = sp[0]; T.sn[1] = sp[1];
  };
  auto process = [&](const Tok1& T, int m) {
    bf16_t* row = QKV + (size_t)m * W1;
    *(u32x4*)(row + grp * 64 + sub * 8) = normrope8(T.q0, gq, true, T.cs, T.sn, sub, 0.125f * LOG2E);
    *(u32x4*)(row + 512 + grp * 64 + sub * 8) = normrope8(T.q1, gq, true, T.cs, T.sn, sub, 0.125f * LOG2E);
    const u32x4 r = normrope8(T.k, gk, true, T.cs, T.sn, sub, 1.f);
    if (grp < 4) *(u32x4*)(row + kcol) = r;
  };
  Tok1 A, B;
  int m = F.gw;
  if (m < NTOK) load(A, m);
  while (m < NTOK) {
    const int m1 = m + F.NGW;
    if (m1 < NTOK) load(B, m1);
    process(A, m);
    if (m1 >= NTOK) break;
    const int m2 = m1 + F.NGW;
    if (m2 < NTOK) load(A, m2);
    process(B, m1);
    m = m2;
  }
}

DI void dil_phase(const Ctx& F, const Params& P) {
  const bf16_t* QKV = (const bf16_t*)(P.ws + WS_PROJ); bf16_t* MIX = (bf16_t*)(P.ws + WS_MIX);
  LAS unsigned char* kst = F.lds + F.wave * 8192;
  LAS unsigned char* vst = kst + 4096;
  float cshift; { const int l0 = lane_id_v(); cshift = 8.f * wave_max(fabsf(P.in[I_QN1][l0])) * wave_max(fabsf(P.in[I_KN1][l0])) * 1.02f; }
  const float c2 = cshift * LOG2E;
  const int gwv = ((F.G % 8 == 0) ? ((int)(blockIdx.x % 8) * (F.G / 8) + (int)(blockIdx.x / 8)) : (int)blockIdx.x) * 8 + F.wave;
  const int lane = lane_id_v(), c = lane & 31, half = lane >> 5, qi = c >> 2, gq = c & 3;
  const int q4 = (lane & 15) >> 2, p4 = lane & 3, blk = (lane >> 4) & 1;
  const int lrow = lane >> 3, lch = lane & 7;
  const int woff = lrow * 128 + ((lch ^ (lrow & 7)) << 4);
  const int kra = c * 128 + ((half ^ (c & 7)) << 4);
  const int r1 = 4 * half + q4;
  const int tra0 = r1 * 128 + (((2 * blk + (p4 >> 1)) ^ (r1 & 7)) << 4) + (p4 & 1) * 8;
  for (int it = gwv; it < 32768; it += F.NGW) {
    const int r = it & 15, tile = (it >> 4) & 31, kh = (it >> 9) & 3, b = it >> 11;
    const size_t rb = (size_t)b * SEQ; const int tmax = tile * 128 + r + 112, tq = tile * 128 + r + 16 * qi;
    bf16x8 qf[4];
    { const bf16_t* qp = QKV + (rb + tq) * W1 + (4 * kh + gq) * 64 + 8 * half;
#pragma unroll
      for (int ks = 0; ks < 4; ++ks) qf[ks] = *(const bf16x8*)(qp + 16 * ks); }
    f32x16 o0, o1;
#pragma unroll
    for (int i = 0; i < 16; ++i) { o0[i] = 0.f; o1[i] = 0.f; }
    float lsum = 0.f;
    const char* sbase = (const char*)(QKV + rb * W1 + 1024 + kh * 64) ;
    constexpr int RP = W1 * 2;
    u32x4 gk[4], gv[4];
    auto issue = [&](int ti) { const int sh = ti < 8 ? 0 : (ti < 13 ? 2 : 4), T = ti < 8 ? ti : (ti < 13 ? ti - 8 : ti - 13);
      const int v0 = (tmax - ((32 * T + lrow) << sh)) * RP + lch * 16; const int dv = (8 << sh) * RP;
#pragma unroll
      for (int i = 0; i < 4; ++i) { int vo = v0 - i * dv; vo = vo < lch * 16 ? lch * 16 : vo;
        const char* rp = sbase + (unsigned)vo; gk[i] = *(const u32x4*)rp; gv[i] = *(const u32x4*)(rp + 512); } };
    issue(0);
#pragma unroll 1
    for (int ti = 0; ti < 18; ++ti) {
      const int sh = ti < 8 ? 0 : (ti < 13 ? 2 : 4), T = ti < 8 ? ti : (ti < 13 ? ti - 8 : ti - 13);
#pragma unroll
      for (int i = 0; i < 4; ++i) { *(LAS u32x4*)(kst + woff + i * 1024) = gk[i]; *(LAS u32x4*)(vst + woff + i * 1024) = gv[i]; }
      if (ti + 1 < 18) issue(ti + 1);
      asm volatile("" ::: "memory");
      f32x16 s;
#pragma unroll
      for (int i = 0; i < 16; ++i) s[i] = -c2;
#pragma unroll
      for (int ks = 0; ks < 4; ++ks) { const bf16x8 kf = *(const LAS bf16x8*)(kst + (kra ^ (ks << 5))); s = __builtin_amdgcn_mfma_f32_32x32x16_bf16(kf, qf[ks], s, 0, 0, 0); }
      unsigned m32;
      { const int ei = (16 >> sh) * (7 - qi); const int nmax = tmax >> sh; const int hn = (ei + 128 < nmax) ? ei + 128 : nmax;
        const int lo = ei - 32 * T - 4 * half, hi = hn - 32 * T - 4 * half;
        const int loc = lo < 0 ? 0 : lo, hic = hi > 31 ? 31 : hi;
        m32 = (loc <= hic) ? ((0xFFFFFFFFu >> (31 - hic)) & (0xFFFFFFFFu << loc)) : 0u; }
#pragma unroll
      for (int reg = 0; reg < 16; ++reg) { const int mb = __builtin_amdgcn_sbfe((int)m32, (reg & 3) + 8 * (reg >> 2), 1);
        const float p = __int_as_float(__float_as_int(__builtin_amdgcn_exp2f(s[reg])) & mb); s[reg] = p; lsum += p; }
#pragma unroll
      for (int st = 0; st < 2; ++st) {
        u32x4 pw; pw.x = pk2(s[8 * st], s[8 * st + 1]); pw.y = pk2(s[8 * st + 2], s[8 * st + 3]); pw.z = pk2(s[8 * st + 4], s[8 * st + 5]); pw.w = pk2(s[8 * st + 6], s[8 * st + 7]);
        const bf16x8 pf = __builtin_bit_cast(bf16x8, pw);
#pragma unroll
        for (int dblk = 0; dblk < 2; ++dblk) {
          const int ta = (tra0 ^ (dblk << 6)) + st * 2048;
          const s16x4 lo4 = tr_read(vst + ta), hi4 = tr_read(vst + ta + 1024);
          const bf16x8 vf = __builtin_shufflevector(lo4, hi4, 0, 1, 2, 3, 4, 5, 6, 7);
          if (dblk == 0) o0 = __builtin_amdgcn_mfma_f32_32x32x16_bf16(vf, pf, o0, 0, 0, 0); else o1 = __builtin_amdgcn_mfma_f32_32x32x16_bf16(vf, pf, o1, 0, 0, 0);
        }
      }
      asm volatile("" ::: "memory");
    }
    lsum += __shfl_xor(lsum, 32);
    const float inv = 1.0f / lsum;
    bf16_t* op = MIX + (rb + tq) * DM + (4 * kh + gq) * 64 + 4 * half;
#pragma unroll
    for (int gI = 0; gI < 4; ++gI) {
      u32x2 w0; w0.x = pk2(o0[4 * gI] * inv, o0[4 * gI + 1] * inv); w0.y = pk2(o0[4 * gI + 2] * inv, o0[4 * gI + 3] * inv); *(u32x2*)(op + 8 * gI) = w0;
      u32x2 w1; w1.x = pk2(o1[4 * gI] * inv, o1[4 * gI + 1] * inv); w1.y = pk2(o1[4 * gI + 2] * inv, o1[4 * gI + 3] * inv); *(u32x2*)(op + 32 + 8 * gI) = w1;
    }
  }
}

#define XB_TMO      128
#define XB_XCNT(j)  (256  + 64 * (j))
#define XB_XSUB(j)  (1280 + 64 * (j))
#define XB_XGEN(j)  (2304 + 64 * (j))
#define XB_TOP      3328
#define XB_TOPGEN   3392
#define XCD_BAR_WORDS 3456
#define XB_SPIN_CAP (1u << 18)

__device__ __forceinline__ unsigned xb_ld(unsigned* p)              { return __hip_atomic_load(p, __ATOMIC_RELAXED, __HIP_MEMORY_SCOPE_AGENT); }
__device__ __forceinline__ unsigned xb_add(unsigned* p, unsigned v) { return __hip_atomic_fetch_add(p, v, __ATOMIC_RELAXED, __HIP_MEMORY_SCOPE_AGENT); }
__device__ __forceinline__ unsigned xb_xcc_id() { return (unsigned)__builtin_amdgcn_s_getreg((3 << 11) | 20) & 0xFu; }
#define XB_SPIN(cond, bar) do { unsigned _sp = 0; while (cond) { __builtin_amdgcn_s_sleep(1); \
    if ((++_sp & 255u) == 0u) { if (xb_ld(&(bar)[XB_TMO])) break; if (_sp > XB_SPIN_CAP) { atomicAdd(&(bar)[XB_TMO], 1u); break; } } } } while (0)

struct XcdBarrier {
    unsigned* bar; unsigned x;
    volatile LAS unsigned* st;
};

__device__ __forceinline__ XcdBarrier xcd_barrier_post(unsigned* bar, volatile LAS unsigned* st) {
    XcdBarrier b; b.bar = bar; b.x = xb_xcc_id(); b.st = st;
    if (threadIdx.x == 0) (void)xb_add(&bar[XB_XCNT(b.x)], 1u);
    return b;
}
__device__ __forceinline__ void xcd_barrier_complete(unsigned* bar, unsigned x, unsigned& nloc, unsigned& nx) {
    const unsigned G = gridDim.x * gridDim.y * gridDim.z;
    unsigned sum, cnt, mine, sp = 0u;
    for (;;) {
        sum = 0u; cnt = 0u; mine = 0u;
#pragma unroll
        for (unsigned j = 0; j < 16; ++j) { const unsigned c = xb_ld(&bar[XB_XCNT(j)]); sum += c; cnt += (c > 0u) ? 1u : 0u; mine = (j == x) ? c : mine; }
        if (sum == G) break;
        __builtin_amdgcn_s_sleep(1);
        if ((++sp & 255u) == 0u) { if (xb_ld(&bar[XB_TMO])) break; if (sp > XB_SPIN_CAP) { atomicAdd(&bar[XB_TMO], 1u); break; } }
    }
    nloc = mine > 0u ? mine : 1u; nx = cnt > 0u ? cnt : 1u;
}

__device__ __forceinline__ void xcd_barrier(const XcdBarrier& b) {
    asm volatile("s_waitcnt vmcnt(0)" ::: "memory");
    __syncthreads();
    if (threadIdx.x == 0) {
        unsigned* bar = b.bar;
        __builtin_amdgcn_s_waitcnt(0);
        unsigned nloc = b.st[0], nx = b.st[1];
        if (nloc == 0u) { xcd_barrier_complete(bar, b.x, nloc, nx); b.st[0] = nloc; b.st[1] = nx; }
        const unsigned old = xb_add(&bar[XB_XSUB(b.x)], 1u);
        const unsigned gen = old / nloc;
        if (old + 1u == (gen + 1u) * nloc) {
            __builtin_amdgcn_fence(__ATOMIC_RELEASE, "agent");
            asm volatile("s_waitcnt vmcnt(0)" ::: "memory");
            const unsigned og = xb_add(&bar[XB_TOP], 1u);
            const unsigned tg = og / nx;
            if (og + 1u == (tg + 1u) * nx) xb_add(&bar[XB_TOPGEN], 1u);
            else XB_SPIN(xb_ld(&bar[XB_TOPGEN]) == tg, bar);
            __builtin_amdgcn_fence(__ATOMIC_ACQUIRE, "agent");
            xb_add(&bar[XB_XGEN(b.x)], 1u);
            asm volatile("s_waitcnt vmcnt(0)" ::: "memory");
        } else {
            XB_SPIN(xb_ld(&bar[XB_XGEN(b.x)]) == gen, bar);
            __builtin_amdgcn_fence(__ATOMIC_ACQUIRE, "agent");
            asm volatile("s_waitcnt vmcnt(0)" ::: "memory");
        }
    }
    __syncthreads();
}


__global__ void __launch_bounds__(512, 2) fwd_megakernel(Params P) {
  extern __shared__ __attribute__((aligned(16))) unsigned char lds_raw[];
  cg::grid_group grid = cg::this_grid();
  Ctx F; F.lds = (LAS unsigned char*)lds_raw; F.wave = __builtin_amdgcn_readfirstlane((int)threadIdx.x >> 6);
  F.G = gridDim.x; F.gw = blockIdx.x * 8 + F.wave; F.NGW = F.G * 8;
  unsigned char* ws = P.ws;
  volatile LAS unsigned* xst = (volatile LAS unsigned*)(F.lds + LDS_BYTES - 16);
  if (threadIdx.x < 2) xst[threadIdx.x] = 0u;
  unsigned* xbar_words = (unsigned*)(ws + WS_CTL + 65536);
  __syncthreads();
  XcdBarrier xbar = xcd_barrier_post(xbar_words, xst);
#define GRID_BAR() xcd_barrier(xbar)

#ifndef PHMASK
#define PHMASK 0xFFFFFFFFu
#endif
#define PH(n) if ((PHMASK >> (n)) & 1u)
#if defined(TIMEDSA) && !defined(TIMEPH)
#define TIMEPH 99
#define TIMEN 1
#endif
#ifdef TIMEPH
  unsigned long long* tsw = (unsigned long long*)(ws + WS_CTL + 4096);
#define TS_BEGIN(n) if ((n) >= TIMEPH && (n) < TIMEPH + TIMEN && (n) == TIMEPH && blockIdx.x == 0 && threadIdx.x == 0) tsw[0] = __builtin_amdgcn_s_memrealtime();
#define TS_END(n) if ((n) == TIMEPH + TIMEN - 1 && blockIdx.x == 0 && threadIdx.x == 0) tsw[1] = __builtin_amdgcn_s_memrealtime();
#else
#define TS_BEGIN(n)
#define TS_END(n)
#endif
  TS_BEGIN(0)
  PH(0) p0_prologue(F, P);
  if (P.ws == nullptr) grid.sync();
  GRID_BAR();
  TS_END(0)
  TS_BEGIN(1)
  PH(1) {
    pg8::DenseSched S; S.init(NTOK, W0P, 1024, ws + WS_WIN0, F.G, (int)blockIdx.x);
    pg8::EpiProj0 E{(bf16_t*)(ws + WS_PROJ), (bf16_t*)(ws + WS_KF), (bf16_t*)(ws + WS_IKF), P.in[I_QN0], P.in[I_KN0], (const float*)(ws + WS_ROPE), (const float*)(ws + WS_ROPE) + SEQ * 32};
    pg8::gemm_phase<pg8::EpiProj0, pg8::DenseSched, true>(F.lds, F.wave, (const char*)(ws + WS_XN), 1024, S, E);
  }
  GRID_BAR();
  TS_END(1)
  TS_BEGIN(2)
  PH(2) p1b_transform0(F, P);
  GRID_BAR();
  TS_END(2)
  TS_BEGIN(3)
  PH(3) dsa_phase(F, P);
  GRID_BAR();
  TS_END(3)
  TS_BEGIN(4)
  PH(4) {
    pg8::DenseSched S; S.init(NTOK, 1024, 1024, ws + WS_WOUT0, F.G, (int)blockIdx.x);
    pg8::EpiResB<true> E{P.in[I_X], (bf16_t*)(ws + WS_XB), DM};
    pg8::gemm_phase<pg8::EpiResB<true>, pg8::DenseSched, true>(F.lds, F.wave, (const char*)(ws + WS_MIX), 1024, S, E);
  }
  GRID_BAR();
  TS_END(4)
  TS_BEGIN(5)
  PH(5) router_phase(F, P, 0);
  GRID_BAR();
  TS_END(5)
  TS_BEGIN(6)
  PH(6) moe_gemms(F, P, 0, xbar);
  GRID_BAR();
  TS_END(6)
  TS_BEGIN(7)
  PH(7) combine_phase(F, P, 0, true);
  GRID_BAR();
  TS_END(7)
  TS_BEGIN(8)
  PH(8) {
    pg8::DenseSched S; S.init(NTOK, W1, 1024, ws + WS_WIN1, F.G, (int)blockIdx.x);
    pg8::EpiQKV1 E{(bf16_t*)(ws + WS_PROJ), P.in[I_QN1], P.in[I_KN1], (const float*)(ws + WS_ROPE), (const float*)(ws + WS_ROPE) + SEQ * 32};
    pg8::gemm_phase<pg8::EpiQKV1, pg8::DenseSched, true>(F.lds, F.wave, (const char*)(ws + WS_XN), 1024, S, E);
  }
  GRID_BAR();
  TS_END(8)
  TS_BEGIN(10)
  PH(10) dil_phase(F, P);
  GRID_BAR();
  TS_END(10)
  TS_BEGIN(11)
  PH(11) {
    pg8::DenseSched S; S.init(NTOK, 1024, 1024, ws + WS_WOUT1, F.G, (int)blockIdx.x);
    pg8::EpiResB<false> E{ws + WS_XB, (bf16_t*)(ws + WS_XB), DM};
    pg8::gemm_phase<pg8::EpiResB<false>, pg8::DenseSched, true>(F.lds, F.wave, (const char*)(ws + WS_MIX), 1024, S, E);
  }
  GRID_BAR();
  TS_END(11)
  TS_BEGIN(12)
  PH(12) router_phase(F, P, 1);
  GRID_BAR();
  TS_END(12)
  TS_BEGIN(13)
  PH(13) moe_gemms(F, P, 1, xbar);
  GRID_BAR();
  TS_END(13)
  TS_BEGIN(14)
  PH(14) combine_phase(F, P, 1, false);
#ifdef TIMEPH
  GRID_BAR();
  TS_END(14)
  GRID_BAR();
  { const unsigned long long dt = (tsw[1] - tsw[0]) * 4ull; const unsigned long long t0 = __builtin_amdgcn_s_memrealtime();
    while (__builtin_amdgcn_s_memrealtime() - t0 < dt) __builtin_amdgcn_s_sleep(32); }
#endif
}

extern "C" void kernel_launch(void* const* d_in, const int* in_sizes, int n_in, void* d_out, int out_size, void* d_ws, size_t ws_size, hipStream_t stream) {
  static int grid_blocks = 0;
  if (!grid_blocks) {
    if (n_in != 28 || out_size != NTOK * DM || ws_size < WS_END) { fprintf(stderr, "kernel_launch: unexpected shapes (n_in %d out %d ws %zu)\n", n_in, out_size, ws_size); grid_blocks = -1; return; }
    int dev = 0, cus = 0, per_cu = 0;
    (void)hipGetDevice(&dev);
    (void)hipDeviceGetAttribute(&cus, hipDeviceAttributeMultiprocessorCount, dev);
    (void)hipFuncSetAttribute((const void*)fwd_megakernel, hipFuncAttributeMaxDynamicSharedMemorySize, LDS_BYTES);
    (void)hipOccupancyMaxActiveBlocksPerMultiprocessor(&per_cu, (const void*)fwd_megakernel, 512, LDS_BYTES);
    if (per_cu < 1) per_cu = 1;
    grid_blocks = cus * per_cu;
  }
  if (grid_blocks < 0) return;
  Params p{};
  for (int i = 0; i < 28; ++i) p.in[i] = (const float*)d_in[i];
  p.out = (float*)d_out; p.ws = (unsigned char*)d_ws;
  (void)hipMemsetAsync((unsigned char*)d_ws + WS_CTL + 65536, 0, XCD_BAR_WORDS * 4, stream);
  void* args[] = {&p};
  hipError_t e = hipLaunchCooperativeKernel((const void*)fwd_megakernel, dim3(grid_blocks), dim3(512), args, LDS_BYTES, stream);
  if (e != hipSuccess) fprintf(stderr, "cooperative launch failed: %s (grid %d)\n", hipGetErrorString(e), grid_blocks);
}
```

```cpp
#include <hip/hip_runtime.h>
#include <hip/hip_cooperative_groups.h>
#include <cstdio>
#include <cstdint>
namespace cg = cooperative_groups;

#define LAS __attribute__((address_space(3)))
#define DI __device__ __forceinline__
typedef unsigned short bf16_t;
typedef short bf16x8 __attribute__((ext_vector_type(8)));
typedef short s16x4 __attribute__((ext_vector_type(4)));
typedef float f32x2 __attribute__((ext_vector_type(2)));
typedef float f32x4 __attribute__((ext_vector_type(4)));
typedef float f32x16 __attribute__((ext_vector_type(16)));
typedef unsigned u32x2 __attribute__((ext_vector_type(2)));
typedef unsigned u32x4 __attribute__((ext_vector_type(4)));
typedef int i32x4 __attribute__((ext_vector_type(4)));
typedef __bf16 bf16x2_t __attribute__((ext_vector_type(2)));

constexpr int NTOK = 65536, DM = 1024, SEQ = 4096, NBATCH = 16;
constexpr int W0P = 2560, W0V = 2500;
constexpr int W1 = 1536;
constexpr int C_CB = 0, C_CC = 512, C_CH = 1024, C_Q = 1536, C_K = 2048, C_V = 2112, C_IQ = 2176, C_IK = 2432, C_IW = 2496;
constexpr int NEXP = 32, DEXP = 512;
constexpr int MAXROWS = 139264;
constexpr float NORM_EPS = 1e-6f;
constexpr float LOG2E = 1.4426950408889634f;

constexpr size_t MiB = 1u << 20;
constexpr size_t WS_CTL = 0;
constexpr size_t WS_ROPE = 1 * MiB;
constexpr size_t WS_WR0 = 2 * MiB, WS_WR1 = 2 * MiB + 256 * 1024;
constexpr size_t WS_WIN0 = 3 * MiB, WS_WOUT0 = 8 * MiB, WS_WIN1 = 10 * MiB, WS_WOUT1 = 13 * MiB;
constexpr size_t WS_WGU0 = 16 * MiB, WS_WD0 = 80 * MiB, WS_WGU1 = 112 * MiB, WS_WD1 = 176 * MiB;
constexpr size_t WS_XN = 208 * MiB;
constexpr size_t WS_MIX = 337 * MiB;
constexpr size_t WS_H = 337 * MiB;
constexpr size_t WS_XB = 473 * MiB;
constexpr size_t WS_PROJ = 601 * MiB;
constexpr size_t WS_LIST = 921 * MiB;
constexpr size_t WS_ASG = 929 * MiB;
constexpr size_t WS_ASGG = 930 * MiB;
constexpr size_t WS_IKF = 931 * MiB, WS_KF = 939 * MiB, WS_VTF = 947 * MiB;
constexpr size_t WS_RSL = 955 * MiB;
constexpr size_t WS_END = 963 * MiB;

constexpr int LDS_BYTES = 155648;
constexpr int LDS_LIST = 131072;
constexpr int LDS_MISC = 131072 + 16384;

DI unsigned pk2(float lo, float hi) { f32x2 v = {lo, hi}; bf16x2_t b = __builtin_convertvector(v, bf16x2_t); return __builtin_bit_cast(unsigned, b); }
DI float bflo(unsigned w) { return __uint_as_float(w << 16); }
DI float bfhi(unsigned w) { return __uint_as_float(w & 0xffff0000u); }
DI float bf1(bf16_t h) { return __uint_as_float((unsigned)h << 16); }
DI int opaque(int x) { asm volatile("" : "+v"(x)); return x; }
DI int lane_id_v() { int l; asm volatile("v_mbcnt_lo_u32_b32 %0, -1, 0\n\tv_mbcnt_hi_u32_b32 %0, -1, %0" : "=v"(l)); return l; }
DI float wave_sum(float v) {
#pragma unroll
  for (int o = 1; o < 64; o <<= 1) v += __shfl_xor(v, o);
  return v;
}
DI float wave_max(float v) {
#pragma unroll
  for (int o = 1; o < 64; o <<= 1) v = fmaxf(v, __shfl_xor(v, o));
  return v;
}
DI unsigned wave_sum_u(unsigned v) {
#pragma unroll
  for (int o = 1; o < 64; o <<= 1) v += (unsigned)__shfl_xor((int)v, o);
  return v;
}

namespace pg8 {
constexpr int BM = 256, BK = 64, HALF = 128, HTB = HALF * BK * 2, STAGE_BYTES = 8 * HTB, NXCD = 8, WGM = 8;
DI int lds_byte(int r, int c) { const int st = (r >> 4) * 2 + (c >> 5), rr = r & 15, cc = c & 31, ob = rr * 64 + cc * 2; return st * 1024 + (ob ^ (((ob >> 9) & 1) << 5)); }
DI void stage_rc(int b, int& R, int& C) { const int st = b / 1024, sb = b % 1024, swz = sb ^ (((sb >> 9) & 1) << 5); R = (st >> 1) * 16 + swz / 64; C = (st & 1) * 32 + (swz % 64) / 2; }
DI int perm32(int rho) { const int n = rho >> 4, i = rho & 15; return 8 * (i >> 2) + 4 * n + (i & 3); }

struct Unit { const char* b; int p0, p1, p2, p3; };

struct EpiBf16 {
  static constexpr bool PERM = true;
  bf16_t* O; int ldc;
  DI void operator()(const f32x4 (&acc)[2][2][4][2], const Unit& u, int wr, int wc, int fr, int fq) const {
    const int row0 = u.p0 + wr * 64 + fr, col0 = u.p1 + wc * 32 + 8 * fq;
#pragma unroll
    for (int ai = 0; ai < 2; ++ai)
#pragma unroll
      for (int m = 0; m < 4; ++m) { bf16_t* rowp = O + (size_t)(row0 + ai * HALF + m * 16) * ldc + col0;
#pragma unroll
        for (int bj = 0; bj < 2; ++bj) { const f32x4 v0 = acc[ai][bj][m][0], v1 = acc[ai][bj][m][1];
          u32x4 w; w.x = pk2(v0[0], v0[1]); w.y = pk2(v0[2], v0[3]); w.z = pk2(v1[0], v1[1]); w.w = pk2(v1[2], v1[3]);
          *(u32x4*)(rowp + bj * HALF) = w; } }
  }
};
template <bool BASE_F32> struct EpiResB {
  static constexpr bool PERM = true;
  const void* base; bf16_t* out; int ldc;
  DI void operator()(const f32x4 (&acc)[2][2][4][2], const Unit& u, int wr, int wc, int fr, int fq) const {
    const int row0 = u.p0 + wr * 64 + fr, col0 = u.p1 + wc * 32 + 8 * fq;
#pragma unroll
    for (int ai = 0; ai < 2; ++ai)
#pragma unroll
      for (int m = 0; m < 4; ++m) { const size_t off = (size_t)(row0 + ai * HALF + m * 16) * ldc + col0;
#pragma unroll
        for (int bj = 0; bj < 2; ++bj) { f32x4 v0 = acc[ai][bj][m][0], v1 = acc[ai][bj][m][1];
          if (BASE_F32) { const float* bp = (const float*)base + off + bj * HALF; v0 = v0 + *(const f32x4*)bp; v1 = v1 + *(const f32x4*)(bp + 4); }
          else { const u32x4 b = *(const u32x4*)((const bf16_t*)base + off + bj * HALF);
            v0 = v0 + (f32x4){bflo(b.x), bfhi(b.x), bflo(b.y), bfhi(b.y)}; v1 = v1 + (f32x4){bflo(b.z), bfhi(b.z), bflo(b.w), bfhi(b.w)}; }
          u32x4 w; w.x = pk2(v0[0], v0[1]); w.y = pk2(v0[2], v0[3]); w.z = pk2(v1[0], v1[1]); w.w = pk2(v1[2], v1[3]);
          *(u32x4*)(out + off + bj * HALF) = w; } }
  }
};
struct EpiQKV1 {
  static constexpr bool PERM = true;
  bf16_t* O; const float* qg; const float* kg; const float* cosT; const float* sinT;
  DI void operator()(const f32x4 (&acc)[2][2][4][2], const Unit& u, int wr, int wc, int fr, int fq) const {
    const int tilec = u.p1 >> 8;
    const int row0 = u.p0 + wr * 64 + fr, col0 = u.p1 + wc * 64 + 8 * fq;
    if (tilec == 5) {
#pragma unroll
      for (int ai = 0; ai < 2; ++ai)
#pragma unroll
        for (int m = 0; m < 4; ++m) { bf16_t* rowp = O + (size_t)(row0 + ai * HALF + m * 16) * W1 + col0;
#pragma unroll
          for (int bj = 0; bj < 2; ++bj) { const f32x4 v0 = acc[ai][bj][m][0], v1 = acc[ai][bj][m][1];
            u32x4 w; w.x = pk2(v0[0], v0[1]); w.y = pk2(v0[2], v0[3]); w.z = pk2(v1[0], v1[1]); w.w = pk2(v1[2], v1[3]); *(u32x4*)(rowp + 32 * bj) = w; } }
      return;
    }
    const float* gp = (tilec == 4 ? kg : qg) + 8 * fq; const float osc = tilec == 4 ? 1.f : 0.125f * LOG2E;
    float g0[8], g1[8];
#pragma unroll
    for (int i = 0; i < 8; ++i) { g0[i] = gp[i]; g1[i] = gp[32 + i]; }
#pragma unroll
    for (int ai = 0; ai < 2; ++ai)
#pragma unroll
      for (int m = 0; m < 4; ++m) {
        const int row = row0 + ai * HALF + m * 16; const int t = row & (SEQ - 1);
        const f32x4 a0 = acc[ai][0][m][0], a1 = acc[ai][0][m][1], b0 = acc[ai][1][m][0], b1 = acc[ai][1][m][1];
        float x1[8] = {a0[0], a0[1], a0[2], a0[3], a1[0], a1[1], a1[2], a1[3]}, x2[8] = {b0[0], b0[1], b0[2], b0[3], b1[0], b1[1], b1[2], b1[3]};
        float ss = 0.f;
#pragma unroll
        for (int i = 0; i < 8; ++i) ss += x1[i] * x1[i] + x2[i] * x2[i];
        ss += __shfl_xor(ss, 16); ss += __shfl_xor(ss, 32);
        const float rstd = 1.0f / sqrtf(ss * (1.f / 64.f) + NORM_EPS);
        const f32x4* cp = (const f32x4*)(cosT + t * 32 + 8 * fq); const f32x4* sp = (const f32x4*)(sinT + t * 32 + 8 * fq);
        const f32x4 c0 = cp[0], c1 = cp[1], s0 = sp[0], s1 = sp[1];
        const float cv[8] = {c0[0], c0[1], c0[2], c0[3], c1[0], c1[1], c1[2], c1[3]}, sv[8] = {s0[0], s0[1], s0[2], s0[3], s1[0], s1[1], s1[2], s1[3]};
        float o1[8], o2[8];
#pragma unroll
        for (int i = 0; i < 8; ++i) { const float y1 = x1[i] * rstd * g0[i], y2 = x2[i] * rstd * g1[i]; o1[i] = (y1 * cv[i] - y2 * sv[i]) * osc; o2[i] = (y1 * sv[i] + y2 * cv[i]) * osc; }
        bf16_t* rowp = O + (size_t)row * W1 + col0;
        u32x4 w; w.x = pk2(o1[0], o1[1]); w.y = pk2(o1[2], o1[3]); w.z = pk2(o1[4], o1[5]); w.w = pk2(o1[6], o1[7]); *(u32x4*)rowp = w;
        w.x = pk2(o2[0], o2[1]); w.y = pk2(o2[2], o2[3]); w.z = pk2(o2[4], o2[5]); w.w = pk2(o2[6], o2[7]); *(u32x4*)(rowp + 32) = w;
      }
  }
};
struct EpiProj0 {
  static constexpr bool PERM = true;
  bf16_t* O; bf16_t* KFo; bf16_t* IKFo; const float* qg; const float* kg; const float* cosT; const float* sinT;
  DI void operator()(const f32x4 (&acc)[2][2][4][2], const Unit& u, int wr, int wc, int fr, int fq) const {
    const int grp64 = (u.p1 >> 6) + wc;
    const int row0 = u.p0 + wr * 64 + fr, col0 = u.p1 + wc * 64 + 8 * fq;
    const bool rope = (grp64 >= 24 && grp64 <= 32) || (grp64 >= 34 && grp64 <= 38);
    if (!rope) {
#pragma unroll
      for (int ai = 0; ai < 2; ++ai)
#pragma unroll
        for (int m = 0; m < 4; ++m) { bf16_t* rowp = O + (size_t)(row0 + ai * HALF + m * 16) * W0P + col0;
#pragma unroll
          for (int bj = 0; bj < 2; ++bj) { const f32x4 v0 = acc[ai][bj][m][0], v1 = acc[ai][bj][m][1];
            u32x4 w; w.x = pk2(v0[0], v0[1]); w.y = pk2(v0[2], v0[3]); w.z = pk2(v1[0], v1[1]); w.w = pk2(v1[2], v1[3]); *(u32x4*)(rowp + 32 * bj) = w; } }
      return;
    }
    const bool norm = grp64 <= 32;
    const float* gp = (grp64 == 32 ? kg : qg) + 8 * fq;
    float g0[8], g1[8];
#pragma unroll
    for (int i = 0; i < 8; ++i) { g0[i] = norm ? gp[i] : 1.f; g1[i] = norm ? gp[32 + i] : 1.f; }
    bf16_t* frag = grp64 == 32 ? KFo : (grp64 == 38 ? IKFo : nullptr);
#pragma unroll
    for (int ai = 0; ai < 2; ++ai)
#pragma unroll
      for (int m = 0; m < 4; ++m) {
        const int row = row0 + ai * HALF + m * 16; const int t = row & (SEQ - 1);
        const f32x4 a0 = acc[ai][0][m][0], a1 = acc[ai][0][m][1], b0 = acc[ai][1][m][0], b1 = acc[ai][1][m][1];
        float x1[8] = {a0[0], a0[1], a0[2], a0[3], a1[0], a1[1], a1[2], a1[3]}, x2[8] = {b0[0], b0[1], b0[2], b0[3], b1[0], b1[1], b1[2], b1[3]};
        float ss = 0.f;
#pragma unroll
        for (int i = 0; i < 8; ++i) ss += x1[i] * x1[i] + x2[i] * x2[i];
        ss += __shfl_xor(ss, 16); ss += __shfl_xor(ss, 32);
        const float rstd = norm ? 1.0f / sqrtf(ss * (1.f / 64.f) + NORM_EPS) : 1.f;
        const f32x4* cp = (const f32x4*)(cosT + t * 32 + 8 * fq); const f32x4* sp = (const f32x4*)(sinT + t * 32 + 8 * fq);
        const f32x4 c0 = cp[0], c1 = cp[1], s0 = sp[0], s1 = sp[1];
        const float cv[8] = {c0[0], c0[1], c0[2], c0[3], c1[0], c1[1], c1[2], c1[3]}, sv[8] = {s0[0], s0[1], s0[2], s0[3], s1[0], s1[1], s1[2], s1[3]};
        float o1[8], o2[8];
#pragma unroll
        for (int i = 0; i < 8; ++i) { const float y1 = x1[i] * rstd * g0[i], y2 = x2[i] * rstd * g1[i]; o1[i] = y1 * cv[i] - y2 * sv[i]; o2[i] = y1 * sv[i] + y2 * cv[i]; }
        u32x4 w1, w2; w1.x = pk2(o1[0], o1[1]); w1.y = pk2(o1[2], o1[3]); w1.z = pk2(o1[4], o1[5]); w1.w = pk2(o1[6], o1[7]);
        w2.x = pk2(o2[0], o2[1]); w2.y = pk2(o2[2], o2[3]); w2.z = pk2(o2[4], o2[5]); w2.w = pk2(o2[6], o2[7]);
        if (frag) {
          const size_t fo = ((((size_t)(row >> 12) * 128 + (t >> 5)) * 4 + (fq >> 1)) * 64 + (fq & 1) * 32 + (t & 31)) * 8;
          *(u32x4*)(frag + fo) = w1; *(u32x4*)(frag + fo + 2 * 64 * 8) = w2;
        } else { bf16_t* rowp = O + (size_t)row * W0P + col0; *(u32x4*)rowp = w1; *(u32x4*)(rowp + 32) = w2; }
      }
  }
};
struct EpiResF32 {
  static constexpr bool PERM = false;
  const float* base; float* out; int ldc;
  DI void operator()(const f32x4 (&acc)[2][2][4][2], const Unit& u, int wr, int wc, int fr, int fq) const {
    const int row0 = u.p0 + wr * 64 + fr, col0 = u.p1 + wc * 32 + 4 * fq;
#pragma unroll
    for (int ai = 0; ai < 2; ++ai)
#pragma unroll
      for (int m = 0; m < 4; ++m) { const size_t off = (size_t)(row0 + ai * HALF + m * 16) * ldc + col0;
#pragma unroll
        for (int bj = 0; bj < 2; ++bj)
#pragma unroll
          for (int n = 0; n < 2; ++n) { const f32x4 bs = *(const f32x4*)(base + off + bj * HALF + n * 16); *(f32x4*)(out + off + bj * HALF + n * 16) = bs + acc[ai][bj][m][n]; } }
  }
};
DI float silu_mul(float g, float u) { return g * u * __builtin_amdgcn_rcpf(1.0f + __builtin_amdgcn_exp2f(-g * LOG2E)); }
struct EpiSwiGLU {
  static constexpr bool PERM = true;
  bf16_t* H; const float* RSL; const LAS int* cnt;
  DI void operator()(const f32x4 (&acc)[2][2][4][2], const Unit& u, int wr, int wc, int fr, int fq) const {
    const int row0 = u.p0 + wr * 64 + fr, col0 = u.p1 + wc * 32 + 8 * fq; const int ce = __builtin_amdgcn_readfirstlane(cnt[u.p2]);
#pragma unroll
    for (int ai = 0; ai < 2; ++ai)
#pragma unroll
      for (int m = 0; m < 4; ++m) { bf16_t* rowp = H + (size_t)(row0 + ai * HALF + m * 16) * DEXP + col0;
        const int lrow = u.p3 * BM + wr * 64 + fr + ai * HALF + m * 16; const float rs = (lrow < ce) ? RSL[u.p2 * 65536 + lrow] : 0.f;
        const f32x4 g0 = acc[ai][0][m][0] * rs, g1 = acc[ai][0][m][1] * rs, u0 = acc[ai][1][m][0] * rs, u1 = acc[ai][1][m][1] * rs;
        u32x4 w; w.x = pk2(silu_mul(g0[0], u0[0]), silu_mul(g0[1], u0[1])); w.y = pk2(silu_mul(g0[2], u0[2]), silu_mul(g0[3], u0[3]));
        w.z = pk2(silu_mul(g1[0], u1[0]), silu_mul(g1[1], u1[1])); w.w = pk2(silu_mul(g1[2], u1[2]), silu_mul(g1[3], u1[3]));
        *(u32x4*)rowp = w; }
  }
};

struct DenseSched {
  static constexpr bool NEXT_IN_LDS = false;
  int nM, nN, nwg, G, c, K; const char* Bt;
  DI void init(int M, int N, int K_, const void* Bt_, int G_, int c_) { nM = M / BM; nN = N / BM; nwg = nM * nN; G = G_; c = c_; K = K_; Bt = (const char*)Bt_; }
  DI bool next(int i, Unit& u) const {
    const long L = (long)i * G + c; if (L >= nwg) return false;
    int wgid = (int)L; { const int q = nwg / NXCD, r = nwg % NXCD, xcd = wgid % NXCD, off = wgid / NXCD; wgid = (xcd < r ? xcd * (q + 1) : r * (q + 1) + (xcd - r) * q) + off; }
    const int nig = WGM * nN, gid = wgid / nig, fm = gid * WGM, gsz = (nM - fm) < WGM ? (nM - fm) : WGM;
    const int pm = fm + ((wgid % nig) % gsz), pn = (wgid % nig) / gsz;
    u.p0 = pm * BM; u.p1 = pn * BM; u.p2 = 0; u.p3 = 0; u.b = Bt + (size_t)pn * BM * K * 2; return true;
  }
  DI void a_off(const Unit& u, const int (&R)[2], const int (&C)[2], unsigned (&o)[2][2]) const {
#pragma unroll
    for (int h = 0; h < 2; ++h)
#pragma unroll
      for (int i = 0; i < 2; ++i) o[h][i] = (unsigned)((u.p0 + h * HALF + R[i]) * K + C[i]) * 2u;
  }
};
template <bool GATHER> struct MoeSched {
  static constexpr bool NEXT_IN_LDS = GATHER;
  const LAS int* pb; const LAS int* cnt; const int* list; const char* W; int G, c, K;
  DI bool next(int i, Unit& u) const {
    const int L = i * G + c; const int total = __builtin_amdgcn_readfirstlane(pb[NEXP]) * 4; if (L >= total) return false;
    const int rbg = L >> 2, pn = L & 3; int e = 0;
    for (int j = 1; j < NEXP; ++j) e = (__builtin_amdgcn_readfirstlane(pb[j]) <= rbg) ? j : e;
    u.p0 = rbg * BM; u.p1 = pn * (GATHER ? 128 : 256); u.p2 = e; u.p3 = rbg - __builtin_amdgcn_readfirstlane(pb[e]);
    u.b = W + (size_t)(e * 1024 + pn * 256) * K * 2; return true;
  }
  DI void a_off(const Unit& u, const int (&R)[2], const int (&C)[2], unsigned (&o)[2][2]) const {
    if (GATHER) {
      const int ce = __builtin_amdgcn_readfirstlane(cnt[u.p2]);
#pragma unroll
      for (int h = 0; h < 2; ++h)
#pragma unroll
        for (int i = 0; i < 2; ++i) { const int row = u.p3 * BM + h * HALF + R[i]; const int tok = (row < ce) ? list[u.p2 * 65536 + row] : 0; o[h][i] = (unsigned)(tok * K + C[i]) * 2u; }
    } else {
#pragma unroll
      for (int h = 0; h < 2; ++h)
#pragma unroll
        for (int i = 0; i < 2; ++i) o[h][i] = (unsigned)((u.p0 + h * HALF + R[i]) * K + C[i]) * 2u;
    }
  }
};

template <class Epi, class Sched, bool ALIGN_EPI>
DI void gemm_phase(LAS unsigned char* lds, const int wave_id, const char* gA, const int K, const Sched& S, const Epi& E) {
  const int lane = lane_id_v(), wid = wave_id, tid = wid * 64 + lane, wr = wid >> 2, wc = wid & 3, fr = lane & 15, fq = lane >> 4;
  const int nt = K / BK;
  unsigned voffB[2];
  { int R, C; stage_rc(tid * 16, R, C);
    const int Rb = Epi::PERM ? ((R & ~31) + perm32(R & 31)) : R; voffB[0] = (unsigned)(Rb * K + C) * 2u; voffB[1] = voffB[0] + (unsigned)(64 * K * 2); }
#define PG8_RC(Rp, Cp) int Rp[2], Cp[2]; { int R_, C_; stage_rc(opaque(tid) * 16, R_, C_); Rp[0] = R_; Cp[0] = C_; Rp[1] = R_ + 64; Cp[1] = C_; }
  const size_t kstep = (size_t)(BK * 2);
  const size_t hstep = (size_t)HALF * K * 2;
  const unsigned ldsw = (unsigned)wid * 1024u;
  const int aoff = lds_byte(wr * 64 + fr, fq * 8), boff = lds_byte(wc * 32 + fr, fq * 8);
#define PG8_SA(b, h) (((b) * 2 + (h)) * HTB)
#define PG8_SB(b, h) ((4 + (b) * 2 + (h)) * HTB)
#define PG8_STAGE_B(bufoff, gbase) do { _Pragma("unroll") for (int _i = 0; _i < 2; ++_i) \
    __builtin_amdgcn_global_load_lds((const unsigned*)((const char*)(gbase) + voffB[_i]), (LAS unsigned*)(lds + (bufoff) + ldsw + _i * 8192), 16, 0, 0); } while (0)
#define PG8_STAGE_A(bufoff, kb, offs) do { _Pragma("unroll") for (int _i = 0; _i < 2; ++_i) \
    __builtin_amdgcn_global_load_lds((const unsigned*)(gA + (size_t)(kb) + (offs)[_i]), (LAS unsigned*)(lds + (bufoff) + ldsw + _i * 8192), 16, 0, 0); } while (0)
#define PG8_LDA(dst, b, h) do { _Pragma("unroll") for (int m = 0; m < 4; ++m) _Pragma("unroll") for (int k = 0; k < 2; ++k) dst[m][k] = *(const LAS bf16x8*)(lds + PG8_SA(b, h) + aoff + m * 2048 + k * 1024); } while (0)
#define PG8_LDB(dst, b, h) do { _Pragma("unroll") for (int n = 0; n < 2; ++n) _Pragma("unroll") for (int k = 0; k < 2; ++k) dst[n][k] = *(const LAS bf16x8*)(lds + PG8_SB(b, h) + boff + n * 2048 + k * 1024); } while (0)
#define PG8_MMA(ai, bj, At, Bt) do { __builtin_amdgcn_s_setprio(1); _Pragma("unroll") for (int m = 0; m < 4; ++m) _Pragma("unroll") for (int n = 0; n < 2; ++n) _Pragma("unroll") for (int k = 0; k < 2; ++k) \
    acc[ai][bj][m][n] = __builtin_amdgcn_mfma_f32_16x16x32_bf16(Bt[n][k], At[m][k], acc[ai][bj][m][n], 0, 0, 0); __builtin_amdgcn_s_setprio(0); } while (0)
#define PG8_WAIT_V(n) asm volatile("s_waitcnt vmcnt(" #n ")" ::: "memory")
#define PG8_WAIT_L(n) asm volatile("s_waitcnt lgkmcnt(" #n ")" ::: "memory")
#define PG8_BAR __builtin_amdgcn_s_barrier()
#define PG8_SCHED __builtin_amdgcn_sched_barrier(0)
  Unit cur, nxt; int ui = 0;
  if (!S.next(0, cur)) return;
  unsigned ca[2][2];
  { PG8_RC(Rp, Cp) S.a_off(cur, Rp, Cp, ca); }
  f32x4 acc[2][2][4][2];
#pragma unroll
  for (int a = 0; a < 2; ++a)
#pragma unroll
    for (int b = 0; b < 2; ++b)
#pragma unroll
      for (int m = 0; m < 4; ++m)
#pragma unroll
        for (int n = 0; n < 2; ++n) acc[a][b][m][n] = (f32x4){0.f, 0.f, 0.f, 0.f};
  bf16x8 At[4][2], B0[2][2], B1[2][2];
  const char* cB = cur.b;
  PG8_STAGE_B(PG8_SB(0, 0), cB); PG8_STAGE_B(PG8_SB(0, 1), cB + hstep); PG8_STAGE_A(PG8_SA(0, 0), 0, ca[0]); PG8_STAGE_A(PG8_SA(0, 1), 0, ca[1]);
  if (wr == 1) PG8_BAR;
  PG8_WAIT_V(2); PG8_BAR;
  PG8_STAGE_B(PG8_SB(1, 0), cB + kstep); PG8_STAGE_A(PG8_SA(1, 0), kstep, ca[0]); PG8_STAGE_B(PG8_SB(1, 1), cB + hstep + kstep);
  PG8_WAIT_V(6); PG8_BAR;
  for (;;) {
    const bool has_next = S.next(ui + 1, nxt);
    if (Sched::NEXT_IN_LDS) {
      unsigned na[2][2];
      if (has_next) { PG8_RC(Rp, Cp) S.a_off(nxt, Rp, Cp, na); }
      else {
#pragma unroll
        for (int h = 0; h < 2; ++h)
#pragma unroll
          for (int i = 0; i < 2; ++i) na[h][i] = ca[h][i];
      }
      *(LAS u32x4*)(lds + STAGE_BYTES + 8192 + tid * 16) = (u32x4){na[0][0], na[0][1], na[1][0], na[1][1]};
    }
    const char* nB = has_next ? nxt.b : cB;
    for (int t = 0; t < nt; t += 2) {
      const bool last = (t == nt - 2);
      PG8_LDB(B0, 0, 0); PG8_LDB(B1, 0, 1); PG8_SCHED; PG8_LDA(At, 0, 0); PG8_STAGE_A(PG8_SA(1, 1), (size_t)(t + 1) * kstep, ca[1]);
      PG8_WAIT_V(8); PG8_WAIT_L(0); PG8_BAR; PG8_MMA(0, 0, At, B0); PG8_MMA(0, 1, At, B1); PG8_BAR; PG8_SCHED;
      const size_t kb2 = last ? 0 : (size_t)(t + 2) * kstep;
      const char* b2 = last ? nB : cB + (size_t)(t + 2) * kstep;
      if (last) {
        if (Sched::NEXT_IN_LDS) { const u32x4 v = *(const LAS u32x4*)(lds + STAGE_BYTES + 8192 + tid * 16); ca[0][0] = v.x; ca[0][1] = v.y; ca[1][0] = v.z; ca[1][1] = v.w; }
        else if (has_next) { PG8_RC(Rp, Cp) S.a_off(nxt, Rp, Cp, ca); }
      }
      PG8_LDA(At, 0, 1); PG8_STAGE_B(PG8_SB(0, 0), b2); PG8_STAGE_B(PG8_SB(0, 1), b2 + hstep); PG8_STAGE_A(PG8_SA(0, 0), kb2, ca[0]);
      PG8_WAIT_V(8); PG8_WAIT_L(0); PG8_BAR; PG8_MMA(1, 0, At, B0); PG8_MMA(1, 1, At, B1); PG8_BAR; PG8_SCHED;
      PG8_LDB(B0, 1, 0); PG8_LDB(B1, 1, 1); PG8_SCHED; PG8_LDA(At, 1, 0); PG8_STAGE_A(PG8_SA(0, 1), kb2, ca[1]);
      PG8_WAIT_V(8); PG8_WAIT_L(0); PG8_BAR; PG8_MMA(0, 0, At, B0); PG8_MMA(0, 1, At, B1); PG8_BAR; PG8_SCHED;
      PG8_LDA(At, 1, 1); PG8_STAGE_B(PG8_SB(1, 0), b2 + kstep); PG8_STAGE_B(PG8_SB(1, 1), b2 + kstep + hstep); PG8_STAGE_A(PG8_SA(1, 0), kb2 + kstep, ca[0]);
      PG8_WAIT_V(8); PG8_WAIT_L(0); PG8_BAR; PG8_MMA(1, 0, At, B0); PG8_MMA(1, 1, At, B1); PG8_BAR; PG8_SCHED;
    }
    if constexpr (ALIGN_EPI) { if (wr == 0) PG8_BAR; }
    E(acc, cur, wr, wc, fr, fq);
    if (!has_next) break;
#pragma unroll
    for (int a = 0; a < 2; ++a)
#pragma unroll
      for (int b = 0; b < 2; ++b)
#pragma unroll
        for (int m = 0; m < 4; ++m)
#pragma unroll
          for (int n = 0; n < 2; ++n) acc[a][b][m][n] = (f32x4){0.f, 0.f, 0.f, 0.f};
    cur = nxt; cB = nB; ++ui;
    if constexpr (ALIGN_EPI) { if (wr == 1) PG8_BAR; }
  }
  PG8_WAIT_V(0);
  if constexpr (!ALIGN_EPI) { if (wr == 0) PG8_BAR; }
  PG8_BAR;
#undef PG8_RC
#undef PG8_SA
#undef PG8_SB
#undef PG8_STAGE_A
#undef PG8_STAGE_B
#undef PG8_LDA
#undef PG8_LDB
#undef PG8_MMA
#undef PG8_WAIT_V
#undef PG8_WAIT_L
#undef PG8_BAR
#undef PG8_SCHED
}
}

struct Params { const float* in[28]; float* out; unsigned char* ws; };
enum { I_X = 0, I_ANORM0, I_WIN0, I_CONVW, I_QN0, I_KN0, I_WOUT0, I_FNORM0, I_WRG0, I_BRG0, I_WRE0, I_BRE0, I_WG0, I_WU0, I_WD0,
       I_ANORM1, I_WIN1, I_QN1, I_KN1, I_WOUT1, I_FNORM1, I_WRG1, I_BRG1, I_WRE1, I_BRE1, I_WG1, I_WU1, I_WD1 };

struct Ctx { LAS unsigned char* lds; int wave, G, gw, NGW; };

struct TrDesc { const float* W; const float* gain; bf16_t* WT; int K, N, nvalid, mode, nblk, item; };
DI void tr_load(const TrDesc& d, int lane, f32x4 (&r)[8]) {
  const int kb = d.item / d.nblk, nb = d.item % d.nblk, k0 = 64 * kb, n = 32 * nb + 4 * (lane & 7);
#pragma unroll
  for (int i = 0; i < 8; ++i) { const int kk = 8 * i + (lane >> 3); r[i] = (n < d.nvalid) ? *(const f32x4*)(d.W + (size_t)(k0 + kk) * d.N + n) : (f32x4){0.f, 0.f, 0.f, 0.f}; }
}
DI void tr_finish(const TrDesc& d, int lane, const f32x4 (&r)[8], LAS float* scr) {
  const int kb = d.item / d.nblk, nb = d.item % d.nblk, k0 = 64 * kb, n0 = 32 * nb;
#pragma unroll
  for (int i = 0; i < 8; ++i) { const int kk = 8 * i + (lane >> 3); const float g = d.gain ? d.gain[k0 + kk] : 1.f; LAS float* s = scr + kk * 33 + 4 * (lane & 7);
    s[0] = r[i].x * g; s[1] = r[i].y * g; s[2] = r[i].z * g; s[3] = r[i].w * g; }
  asm volatile("s_waitcnt lgkmcnt(0)" ::: "memory");
  const int c = lane & 7;
#pragma unroll
  for (int j = 0; j < 4; ++j) { const int nn = (lane >> 3) + 8 * j; const LAS float* s = scr + (8 * c) * 33 + nn;
    u32x4 o; o.x = pk2(s[0 * 33], s[1 * 33]); o.y = pk2(s[2 * 33], s[3 * 33]); o.z = pk2(s[4 * 33], s[5 * 33]); o.w = pk2(s[6 * 33], s[7 * 33]);
    const int ng = n0 + nn; const int drow = (d.mode == 0) ? ng : (d.mode == 3 ? ((ng & ~255) + 128 * ((ng >> 5) & 1) + 32 * ((ng >> 6) & 3) + (ng & 31)) : ((ng >> 7) * 256 + (ng & 127) + (d.mode == 2 ? 128 : 0)));
    *(u32x4*)(d.WT + (size_t)drow * d.K + k0 + 8 * c) = o; }
  asm volatile("s_waitcnt lgkmcnt(0)" ::: "memory");
}
constexpr int TR_I_IN0 = 16 * 80, TR_I_OUT = 16 * 32, TR_I_GU = 32 * 16 * 16, TR_I_DN = 32 * 8 * 32, TR_I_IN1 = 16 * 48;
constexpr int TR_EARLY = TR_I_IN0 + TR_I_OUT, TR_MOE = 2 * TR_I_GU + TR_I_DN, TR_TOTAL = TR_EARLY + TR_MOE + TR_I_IN1 + TR_I_OUT + TR_MOE;
DI TrDesc tr_desc(const Params& P, int it) {
  unsigned char* ws = P.ws; TrDesc d; int r = it;
  if (r < TR_I_IN0) { d.W = P.in[I_WIN0]; d.gain = P.in[I_ANORM0]; d.WT = (bf16_t*)(ws + WS_WIN0); d.K = 1024; d.N = W0V; d.nvalid = W0V; d.mode = 3; d.nblk = 80; d.item = r; return d; }
  r -= TR_I_IN0;
  if (r < TR_I_OUT) { d.W = P.in[I_WOUT0]; d.gain = nullptr; d.WT = (bf16_t*)(ws + WS_WOUT0); d.K = 1024; d.N = 1024; d.nvalid = 1024; d.mode = 0; d.nblk = 32; d.item = r; return d; }
  r -= TR_I_OUT;
  int L = 0;
  if (r >= TR_MOE) { r -= TR_MOE;
    if (r < TR_I_IN1) { d.W = P.in[I_WIN1]; d.gain = P.in[I_ANORM1]; d.WT = (bf16_t*)(ws + WS_WIN1); d.K = 1024; d.N = W1; d.nvalid = W1; d.mode = 3; d.nblk = 48; d.item = r; return d; }
    r -= TR_I_IN1;
    if (r < TR_I_OUT) { d.W = P.in[I_WOUT1]; d.gain = nullptr; d.WT = (bf16_t*)(ws + WS_WOUT1); d.K = 1024; d.N = 1024; d.nvalid = 1024; d.mode = 0; d.nblk = 32; d.item = r; return d; }
    r -= TR_I_OUT; L = 1; }
  const float* fnorm = P.in[L ? I_FNORM1 : I_FNORM0];
  if (r < 2 * TR_I_GU) { const int up = r >= TR_I_GU; if (up) r -= TR_I_GU; const int e = r >> 8;
    d.W = P.in[up ? (L ? I_WU1 : I_WU0) : (L ? I_WG1 : I_WG0)] + (size_t)e * 1024 * 512; d.gain = fnorm; d.WT = (bf16_t*)(ws + (L ? WS_WGU1 : WS_WGU0)) + (size_t)e * 1024 * 1024;
    d.K = 1024; d.N = 512; d.nvalid = 512; d.mode = up ? 2 : 1; d.nblk = 16; d.item = r & 255; return d; }
  r -= 2 * TR_I_GU;
  { const int e = r >> 8; d.W = P.in[L ? I_WD1 : I_WD0] + (size_t)e * 512 * 1024; d.gain = nullptr; d.WT = (bf16_t*)(ws + (L ? WS_WD1 : WS_WD0)) + (size_t)e * 1024 * 512; d.K = 512; d.N = 1024; d.nvalid = 1024; d.mode = 0; d.nblk = 32; d.item = r & 255; return d; }
}
DI void rms_row_to_bf16(const float* xrow, bf16_t* orow, int lane) {
  const f32x4* xr = (const f32x4*)xrow + lane;
  f32x4 v[4]; float s = 0.f;
#pragma unroll
  for (int j = 0; j < 4; ++j) { v[j] = xr[64 * j]; s += (v[j].x * v[j].x + v[j].y * v[j].y) + (v[j].z * v[j].z + v[j].w * v[j].w); }
  const float rstd = 1.0f / sqrtf(wave_sum(s) * (1.f / DM) + NORM_EPS);
  unsigned long long* o8 = (unsigned long long*)orow + lane;
#pragma unroll
  for (int j = 0; j < 4; ++j) o8[64 * j] = (unsigned long long)pk2(v[j].x * rstd, v[j].y * rstd) | ((unsigned long long)pk2(v[j].z * rstd, v[j].w * rstd) << 32);
}
DI void p0_prologue(const Ctx& F, const Params& P) {
  unsigned char* ws = P.ws; const int lane = lane_id_v(); const int tid = F.wave * 64 + lane;
  LAS float* scr = (LAS float*)(F.lds + F.wave * 16384);
  {
    const int NIT = TR_EARLY;
    int it = F.gw;
    f32x4 ra[8], rb[8];
    TrDesc da, db;
    if (it < NIT) { da = tr_desc(P, it); tr_load(da, lane, ra); }
    while (it < NIT) {
      const int itn = it + F.NGW;
      if (itn < NIT) { db = tr_desc(P, itn); tr_load(db, lane, rb); }
      tr_finish(da, lane, ra, scr);
      if (itn >= NIT) break;
      const int itn2 = itn + F.NGW;
      if (itn2 < NIT) { da = tr_desc(P, itn2); tr_load(da, lane, ra); }
      tr_finish(db, lane, rb, scr);
      it = itn2;
    }
  }
  for (int m = F.gw; m < NTOK; m += F.NGW) rms_row_to_bf16(P.in[I_X] + (size_t)m * DM, (bf16_t*)(ws + WS_XN) + (size_t)m * DM, lane);
  const int gt = blockIdx.x * 512 + tid, NGT = F.G * 512;
  for (int i = gt; i < 512; i += NGT) ((unsigned*)(ws + WS_XN + (size_t)NTOK * DM * 2))[i] = 0u;
  for (int i = gt; i < 128; i += NGT) ((int*)(ws + WS_CTL))[i] = 0;
  for (int i = gt; i < SEQ * 32; i += NGT) {
    const int t = i >> 5, k = i & 31;
    const float inv = (float)exp2(-(double)k * (13.287712379549449 / 32.0));
    const float ang = (float)t * inv;
    const double rev = (double)ang * 0.15915494309189535; const float fr = (float)(rev - rint(rev));
    ((float*)(ws + WS_ROPE))[i] = __builtin_amdgcn_cosf(fr); ((float*)(ws + WS_ROPE))[SEQ * 32 + i] = __builtin_amdgcn_sinf(fr);
  }
  for (int i = gt; i < 2 * 36 * 1024; i += NGT) {
    const int L = i / (36 * 1024), r = i % (36 * 1024), j = r >> 10, k = r & 1023;
    const float g = P.in[L ? I_FNORM1 : I_FNORM0][k];
    float w; if (j < 4) w = P.in[L ? I_WRG1 : I_WRG0][k * 4 + j]; else { const int gg = (j - 4) >> 3, e = (j - 4) & 7; w = P.in[L ? I_WRE1 : I_WRE0][((size_t)gg * 1024 + k) * 8 + e]; }
    w *= g;
    const unsigned hi = pk2(w, 0.f) & 0xffffu; const float lo = w - __uint_as_float(hi << 16);
    bf16_t* base = (bf16_t*)(ws + (L ? WS_WR1 : WS_WR0));
    base[r] = (bf16_t)hi; base[36 * 1024 + r] = (bf16_t)(pk2(lo, 0.f) & 0xffffu);
  }
  for (int i = gt; i < 2 * 36; i += NGT) { const int L = i / 36, j = i % 36; ((float*)(ws + (L ? WS_WR1 : WS_WR0) + 147456))[j] = (j < 4) ? P.in[L ? I_BRG1 : I_BRG0][j] : P.in[L ? I_BRE1 : I_BRE0][j - 4]; }
}

DI u32x4 normrope8(const u32x4 w, const float (&gv)[8], bool do_norm, const f32x4 (&cs)[2], const f32x4 (&sn)[2], int sub, float oscale) {
  float v[8] = {bflo(w.x), bfhi(w.x), bflo(w.y), bfhi(w.y), bflo(w.z), bfhi(w.z), bflo(w.w), bfhi(w.w)};
  if (do_norm) {
    float s = 0.f;
#pragma unroll
    for (int j = 0; j < 8; ++j) s += v[j] * v[j];
    s += __shfl_xor(s, 1); s += __shfl_xor(s, 2); s += __shfl_xor(s, 4);
    const float rstd = 1.0f / sqrtf(s * (1.f / 64.f) + NORM_EPS);
#pragma unroll
    for (int j = 0; j < 8; ++j) v[j] = v[j] * rstd * gv[j];
  }
  const float sg = (sub & 4) ? 1.f : -1.f;
  const float cv[8] = {cs[0].x, cs[0].y, cs[0].z, cs[0].w, cs[1].x, cs[1].y, cs[1].z, cs[1].w};
  const float sv[8] = {sn[0].x, sn[0].y, sn[0].z, sn[0].w, sn[1].x, sn[1].y, sn[1].z, sn[1].w};
  float o[8];
#pragma unroll
  for (int j = 0; j < 8; ++j) { const float pr = __shfl_xor(v[j], 4); o[j] = (v[j] * cv[j] + sg * pr * sv[j]) * oscale; }
  u32x4 r; r.x = pk2(o[0], o[1]); r.y = pk2(o[2], o[3]); r.z = pk2(o[4], o[5]); r.w = pk2(o[6], o[7]);
  return r;
}
struct Tok0 { u32x4 cb, cc[3], ch[3]; bf16_t v; };
DI void p1b_transform0(const Ctx& F, const Params& P) {
  bf16_t* PROJ = (bf16_t*)(P.ws + WS_PROJ); bf16_t* MIX = (bf16_t*)(P.ws + WS_MIX);
  const int lane = lane_id_v();
  float cw[8][3];
#pragma unroll
  for (int j = 0; j < 8; ++j) { const float* w = P.in[I_CONVW] + (8 * lane + j) * 3; cw[j][0] = w[0]; cw[j][1] = w[1]; cw[j][2] = w[2]; }
  auto load = [&](Tok0& T, int m) {
    const int t = m & (SEQ - 1); const bf16_t* row = PROJ + (size_t)m * W0P;
    T.cb = *(const u32x4*)(row + C_CB + 8 * lane); T.v = row[C_V + lane];
#pragma unroll
    for (int d = 0; d < 3; ++d) { const int back = 2 - d; const bf16_t* r2 = row - (size_t)(t >= back ? back : 0) * W0P; T.cc[d] = *(const u32x4*)(r2 + C_CC + 8 * lane); T.ch[d] = *(const u32x4*)(r2 + C_CH + 8 * lane); }
  };
  auto process = [&](const Tok0& T, int m) {
    const int t = m & (SEQ - 1);
    { const int kk = t & 31, st = kk >> 4, rem = kk & 15, hf = (rem >> 2) & 1, j = 4 * (rem >> 3) + (rem & 3);
      const size_t vo = (((((size_t)(m >> 12) * 128 + (t >> 5)) * 2 + st) * 2 + (lane >> 5)) * 64 + hf * 32 + (lane & 31)) * 8 + j;
      ((bf16_t*)(P.ws + WS_VTF))[vo] = T.v; }
    { float u[3][8];
#pragma unroll
      for (int d = 0; d < 3; ++d) { const bool okd = t >= 2 - d; const u32x4 a = T.cc[d], b = T.ch[d];
        u[d][0] = okd ? bflo(a.x) * bflo(b.x) : 0.f; u[d][1] = okd ? bfhi(a.x) * bfhi(b.x) : 0.f; u[d][2] = okd ? bflo(a.y) * bflo(b.y) : 0.f; u[d][3] = okd ? bfhi(a.y) * bfhi(b.y) : 0.f;
        u[d][4] = okd ? bflo(a.z) * bflo(b.z) : 0.f; u[d][5] = okd ? bfhi(a.z) * bfhi(b.z) : 0.f; u[d][6] = okd ? bflo(a.w) * bflo(b.w) : 0.f; u[d][7] = okd ? bfhi(a.w) * bfhi(b.w) : 0.f; }
      const u32x4 cb = T.cb;
      const float cbv[8] = {bflo(cb.x), bfhi(cb.x), bflo(cb.y), bfhi(cb.y), bflo(cb.z), bfhi(cb.z), bflo(cb.w), bfhi(cb.w)};
      float o[8];
#pragma unroll
      for (int j = 0; j < 8; ++j) o[j] = cbv[j] * (u[0][j] * cw[j][0] + u[1][j] * cw[j][1] + u[2][j] * cw[j][2]);
      u32x4 r; r.x = pk2(o[0], o[1]); r.y = pk2(o[2], o[3]); r.z = pk2(o[4], o[5]); r.w = pk2(o[6], o[7]);
      *(u32x4*)(MIX + (size_t)m * DM + 8 * lane) = r; }
  };
  Tok0 A, B;
  int m = F.gw;
  if (m < NTOK) load(A, m);
  while (m < NTOK) {
    const int m1 = m + F.NGW;
    if (m1 < NTOK) load(B, m1);
    process(A, m);
    if (m1 >= NTOK) break;
    const int m2 = m1 + F.NGW;
    if (m2 < NTOK) load(A, m2);
    process(B, m1);
    m = m2;
  }
}

DI unsigned f2key(float f) { const unsigned b = __float_as_uint(f); return b ^ ((unsigned)((int)b >> 31) | 0x80000000u); }
DI s16x4 tr_read(LAS unsigned char* p) { typedef short v4i16_t __attribute__((ext_vector_type(4))); return __builtin_bit_cast(s16x4, __builtin_amdgcn_ds_read_tr16_b64_v4i16((LAS v4i16_t*)p)); }
#define DPP_U(v, ctrl) ((unsigned)__builtin_amdgcn_update_dpp(0, (int)(v), (ctrl), 0xF, 0xF, true))
DI unsigned wave_total_u(unsigned v) {
  v += DPP_U(v, 0xB1); v += DPP_U(v, 0x4E); v += DPP_U(v, 0x124); v += DPP_U(v, 0x128);
  return (unsigned)__builtin_amdgcn_readlane((int)v, 0) + (unsigned)__builtin_amdgcn_readlane((int)v, 16) + (unsigned)__builtin_amdgcn_readlane((int)v, 32) + (unsigned)__builtin_amdgcn_readlane((int)v, 48);
}
DI unsigned wave_maxall_u(unsigned v) {
  v = max(v, DPP_U(v, 0xB1)); v = max(v, DPP_U(v, 0x4E)); v = max(v, DPP_U(v, 0x124)); v = max(v, DPP_U(v, 0x128));
  const unsigned a = (unsigned)__builtin_amdgcn_readlane((int)v, 0), b = (unsigned)__builtin_amdgcn_readlane((int)v, 16), c = (unsigned)__builtin_amdgcn_readlane((int)v, 32), d = (unsigned)__builtin_amdgcn_readlane((int)v, 48);
  return max(max(a, b), max(c, d));
}
DI unsigned lane_prefix(unsigned long long m) { return __builtin_amdgcn_mbcnt_hi((unsigned)(m >> 32), __builtin_amdgcn_mbcnt_lo((unsigned)m, 0u)); }

DI void dsa_phase(const Ctx& F, const Params& P) {
  const bf16_t* PROJ = (const bf16_t*)(P.ws + WS_PROJ); bf16_t* MIX = (bf16_t*)(P.ws + WS_MIX);
  const bf16_t* IKF = (const bf16_t*)(P.ws + WS_IKF); const bf16_t* KF = (const bf16_t*)(P.ws + WS_KF); const bf16_t* VTF = (const bf16_t*)(P.ws + WS_VTF);
  LAS unsigned* sc = (LAS unsigned*)F.lds;
  LAS unsigned* msk32 = (LAS unsigned*)(F.lds + LDS_MISC);
  LAS float* trscr = (LAS float*)(F.lds + 67584 + F.wave * 8448);
  int trk = 0;
  LAS float* part = (LAS float*)F.lds;
  const int w = F.wave;
  float cshift; { const int l0 = lane_id_v(); cshift = 8.f * wave_max(fabsf(P.in[I_QN0][l0])) * wave_max(fabsf(P.in[I_KN0][l0])) * 1.02f; }
  const float c1 = 0.125f * LOG2E, c2 = __builtin_amdgcn_readfirstlane(__float_as_int(cshift * LOG2E)) == 0 ? 0.f : __int_as_float(__builtin_amdgcn_readfirstlane(__float_as_int(cshift * LOG2E)));
#ifdef TIMEDSA
  unsigned long long tacc = 0ull, tmark = 0ull;
#define DSA_T0(n) if (TIMEDSA == (n)) tmark = __builtin_amdgcn_s_memrealtime();
#define DSA_T1(n) if (TIMEDSA == (n)) tacc += __builtin_amdgcn_s_memrealtime() - tmark;
#else
#define DSA_T0(n)
#define DSA_T1(n)
#endif
  for (int v = blockIdx.x; v < 8192; v += gridDim.x) {
    const int cidx = v & 255, jj = v >> 8, b = jj >> 1, tb = (jj & 1) ? (511 - cidx) : cidx;
    const int t0 = tb * 8; const size_t rb = (size_t)b * SEQ;
    const int ntile = (t0 + 8 + 31) >> 5;
    const int lane = lane_id_v();
    const int c = lane & 31, half = lane >> 5, qc = c >> 2, hx = c & 3;
    DSA_T0(1)
    {
      bf16x8 af[4];
      { const bf16_t* ap = PROJ + (rb + t0 + qc) * W0P + C_IQ + hx * 64 + 8 * half;
#pragma unroll
        for (int ks = 0; ks < 4; ++ks) af[ks] = *(const bf16x8*)(ap + 16 * ks); }
      float wq[4][4];
#pragma unroll
      for (int g = 0; g < 4; ++g) { const u32x2 ww = *(const u32x2*)(PROJ + (rb + t0 + 2 * g + half) * W0P + C_IW);
        wq[g][0] = bflo(ww.x) * 0.0625f; wq[g][1] = bfhi(ww.x) * 0.0625f; wq[g][2] = bflo(ww.y) * 0.0625f; wq[g][3] = bfhi(ww.y) * 0.0625f; }
      const bf16_t* fb = IKF + ((size_t)b * 128 * 4 * 64 + lane) * 8;
      const int Tlast = ntile - 1;
      auto ld1 = [&](bf16x8 (&d)[4], int T) { const int Tc = T < Tlast ? T : Tlast;
#pragma unroll
        for (int ks = 0; ks < 4; ++ks) d[ks] = *(const bf16x8*)(fb + (size_t)(Tc * 4 + ks) * 512); };
      auto cp1 = [&](const bf16x8 (&bfr)[4], int T) {
        f32x16 acc;
#pragma unroll
        for (int i = 0; i < 16; ++i) acc[i] = 0.f;
#pragma unroll
        for (int ks = 0; ks < 4; ++ks) acc = __builtin_amdgcn_mfma_f32_32x32x16_bf16(af[ks], bfr[ks], acc, 0, 0, 0);
        const int s = 32 * T + c;
        const bool edge = 32 * T + 31 > t0;
#pragma unroll
        for (int g = 0; g < 4; ++g) {
          float sv = __builtin_fmaf(wq[g][3], fmaxf(acc[4 * g + 3], 0.f), __builtin_fmaf(wq[g][2], fmaxf(acc[4 * g + 2], 0.f), __builtin_fmaf(wq[g][1], fmaxf(acc[4 * g + 1], 0.f), __builtin_fmaf(wq[g][0], fmaxf(acc[4 * g], 0.f), 0.f))));
          const int ql = 2 * g + half;
          unsigned key = f2key(sv);
          if (edge) key = (s <= t0 + ql) ? key : 0u;
          sc[ql * 4096 + s] = key;
        } };
      bf16x8 r0[4], r1[4], r2[4], r3[4];
      if (w < ntile) { ld1(r0, w); ld1(r1, w + 8); ld1(r2, w + 16); ld1(r3, w + 24); }
      for (int T = w; T < ntile; T += 32) {
        cp1(r0, T); ld1(r0, T + 32); __builtin_amdgcn_sched_barrier(0);
        if (T + 8 < ntile) { cp1(r1, T + 8); ld1(r1, T + 40); __builtin_amdgcn_sched_barrier(0); }
        if (T + 16 < ntile) { cp1(r2, T + 16); ld1(r2, T + 48); __builtin_amdgcn_sched_barrier(0); }
        if (T + 24 < ntile) { cp1(r3, T + 24); ld1(r3, T + 56); __builtin_amdgcn_sched_barrier(0); }
      }
    }
    __syncthreads();
    asm volatile("" ::: "memory"); __builtin_amdgcn_sched_barrier(0);
    DSA_T1(1)
    DSA_T0(2)
    {
      const int lane = lane_id_v();
      const int t = t0 + w;
      const int nch = (t >> 10) + 1;
      unsigned u[64];
#pragma unroll
      for (int ch = 0; ch < 4; ++ch) {
        if (ch < nch) {
#pragma unroll
          for (int k2 = 0; k2 < 16; ++k2) { const int j = 16 * ch + k2; const unsigned x = sc[w * 4096 + 64 * j + lane]; u[j] = (lane <= t - 64 * j) ? x : 0u; }
        } else {
#pragma unroll
          for (int k2 = 0; k2 < 16; ++k2) u[16 * ch + k2] = 0u;
        }
      }
      unsigned thr = 0u; int sthr = -1;
      if (t >= 256) {
        unsigned prefix = 0u; bool exact = false; int startbit = 31;
        {
          unsigned mx = 0u;
#pragma unroll
          for (int ch = 0; ch < 4; ++ch) if (ch < nch) {
#pragma unroll
            for (int k2 = 0; k2 < 16; ++k2) mx = max(mx, u[16 * ch + k2]);
          }
          const unsigned trial = wave_maxall_u(mx) & 0xFF800000u;
          unsigned cnt = 0u;
#pragma unroll
          for (int ch = 0; ch < 4; ++ch) if (ch < nch) {
#pragma unroll
            for (int k2 = 0; k2 < 16; ++k2) cnt += (u[16 * ch + k2] >= trial) ? 1u : 0u;
          }
          cnt = wave_total_u(cnt);
          if (cnt >= 256u) { prefix = trial; startbit = 22; exact = (cnt == 256u); }
        }
        if (!exact) {
          for (int bit = startbit; bit >= 0; --bit) {
            const unsigned trial = prefix | (1u << bit);
            unsigned cnt = 0u;
#pragma unroll
            for (int ch = 0; ch < 4; ++ch) if (ch < nch) {
#pragma unroll
              for (int k2 = 0; k2 < 16; ++k2) cnt += (u[16 * ch + k2] >= trial) ? 1u : 0u;
            }
            cnt = wave_total_u(cnt);
            if (cnt >= 256u) prefix = trial;
            if (cnt == 256u) { exact = true; break; }
          }
        }
        if (exact) thr = prefix - 1u;
        else {
          thr = prefix; unsigned cgt = 0u;
#pragma unroll
          for (int j = 0; j < 64; ++j) cgt += (u[j] > thr) ? 1u : 0u;
          cgt = wave_total_u(cgt);
          const int need = 256 - (int)cgt;
          int tbf = 0;
#pragma unroll
          for (int ch = 0; ch < 4; ++ch) if (ch < nch) {
#pragma unroll
            for (int k2 = 0; k2 < 16; ++k2) { const int j = 16 * ch + k2; const bool eq = u[j] == thr; const unsigned long long m = __ballot(eq);
              const unsigned long long hit = __ballot(eq && (tbf + (int)lane_prefix(m) == need - 1));
              if (hit) sthr = 64 * j + __builtin_ctzll(hit);
              tbf += __builtin_popcountll(m); }
          }
        }
      }
      if (sthr < 0) {
#pragma unroll
        for (int ch = 0; ch < 4; ++ch) {
          if (ch < nch) {
#pragma unroll
            for (int k2 = 0; k2 < 16; ++k2) { const int j = 16 * ch + k2; const unsigned long long m = __ballot(u[j] > thr);
              if (lane == 0) *(LAS u32x2*)(msk32 + w * 128 + 2 * j) = (u32x2){(unsigned)m, (unsigned)(m >> 32)}; }
          } else if (lane < 16) *(LAS u32x2*)(msk32 + w * 128 + 2 * (16 * ch + lane)) = (u32x2){0u, 0u};
        }
      } else {
#pragma unroll
        for (int ch = 0; ch < 4; ++ch) {
          if (ch < nch) {
#pragma unroll
            for (int k2 = 0; k2 < 16; ++k2) { const int j = 16 * ch + k2; const bool sel = (u[j] > thr) || (u[j] == thr && lane <= sthr - 64 * j); const unsigned long long m = __ballot(sel);
              if (lane == 0) *(LAS u32x2*)(msk32 + w * 128 + 2 * j) = (u32x2){(unsigned)m, (unsigned)(m >> 32)}; }
          } else if (lane < 16) *(LAS u32x2*)(msk32 + w * 128 + 2 * (16 * ch + lane)) = (u32x2){0u, 0u};
        }
      }
    }
    __syncthreads();
    asm volatile("" ::: "memory"); __builtin_amdgcn_sched_barrier(0);
    DSA_T1(2)
    {
      const int tit = TR_EARLY + F.gw + trk * F.NGW;
      if (tit < TR_TOTAL) { const int tl = lane_id_v(); const TrDesc td = tr_desc(P, tit); f32x4 tr8[8]; tr_load(td, tl, tr8); tr_finish(td, tl, tr8, trscr); }
      ++trk;
    }
    asm volatile("" ::: "memory"); __builtin_amdgcn_sched_barrier(0);
    DSA_T0(3)
    {
      const int lane = lane_id_v(); const int c = lane & 31, half = lane >> 5, qc = c >> 2, hx = c & 3;
      const int cbw = w & 1, kq = w >> 1;
      const int tq = t0 + qc;
      bf16x8 qf[4];
      { const bf16_t* qp = PROJ + (rb + tq) * W0P + C_Q + (4 * cbw + hx) * 64 + 8 * half; const float qs = 0.125f * LOG2E;
#pragma unroll
        for (int ks = 0; ks < 4; ++ks) { const u32x4 qv = *(const u32x4*)(qp + 16 * ks);
          u32x4 qo; qo.x = pk2(bflo(qv.x) * qs, bfhi(qv.x) * qs); qo.y = pk2(bflo(qv.y) * qs, bfhi(qv.y) * qs); qo.z = pk2(bflo(qv.z) * qs, bfhi(qv.z) * qs); qo.w = pk2(bflo(qv.w) * qs, bfhi(qv.w) * qs);
          qf[ks] = __builtin_bit_cast(bf16x8, qo); } }
      f32x16 o0, o1;
#pragma unroll
      for (int i = 0; i < 16; ++i) { o0[i] = 0.f; o1[i] = 0.f; }
      float lsum = 0.f;
      const bf16_t* kb = KF + ((size_t)b * 128 * 4 * 64 + lane) * 8;
      const bf16_t* vb = VTF + ((size_t)b * 128 * 4 * 64 + lane) * 8;
      const int Tlast = ntile - 1;
      auto ldk = [&](bf16x8 (&kf)[4], int T) { const int Tc = T < Tlast ? T : Tlast;
#pragma unroll
        for (int ks = 0; ks < 4; ++ks) kf[ks] = *(const bf16x8*)(kb + (size_t)(Tc * 4 + ks) * 512); };
      auto ldv = [&](bf16x8 (&vf)[4], int T) { const int Tc = T < Tlast ? T : Tlast;
#pragma unroll
        for (int ks = 0; ks < 4; ++ks) vf[ks] = *(const bf16x8*)(vb + (size_t)(Tc * 4 + ks) * 512); };
      auto qk = [&](f32x16& s, const bf16x8 (&kf)[4]) {
#pragma unroll
        for (int i = 0; i < 16; ++i) s[i] = -c2;
#pragma unroll
        for (int ks = 0; ks < 4; ++ks) s = __builtin_amdgcn_mfma_f32_32x32x16_bf16(kf[ks], qf[ks], s, 0, 0, 0); };
      auto smpv = [&](f32x16& s, const bf16x8 (&vf)[4], int T) {
        const unsigned mw = msk32[qc * 128 + T] >> (4 * half);
#pragma unroll
        for (int r = 0; r < 16; ++r) {
          int mb; asm("v_bfe_i32 %0, %1, %2, 1" : "=v"(mb) : "v"(mw), "n"((r & 3) + 8 * (r >> 2)));
          const float p = __int_as_float(__float_as_int(__builtin_amdgcn_exp2f(s[r])) & mb); s[r] = p; lsum += p; }
#pragma unroll
        for (int st = 0; st < 2; ++st) {
          u32x4 pw; pw.x = pk2(s[8 * st], s[8 * st + 1]); pw.y = pk2(s[8 * st + 2], s[8 * st + 3]); pw.z = pk2(s[8 * st + 4], s[8 * st + 5]); pw.w = pk2(s[8 * st + 6], s[8 * st + 7]);
          const bf16x8 pf = __builtin_bit_cast(bf16x8, pw);
          o0 = __builtin_amdgcn_mfma_f32_32x32x16_bf16(vf[2 * st], pf, o0, 0, 0, 0);
          o1 = __builtin_amdgcn_mfma_f32_32x32x16_bf16(vf[2 * st + 1], pf, o1, 0, 0, 0);
        } };
      bf16x8 ka[4], va[4], kb2[4], vb2[4];
      f32x16 sa, sb;
      if (kq < ntile) {
        ldk(ka, kq); ldv(va, kq); ldk(kb2, kq + 4); ldv(vb2, kq + 4);
        qk(sa, ka); ldk(ka, kq + 8);
        for (int T = kq; T < ntile; T += 8) {
          if (T + 4 < ntile) { qk(sb, kb2); ldk(kb2, T + 12); }
          smpv(sa, va, T); ldv(va, T + 8);
          __builtin_amdgcn_sched_barrier(0);
          if (T + 4 < ntile) {
            if (T + 8 < ntile) { qk(sa, ka); ldk(ka, T + 16); }
            smpv(sb, vb2, T + 4); ldv(vb2, T + 12);
            __builtin_amdgcn_sched_barrier(0);
          }
        }
      }
      lsum += __shfl_xor(lsum, 32);
      LAS float* pw_ = part + w * (33 * 64) + lane;
#pragma unroll
      for (int i = 0; i < 16; ++i) { pw_[i * 64] = o0[i]; pw_[(16 + i) * 64] = o1[i]; }
      pw_[32 * 64] = lsum;
      __syncthreads();
      float acc8[8]; float lt = 0.f;
#pragma unroll
      for (int i = 0; i < 8; ++i) acc8[i] = 0.f;
#pragma unroll
      for (int k4 = 0; k4 < 4; ++k4) { const LAS float* pr = part + (2 * k4 + cbw) * (33 * 64) + lane;
#pragma unroll
        for (int i = 0; i < 8; ++i) acc8[i] += pr[(8 * kq + i) * 64];
        lt += pr[32 * 64]; }
      const float inv = 1.0f / lt;
      bf16_t* op = MIX + (rb + tq) * DM + 512 + (4 * cbw + hx) * 64 + 32 * (kq >> 1) + 16 * (kq & 1) + 4 * half;
      u32x2 w0; w0.x = pk2(acc8[0] * inv, acc8[1] * inv); w0.y = pk2(acc8[2] * inv, acc8[3] * inv); *(u32x2*)op = w0;
      u32x2 w1; w1.x = pk2(acc8[4] * inv, acc8[5] * inv); w1.y = pk2(acc8[6] * inv, acc8[7] * inv); *(u32x2*)(op + 8) = w1;
    }
    __syncthreads();
    DSA_T1(3)
  }
  for (;; ++trk) { const int tit = TR_EARLY + F.gw + trk * F.NGW; if (tit >= TR_TOTAL) break; const int tl = lane_id_v(); const TrDesc td = tr_desc(P, tit); f32x4 tr8[8]; tr_load(td, tl, tr8); tr_finish(td, tl, tr8, trscr); }
#ifdef TIMEDSA
  if (blockIdx.x == 0 && w == 0 && lane_id_v() == 0) { unsigned long long* tsw = (unsigned long long*)(P.ws + WS_CTL + 4096); tsw[0] = 0ull; tsw[1] = tacc; }
#endif
}

DI void route_lane(const float (&lg)[36], int& x0, int& x1, float& g0, float& g1) {
  int gs = 0; float gm = lg[0];
#pragma unroll
  for (int j = 1; j < 4; ++j) { const bool gt = lg[j] > gm; gm = gt ? lg[j] : gm; gs = gt ? j : gs; }
  float z = 0.f;
#pragma unroll
  for (int j = 0; j < 4; ++j) z += __expf(lg[j] - gm);
  const float pg = 1.0f / z;
  float le[8];
#pragma unroll
  for (int i = 0; i < 8; ++i) le[i] = gs == 0 ? lg[4 + i] : (gs == 1 ? lg[12 + i] : (gs == 2 ? lg[20 + i] : lg[28 + i]));
  int i0e = 0; float m0 = le[0];
#pragma unroll
  for (int i = 1; i < 8; ++i) { const bool gt = le[i] > m0; m0 = gt ? le[i] : m0; i0e = gt ? i : i0e; }
  int i1e = -1; float m1 = -INFINITY;
#pragma unroll
  for (int i = 0; i < 8; ++i) { const bool gt = (i != i0e) && (le[i] > m1); m1 = gt ? le[i] : m1; i1e = gt ? i : i1e; }
  const float e1 = __expf(m1 - m0);
  g0 = pg / (1.0f + e1); g1 = pg * e1 / (1.0f + e1);
  x0 = gs * 8 + i0e; x1 = gs * 8 + i1e;
}
DI void router_phase(const Ctx& F, const Params& P, int L) {
  unsigned char* ws = P.ws;
  constexpr int WSTR = 2064;
  constexpr int L_WH = 0, L_WL = 36 * WSTR, L_ZERO = 2 * 36 * WSTR, L_CNT = L_ZERO + WSTR, L_ASG = L_CNT + 256, L_RS = L_ASG + 4096;
  static_assert(L_ASG + 4096 <= LDS_BYTES - 16, "router LDS map");
  LAS unsigned char* lds = F.lds;
  LAS int* lcnt = (LAS int*)(lds + L_CNT); LAS int* lbase = lcnt + 32;
  LAS i32x4* lasg = (LAS i32x4*)(lds + L_ASG);
  const bf16_t* wsrc = (const bf16_t*)(ws + (L ? WS_WR1 : WS_WR0));
  const float* bias = (const float*)(ws + (L ? WS_WR1 : WS_WR0) + 147456);
  const int lane = lane_id_v(); const int w = F.wave; const int tid = w * 64 + lane;
  int* cnt = (int*)(ws + WS_CTL) + L * 64; int* list = (int*)(ws + WS_LIST); float* RSL = (float*)(ws + WS_RSL);
  int4* asg = (int4*)(ws + WS_ASG); float2* asgg = (float2*)(ws + WS_ASGG);
  const bf16_t* XB = (const bf16_t*)(ws + WS_XB);
  const int niter = (NTOK + F.NGW - 1) / F.NGW;
  for (int i0 = 0; i0 < niter; i0 += 32) {
    for (int i = tid; i < 2 * 36 * 128; i += 512) { const int row = i >> 7, ch = i & 127; *(LAS u32x4*)(lds + row * WSTR + ch * 16) = *(const u32x4*)(wsrc + row * 1024 + ch * 8); }
    for (int i = tid; i < 128; i += 512) *(LAS u32x4*)(lds + L_ZERO + i * 16) = (u32x4){0u, 0u, 0u, 0u};
    if (tid < 32) lcnt[tid] = 0;
    __syncthreads();
    const int c = lane & 31, half = lane >> 5;
    const int it_r = i0 + c; const int m_r = F.gw + it_r * F.NGW; const bool ok_r = (it_r < niter) && (m_r < NTOK);
    const bf16_t* arow = XB + (size_t)(ok_r ? m_r : F.gw) * DM + 8 * half;
    const int b0off = c * WSTR + 16 * half;
    const int b1off = (c < 4 ? (32 + c) * WSTR : (L_ZERO - L_WH)) + 16 * half;
    f32x16 d0, d1, dx;
#pragma unroll
    for (int i = 0; i < 16; ++i) { d0[i] = 0.f; d1[i] = 0.f; dx[i] = 0.f; }
    bf16x8 ar[8];
#pragma unroll
    for (int j = 0; j < 8; ++j) ar[j] = *(const bf16x8*)(arow + 16 * j);
    for (int k8 = 0; k8 < 64; k8 += 8) {
#pragma unroll
      for (int j = 0; j < 8; ++j) {
        const int ks = k8 + j;
        const bf16x8 a_cur = ar[j];
        const bf16x8 h0 = *(const LAS bf16x8*)(lds + L_WH + b0off + 32 * ks), l0 = *(const LAS bf16x8*)(lds + L_WL + b0off + 32 * ks);
        const bf16x8 h1 = *(const LAS bf16x8*)(lds + L_WH + b1off + 32 * ks), l1 = *(const LAS bf16x8*)(lds + (c < 4 ? L_WL : L_WH) + b1off + 32 * ks);
        d0 = __builtin_amdgcn_mfma_f32_32x32x16_bf16(a_cur, h0, d0, 0, 0, 0); d0 = __builtin_amdgcn_mfma_f32_32x32x16_bf16(a_cur, l0, d0, 0, 0, 0);
        d1 = __builtin_amdgcn_mfma_f32_32x32x16_bf16(a_cur, h1, d1, 0, 0, 0); d1 = __builtin_amdgcn_mfma_f32_32x32x16_bf16(a_cur, l1, d1, 0, 0, 0);
        dx = __builtin_amdgcn_mfma_f32_32x32x16_bf16(a_cur, a_cur, dx, 0, 0, 0);
        if (k8 + 8 < 64) ar[j] = *(const bf16x8*)(arow + 16 * (ks + 8));
      }
    }
    __syncthreads();
    LAS float* tw = (LAS float*)(lds + w * 8192);
#pragma unroll
    for (int i = 0; i < 16; ++i) { const int row = (i & 3) + 8 * (i >> 2) + 4 * half; tw[row * 40 + c] = d0[i]; if (c < 4) tw[row * 40 + 32 + c] = d1[i]; if (row == c) tw[row * 40 + 36] = dx[i]; }
    asm volatile("s_waitcnt lgkmcnt(0)" ::: "memory");
    if (lane < 32) {
      const int it_t = i0 + lane; const int m = F.gw + it_t * F.NGW;
      if (it_t < niter && m < NTOK) {
        const LAS f32x4* tr4 = (const LAS f32x4*)(tw + lane * 40);
        float raw[40];
#pragma unroll
        for (int q = 0; q < 10; ++q) { const f32x4 v4 = tr4[q]; raw[4 * q] = v4.x; raw[4 * q + 1] = v4.y; raw[4 * q + 2] = v4.z; raw[4 * q + 3] = v4.w; }
        const float rstd = 1.0f / sqrtf(raw[36] * (1.f / DM) + NORM_EPS);
        float lg[36];
#pragma unroll
        for (int j = 0; j < 36; ++j) lg[j] = raw[j] * rstd + bias[j];
        int x0, x1; float g0, g1; route_lane(lg, x0, x1, g0, g1);
        const int r0 = __hip_atomic_fetch_add(lcnt + x0, 1, __ATOMIC_RELAXED, __HIP_MEMORY_SCOPE_WORKGROUP);
        const int r1 = __hip_atomic_fetch_add(lcnt + x1, 1, __ATOMIC_RELAXED, __HIP_MEMORY_SCOPE_WORKGROUP);
        lasg[lane * 8 + w] = (i32x4){x0, x1, r0, r1}; asgg[m] = make_float2(g0, g1);
        tw[lane * 40 + 37] = rstd;
      }
    }
    __syncthreads();
    if (tid < 32) lbase[tid] = atomicAdd(cnt + tid, lcnt[tid]);
    __syncthreads();
    if (tid < 256) {
      const int ii = tid >> 3, wv = tid & 7; const int m = (int)blockIdx.x * 8 + wv + (i0 + ii) * F.NGW;
      if (i0 + ii < niter && m < NTOK) {
        const i32x4 a = lasg[tid]; const int r0 = lbase[a.x] + a.z, r1 = lbase[a.y] + a.w;
        const float rs = ((const LAS float*)(lds + wv * 8192))[ii * 40 + 37];
        list[a.x * 65536 + r0] = m; list[a.y * 65536 + r1] = m; asg[m] = make_int4(a.x, a.y, r0, r1);
        RSL[a.x * 65536 + r0] = rs; RSL[a.y * 65536 + r1] = rs;
      }
    }
    __syncthreads();
  }
}
DI void moe_setup(const Ctx& F, const Params& P, int L) {
  LAS int* pb = (LAS int*)(F.lds + LDS_MISC); LAS int* cl = pb + 64;
  const int* cnt = (const int*)(P.ws + WS_CTL) + L * 64;
  const int tid = F.wave * 64 + lane_id_v();
  __syncthreads();
  if (tid < 32) cl[tid] = cnt[tid];
  __syncthreads();
  if (tid == 0) { int a = 0; for (int e = 0; e < NEXP; ++e) { pb[e] = a; a += (cl[e] + 255) >> 8; } pb[NEXP] = a; }
  __syncthreads();
}
struct CRows { u32x2 x[4], y0[4], y1[4]; };
DI void combine_phase(const Ctx& F, const Params& P, int L, bool with_norm) {
  unsigned char* ws = P.ws;
  moe_setup(F, P, L);
  const LAS int* pb = (const LAS int*)(F.lds + LDS_MISC);
  const int4* asg = (const int4*)(ws + WS_ASG); const float2* asgg = (const float2*)(ws + WS_ASGG);
  const bf16_t* Y = (const bf16_t*)(ws + WS_PROJ); bf16_t* XN = (bf16_t*)(ws + WS_XN); bf16_t* XB = (bf16_t*)(ws + WS_XB);
  const int lane = lane_id_v();
  auto rows = [&](CRows& R, int m, const int4 a) {
    const size_t row0 = (size_t)pb[a.x] * 256 + a.z, row1 = (size_t)pb[a.y] * 256 + a.w;
    const u32x2* xr = (const u32x2*)(XB + (size_t)m * DM) + lane; const u32x2* y0 = (const u32x2*)(Y + row0 * DM) + lane; const u32x2* y1 = (const u32x2*)(Y + row1 * DM) + lane;
#pragma unroll
    for (int j = 0; j < 4; ++j) { R.x[j] = xr[64 * j]; R.y0[j] = y0[64 * j]; R.y1[j] = y1[64 * j]; } };
  auto finish = [&](const CRows& R, int m, const float2 gg) {
    u32x2* xr = (u32x2*)(XB + (size_t)m * DM) + lane; f32x4* orow = (f32x4*)(P.out + (size_t)m * DM) + lane;
    f32x4 v[4]; float ss = 0.f;
#pragma unroll
    for (int j = 0; j < 4; ++j) { const u32x2 xb = R.x[j], a0 = R.y0[j], a1 = R.y1[j]; f32x4 x = (f32x4){bflo(xb.x), bfhi(xb.x), bflo(xb.y), bfhi(xb.y)};
      x.x += gg.x * bflo(a0.x) + gg.y * bflo(a1.x); x.y += gg.x * bfhi(a0.x) + gg.y * bfhi(a1.x); x.z += gg.x * bflo(a0.y) + gg.y * bflo(a1.y); x.w += gg.x * bfhi(a0.y) + gg.y * bfhi(a1.y);
      if (with_norm) { u32x2 o; o.x = pk2(x.x, x.y); o.y = pk2(x.z, x.w); xr[64 * j] = o; } else orow[64 * j] = x;
      v[j] = x; ss += (x.x * x.x + x.y * x.y) + (x.z * x.z + x.w * x.w); }
    if (with_norm) {
      const float rstd = 1.0f / sqrtf(wave_sum(ss) * (1.f / DM) + NORM_EPS);
      unsigned long long* o8 = (unsigned long long*)(XN + (size_t)m * DM) + lane;
#pragma unroll
      for (int j = 0; j < 4; ++j) o8[64 * j] = (unsigned long long)pk2(v[j].x * rstd, v[j].y * rstd) | ((unsigned long long)pk2(v[j].z * rstd, v[j].w * rstd) << 32);
    } };
  const int n = (NTOK - F.gw + F.NGW - 1) / F.NGW;
  if (n <= 0) return;
  CRows RA, RB;
  int4 a0 = asg[F.gw]; float2 g0 = asgg[F.gw];
  int4 a1 = a0; float2 g1 = g0; if (n > 1) { a1 = asg[F.gw + F.NGW]; g1 = asgg[F.gw + F.NGW]; }
  rows(RA, F.gw, a0);
  for (int i = 0; i < n; i += 2) {
    const int m0 = F.gw + i * F.NGW, m1 = m0 + F.NGW, m2 = m1 + F.NGW, m3 = m2 + F.NGW;
    int4 a2 = a0; float2 g2 = g0; if (i + 2 < n) { a2 = asg[m2]; g2 = asgg[m2]; }
    if (i + 1 < n) rows(RB, m1, a1);
    finish(RA, m0, g0);
    if (i + 1 >= n) break;
    int4 a3 = a0; float2 g3 = g0; if (i + 3 < n) { a3 = asg[m3]; g3 = asgg[m3]; }
    if (i + 2 < n) rows(RA, m2, a2);
    finish(RB, m1, g1);
    a0 = a2; g0 = g2; a1 = a3; g1 = g3;
  }
}
template <class Bar> DI void moe_gemms(const Ctx& F, const Params& P, int L, const Bar& gbar) {
  unsigned char* ws = P.ws;
  const int vcu = (F.G % 8 == 0) ? ((int)(blockIdx.x % 8) * (F.G / 8) + (int)(blockIdx.x / 8)) : (int)blockIdx.x;
  moe_setup(F, P, L);
  {
    pg8::MoeSched<true> S{(const LAS int*)(F.lds + LDS_MISC), (const LAS int*)(F.lds + LDS_MISC) + 64, (const int*)(ws + WS_LIST), (const char*)(ws + (L ? WS_WGU1 : WS_WGU0)), F.G, vcu, 1024};
    pg8::EpiSwiGLU E{(bf16_t*)(ws + WS_H), (const float*)(ws + WS_RSL), (const LAS int*)(F.lds + LDS_MISC) + 64};
    pg8::gemm_phase<pg8::EpiSwiGLU, pg8::MoeSched<true>, true>(F.lds, F.wave, (const char*)(ws + WS_XB), 1024, S, E);
  }
  xcd_barrier(gbar);
  {
    pg8::MoeSched<false> S{(const LAS int*)(F.lds + LDS_MISC), (const LAS int*)(F.lds + LDS_MISC) + 64, nullptr, (const char*)(ws + (L ? WS_WD1 : WS_WD0)), F.G, vcu, 512};
    pg8::EpiBf16 E{(bf16_t*)(ws + WS_PROJ), DM};
    pg8::gemm_phase<pg8::EpiBf16, pg8::MoeSched<false>, true>(F.lds, F.wave, (const char*)(ws + WS_H), 512, S, E);
  }
}

struct Tok1 { u32x4 q0, q1, k; f32x4 cs[2], sn[2]; };
DI void p8b_transform1(const Ctx& F, const Params& P) {
  bf16_t* QKV = (bf16_t*)(P.ws + WS_PROJ);
  const float* cosT = (const float*)(P.ws + WS_ROPE); const float* sinT = cosT + SEQ * 32;
  const int lane = lane_id_v(), sub = lane & 7, grp = lane >> 3;
  float gq[8], gk[8];
#pragma unroll
  for (int j = 0; j < 8; ++j) { gq[j] = P.in[I_QN1][8 * sub + j]; gk[j] = P.in[I_KN1][8 * sub + j]; }
  const int kcol = 1024 + (grp & 3) * 64 + sub * 8;
  auto load = [&](Tok1& T, int m) {
    const int t = m & (SEQ - 1); const bf16_t* row = QKV + (size_t)m * W1;
    T.q0 = *(const u32x4*)(row + grp * 64 + sub * 8); T.q1 = *(const u32x4*)(row + 512 + grp * 64 + sub * 8); T.k = *(const u32x4*)(row + kcol);
    const f32x4* cp = (const f32x4*)(cosT + t * 32 + 8 * (sub & 3)); const f32x4* sp = (const f32x4*)(sinT + t * 32 + 8 * (sub & 3));
    T.cs[0] = cp[0]; T.cs[1] = cp[1]; T.sn[0] = sp[0]; T.sn[1] = sp[1];
  };
  auto process = [&](const Tok1& T, int m) {
    bf16_t* row = QKV + (size_t)m * W1;
    *(u32x4*)(row + grp * 64 + sub * 8) = normrope8(T.q0, gq, true, T.cs, T.sn, sub, 0.125f * LOG2E);
    *(u32x4*)(row + 512 + grp * 64 + sub * 8) = normrope8(T.q1, gq, true, T.cs, T.sn, sub, 0.125f * LOG2E);
    const u32x4 r = normrope8(T.k, gk, true, T.cs, T.sn, sub, 1.f);
    if (grp < 4) *(u32x4*)(row + kcol) = r;
  };
  Tok1 A, B;
  int m = F.gw;
  if (m < NTOK) load(A, m);
  while (m < NTOK) {
    const int m1 = m + F.NGW;
    if (m1 < NTOK) load(B, m1);
    process(A, m);
    if (m1 >= NTOK) break;
    const int m2 = m1 + F.NGW;
    if (m2 < NTOK) load(A, m2);
    process(B, m1);
    m = m2;
  }
}

DI void dil_phase(const Ctx& F, const Params& P) {
  const bf16_t* QKV = (const bf16_t*)(P.ws + WS_PROJ); bf16_t* MIX = (bf16_t*)(P.ws + WS_MIX);
  LAS unsigned char* kst = F.lds + F.wave * 8192;
  LAS unsigned char* vst = kst + 4096;
  float cshift; { const int l0 = lane_id_v(); cshift = 8.f * wave_max(fabsf(P.in[I_QN1][l0])) * wave_max(fabsf(P.in[I_KN1][l0])) * 1.02f; }
  const float c2 = cshift * LOG2E;
  const int gwv = ((F.G % 8 == 0) ? ((int)(blockIdx.x % 8) * (F.G / 8) + (int)(blockIdx.x / 8)) : (int)blockIdx.x) * 8 + F.wave;
  const int lane = lane_id_v(), c = lane & 31, half = lane >> 5, qi = c >> 2, gq = c & 3;
  const int q4 = (lane & 15) >> 2, p4 = lane & 3, blk = (lane >> 4) & 1;
  const int lrow = lane >> 3, lch = lane & 7;
  const int woff = lrow * 128 + ((lch ^ (lrow & 7)) << 4);
  const int kra = c * 128 + ((half ^ (c & 7)) << 4);
  const int r1 = 4 * half + q4;
  const int tra0 = r1 * 128 + (((2 * blk + (p4 >> 1)) ^ (r1 & 7)) << 4) + (p4 & 1) * 8;
  for (int it = gwv; it < 32768; it += F.NGW) {
    const int r = it & 15, tile = (it >> 4) & 31, kh = (it >> 9) & 3, b = it >> 11;
    const size_t rb = (size_t)b * SEQ; const int tmax = tile * 128 + r + 112, tq = tile * 128 + r + 16 * qi;
    bf16x8 qf[4];
    { const bf16_t* qp = QKV + (rb + tq) * W1 + (4 * kh + gq) * 64 + 8 * half;
#pragma unroll
      for (int ks = 0; ks < 4; ++ks) qf[ks] = *(const bf16x8*)(qp + 16 * ks); }
    f32x16 o0, o1;
#pragma unroll
    for (int i = 0; i < 16; ++i) { o0[i] = 0.f; o1[i] = 0.f; }
    float lsum = 0.f;
    const char* sbase = (const char*)(QKV + rb * W1 + 1024 + kh * 64) ;
    constexpr int RP = W1 * 2;
    u32x4 gk[4], gv[4];
    auto issue = [&](int ti) { const int sh = ti < 8 ? 0 : (ti < 13 ? 2 : 4), T = ti < 8 ? ti : (ti < 13 ? ti - 8 : ti - 13);
      const int v0 = (tmax - ((32 * T + lrow) << sh)) * RP + lch * 16; const int dv = (8 << sh) * RP;
#pragma unroll
      for (int i = 0; i < 4; ++i) { int vo = v0 - i * dv; vo = vo < lch * 16 ? lch * 16 : vo;
        const char* rp = sbase + (unsigned)vo; gk[i] = *(const u32x4*)rp; gv[i] = *(const u32x4*)(rp + 512); } };
    issue(0);
#pragma unroll 1
    for (int ti = 0; ti < 18; ++ti) {
      const int sh = ti < 8 ? 0 : (ti < 13 ? 2 : 4), T = ti < 8 ? ti : (ti < 13 ? ti - 8 : ti - 13);
#pragma unroll
      for (int i = 0; i < 4; ++i) { *(LAS u32x4*)(kst + woff + i * 1024) = gk[i]; *(LAS u32x4*)(vst + woff + i * 1024) = gv[i]; }
      if (ti + 1 < 18) issue(ti + 1);
      asm volatile("" ::: "memory");
      f32x16 s;
#pragma unroll
      for (int i = 0; i < 16; ++i) s[i] = -c2;
#pragma unroll
      for (int ks = 0; ks < 4; ++ks) { const bf16x8 kf = *(const LAS bf16x8*)(kst + (kra ^ (ks << 5))); s = __builtin_amdgcn_mfma_f32_32x32x16_bf16(kf, qf[ks], s, 0, 0, 0); }
      unsigned m32;
      { const int ei = (16 >> sh) * (7 - qi); const int nmax = tmax >> sh; const int hn = (ei + 128 < nmax) ? ei + 128 : nmax;
        const int lo = ei - 32 * T - 4 * half, hi = hn - 32 * T - 4 * half;
        const int loc = lo < 0 ? 0 : lo, hic = hi > 31 ? 31 : hi;
        m32 = (loc <= hic) ? ((0xFFFFFFFFu >> (31 - hic)) & (0xFFFFFFFFu << loc)) : 0u; }
#pragma unroll
      for (int reg = 0; reg < 16; ++reg) { const int mb = __builtin_amdgcn_sbfe((int)m32, (reg & 3) + 8 * (reg >> 2), 1);
        const float p = __int_as_float(__float_as_int(__builtin_amdgcn_exp2f(s[reg])) & mb); s[reg] = p; lsum += p; }
#pragma unroll
      for (int st = 0; st < 2; ++st) {
        u32x4 pw; pw.x = pk2(s[8 * st], s[8 * st + 1]); pw.y = pk2(s[8 * st + 2], s[8 * st + 3]); pw.z = pk2(s[8 * st + 4], s[8 * st + 5]); pw.w = pk2(s[8 * st + 6], s[8 * st + 7]);
        const bf16x8 pf = __builtin_bit_cast(bf16x8, pw);
#pragma unroll
        for (int dblk = 0; dblk < 2; ++dblk) {
          const int ta = (tra0 ^ (dblk << 6)) + st * 2048;
          const s16x4 lo4 = tr_read(vst + ta), hi4 = tr_read(vst + ta + 1024);
          const bf16x8 vf = __builtin_shufflevector(lo4, hi4, 0, 1, 2, 3, 4, 5, 6, 7);
          if (dblk == 0) o0 = __builtin_amdgcn_mfma_f32_32x32x16_bf16(vf, pf, o0, 0, 0, 0); else o1 = __builtin_amdgcn_mfma_f32_32x32x16_bf16(vf, pf, o1, 0, 0, 0);
        }
      }
      asm volatile("" ::: "memory");
    }
    lsum += __shfl_xor(lsum, 32);
    const float inv = 1.0f / lsum;
    bf16_t* op = MIX + (rb + tq) * DM + (4 * kh + gq) * 64 + 4 * half;
#pragma unroll
    for (int gI = 0; gI < 4; ++gI) {
      u32x2 w0; w0.x = pk2(o0[4 * gI] * inv, o0[4 * gI + 1] * inv); w0.y = pk2(o0[4 * gI + 2] * inv, o0[4 * gI + 3] * inv); *(u32x2*)(op + 8 * gI) = w0;
      u32x2 w1; w1.x = pk2(o1[4 * gI] * inv, o1[4 * gI + 1] * inv); w1.y = pk2(o1[4 * gI + 2] * inv, o1[4 * gI + 3] * inv); *(u32x2*)(op + 32 + 8 * gI) = w1;
    }
  }
}

#define XB_TMO      128
#define XB_XCNT(j)  (256  + 64 * (j))
#define XB_XSUB(j)  (1280 + 64 * (j))
#define XB_XGEN(j)  (2304 + 64 * (j))
#define XB_TOP      3328
#define XB_TOPGEN   3392
#define XCD_BAR_WORDS 3456
#define XB_SPIN_CAP (1u << 18)

__device__ __forceinline__ unsigned xb_ld(unsigned* p)              { return __hip_atomic_load(p, __ATOMIC_RELAXED, __HIP_MEMORY_SCOPE_AGENT); }
__device__ __forceinline__ unsigned xb_add(unsigned* p, unsigned v) { return __hip_atomic_fetch_add(p, v, __ATOMIC_RELAXED, __HIP_MEMORY_SCOPE_AGENT); }
__device__ __forceinline__ unsigned xb_xcc_id() { return (unsigned)__builtin_amdgcn_s_getreg((3 << 11) | 20) & 0xFu; }
#define XB_SPIN(cond, bar) do { unsigned _sp = 0; while (cond) { __builtin_amdgcn_s_sleep(1); \
    if ((++_sp & 255u) == 0u) { if (xb_ld(&(bar)[XB_TMO])) break; if (_sp > XB_SPIN_CAP) { atomicAdd(&(bar)[XB_TMO], 1u); break; } } } } while (0)

struct XcdBarrier {
    unsigned* bar; unsigned x;
    volatile LAS unsigned* st;
};

__device__ __forceinline__ XcdBarrier xcd_barrier_post(unsigned* bar, volatile LAS unsigned* st) {
    XcdBarrier b; b.bar = bar; b.x = xb_xcc_id(); b.st = st;
    if (threadIdx.x == 0) (void)xb_add(&bar[XB_XCNT(b.x)], 1u);
    return b;
}
__device__ __forceinline__ void xcd_barrier_complete(unsigned* bar, unsigned x, unsigned& nloc, unsigned& nx) {
    const unsigned G = gridDim.x * gridDim.y * gridDim.z;
    unsigned sum, cnt, mine, sp = 0u;
    for (;;) {
        sum = 0u; cnt = 0u; mine = 0u;
#pragma unroll
        for (unsigned j = 0; j < 16; ++j) { const unsigned c = xb_ld(&bar[XB_XCNT(j)]); sum += c; cnt += (c > 0u) ? 1u : 0u; mine = (j == x) ? c : mine; }
        if (sum == G) break;
        __builtin_amdgcn_s_sleep(1);
        if ((++sp & 255u) == 0u) { if (xb_ld(&bar[XB_TMO])) break; if (sp > XB_SPIN_CAP) { atomicAdd(&bar[XB_TMO], 1u); break; } }
    }
    nloc = mine > 0u ? mine : 1u; nx = cnt > 0u ? cnt : 1u;
}

__device__ __forceinline__ void xcd_barrier(const XcdBarrier& b) {
    asm volatile("s_waitcnt vmcnt(0)" ::: "memory");
    __syncthreads();
    if (threadIdx.x == 0) {
        unsigned* bar = b.bar;
        __builtin_amdgcn_s_waitcnt(0);
        unsigned nloc = b.st[0], nx = b.st[1];
        if (nloc == 0u) { xcd_barrier_complete(bar, b.x, nloc, nx); b.st[0] = nloc; b.st[1] = nx; }
        const unsigned old = xb_add(&bar[XB_XSUB(b.x)], 1u);
        const unsigned gen = old / nloc;
        if (old + 1u == (gen + 1u) * nloc) {
            __builtin_amdgcn_fence(__ATOMIC_RELEASE, "agent");
            asm volatile("s_waitcnt vmcnt(0)" ::: "memory");
            const unsigned og = xb_add(&bar[XB_TOP], 1u);
            const unsigned tg = og / nx;
            if (og + 1u == (tg + 1u) * nx) xb_add(&bar[XB_TOPGEN], 1u);
            else XB_SPIN(xb_ld(&bar[XB_TOPGEN]) == tg, bar);
            __builtin_amdgcn_fence(__ATOMIC_ACQUIRE, "agent");
            xb_add(&bar[XB_XGEN(b.x)], 1u);
            asm volatile("s_waitcnt vmcnt(0)" ::: "memory");
        } else {
            XB_SPIN(xb_ld(&bar[XB_XGEN(b.x)]) == gen, bar);
            __builtin_amdgcn_fence(__ATOMIC_ACQUIRE, "agent");
            asm volatile("s_waitcnt vmcnt(0)" ::: "memory");
        }
    }
    __syncthreads();
}


__global__ void __launch_bounds__(512, 2) fwd_megakernel(Params P) {
  extern __shared__ __attribute__((aligned(16))) unsigned char lds_raw[];
  cg::grid_group grid = cg::this_grid();
  Ctx F; F.lds = (LAS unsigned char*)lds_raw; F.wave = __builtin_amdgcn_readfirstlane((int)threadIdx.x >> 6);
  F.G = gridDim.x; F.gw = blockIdx.x * 8 + F.wave; F.NGW = F.G * 8;
  unsigned char* ws = P.ws;
  volatile LAS unsigned* xst = (volatile LAS unsigned*)(F.lds + LDS_BYTES - 16);
  if (threadIdx.x < 2) xst[threadIdx.x] = 0u;
  unsigned* xbar_words = (unsigned*)(ws + WS_CTL + 65536);
  __syncthreads();
  XcdBarrier xbar = xcd_barrier_post(xbar_words, xst);
#define GRID_BAR() xcd_barrier(xbar)

#ifndef PHMASK
#define PHMASK 0xFFFFFFFFu
#endif
#define PH(n) if ((PHMASK >> (n)) & 1u)
#if defined(TIMEDSA) && !defined(TIMEPH)
#define TIMEPH 99
#define TIMEN 1
#endif
#ifdef TIMEPH
  unsigned long long* tsw = (unsigned long long*)(ws + WS_CTL + 4096);
#define TS_BEGIN(n) if ((n) >= TIMEPH && (n) < TIMEPH + TIMEN && (n) == TIMEPH && blockIdx.x == 0 && threadIdx.x == 0) tsw[0] = __builtin_amdgcn_s_memrealtime();
#define TS_END(n) if ((n) == TIMEPH + TIMEN - 1 && blockIdx.x == 0 && threadIdx.x == 0) tsw[1] = __builtin_amdgcn_s_memrealtime();
#else
#define TS_BEGIN(n)
#define TS_END(n)
#endif
  TS_BEGIN(0)
  PH(0) p0_prologue(F, P);
  if (P.ws == nullptr) grid.sync();
  GRID_BAR();
  TS_END(0)
  TS_BEGIN(1)
  PH(1) {
    pg8::DenseSched S; S.init(NTOK, W0P, 1024, ws + WS_WIN0, F.G, (int)blockIdx.x);
    pg8::EpiProj0 E{(bf16_t*)(ws + WS_PROJ), (bf16_t*)(ws + WS_KF), (bf16_t*)(ws + WS_IKF), P.in[I_QN0], P.in[I_KN0], (const float*)(ws + WS_ROPE), (const float*)(ws + WS_ROPE) + SEQ * 32};
    pg8::gemm_phase<pg8::EpiProj0, pg8::DenseSched, true>(F.lds, F.wave, (const char*)(ws + WS_XN), 1024, S, E);
  }
  GRID_BAR();
  TS_END(1)
  TS_BEGIN(2)
  PH(2) p1b_transform0(F, P);
  GRID_BAR();
  TS_END(2)
  TS_BEGIN(3)
  PH(3) dsa_phase(F, P);
  GRID_BAR();
  TS_END(3)
  TS_BEGIN(4)
  PH(4) {
    pg8::DenseSched S; S.init(NTOK, 1024, 1024, ws + WS_WOUT0, F.G, (int)blockIdx.x);
    pg8::EpiResB<true> E{P.in[I_X], (bf16_t*)(ws + WS_XB), DM};
    pg8::gemm_phase<pg8::EpiResB<true>, pg8::DenseSched, true>(F.lds, F.wave, (const char*)(ws + WS_MIX), 1024, S, E);
  }
  GRID_BAR();
  TS_END(4)
  TS_BEGIN(5)
  PH(5) router_phase(F, P, 0);
  GRID_BAR();
  TS_END(5)
  TS_BEGIN(6)
  PH(6) moe_gemms(F, P, 0, xbar);
  GRID_BAR();
  TS_END(6)
  TS_BEGIN(7)
  PH(7) combine_phase(F, P, 0, true);
  GRID_BAR();
  TS_END(7)
  TS_BEGIN(8)
  PH(8) {
    pg8::DenseSched S; S.init(NTOK, W1, 1024, ws + WS_WIN1, F.G, (int)blockIdx.x);
    pg8::EpiQKV1 E{(bf16_t*)(ws + WS_PROJ), P.in[I_QN1], P.in[I_KN1], (const float*)(ws + WS_ROPE), (const float*)(ws + WS_ROPE) + SEQ * 32};
    pg8::gemm_phase<pg8::EpiQKV1, pg8::DenseSched, true>(F.lds, F.wave, (const char*)(ws + WS_XN), 1024, S, E);
  }
  GRID_BAR();
  TS_END(8)
  TS_BEGIN(10)
  PH(10) dil_phase(F, P);
  GRID_BAR();
  TS_END(10)
  TS_BEGIN(11)
  PH(11) {
    pg8::DenseSched S; S.init(NTOK, 1024, 1024, ws + WS_WOUT1, F.G, (int)blockIdx.x);
    pg8::EpiResB<false> E{ws + WS_XB, (bf16_t*)(ws + WS_XB), DM};
    pg8::gemm_phase<pg8::EpiResB<false>, pg8::DenseSched, true>(F.lds, F.wave, (const char*)(ws + WS_MIX), 1024, S, E);
  }
  GRID_BAR();
  TS_END(11)
  TS_BEGIN(12)
  PH(12) router_phase(F, P, 1);
  GRID_BAR();
  TS_END(12)
  TS_BEGIN(13)
  PH(13) moe_gemms(F, P, 1, xbar);
  GRID_BAR();
  TS_END(13)
  TS_BEGIN(14)
  PH(14) combine_phase(F, P, 1, false);
#ifdef TIMEPH
  GRID_BAR();
  TS_END(14)
  GRID_BAR();
  { const unsigned long long dt = (tsw[1] - tsw[0]) * 4ull; const unsigned long long t0 = __builtin_amdgcn_s_memrealtime();
    while (__builtin_amdgcn_s_memrealtime() - t0 < dt) __builtin_amdgcn_s_sleep(32); }
#endif
}

extern "C" void kernel_launch(void* const* d_in, const int* in_sizes, int n_in, void* d_out, int out_size, void* d_ws, size_t ws_size, hipStream_t stream) {
  static int grid_blocks = 0;
  if (!grid_blocks) {
    if (n_in != 28 || out_size != NTOK * DM || ws_size < WS_END) { fprintf(stderr, "kernel_launch: unexpected shapes (n_in %d out %d ws %zu)\n", n_in, out_size, ws_size); grid_blocks = -1; return; }
    int dev = 0, cus = 0, per_cu = 0;
    (void)hipGetDevice(&dev);
    (void)hipDeviceGetAttribute(&cus, hipDeviceAttributeMultiprocessorCount, dev);
    (void)hipFuncSetAttribute((const void*)fwd_megakernel, hipFuncAttributeMaxDynamicSharedMemorySize, LDS_BYTES);
    (void)hipOccupancyMaxActiveBlocksPerMultiprocessor(&per_cu, (const void*)fwd_megakernel, 512, LDS_BYTES);
    if (per_cu < 1) per_cu = 1;
    grid_blocks = cus * per_cu;
  }
  if (grid_blocks < 0) return;
  Params p{};
  for (int i = 0; i < 28; ++i) p.in[i] = (const float*)d_in[i];
  p.out = (float*)d_out; p.ws = (unsigned char*)d_ws;
  (void)hipMemsetAsync((unsigned char*)d_ws + WS_CTL + 65536, 0, XCD_BAR_WORDS * 4, stream);
  void* args[] = {&p};
  hipError_t e = hipLaunchCooperativeKernel((const void*)fwd_megakernel, dim3(grid_blocks), dim3(512), args, LDS_BYTES, stream);
  if (e != hipSuccess) fprintf(stderr, "cooperative launch failed: %s (grid %d)\n", hipGetErrorString(e), grid_blocks);
}
```

```cpp
#include <hip/hip_runtime.h>
#include <hip/hip_cooperative_groups.h>
#include <cstdio>
#include <cstdint>
namespace cg = cooperative_groups;

#define LAS __attribute__((address_space(3)))
#define DI __device__ __forceinline__
typedef unsigned short bf16_t;
typedef short bf16x8 __attribute__((ext_vector_type(8)));
typedef short s16x4 __attribute__((ext_vector_type(4)));
typedef float f32x2 __attribute__((ext_vector_type(2)));
typedef float f32x4 __attribute__((ext_vector_type(4)));
typedef float f32x16 __attribute__((ext_vector_type(16)));
typedef unsigned u32x2 __attribute__((ext_vector_type(2)));
typedef unsigned u32x4 __attribute__((ext_vector_type(4)));
typedef int i32x4 __attribute__((ext_vector_type(4)));
typedef __bf16 bf16x2_t __attribute__((ext_vector_type(2)));

constexpr int NTOK = 65536, DM = 1024, SEQ = 4096, NBATCH = 16;
constexpr int W0P = 2560, W0V = 2500;
constexpr int W1 = 1536;
constexpr int C_CB = 0, C_CC = 512, C_CH = 1024, C_Q = 1536, C_K = 2048, C_V = 2112, C_IQ = 2176, C_IK = 2432, C_IW = 2496;
constexpr int NEXP = 32, DEXP = 512;
constexpr int MAXROWS = 139264;
constexpr float NORM_EPS = 1e-6f;
constexpr float LOG2E = 1.4426950408889634f;

constexpr size_t MiB = 1u << 20;
constexpr size_t WS_CTL = 0;
constexpr size_t WS_ROPE = 1 * MiB;
constexpr size_t WS_WR0 = 2 * MiB, WS_WR1 = 2 * MiB + 256 * 1024;
constexpr size_t WS_WIN0 = 3 * MiB, WS_WOUT0 = 8 * MiB, WS_WIN1 = 10 * MiB, WS_WOUT1 = 13 * MiB;
constexpr size_t WS_WGU0 = 16 * MiB, WS_WD0 = 80 * MiB, WS_WGU1 = 112 * MiB, WS_WD1 = 176 * MiB;
constexpr size_t WS_XN = 208 * MiB;
constexpr size_t WS_MIX = 337 * MiB;
constexpr size_t WS_H = 337 * MiB;
constexpr size_t WS_XB = 473 * MiB;
constexpr size_t WS_PROJ = 601 * MiB;
constexpr size_t WS_LIST = 921 * MiB;
constexpr size_t WS_ASG = 929 * MiB;
constexpr size_t WS_ASGG = 930 * MiB;
constexpr size_t WS_IKF = 931 * MiB, WS_KF = 939 * MiB, WS_VTF = 947 * MiB;
constexpr size_t WS_RSL = 955 * MiB;
constexpr size_t WS_END = 963 * MiB;

constexpr int LDS_BYTES = 155648;
constexpr int LDS_LIST = 131072;
constexpr int LDS_MISC = 131072 + 16384;

DI unsigned pk2(float lo, float hi) { f32x2 v = {lo, hi}; bf16x2_t b = __builtin_convertvector(v, bf16x2_t); return __builtin_bit_cast(unsigned, b); }
DI float bflo(unsigned w) { return __uint_as_float(w << 16); }
DI float bfhi(unsigned w) { return __uint_as_float(w & 0xffff0000u); }
DI float bf1(bf16_t h) { return __uint_as_float((unsigned)h << 16); }
DI int opaque(int x) { asm volatile("" : "+v"(x)); return x; }
DI int lane_id_v() { int l; asm volatile("v_mbcnt_lo_u32_b32 %0, -1, 0\n\tv_mbcnt_hi_u32_b32 %0, -1, %0" : "=v"(l)); return l; }
DI float wave_sum(float v) {
#pragma unroll
  for (int o = 1; o < 64; o <<= 1) v += __shfl_xor(v, o);
  return v;
}
DI float wave_max(float v) {
#pragma unroll
  for (int o = 1; o < 64; o <<= 1) v = fmaxf(v, __shfl_xor(v, o));
  return v;
}
DI unsigned wave_sum_u(unsigned v) {
#pragma unroll
  for (int o = 1; o < 64; o <<= 1) v += (unsigned)__shfl_xor((int)v, o);
  return v;
}

namespace pg8 {
constexpr int BM = 256, BK = 64, HALF = 128, HTB = HALF * BK * 2, STAGE_BYTES = 8 * HTB, NXCD = 8, WGM = 8;
DI int lds_byte(int r, int c) { const int st = (r >> 4) * 2 + (c >> 5), rr = r & 15, cc = c & 31, ob = rr * 64 + cc * 2; return st * 1024 + (ob ^ (((ob >> 9) & 1) << 5)); }
DI void stage_rc(int b, int& R, int& C) { const int st = b / 1024, sb = b % 1024, swz = sb ^ (((sb >> 9) & 1) << 5); R = (st >> 1) * 16 + swz / 64; C = (st & 1) * 32 + (swz % 64) / 2; }
DI int perm32(int rho) { const int n = rho >> 4, i = rho & 15; return 8 * (i >> 2) + 4 * n + (i & 3); }

struct Unit { const char* b; int p0, p1, p2, p3; };

struct EpiBf16 {
  static constexpr bool PERM = true;
  bf16_t* O; int ldc;
  DI void operator()(const f32x4 (&acc)[2][2][4][2], const Unit& u, int wr, int wc, int fr, int fq) const {
    const int row0 = u.p0 + wr * 64 + fr, col0 = u.p1 + wc * 32 + 8 * fq;
#pragma unroll
    for (int ai = 0; ai < 2; ++ai)
#pragma unroll
      for (int m = 0; m < 4; ++m) { bf16_t* rowp = O + (size_t)(row0 + ai * HALF + m * 16) * ldc + col0;
#pragma unroll
        for (int bj = 0; bj < 2; ++bj) { const f32x4 v0 = acc[ai][bj][m][0], v1 = acc[ai][bj][m][1];
          u32x4 w; w.x = pk2(v0[0], v0[1]); w.y = pk2(v0[2], v0[3]); w.z = pk2(v1[0], v1[1]); w.w = pk2(v1[2], v1[3]);
          *(u32x4*)(rowp + bj * HALF) = w; } }
  }
};
template <bool BASE_F32> struct EpiResB {
  static constexpr bool PERM = true;
  const void* base; bf16_t* out; int ldc;
  DI void operator()(const f32x4 (&acc)[2][2][4][2], const Unit& u, int wr, int wc, int fr, int fq) const {
    const int row0 = u.p0 + wr * 64 + fr, col0 = u.p1 + wc * 32 + 8 * fq;
#pragma unroll
    for (int ai = 0; ai < 2; ++ai)
#pragma unroll
      for (int m = 0; m < 4; ++m) { const size_t off = (size_t)(row0 + ai * HALF + m * 16) * ldc + col0;
#pragma unroll
        for (int bj = 0; bj < 2; ++bj) { f32x4 v0 = acc[ai][bj][m][0], v1 = acc[ai][bj][m][1];
          if (BASE_F32) { const float* bp = (const float*)base + off + bj * HALF; v0 = v0 + *(const f32x4*)bp; v1 = v1 + *(const f32x4*)(bp + 4); }
          else { const u32x4 b = *(const u32x4*)((const bf16_t*)base + off + bj * HALF);
            v0 = v0 + (f32x4){bflo(b.x), bfhi(b.x), bflo(b.y), bfhi(b.y)}; v1 = v1 + (f32x4){bflo(b.z), bfhi(b.z), bflo(b.w), bfhi(b.w)}; }
          u32x4 w; w.x = pk2(v0[0], v0[1]); w.y = pk2(v0[2], v0[3]); w.z = pk2(v1[0], v1[1]); w.w = pk2(v1[2], v1[3]);
          *(u32x4*)(out + off + bj * HALF) = w; } }
  }
};
struct EpiQKV1 {
  static constexpr bool PERM = true;
  bf16_t* O; const float* qg; const float* kg; const float* cosT; const float* sinT;
  DI void operator()(const f32x4 (&acc)[2][2][4][2], const Unit& u, int wr, int wc, int fr, int fq) const {
    const int tilec = u.p1 >> 8;
    const int row0 = u.p0 + wr * 64 + fr, col0 = u.p1 + wc * 64 + 8 * fq;
    if (tilec == 5) {
#pragma unroll
      for (int ai = 0; ai < 2; ++ai)
#pragma unroll
        for (int m = 0; m < 4; ++m) { bf16_t* rowp = O + (size_t)(row0 + ai * HALF + m * 16) * W1 + col0;
#pragma unroll
          for (int bj = 0; bj < 2; ++bj) { const f32x4 v0 = acc[ai][bj][m][0], v1 = acc[ai][bj][m][1];
            u32x4 w; w.x = pk2(v0[0], v0[1]); w.y = pk2(v0[2], v0[3]); w.z = pk2(v1[0], v1[1]); w.w = pk2(v1[2], v1[3]); *(u32x4*)(rowp + 32 * bj) = w; } }
      return;
    }
    const float* gp = (tilec == 4 ? kg : qg) + 8 * fq; const float osc = tilec == 4 ? 1.f : 0.125f * LOG2E;
    float g0[8], g1[8];
#pragma unroll
    for (int i = 0; i < 8; ++i) { g0[i] = gp[i]; g1[i] = gp[32 + i]; }
#pragma unroll
    for (int ai = 0; ai < 2; ++ai)
#pragma unroll
      for (int m = 0; m < 4; ++m) {
        const int row = row0 + ai * HALF + m * 16; const int t = row & (SEQ - 1);
        const f32x4 a0 = acc[ai][0][m][0], a1 = acc[ai][0][m][1], b0 = acc[ai][1][m][0], b1 = acc[ai][1][m][1];
        float x1[8] = {a0[0], a0[1], a0[2], a0[3], a1[0], a1[1], a1[2], a1[3]}, x2[8] = {b0[0], b0[1], b0[2], b0[3], b1[0], b1[1], b1[2], b1[3]};
        float ss = 0.f;
#pragma unroll
        for (int i = 0; i < 8; ++i) ss += x1[i] * x1[i] + x2[i] * x2[i];
        ss += __shfl_xor(ss, 16); ss += __shfl_xor(ss, 32);
        const float rstd = 1.0f / sqrtf(ss * (1.f / 64.f) + NORM_EPS);
        const f32x4* cp = (const f32x4*)(cosT + t * 32 + 8 * fq); const f32x4* sp = (const f32x4*)(sinT + t * 32 + 8 * fq);
        const f32x4 c0 = cp[0], c1 = cp[1], s0 = sp[0], s1 = sp[1];
        const float cv[8] = {c0[0], c0[1], c0[2], c0[3], c1[0], c1[1], c1[2], c1[3]}, sv[8] = {s0[0], s0[1], s0[2], s0[3], s1[0], s1[1], s1[2], s1[3]};
        float o1[8], o2[8];
#pragma unroll
        for (int i = 0; i < 8; ++i) { const float y1 = x1[i] * rstd * g0[i], y2 = x2[i] * rstd * g1[i]; o1[i] = (y1 * cv[i] - y2 * sv[i]) * osc; o2[i] = (y1 * sv[i] + y2 * cv[i]) * osc; }
        bf16_t* rowp = O + (size_t)row * W1 + col0;
        u32x4 w; w.x = pk2(o1[0], o1[1]); w.y = pk2(o1[2], o1[3]); w.z = pk2(o1[4], o1[5]); w.w = pk2(o1[6], o1[7]); *(u32x4*)rowp = w;
        w.x = pk2(o2[0], o2[1]); w.y = pk2(o2[2], o2[3]); w.z = pk2(o2[4], o2[5]); w.w = pk2(o2[6], o2[7]); *(u32x4*)(rowp + 32) = w;
      }
  }
};
struct EpiProj0 {
  static constexpr bool PERM = true;
  bf16_t* O; bf16_t* KFo; bf16_t* IKFo; bf16_t* VRo; const float* qg; const float* kg; const float* cosT; const float* sinT;
  DI void operator()(const f32x4 (&acc)[2][2][4][2], const Unit& u, int wr, int wc, int fr, int fq) const {
    const int grp64 = (u.p1 >> 6) + wc;
    const int row0 = u.p0 + wr * 64 + fr, col0 = u.p1 + wc * 64 + 8 * fq;
    const bool rope = (grp64 >= 24 && grp64 <= 32) || (grp64 >= 34 && grp64 <= 38);
    if (!rope) {
#pragma unroll
      for (int ai = 0; ai < 2; ++ai)
#pragma unroll
        for (int m = 0; m < 4; ++m) { const int row = row0 + ai * HALF + m * 16;
          bf16_t* rowp = grp64 == 33 ? VRo + (size_t)row * 64 + 8 * fq : O + (size_t)row * W0P + col0;
#pragma unroll
          for (int bj = 0; bj < 2; ++bj) { const f32x4 v0 = acc[ai][bj][m][0], v1 = acc[ai][bj][m][1];
            u32x4 w; w.x = pk2(v0[0], v0[1]); w.y = pk2(v0[2], v0[3]); w.z = pk2(v1[0], v1[1]); w.w = pk2(v1[2], v1[3]); *(u32x4*)(rowp + 32 * bj) = w; } }
      return;
    }
    const bool norm = grp64 <= 32;
    const float* gp = (grp64 == 32 ? kg : qg) + 8 * fq;
    float g0[8], g1[8];
#pragma unroll
    for (int i = 0; i < 8; ++i) { g0[i] = norm ? gp[i] : 1.f; g1[i] = norm ? gp[32 + i] : 1.f; }
    bf16_t* frag = grp64 == 32 ? KFo : (grp64 == 38 ? IKFo : nullptr);
#pragma unroll
    for (int ai = 0; ai < 2; ++ai)
#pragma unroll
      for (int m = 0; m < 4; ++m) {
        const int row = row0 + ai * HALF + m * 16; const int t = row & (SEQ - 1);
        const f32x4 a0 = acc[ai][0][m][0], a1 = acc[ai][0][m][1], b0 = acc[ai][1][m][0], b1 = acc[ai][1][m][1];
        float x1[8] = {a0[0], a0[1], a0[2], a0[3], a1[0], a1[1], a1[2], a1[3]}, x2[8] = {b0[0], b0[1], b0[2], b0[3], b1[0], b1[1], b1[2], b1[3]};
        float ss = 0.f;
#pragma unroll
        for (int i = 0; i < 8; ++i) ss += x1[i] * x1[i] + x2[i] * x2[i];
        ss += __shfl_xor(ss, 16); ss += __shfl_xor(ss, 32);
        const float rstd = norm ? 1.0f / sqrtf(ss * (1.f / 64.f) + NORM_EPS) : 1.f;
        const f32x4* cp = (const f32x4*)(cosT + t * 32 + 8 * fq); const f32x4* sp = (const f32x4*)(sinT + t * 32 + 8 * fq);
        const f32x4 c0 = cp[0], c1 = cp[1], s0 = sp[0], s1 = sp[1];
        const float cv[8] = {c0[0], c0[1], c0[2], c0[3], c1[0], c1[1], c1[2], c1[3]}, sv[8] = {s0[0], s0[1], s0[2], s0[3], s1[0], s1[1], s1[2], s1[3]};
        float o1[8], o2[8];
#pragma unroll
        for (int i = 0; i < 8; ++i) { const float y1 = x1[i] * rstd * g0[i], y2 = x2[i] * rstd * g1[i]; o1[i] = y1 * cv[i] - y2 * sv[i]; o2[i] = y1 * sv[i] + y2 * cv[i]; }
        u32x4 w1, w2; w1.x = pk2(o1[0], o1[1]); w1.y = pk2(o1[2], o1[3]); w1.z = pk2(o1[4], o1[5]); w1.w = pk2(o1[6], o1[7]);
        w2.x = pk2(o2[0], o2[1]); w2.y = pk2(o2[2], o2[3]); w2.z = pk2(o2[4], o2[5]); w2.w = pk2(o2[6], o2[7]);
        if (grp64 == 32) { bf16_t* kr = KFo + (size_t)row * 64 + 8 * fq; *(u32x4*)kr = w1; *(u32x4*)(kr + 32) = w2; }
        else if (frag) {
          const size_t fo = ((((size_t)(row >> 12) * 128 + (t >> 5)) * 4 + (fq >> 1)) * 64 + (fq & 1) * 32 + (t & 31)) * 8;
          *(u32x4*)(frag + fo) = w1; *(u32x4*)(frag + fo + 2 * 64 * 8) = w2;
        } else { bf16_t* rowp = O + (size_t)row * W0P + col0; *(u32x4*)rowp = w1; *(u32x4*)(rowp + 32) = w2; }
      }
  }
};
struct EpiResF32 {
  static constexpr bool PERM = false;
  const float* base; float* out; int ldc;
  DI void operator()(const f32x4 (&acc)[2][2][4][2], const Unit& u, int wr, int wc, int fr, int fq) const {
    const int row0 = u.p0 + wr * 64 + fr, col0 = u.p1 + wc * 32 + 4 * fq;
#pragma unroll
    for (int ai = 0; ai < 2; ++ai)
#pragma unroll
      for (int m = 0; m < 4; ++m) { const size_t off = (size_t)(row0 + ai * HALF + m * 16) * ldc + col0;
#pragma unroll
        for (int bj = 0; bj < 2; ++bj)
#pragma unroll
          for (int n = 0; n < 2; ++n) { const f32x4 bs = *(const f32x4*)(base + off + bj * HALF + n * 16); *(f32x4*)(out + off + bj * HALF + n * 16) = bs + acc[ai][bj][m][n]; } }
  }
};
DI float silu_mul(float g, float u) { return g * u * __builtin_amdgcn_rcpf(1.0f + __builtin_amdgcn_exp2f(-g * LOG2E)); }
struct EpiSwiGLU {
  static constexpr bool PERM = true;
  bf16_t* H; const float* RSL; const LAS int* cnt;
  DI void operator()(const f32x4 (&acc)[2][2][4][2], const Unit& u, int wr, int wc, int fr, int fq) const {
    const int row0 = u.p0 + wr * 64 + fr, col0 = u.p1 + wc * 32 + 8 * fq; const int ce = __builtin_amdgcn_readfirstlane(cnt[u.p2]);
#pragma unroll
    for (int ai = 0; ai < 2; ++ai)
#pragma unroll
      for (int m = 0; m < 4; ++m) { bf16_t* rowp = H + (size_t)(row0 + ai * HALF + m * 16) * DEXP + col0;
        const int lrow = u.p3 * BM + wr * 64 + fr + ai * HALF + m * 16; const float rs = (lrow < ce) ? RSL[u.p2 * 65536 + lrow] : 0.f;
        const f32x4 g0 = acc[ai][0][m][0] * rs, g1 = acc[ai][0][m][1] * rs, u0 = acc[ai][1][m][0] * rs, u1 = acc[ai][1][m][1] * rs;
        u32x4 w; w.x = pk2(silu_mul(g0[0], u0[0]), silu_mul(g0[1], u0[1])); w.y = pk2(silu_mul(g0[2], u0[2]), silu_mul(g0[3], u0[3]));
        w.z = pk2(silu_mul(g1[0], u1[0]), silu_mul(g1[1], u1[1])); w.w = pk2(silu_mul(g1[2], u1[2]), silu_mul(g1[3], u1[3]));
        *(u32x4*)rowp = w; }
  }
};

struct DenseSched {
  static constexpr bool NEXT_IN_LDS = false;
  int nM, nN, nwg, G, c, K; const char* Bt;
  DI void init(int M, int N, int K_, const void* Bt_, int G_, int c_) { nM = M / BM; nN = N / BM; nwg = nM * nN; G = G_; c = c_; K = K_; Bt = (const char*)Bt_; }
  DI bool next(int i, Unit& u) const {
    const long L = (long)i * G + c; if (L >= nwg) return false;
    int wgid = (int)L; { const int q = nwg / NXCD, r = nwg % NXCD, xcd = wgid % NXCD, off = wgid / NXCD; wgid = (xcd < r ? xcd * (q + 1) : r * (q + 1) + (xcd - r) * q) + off; }
    const int nig = WGM * nN, gid = wgid / nig, fm = gid * WGM, gsz = (nM - fm) < WGM ? (nM - fm) : WGM;
    const int pm = fm + ((wgid % nig) % gsz), pn = (wgid % nig) / gsz;
    u.p0 = pm * BM; u.p1 = pn * BM; u.p2 = 0; u.p3 = 0; u.b = Bt + (size_t)pn * BM * K * 2; return true;
  }
  DI void a_off(const Unit& u, const int (&R)[2], const int (&C)[2], unsigned (&o)[2][2]) const {
#pragma unroll
    for (int h = 0; h < 2; ++h)
#pragma unroll
      for (int i = 0; i < 2; ++i) o[h][i] = (unsigned)((u.p0 + h * HALF + R[i]) * K + C[i]) * 2u;
  }
};
template <bool GATHER> struct MoeSched {
  static constexpr bool NEXT_IN_LDS = GATHER;
  const LAS int* pb; const LAS int* cnt; const int* list; const char* W; int G, c, K;
  DI bool next(int i, Unit& u) const {
    const int L = i * G + c; const int total = __builtin_amdgcn_readfirstlane(pb[NEXP]) * 4; if (L >= total) return false;
    const int rbg = L >> 2, pn = L & 3; int e = 0;
    for (int j = 1; j < NEXP; ++j) e = (__builtin_amdgcn_readfirstlane(pb[j]) <= rbg) ? j : e;
    u.p0 = rbg * BM; u.p1 = pn * (GATHER ? 128 : 256); u.p2 = e; u.p3 = rbg - __builtin_amdgcn_readfirstlane(pb[e]);
    u.b = W + (size_t)(e * 1024 + pn * 256) * K * 2; return true;
  }
  DI void a_off(const Unit& u, const int (&R)[2], const int (&C)[2], unsigned (&o)[2][2]) const {
    if (GATHER) {
      const int ce = __builtin_amdgcn_readfirstlane(cnt[u.p2]);
#pragma unroll
      for (int h = 0; h < 2; ++h)
#pragma unroll
        for (int i = 0; i < 2; ++i) { const int row = u.p3 * BM + h * HALF + R[i]; const int tok = (row < ce) ? list[u.p2 * 65536 + row] : 0; o[h][i] = (unsigned)(tok * K + C[i]) * 2u; }
    } else {
#pragma unroll
      for (int h = 0; h < 2; ++h)
#pragma unroll
        for (int i = 0; i < 2; ++i) o[h][i] = (unsigned)((u.p0 + h * HALF + R[i]) * K + C[i]) * 2u;
    }
  }
};

template <class Epi, class Sched, bool ALIGN_EPI>
DI void gemm_phase(LAS unsigned char* lds, const int wave_id, const char* gA, const int K, const Sched& S, const Epi& E) {
  const int lane = lane_id_v(), wid = wave_id, tid = wid * 64 + lane, wr = wid >> 2, wc = wid & 3, fr = lane & 15, fq = lane >> 4;
  const int nt = K / BK;
  unsigned voffB[2];
  { int R, C; stage_rc(tid * 16, R, C);
    const int Rb = Epi::PERM ? ((R & ~31) + perm32(R & 31)) : R; voffB[0] = (unsigned)(Rb * K + C) * 2u; voffB[1] = voffB[0] + (unsigned)(64 * K * 2); }
#define PG8_RC(Rp, Cp) int Rp[2], Cp[2]; { int R_, C_; stage_rc(opaque(tid) * 16, R_, C_); Rp[0] = R_; Cp[0] = C_; Rp[1] = R_ + 64; Cp[1] = C_; }
  const size_t kstep = (size_t)(BK * 2);
  const size_t hstep = (size_t)HALF * K * 2;
  const unsigned ldsw = (unsigned)wid * 1024u;
  const int aoff = lds_byte(wr * 64 + fr, fq * 8), boff = lds_byte(wc * 32 + fr, fq * 8);
#define PG8_SA(b, h) (((b) * 2 + (h)) * HTB)
#define PG8_SB(b, h) ((4 + (b) * 2 + (h)) * HTB)
#define PG8_STAGE_B(bufoff, gbase) do { _Pragma("unroll") for (int _i = 0; _i < 2; ++_i) \
    __builtin_amdgcn_global_load_lds((const unsigned*)((const char*)(gbase) + voffB[_i]), (LAS unsigned*)(lds + (bufoff) + ldsw + _i * 8192), 16, 0, 0); } while (0)
#define PG8_STAGE_A(bufoff, kb, offs) do { _Pragma("unroll") for (int _i = 0; _i < 2; ++_i) \
    __builtin_amdgcn_global_load_lds((const unsigned*)(gA + (size_t)(kb) + (offs)[_i]), (LAS unsigned*)(lds + (bufoff) + ldsw + _i * 8192), 16, 0, 0); } while (0)
#define PG8_LDA(dst, b, h) do { _Pragma("unroll") for (int m = 0; m < 4; ++m) _Pragma("unroll") for (int k = 0; k < 2; ++k) dst[m][k] = *(const LAS bf16x8*)(lds + PG8_SA(b, h) + aoff + m * 2048 + k * 1024); } while (0)
#define PG8_LDB(dst, b, h) do { _Pragma("unroll") for (int n = 0; n < 2; ++n) _Pragma("unroll") for (int k = 0; k < 2; ++k) dst[n][k] = *(const LAS bf16x8*)(lds + PG8_SB(b, h) + boff + n * 2048 + k * 1024); } while (0)
#define PG8_MMA(ai, bj, At, Bt) do { __builtin_amdgcn_s_setprio(1); _Pragma("unroll") for (int m = 0; m < 4; ++m) _Pragma("unroll") for (int n = 0; n < 2; ++n) _Pragma("unroll") for (int k = 0; k < 2; ++k) \
    acc[ai][bj][m][n] = __builtin_amdgcn_mfma_f32_16x16x32_bf16(Bt[n][k], At[m][k], acc[ai][bj][m][n], 0, 0, 0); __builtin_amdgcn_s_setprio(0); } while (0)
#define PG8_WAIT_V(n) asm volatile("s_waitcnt vmcnt(" #n ")" ::: "memory")
#define PG8_WAIT_L(n) asm volatile("s_waitcnt lgkmcnt(" #n ")" ::: "memory")
#define PG8_BAR __builtin_amdgcn_s_barrier()
#define PG8_SCHED __builtin_amdgcn_sched_barrier(0)
  Unit cur, nxt; int ui = 0;
  if (!S.next(0, cur)) return;
  unsigned ca[2][2];
  { PG8_RC(Rp, Cp) S.a_off(cur, Rp, Cp, ca); }
  f32x4 acc[2][2][4][2];
#pragma unroll
  for (int a = 0; a < 2; ++a)
#pragma unroll
    for (int b = 0; b < 2; ++b)
#pragma unroll
      for (int m = 0; m < 4; ++m)
#pragma unroll
        for (int n = 0; n < 2; ++n) acc[a][b][m][n] = (f32x4){0.f, 0.f, 0.f, 0.f};
  bf16x8 At[4][2], B0[2][2], B1[2][2];
  const char* cB = cur.b;
  PG8_STAGE_B(PG8_SB(0, 0), cB); PG8_STAGE_B(PG8_SB(0, 1), cB + hstep); PG8_STAGE_A(PG8_SA(0, 0), 0, ca[0]); PG8_STAGE_A(PG8_SA(0, 1), 0, ca[1]);
  if (wr == 1) PG8_BAR;
  PG8_WAIT_V(2); PG8_BAR;
  PG8_STAGE_B(PG8_SB(1, 0), cB + kstep); PG8_STAGE_A(PG8_SA(1, 0), kstep, ca[0]); PG8_STAGE_B(PG8_SB(1, 1), cB + hstep + kstep);
  PG8_WAIT_V(6); PG8_BAR;
  for (;;) {
    const bool has_next = S.next(ui + 1, nxt);
    if (Sched::NEXT_IN_LDS) {
      unsigned na[2][2];
      if (has_next) { PG8_RC(Rp, Cp) S.a_off(nxt, Rp, Cp, na); }
      else {
#pragma unroll
        for (int h = 0; h < 2; ++h)
#pragma unroll
          for (int i = 0; i < 2; ++i) na[h][i] = ca[h][i];
      }
      *(LAS u32x4*)(lds + STAGE_BYTES + 8192 + tid * 16) = (u32x4){na[0][0], na[0][1], na[1][0], na[1][1]};
    }
    const char* nB = has_next ? nxt.b : cB;
    for (int t = 0; t < nt; t += 2) {
      const bool last = (t == nt - 2);
      PG8_LDB(B0, 0, 0); PG8_LDB(B1, 0, 1); PG8_SCHED; PG8_LDA(At, 0, 0); PG8_STAGE_A(PG8_SA(1, 1), (size_t)(t + 1) * kstep, ca[1]);
      PG8_WAIT_V(8); PG8_WAIT_L(0); PG8_BAR; PG8_MMA(0, 0, At, B0); PG8_MMA(0, 1, At, B1); PG8_BAR; PG8_SCHED;
      const size_t kb2 = last ? 0 : (size_t)(t + 2) * kstep;
      const char* b2 = last ? nB : cB + (size_t)(t + 2) * kstep;
      if (last) {
        if (Sched::NEXT_IN_LDS) { const u32x4 v = *(const LAS u32x4*)(lds + STAGE_BYTES + 8192 + tid * 16); ca[0][0] = v.x; ca[0][1] = v.y; ca[1][0] = v.z; ca[1][1] = v.w; }
        else if (has_next) { PG8_RC(Rp, Cp) S.a_off(nxt, Rp, Cp, ca); }
      }
      PG8_LDA(At, 0, 1); PG8_STAGE_B(PG8_SB(0, 0), b2); PG8_STAGE_B(PG8_SB(0, 1), b2 + hstep); PG8_STAGE_A(PG8_SA(0, 0), kb2, ca[0]);
      PG8_WAIT_V(8); PG8_WAIT_L(0); PG8_BAR; PG8_MMA(1, 0, At, B0); PG8_MMA(1, 1, At, B1); PG8_BAR; PG8_SCHED;
      PG8_LDB(B0, 1, 0); PG8_LDB(B1, 1, 1); PG8_SCHED; PG8_LDA(At, 1, 0); PG8_STAGE_A(PG8_SA(0, 1), kb2, ca[1]);
      PG8_WAIT_V(8); PG8_WAIT_L(0); PG8_BAR; PG8_MMA(0, 0, At, B0); PG8_MMA(0, 1, At, B1); PG8_BAR; PG8_SCHED;
      PG8_LDA(At, 1, 1); PG8_STAGE_B(PG8_SB(1, 0), b2 + kstep); PG8_STAGE_B(PG8_SB(1, 1), b2 + kstep + hstep); PG8_STAGE_A(PG8_SA(1, 0), kb2 + kstep, ca[0]);
      PG8_WAIT_V(8); PG8_WAIT_L(0); PG8_BAR; PG8_MMA(1, 0, At, B0); PG8_MMA(1, 1, At, B1); PG8_BAR; PG8_SCHED;
    }
    if constexpr (ALIGN_EPI) { if (wr == 0) PG8_BAR; }
    E(acc, cur, wr, wc, fr, fq);
    if (!has_next) break;
#pragma unroll
    for (int a = 0; a < 2; ++a)
#pragma unroll
      for (int b = 0; b < 2; ++b)
#pragma unroll
        for (int m = 0; m < 4; ++m)
#pragma unroll
          for (int n = 0; n < 2; ++n) acc[a][b][m][n] = (f32x4){0.f, 0.f, 0.f, 0.f};
    cur = nxt; cB = nB; ++ui;
    if constexpr (ALIGN_EPI) { if (wr == 1) PG8_BAR; }
  }
  PG8_WAIT_V(0);
  if constexpr (!ALIGN_EPI) { if (wr == 0) PG8_BAR; }
  PG8_BAR;
#undef PG8_RC
#undef PG8_SA
#undef PG8_SB
#undef PG8_STAGE_A
#undef PG8_STAGE_B
#undef PG8_LDA
#undef PG8_LDB
#undef PG8_MMA
#undef PG8_WAIT_V
#undef PG8_WAIT_L
#undef PG8_BAR
#undef PG8_SCHED
}
}

struct Params { const float* in[28]; float* out; unsigned char* ws; };
enum { I_X = 0, I_ANORM0, I_WIN0, I_CONVW, I_QN0, I_KN0, I_WOUT0, I_FNORM0, I_WRG0, I_BRG0, I_WRE0, I_BRE0, I_WG0, I_WU0, I_WD0,
       I_ANORM1, I_WIN1, I_QN1, I_KN1, I_WOUT1, I_FNORM1, I_WRG1, I_BRG1, I_WRE1, I_BRE1, I_WG1, I_WU1, I_WD1 };

struct Ctx { LAS unsigned char* lds; int wave, G, gw, NGW; };

struct TrDesc { const float* W; const float* gain; bf16_t* WT; int K, N, nvalid, mode, nblk, item; };
DI void tr_load(const TrDesc& d, int lane, f32x4 (&r)[8]) {
  const int kb = d.item / d.nblk, nb = d.item % d.nblk, k0 = 64 * kb, n = 32 * nb + 4 * (lane & 7);
#pragma unroll
  for (int i = 0; i < 8; ++i) { const int kk = 8 * i + (lane >> 3); r[i] = (n < d.nvalid) ? *(const f32x4*)(d.W + (size_t)(k0 + kk) * d.N + n) : (f32x4){0.f, 0.f, 0.f, 0.f}; }
}
DI void tr_finish(const TrDesc& d, int lane, const f32x4 (&r)[8], LAS float* scr) {
  const int kb = d.item / d.nblk, nb = d.item % d.nblk, k0 = 64 * kb, n0 = 32 * nb;
#pragma unroll
  for (int i = 0; i < 8; ++i) { const int kk = 8 * i + (lane >> 3); const float g = d.gain ? d.gain[k0 + kk] : 1.f; LAS float* s = scr + kk * 33 + 4 * (lane & 7);
    s[0] = r[i].x * g; s[1] = r[i].y * g; s[2] = r[i].z * g; s[3] = r[i].w * g; }
  asm volatile("s_waitcnt lgkmcnt(0)" ::: "memory");
  const int c = lane & 7;
#pragma unroll
  for (int j = 0; j < 4; ++j) { const int nn = (lane >> 3) + 8 * j; const LAS float* s = scr + (8 * c) * 33 + nn;
    u32x4 o; o.x = pk2(s[0 * 33], s[1 * 33]); o.y = pk2(s[2 * 33], s[3 * 33]); o.z = pk2(s[4 * 33], s[5 * 33]); o.w = pk2(s[6 * 33], s[7 * 33]);
    const int ng = n0 + nn; const int drow = (d.mode == 0) ? ng : (d.mode == 3 ? ((ng & ~255) + 128 * ((ng >> 5) & 1) + 32 * ((ng >> 6) & 3) + (ng & 31)) : ((ng >> 7) * 256 + (ng & 127) + (d.mode == 2 ? 128 : 0)));
    *(u32x4*)(d.WT + (size_t)drow * d.K + k0 + 8 * c) = o; }
  asm volatile("s_waitcnt lgkmcnt(0)" ::: "memory");
}
constexpr int TR_I_IN0 = 16 * 80, TR_I_OUT = 16 * 32, TR_I_GU = 32 * 16 * 16, TR_I_DN = 32 * 8 * 32, TR_I_IN1 = 16 * 48;
constexpr int TR_EARLY = TR_I_IN0 + TR_I_OUT, TR_MOE = 2 * TR_I_GU + TR_I_DN, TR_TOTAL = TR_EARLY + TR_MOE + TR_I_IN1 + TR_I_OUT + TR_MOE;
DI TrDesc tr_desc(const Params& P, int it) {
  unsigned char* ws = P.ws; TrDesc d; int r = it;
  if (r < TR_I_IN0) { d.W = P.in[I_WIN0]; d.gain = P.in[I_ANORM0]; d.WT = (bf16_t*)(ws + WS_WIN0); d.K = 1024; d.N = W0V; d.nvalid = W0V; d.mode = 3; d.nblk = 80; d.item = r; return d; }
  r -= TR_I_IN0;
  if (r < TR_I_OUT) { d.W = P.in[I_WOUT0]; d.gain = nullptr; d.WT = (bf16_t*)(ws + WS_WOUT0); d.K = 1024; d.N = 1024; d.nvalid = 1024; d.mode = 0; d.nblk = 32; d.item = r; return d; }
  r -= TR_I_OUT;
  int L = 0;
  if (r >= TR_MOE) { r -= TR_MOE;
    if (r < TR_I_IN1) { d.W = P.in[I_WIN1]; d.gain = P.in[I_ANORM1]; d.WT = (bf16_t*)(ws + WS_WIN1); d.K = 1024; d.N = W1; d.nvalid = W1; d.mode = 3; d.nblk = 48; d.item = r; return d; }
    r -= TR_I_IN1;
    if (r < TR_I_OUT) { d.W = P.in[I_WOUT1]; d.gain = nullptr; d.WT = (bf16_t*)(ws + WS_WOUT1); d.K = 1024; d.N = 1024; d.nvalid = 1024; d.mode = 0; d.nblk = 32; d.item = r; return d; }
    r -= TR_I_OUT; L = 1; }
  const float* fnorm = P.in[L ? I_FNORM1 : I_FNORM0];
  if (r < 2 * TR_I_GU) { const int up = r >= TR_I_GU; if (up) r -= TR_I_GU; const int e = r >> 8;
    d.W = P.in[up ? (L ? I_WU1 : I_WU0) : (L ? I_WG1 : I_WG0)] + (size_t)e * 1024 * 512; d.gain = fnorm; d.WT = (bf16_t*)(ws + (L ? WS_WGU1 : WS_WGU0)) + (size_t)e * 1024 * 1024;
    d.K = 1024; d.N = 512; d.nvalid = 512; d.mode = up ? 2 : 1; d.nblk = 16; d.item = r & 255; return d; }
  r -= 2 * TR_I_GU;
  { const int e = r >> 8; d.W = P.in[L ? I_WD1 : I_WD0] + (size_t)e * 512 * 1024; d.gain = nullptr; d.WT = (bf16_t*)(ws + (L ? WS_WD1 : WS_WD0)) + (size_t)e * 1024 * 512; d.K = 512; d.N = 1024; d.nvalid = 1024; d.mode = 0; d.nblk = 32; d.item = r & 255; return d; }
}
DI void rms_row_to_bf16(const float* xrow, bf16_t* orow, int lane) {
  const f32x4* xr = (const f32x4*)xrow + lane;
  f32x4 v[4]; float s = 0.f;
#pragma unroll
  for (int j = 0; j < 4; ++j) { v[j] = xr[64 * j]; s += (v[j].x * v[j].x + v[j].y * v[j].y) + (v[j].z * v[j].z + v[j].w * v[j].w); }
  const float rstd = 1.0f / sqrtf(wave_sum(s) * (1.f / DM) + NORM_EPS);
  unsigned long long* o8 = (unsigned long long*)orow + lane;
#pragma unroll
  for (int j = 0; j < 4; ++j) o8[64 * j] = (unsigned long long)pk2(v[j].x * rstd, v[j].y * rstd) | ((unsigned long long)pk2(v[j].z * rstd, v[j].w * rstd) << 32);
}
DI void p0_prologue(const Ctx& F, const Params& P) {
  unsigned char* ws = P.ws; const int lane = lane_id_v(); const int tid = F.wave * 64 + lane;
  LAS float* scr = (LAS float*)(F.lds + F.wave * 16384);
  {
    const int NIT = TR_EARLY;
    int it = F.gw;
    f32x4 ra[8], rb[8];
    TrDesc da, db;
    if (it < NIT) { da = tr_desc(P, it); tr_load(da, lane, ra); }
    while (it < NIT) {
      const int itn = it + F.NGW;
      if (itn < NIT) { db = tr_desc(P, itn); tr_load(db, lane, rb); }
      tr_finish(da, lane, ra, scr);
      if (itn >= NIT) break;
      const int itn2 = itn + F.NGW;
      if (itn2 < NIT) { da = tr_desc(P, itn2); tr_load(da, lane, ra); }
      tr_finish(db, lane, rb, scr);
      it = itn2;
    }
  }
  for (int m = F.gw; m < NTOK; m += F.NGW) rms_row_to_bf16(P.in[I_X] + (size_t)m * DM, (bf16_t*)(ws + WS_XN) + (size_t)m * DM, lane);
  const int gt = blockIdx.x * 512 + tid, NGT = F.G * 512;
  for (int i = gt; i < 512; i += NGT) ((unsigned*)(ws + WS_XN + (size_t)NTOK * DM * 2))[i] = 0u;
  for (int i = gt; i < 128; i += NGT) ((int*)(ws + WS_CTL))[i] = 0;
  for (int i = gt; i < SEQ * 32; i += NGT) {
    const int t = i >> 5, k = i & 31;
    const float inv = (float)exp2(-(double)k * (13.287712379549449 / 32.0));
    const float ang = (float)t * inv;
    const double rev = (double)ang * 0.15915494309189535; const float fr = (float)(rev - rint(rev));
    ((float*)(ws + WS_ROPE))[i] = __builtin_amdgcn_cosf(fr); ((float*)(ws + WS_ROPE))[SEQ * 32 + i] = __builtin_amdgcn_sinf(fr);
  }
  for (int i = gt; i < 2 * 36 * 1024; i += NGT) {
    const int L = i / (36 * 1024), r = i % (36 * 1024), j = r >> 10, k = r & 1023;
    const float g = P.in[L ? I_FNORM1 : I_FNORM0][k];
    float w; if (j < 4) w = P.in[L ? I_WRG1 : I_WRG0][k * 4 + j]; else { const int gg = (j - 4) >> 3, e = (j - 4) & 7; w = P.in[L ? I_WRE1 : I_WRE0][((size_t)gg * 1024 + k) * 8 + e]; }
    w *= g;
    const unsigned hi = pk2(w, 0.f) & 0xffffu; const float lo = w - __uint_as_float(hi << 16);
    bf16_t* base = (bf16_t*)(ws + (L ? WS_WR1 : WS_WR0));
    base[r] = (bf16_t)hi; base[36 * 1024 + r] = (bf16_t)(pk2(lo, 0.f) & 0xffffu);
  }
  for (int i = gt; i < 2 * 36; i += NGT) { const int L = i / 36, j = i % 36; ((float*)(ws + (L ? WS_WR1 : WS_WR0) + 147456))[j] = (j < 4) ? P.in[L ? I_BRG1 : I_BRG0][j] : P.in[L ? I_BRE1 : I_BRE0][j - 4]; }
}

DI u32x4 normrope8(const u32x4 w, const float (&gv)[8], bool do_norm, const f32x4 (&cs)[2], const f32x4 (&sn)[2], int sub, float oscale) {
  float v[8] = {bflo(w.x), bfhi(w.x), bflo(w.y), bfhi(w.y), bflo(w.z), bfhi(w.z), bflo(w.w), bfhi(w.w)};
  if (do_norm) {
    float s = 0.f;
#pragma unroll
    for (int j = 0; j < 8; ++j) s += v[j] * v[j];
    s += __shfl_xor(s, 1); s += __shfl_xor(s, 2); s += __shfl_xor(s, 4);
    const float rstd = 1.0f / sqrtf(s * (1.f / 64.f) + NORM_EPS);
#pragma unroll
    for (int j = 0; j < 8; ++j) v[j] = v[j] * rstd * gv[j];
  }
  const float sg = (sub & 4) ? 1.f : -1.f;
  const float cv[8] = {cs[0].x, cs[0].y, cs[0].z, cs[0].w, cs[1].x, cs[1].y, cs[1].z, cs[1].w};
  const float sv[8] = {sn[0].x, sn[0].y, sn[0].z, sn[0].w, sn[1].x, sn[1].y, sn[1].z, sn[1].w};
  float o[8];
#pragma unroll
  for (int j = 0; j < 8; ++j) { const float pr = __shfl_xor(v[j], 4); o[j] = (v[j] * cv[j] + sg * pr * sv[j]) * oscale; }
  u32x4 r; r.x = pk2(o[0], o[1]); r.y = pk2(o[2], o[3]); r.z = pk2(o[4], o[5]); r.w = pk2(o[6], o[7]);
  return r;
}
struct Tok0 { u32x4 cb, cc[3], ch[3]; };
DI void p1b_transform0(const Ctx& F, const Params& P) {
  bf16_t* PROJ = (bf16_t*)(P.ws + WS_PROJ); bf16_t* MIX = (bf16_t*)(P.ws + WS_MIX);
  const int lane = lane_id_v();
  float cw[8][3];
#pragma unroll
  for (int j = 0; j < 8; ++j) { const float* w = P.in[I_CONVW] + (8 * lane + j) * 3; cw[j][0] = w[0]; cw[j][1] = w[1]; cw[j][2] = w[2]; }
  auto load = [&](Tok0& T, int m) {
    const int t = m & (SEQ - 1); const bf16_t* row = PROJ + (size_t)m * W0P;
    T.cb = *(const u32x4*)(row + C_CB + 8 * lane);
#pragma unroll
    for (int d = 0; d < 3; ++d) { const int back = 2 - d; const bf16_t* r2 = row - (size_t)(t >= back ? back : 0) * W0P; T.cc[d] = *(const u32x4*)(r2 + C_CC + 8 * lane); T.ch[d] = *(const u32x4*)(r2 + C_CH + 8 * lane); }
  };
  auto process = [&](const Tok0& T, int m) {
    const int t = m & (SEQ - 1);
    { float u[3][8];
#pragma unroll
      for (int d = 0; d < 3; ++d) { const bool okd = t >= 2 - d; const u32x4 a = T.cc[d], b = T.ch[d];
        u[d][0] = okd ? bflo(a.x) * bflo(b.x) : 0.f; u[d][1] = okd ? bfhi(a.x) * bfhi(b.x) : 0.f; u[d][2] = okd ? bflo(a.y) * bflo(b.y) : 0.f; u[d][3] = okd ? bfhi(a.y) * bfhi(b.y) : 0.f;
        u[d][4] = okd ? bflo(a.z) * bflo(b.z) : 0.f; u[d][5] = okd ? bfhi(a.z) * bfhi(b.z) : 0.f; u[d][6] = okd ? bflo(a.w) * bflo(b.w) : 0.f; u[d][7] = okd ? bfhi(a.w) * bfhi(b.w) : 0.f; }
      const u32x4 cb = T.cb;
      const float cbv[8] = {bflo(cb.x), bfhi(cb.x), bflo(cb.y), bfhi(cb.y), bflo(cb.z), bfhi(cb.z), bflo(cb.w), bfhi(cb.w)};
      float o[8];
#pragma unroll
      for (int j = 0; j < 8; ++j) o[j] = cbv[j] * (u[0][j] * cw[j][0] + u[1][j] * cw[j][1] + u[2][j] * cw[j][2]);
      u32x4 r; r.x = pk2(o[0], o[1]); r.y = pk2(o[2], o[3]); r.z = pk2(o[4], o[5]); r.w = pk2(o[6], o[7]);
      *(u32x4*)(MIX + (size_t)m * DM + 8 * lane) = r; }
  };
  Tok0 A, B;
  int m = F.gw;
  if (m < NTOK) load(A, m);
  while (m < NTOK) {
    const int m1 = m + F.NGW;
    if (m1 < NTOK) load(B, m1);
    process(A, m);
    if (m1 >= NTOK) break;
    const int m2 = m1 + F.NGW;
    if (m2 < NTOK) load(A, m2);
    process(B, m1);
    m = m2;
  }
}

DI unsigned f2key(float f) { const unsigned b = __float_as_uint(f); return b ^ ((unsigned)((int)b >> 31) | 0x80000000u); }
DI s16x4 tr_read(LAS unsigned char* p) { typedef short v4i16_t __attribute__((ext_vector_type(4))); return __builtin_bit_cast(s16x4, __builtin_amdgcn_ds_read_tr16_b64_v4i16((LAS v4i16_t*)p)); }
#define DPP_U(v, ctrl) ((unsigned)__builtin_amdgcn_update_dpp(0, (int)(v), (ctrl), 0xF, 0xF, true))
DI unsigned wave_total_u(unsigned v) {
  v += DPP_U(v, 0xB1); v += DPP_U(v, 0x4E); v += DPP_U(v, 0x124); v += DPP_U(v, 0x128);
  return (unsigned)__builtin_amdgcn_readlane((int)v, 0) + (unsigned)__builtin_amdgcn_readlane((int)v, 16) + (unsigned)__builtin_amdgcn_readlane((int)v, 32) + (unsigned)__builtin_amdgcn_readlane((int)v, 48);
}
DI unsigned wave_maxall_u(unsigned v) {
  v = max(v, DPP_U(v, 0xB1)); v = max(v, DPP_U(v, 0x4E)); v = max(v, DPP_U(v, 0x124)); v = max(v, DPP_U(v, 0x128));
  const unsigned a = (unsigned)__builtin_amdgcn_readlane((int)v, 0), b = (unsigned)__builtin_amdgcn_readlane((int)v, 16), c = (unsigned)__builtin_amdgcn_readlane((int)v, 32), d = (unsigned)__builtin_amdgcn_readlane((int)v, 48);
  return max(max(a, b), max(c, d));
}
DI unsigned lane_prefix(unsigned long long m) { return __builtin_amdgcn_mbcnt_hi((unsigned)(m >> 32), __builtin_amdgcn_mbcnt_lo((unsigned)m, 0u)); }

DI void dsa_phase(const Ctx& F, const Params& P) {
  const bf16_t* PROJ = (const bf16_t*)(P.ws + WS_PROJ); bf16_t* MIX = (bf16_t*)(P.ws + WS_MIX);
  const bf16_t* IKF = (const bf16_t*)(P.ws + WS_IKF); const bf16_t* KF = (const bf16_t*)(P.ws + WS_KF); const bf16_t* VTF = (const bf16_t*)(P.ws + WS_VTF);
  LAS unsigned* sc = (LAS unsigned*)F.lds;
  LAS unsigned* msk32 = (LAS unsigned*)(F.lds + LDS_MISC);
  LAS float* trscr = (LAS float*)(F.lds + F.wave * 16384);
  int trk = 0;
  LAS float* part = (LAS float*)F.lds;
  const int w = F.wave;
  float cshift; { const int l0 = lane_id_v(); cshift = 8.f * wave_max(fabsf(P.in[I_QN0][l0])) * wave_max(fabsf(P.in[I_KN0][l0])) * 1.02f; }
  const float c1 = 0.125f * LOG2E, c2 = __builtin_amdgcn_readfirstlane(__float_as_int(cshift * LOG2E)) == 0 ? 0.f : __int_as_float(__builtin_amdgcn_readfirstlane(__float_as_int(cshift * LOG2E)));
#ifdef TIMEDSA
  unsigned long long tacc = 0ull, tmark = 0ull;
#define DSA_T0(n) if (TIMEDSA == (n)) tmark = __builtin_amdgcn_s_memrealtime();
#define DSA_T1(n) if (TIMEDSA == (n)) tacc += __builtin_amdgcn_s_memrealtime() - tmark;
#else
#define DSA_T0(n)
#define DSA_T1(n)
#endif
  for (int v = blockIdx.x; v < 8192; v += gridDim.x) {
    const int cidx = v & 255, jj = v >> 8, b = jj >> 1, tb = (jj & 1) ? (511 - cidx) : cidx;
    const int t0 = tb * 8; const size_t rb = (size_t)b * SEQ;
    const int ntile = (t0 + 8 + 31) >> 5;
    const int lane = lane_id_v();
    const int c = lane & 31, half = lane >> 5, qc = c >> 2, hx = c & 3;
    DSA_T0(1)
    {
      bf16x8 af[4];
      { const bf16_t* ap = PROJ + (rb + t0 + qc) * W0P + C_IQ + hx * 64 + 8 * half;
#pragma unroll
        for (int ks = 0; ks < 4; ++ks) af[ks] = *(const bf16x8*)(ap + 16 * ks); }
      float wq[4][4];
#pragma unroll
      for (int g = 0; g < 4; ++g) { const u32x2 ww = *(const u32x2*)(PROJ + (rb + t0 + 2 * g + half) * W0P + C_IW);
        wq[g][0] = bflo(ww.x) * 0.0625f; wq[g][1] = bfhi(ww.x) * 0.0625f; wq[g][2] = bflo(ww.y) * 0.0625f; wq[g][3] = bfhi(ww.y) * 0.0625f; }
      const bf16_t* fb = IKF + ((size_t)b * 128 * 4 * 64 + lane) * 8;
      const int Tlast = ntile - 1;
      auto ld1 = [&](bf16x8 (&d)[4], int T) { const int Tc = T < Tlast ? T : Tlast;
#pragma unroll
        for (int ks = 0; ks < 4; ++ks) d[ks] = *(const bf16x8*)(fb + (size_t)(Tc * 4 + ks) * 512); };
      auto cp1 = [&](const bf16x8 (&bfr)[4], int T) {
        f32x16 acc;
#pragma unroll
        for (int i = 0; i < 16; ++i) acc[i] = 0.f;
#pragma unroll
        for (int ks = 0; ks < 4; ++ks) acc = __builtin_amdgcn_mfma_f32_32x32x16_bf16(af[ks], bfr[ks], acc, 0, 0, 0);
        const int s = 32 * T + c;
        const bool edge = 32 * T + 31 > t0;
#pragma unroll
        for (int g = 0; g < 4; ++g) {
          float sv = __builtin_fmaf(wq[g][3], fmaxf(acc[4 * g + 3], 0.f), __builtin_fmaf(wq[g][2], fmaxf(acc[4 * g + 2], 0.f), __builtin_fmaf(wq[g][1], fmaxf(acc[4 * g + 1], 0.f), __builtin_fmaf(wq[g][0], fmaxf(acc[4 * g], 0.f), 0.f))));
          const int ql = 2 * g + half;
          unsigned key = f2key(sv);
          if (edge) key = (s <= t0 + ql) ? key : 0u;
          sc[ql * 4096 + s] = key;
        } };
      bf16x8 r0[4], r1[4], r2[4], r3[4];
      if (w < ntile) { ld1(r0, w); ld1(r1, w + 8); ld1(r2, w + 16); ld1(r3, w + 24); }
      for (int T = w; T < ntile; T += 32) {
        cp1(r0, T); ld1(r0, T + 32); __builtin_amdgcn_sched_barrier(0);
        if (T + 8 < ntile) { cp1(r1, T + 8); ld1(r1, T + 40); __builtin_amdgcn_sched_barrier(0); }
        if (T + 16 < ntile) { cp1(r2, T + 16); ld1(r2, T + 48); __builtin_amdgcn_sched_barrier(0); }
        if (T + 24 < ntile) { cp1(r3, T + 24); ld1(r3, T + 56); __builtin_amdgcn_sched_barrier(0); }
      }
    }
    __syncthreads();
    asm volatile("" ::: "memory"); __builtin_amdgcn_sched_barrier(0);
    DSA_T1(1)
    DSA_T0(2)
    const int t = t0 + w;
    LAS unsigned short* lst = (LAS unsigned short*)(F.lds + LDS_MISC + w * 512);
    int nvalid = 256;
    {
      const int lane = lane_id_v();
      if (t < 256) {
        nvalid = t + 1;
#pragma unroll
        for (int p = 0; p < 4; ++p) lst[p * 64 + lane] = (unsigned short)(p * 64 + lane);
      } else {
        const int nch = (t >> 10) + 1;
        unsigned u[64];
#pragma unroll
        for (int ch = 0; ch < 4; ++ch) {
          if (ch < nch) {
#pragma unroll
            for (int k2 = 0; k2 < 16; ++k2) { const int j = 16 * ch + k2; const unsigned x = sc[w * 4096 + 64 * j + lane]; u[j] = (lane <= t - 64 * j) ? x : 0u; }
          } else {
#pragma unroll
            for (int k2 = 0; k2 < 16; ++k2) u[16 * ch + k2] = 0u;
          }
        }
        unsigned prefix = 0u; bool exact = false; int startbit = 31;
        {
          unsigned mx = 0u;
#pragma unroll
          for (int ch = 0; ch < 4; ++ch) if (ch < nch) {
#pragma unroll
            for (int k2 = 0; k2 < 16; ++k2) mx = max(mx, u[16 * ch + k2]);
          }
          const unsigned trial = wave_maxall_u(mx) & 0xFF800000u;
          unsigned cnt = 0u;
#pragma unroll
          for (int ch = 0; ch < 4; ++ch) if (ch < nch) {
#pragma unroll
            for (int k2 = 0; k2 < 16; ++k2) cnt += (u[16 * ch + k2] >= trial) ? 1u : 0u;
          }
          cnt = wave_total_u(cnt);
          if (cnt >= 256u) { prefix = trial; startbit = 22; exact = (cnt == 256u); }
        }
        if (!exact) {
          for (int bit = startbit; bit >= 0; --bit) {
            const unsigned trial = prefix | (1u << bit);
            unsigned cnt = 0u;
#pragma unroll
            for (int ch = 0; ch < 4; ++ch) if (ch < nch) {
#pragma unroll
              for (int k2 = 0; k2 < 16; ++k2) cnt += (u[16 * ch + k2] >= trial) ? 1u : 0u;
            }
            cnt = wave_total_u(cnt);
            if (cnt >= 256u) prefix = trial;
            if (cnt == 256u) { exact = true; break; }
          }
        }
        const unsigned thr = exact ? prefix - 1u : prefix;
        int base = 0;
#pragma unroll
        for (int ch = 0; ch < 4; ++ch) if (ch < nch) {
#pragma unroll
          for (int k2 = 0; k2 < 16; ++k2) { const int j = 16 * ch + k2; const bool sel = u[j] > thr; const unsigned long long m = __ballot(sel);
            if (sel) lst[base + (int)lane_prefix(m)] = (unsigned short)(64 * j + lane);
            base += __builtin_popcountll(m); }
        }
        if (!exact) { const int need = 256 - base; int tbf = 0;
#pragma unroll
          for (int ch = 0; ch < 4; ++ch) if (ch < nch) {
#pragma unroll
            for (int k2 = 0; k2 < 16; ++k2) { const int j = 16 * ch + k2; const bool eq = u[j] == thr; const unsigned long long m = __ballot(eq); const int r = tbf + (int)lane_prefix(m);
              if (eq && r < need) lst[base + r] = (unsigned short)(64 * j + lane);
              tbf += __builtin_popcountll(m); }
          } }
      }
    }
    asm volatile("" ::: "memory"); __builtin_amdgcn_sched_barrier(0);
    DSA_T1(2)
    DSA_T0(3)
    {
      const int lane = lane_id_v(); const int hcol = lane & 15, g = lane >> 4;
      const bf16_t* KR = (const bf16_t*)(P.ws + WS_KF) + rb * 64 + 8 * g; const bf16_t* VR = (const bf16_t*)(P.ws + WS_VTF) + rb * 64;
      bf16x8 qf[2];
      { const bf16_t* qp = PROJ + (rb + t) * W0P + C_Q + (hcol & 7) * 64 + 8 * g; const float qs = hcol < 8 ? 0.125f * LOG2E : 0.f;
#pragma unroll
        for (int ks = 0; ks < 2; ++ks) { const u32x4 qv = *(const u32x4*)(qp + 32 * ks);
          u32x4 qo; qo.x = pk2(bflo(qv.x) * qs, bfhi(qv.x) * qs); qo.y = pk2(bflo(qv.y) * qs, bfhi(qv.y) * qs); qo.z = pk2(bflo(qv.z) * qs, bfhi(qv.z) * qs); qo.w = pk2(bflo(qv.w) * qs, bfhi(qv.w) * qs);
          qf[ks] = __builtin_bit_cast(bf16x8, qo); } }
      bf16x8 kf[16][2];
#pragma unroll
      for (int T = 0; T < 16; ++T) { const int kidx = lst[16 * T + hcol]; const bf16_t* kp = KR + (size_t)kidx * 64; kf[T][0] = *(const bf16x8*)kp; kf[T][1] = *(const bf16x8*)(kp + 32); }
      f32x4 acc[16];
#pragma unroll
      for (int T = 0; T < 16; ++T) { f32x4 a = {-c2, -c2, -c2, -c2};
        a = __builtin_amdgcn_mfma_f32_16x16x32_bf16(kf[T][0], qf[0], a, 0, 0, 0); a = __builtin_amdgcn_mfma_f32_16x16x32_bf16(kf[T][1], qf[1], a, 0, 0, 0); acc[T] = a; }
      LAS unsigned char* vst = F.lds + w * 16384;
      const bf16_t* vrl = VR + (lane & 7) * 8;
#pragma unroll
      for (int i = 0; i < 16; ++i) { const int kidx = lst[8 * i + (lane >> 3)];
        __builtin_amdgcn_global_load_lds((const unsigned*)(vrl + (size_t)kidx * 64), (LAS unsigned*)(vst + i * 1024), 16, 0, 0); }
      if (nvalid == 256) {
#pragma unroll
        for (int T = 0; T < 16; ++T)
#pragma unroll
          for (int r = 0; r < 4; ++r) acc[T][r] = __builtin_amdgcn_exp2f(acc[T][r]);
      } else {
#pragma unroll
        for (int T = 0; T < 16; ++T)
#pragma unroll
          for (int r = 0; r < 4; ++r) acc[T][r] = (16 * T + 4 * g + r < nvalid) ? __builtin_amdgcn_exp2f(acc[T][r]) : 0.f;
      }
      bf16x8 pf[8];
#pragma unroll
      for (int m = 0; m < 8; ++m) { u32x4 pw; pw.x = pk2(acc[2 * m][0], acc[2 * m][1]); pw.y = pk2(acc[2 * m][2], acc[2 * m][3]); pw.z = pk2(acc[2 * m + 1][0], acc[2 * m + 1][1]); pw.w = pk2(acc[2 * m + 1][2], acc[2 * m + 1][3]); pf[m] = __builtin_bit_cast(bf16x8, pw); }
      f32x4 o[4], ol = {0.f, 0.f, 0.f, 0.f};
#pragma unroll
      for (int n = 0; n < 4; ++n) o[n] = (f32x4){0.f, 0.f, 0.f, 0.f};
      const bf16x8 ones8 = (bf16x8){0x3f80, 0x3f80, 0x3f80, 0x3f80, 0x3f80, 0x3f80, 0x3f80, 0x3f80};
      const int q4 = (lane & 15) >> 2, p4 = lane & 3;
#pragma unroll
      for (int hh = 0; hh < 2; ++hh) {
        if (hh == 1) {
          asm volatile("s_waitcnt lgkmcnt(0)" ::: "memory");
#pragma unroll
          for (int i = 0; i < 16; ++i) { const int kidx = lst[128 + 8 * i + (lane >> 3)];
            __builtin_amdgcn_global_load_lds((const unsigned*)(vrl + (size_t)kidx * 64), (LAS unsigned*)(vst + i * 1024), 16, 0, 0); }
        }
        asm volatile("s_waitcnt vmcnt(0)" ::: "memory");
#pragma unroll
        for (int mm = 0; mm < 4; ++mm) {
          ol = __builtin_amdgcn_mfma_f32_16x16x32_bf16(ones8, pf[4 * hh + mm], ol, 0, 0, 0);
#pragma unroll
          for (int n = 0; n < 4; ++n) {
            const int r1 = 32 * mm + 4 * g + q4;
            const s16x4 lo = tr_read(vst + r1 * 128 + (16 * n + 4 * p4) * 2), hi = tr_read(vst + (r1 + 16) * 128 + (16 * n + 4 * p4) * 2);
            const bf16x8 vf = __builtin_shufflevector(lo, hi, 0, 1, 2, 3, 4, 5, 6, 7);
            o[n] = __builtin_amdgcn_mfma_f32_16x16x32_bf16(vf, pf[4 * hh + mm], o[n], 0, 0, 0);
          }
        }
        asm volatile("" ::: "memory");
      }
      if (hcol < 8) { const float inv = 1.0f / ol[0]; bf16_t* op = MIX + (rb + t) * DM + 512 + hcol * 64 + 4 * g;
#pragma unroll
        for (int n = 0; n < 4; ++n) { u32x2 w2; w2.x = pk2(o[n][0] * inv, o[n][1] * inv); w2.y = pk2(o[n][2] * inv, o[n][3] * inv); *(u32x2*)(op + 16 * n) = w2; } }
    }
    {
      const int tit = TR_EARLY + F.gw + trk * F.NGW;
      if (tit < TR_TOTAL) { const int tl = lane_id_v(); const TrDesc td = tr_desc(P, tit); f32x4 tr8[8]; tr_load(td, tl, tr8); tr_finish(td, tl, tr8, trscr); }
      ++trk;
    }
    __syncthreads();
    DSA_T1(3)
  }
  for (;; ++trk) { const int tit = TR_EARLY + F.gw + trk * F.NGW; if (tit >= TR_TOTAL) break; const int tl = lane_id_v(); const TrDesc td = tr_desc(P, tit); f32x4 tr8[8]; tr_load(td, tl, tr8); tr_finish(td, tl, tr8, trscr); }
#ifdef TIMEDSA
  if (blockIdx.x == 0 && w == 0 && lane_id_v() == 0) { unsigned long long* tsw = (unsigned long long*)(P.ws + WS_CTL + 4096); tsw[0] = 0ull; tsw[1] = tacc; }
#endif
}

DI void route_lane(const float (&lg)[36], int& x0, int& x1, float& g0, float& g1) {
  int gs = 0; float gm = lg[0];
#pragma unroll
  for (int j = 1; j < 4; ++j) { const bool gt = lg[j] > gm; gm = gt ? lg[j] : gm; gs = gt ? j : gs; }
  float z = 0.f;
#pragma unroll
  for (int j = 0; j < 4; ++j) z += __expf(lg[j] - gm);
  const float pg = 1.0f / z;
  float le[8];
#pragma unroll
  for (int i = 0; i < 8; ++i) le[i] = gs == 0 ? lg[4 + i] : (gs == 1 ? lg[12 + i] : (gs == 2 ? lg[20 + i] : lg[28 + i]));
  int i0e = 0; float m0 = le[0];
#pragma unroll
  for (int i = 1; i < 8; ++i) { const bool gt = le[i] > m0; m0 = gt ? le[i] : m0; i0e = gt ? i : i0e; }
  int i1e = -1; float m1 = -INFINITY;
#pragma unroll
  for (int i = 0; i < 8; ++i) { const bool gt = (i != i0e) && (le[i] > m1); m1 = gt ? le[i] : m1; i1e = gt ? i : i1e; }
  const float e1 = __expf(m1 - m0);
  g0 = pg / (1.0f + e1); g1 = pg * e1 / (1.0f + e1);
  x0 = gs * 8 + i0e; x1 = gs * 8 + i1e;
}
DI void router_phase(const Ctx& F, const Params& P, int L) {
  unsigned char* ws = P.ws;
  constexpr int WSTR = 2064;
  constexpr int L_WH = 0, L_WL = 36 * WSTR, L_ZERO = 2 * 36 * WSTR, L_CNT = L_ZERO + WSTR, L_ASG = L_CNT + 256, L_RS = L_ASG + 4096;
  static_assert(L_ASG + 4096 <= LDS_BYTES - 16, "router LDS map");
  LAS unsigned char* lds = F.lds;
  LAS int* lcnt = (LAS int*)(lds + L_CNT); LAS int* lbase = lcnt + 32;
  LAS i32x4* lasg = (LAS i32x4*)(lds + L_ASG);
  const bf16_t* wsrc = (const bf16_t*)(ws + (L ? WS_WR1 : WS_WR0));
  const float* bias = (const float*)(ws + (L ? WS_WR1 : WS_WR0) + 147456);
  const int lane = lane_id_v(); const int w = F.wave; const int tid = w * 64 + lane;
  int* cnt = (int*)(ws + WS_CTL) + L * 64; int* list = (int*)(ws + WS_LIST); float* RSL = (float*)(ws + WS_RSL);
  int4* asg = (int4*)(ws + WS_ASG); float2* asgg = (float2*)(ws + WS_ASGG);
  const bf16_t* XB = (const bf16_t*)(ws + WS_XB);
  const int niter = (NTOK + F.NGW - 1) / F.NGW;
  for (int i0 = 0; i0 < niter; i0 += 32) {
    for (int i = tid; i < 2 * 36 * 128; i += 512) { const int row = i >> 7, ch = i & 127; *(LAS u32x4*)(lds + row * WSTR + ch * 16) = *(const u32x4*)(wsrc + row * 1024 + ch * 8); }
    for (int i = tid; i < 128; i += 512) *(LAS u32x4*)(lds + L_ZERO + i * 16) = (u32x4){0u, 0u, 0u, 0u};
    if (tid < 32) lcnt[tid] = 0;
    __syncthreads();
    const int c = lane & 31, half = lane >> 5;
    const int it_r = i0 + c; const int m_r = F.gw + it_r * F.NGW; const bool ok_r = (it_r < niter) && (m_r < NTOK);
    const bf16_t* arow = XB + (size_t)(ok_r ? m_r : F.gw) * DM + 8 * half;
    const int b0off = c * WSTR + 16 * half;
    const int b1off = (c < 4 ? (32 + c) * WSTR : (L_ZERO - L_WH)) + 16 * half;
    f32x16 d0, d1, dx;
#pragma unroll
    for (int i = 0; i < 16; ++i) { d0[i] = 0.f; d1[i] = 0.f; dx[i] = 0.f; }
    bf16x8 ar[8];
#pragma unroll
    for (int j = 0; j < 8; ++j) ar[j] = *(const bf16x8*)(arow + 16 * j);
    for (int k8 = 0; k8 < 64; k8 += 8) {
#pragma unroll
      for (int j = 0; j < 8; ++j) {
        const int ks = k8 + j;
        const bf16x8 a_cur = ar[j];
        const bf16x8 h0 = *(const LAS bf16x8*)(lds + L_WH + b0off + 32 * ks), l0 = *(const LAS bf16x8*)(lds + L_WL + b0off + 32 * ks);
        const bf16x8 h1 = *(const LAS bf16x8*)(lds + L_WH + b1off + 32 * ks), l1 = *(const LAS bf16x8*)(lds + (c < 4 ? L_WL : L_WH) + b1off + 32 * ks);
        d0 = __builtin_amdgcn_mfma_f32_32x32x16_bf16(a_cur, h0, d0, 0, 0, 0); d0 = __builtin_amdgcn_mfma_f32_32x32x16_bf16(a_cur, l0, d0, 0, 0, 0);
        d1 = __builtin_amdgcn_mfma_f32_32x32x16_bf16(a_cur, h1, d1, 0, 0, 0); d1 = __builtin_amdgcn_mfma_f32_32x32x16_bf16(a_cur, l1, d1, 0, 0, 0);
        dx = __builtin_amdgcn_mfma_f32_32x32x16_bf16(a_cur, a_cur, dx, 0, 0, 0);
        if (k8 + 8 < 64) ar[j] = *(const bf16x8*)(arow + 16 * (ks + 8));
      }
    }
    __syncthreads();
    LAS float* tw = (LAS float*)(lds + w * 8192);
#pragma unroll
    for (int i = 0; i < 16; ++i) { const int row = (i & 3) + 8 * (i >> 2) + 4 * half; tw[row * 40 + c] = d0[i]; if (c < 4) tw[row * 40 + 32 + c] = d1[i]; if (row == c) tw[row * 40 + 36] = dx[i]; }
    asm volatile("s_waitcnt lgkmcnt(0)" ::: "memory");
    if (lane < 32) {
      const int it_t = i0 + lane; const int m = F.gw + it_t * F.NGW;
      if (it_t < niter && m < NTOK) {
        const LAS f32x4* tr4 = (const LAS f32x4*)(tw + lane * 40);
        float raw[40];
#pragma unroll
        for (int q = 0; q < 10; ++q) { const f32x4 v4 = tr4[q]; raw[4 * q] = v4.x; raw[4 * q + 1] = v4.y; raw[4 * q + 2] = v4.z; raw[4 * q + 3] = v4.w; }
        const float rstd = 1.0f / sqrtf(raw[36] * (1.f / DM) + NORM_EPS);
        float lg[36];
#pragma unroll
        for (int j = 0; j < 36; ++j) lg[j] = raw[j] * rstd + bias[j];
        int x0, x1; float g0, g1; route_lane(lg, x0, x1, g0, g1);
        const int r0 = __hip_atomic_fetch_add(lcnt + x0, 1, __ATOMIC_RELAXED, __HIP_MEMORY_SCOPE_WORKGROUP);
        const int r1 = __hip_atomic_fetch_add(lcnt + x1, 1, __ATOMIC_RELAXED, __HIP_MEMORY_SCOPE_WORKGROUP);
        lasg[lane * 8 + w] = (i32x4){x0, x1, r0, r1}; asgg[m] = make_float2(g0, g1);
        tw[lane * 40 + 37] = rstd;
      }
    }
    __syncthreads();
    if (tid < 32) lbase[tid] = atomicAdd(cnt + tid, lcnt[tid]);
    __syncthreads();
    if (tid < 256) {
      const int ii = tid >> 3, wv = tid & 7; const int m = (int)blockIdx.x * 8 + wv + (i0 + ii) * F.NGW;
      if (i0 + ii < niter && m < NTOK) {
        const i32x4 a = lasg[tid]; const int r0 = lbase[a.x] + a.z, r1 = lbase[a.y] + a.w;
        const float rs = ((const LAS float*)(lds + wv * 8192))[ii * 40 + 37];
        list[a.x * 65536 + r0] = m; list[a.y * 65536 + r1] = m; asg[m] = make_int4(a.x, a.y, r0, r1);
        RSL[a.x * 65536 + r0] = rs; RSL[a.y * 65536 + r1] = rs;
      }
    }
    __syncthreads();
  }
}
DI void moe_setup(const Ctx& F, const Params& P, int L) {
  LAS int* pb = (LAS int*)(F.lds + LDS_MISC); LAS int* cl = pb + 64;
  const int* cnt = (const int*)(P.ws + WS_CTL) + L * 64;
  const int tid = F.wave * 64 + lane_id_v();
  __syncthreads();
  if (tid < 32) cl[tid] = cnt[tid];
  __syncthreads();
  if (tid == 0) { int a = 0; for (int e = 0; e < NEXP; ++e) { pb[e] = a; a += (cl[e] + 255) >> 8; } pb[NEXP] = a; }
  __syncthreads();
}
struct CRows { u32x2 x[4], y0[4], y1[4]; };
DI void combine_phase(const Ctx& F, const Params& P, int L, bool with_norm) {
  unsigned char* ws = P.ws;
  moe_setup(F, P, L);
  const LAS int* pb = (const LAS int*)(F.lds + LDS_MISC);
  const int4* asg = (const int4*)(ws + WS_ASG); const float2* asgg = (const float2*)(ws + WS_ASGG);
  const bf16_t* Y = (const bf16_t*)(ws + WS_PROJ); bf16_t* XN = (bf16_t*)(ws + WS_XN); bf16_t* XB = (bf16_t*)(ws + WS_XB);
  const int lane = lane_id_v();
  auto rows = [&](CRows& R, int m, const int4 a) {
    const size_t row0 = (size_t)pb[a.x] * 256 + a.z, row1 = (size_t)pb[a.y] * 256 + a.w;
    const u32x2* xr = (const u32x2*)(XB + (size_t)m * DM) + lane; const u32x2* y0 = (const u32x2*)(Y + row0 * DM) + lane; const u32x2* y1 = (const u32x2*)(Y + row1 * DM) + lane;
#pragma unroll
    for (int j = 0; j < 4; ++j) { R.x[j] = xr[64 * j]; R.y0[j] = y0[64 * j]; R.y1[j] = y1[64 * j]; } };
  auto finish = [&](const CRows& R, int m, const float2 gg) {
    u32x2* xr = (u32x2*)(XB + (size_t)m * DM) + lane; f32x4* orow = (f32x4*)(P.out + (size_t)m * DM) + lane;
    f32x4 v[4]; float ss = 0.f;
#pragma unroll
    for (int j = 0; j < 4; ++j) { const u32x2 xb = R.x[j], a0 = R.y0[j], a1 = R.y1[j]; f32x4 x = (f32x4){bflo(xb.x), bfhi(xb.x), bflo(xb.y), bfhi(xb.y)};
      x.x += gg.x * bflo(a0.x) + gg.y * bflo(a1.x); x.y += gg.x * bfhi(a0.x) + gg.y * bfhi(a1.x); x.z += gg.x * bflo(a0.y) + gg.y * bflo(a1.y); x.w += gg.x * bfhi(a0.y) + gg.y * bfhi(a1.y);
      if (with_norm) { u32x2 o; o.x = pk2(x.x, x.y); o.y = pk2(x.z, x.w); xr[64 * j] = o; } else orow[64 * j] = x;
      v[j] = x; ss += (x.x * x.x + x.y * x.y) + (x.z * x.z + x.w * x.w); }
    if (with_norm) {
      const float rstd = 1.0f / sqrtf(wave_sum(ss) * (1.f / DM) + NORM_EPS);
      unsigned long long* o8 = (unsigned long long*)(XN + (size_t)m * DM) + lane;
#pragma unroll
      for (int j = 0; j < 4; ++j) o8[64 * j] = (unsigned long long)pk2(v[j].x * rstd, v[j].y * rstd) | ((unsigned long long)pk2(v[j].z * rstd, v[j].w * rstd) << 32);
    } };
  const int n = (NTOK - F.gw + F.NGW - 1) / F.NGW;
  if (n <= 0) return;
  CRows RA, RB;
  int4 a0 = asg[F.gw]; float2 g0 = asgg[F.gw];
  int4 a1 = a0; float2 g1 = g0; if (n > 1) { a1 = asg[F.gw + F.NGW]; g1 = asgg[F.gw + F.NGW]; }
  rows(RA, F.gw, a0);
  for (int i = 0; i < n; i += 2) {
    const int m0 = F.gw + i * F.NGW, m1 = m0 + F.NGW, m2 = m1 + F.NGW, m3 = m2 + F.NGW;
    int4 a2 = a0; float2 g2 = g0; if (i + 2 < n) { a2 = asg[m2]; g2 = asgg[m2]; }
    if (i + 1 < n) rows(RB, m1, a1);
    finish(RA, m0, g0);
    if (i + 1 >= n) break;
    int4 a3 = a0; float2 g3 = g0; if (i + 3 < n) { a3 = asg[m3]; g3 = asgg[m3]; }
    if (i + 2 < n) rows(RA, m2, a2);
    finish(RB, m1, g1);
    a0 = a2; g0 = g2; a1 = a3; g1 = g3;
  }
}
template <class Bar> DI void moe_gemms(const Ctx& F, const Params& P, int L, const Bar& gbar) {
  unsigned char* ws = P.ws;
  const int vcu = (F.G % 8 == 0) ? ((int)(blockIdx.x % 8) * (F.G / 8) + (int)(blockIdx.x / 8)) : (int)blockIdx.x;
  moe_setup(F, P, L);
  {
    pg8::MoeSched<true> S{(const LAS int*)(F.lds + LDS_MISC), (const LAS int*)(F.lds + LDS_MISC) + 64, (const int*)(ws + WS_LIST), (const char*)(ws + (L ? WS_WGU1 : WS_WGU0)), F.G, vcu, 1024};
    pg8::EpiSwiGLU E{(bf16_t*)(ws + WS_H), (const float*)(ws + WS_RSL), (const LAS int*)(F.lds + LDS_MISC) + 64};
    pg8::gemm_phase<pg8::EpiSwiGLU, pg8::MoeSched<true>, true>(F.lds, F.wave, (const char*)(ws + WS_XB), 1024, S, E);
  }
  xcd_barrier(gbar);
  {
    pg8::MoeSched<false> S{(const LAS int*)(F.lds + LDS_MISC), (const LAS int*)(F.lds + LDS_MISC) + 64, nullptr, (const char*)(ws + (L ? WS_WD1 : WS_WD0)), F.G, vcu, 512};
    pg8::EpiBf16 E{(bf16_t*)(ws + WS_PROJ), DM};
    pg8::gemm_phase<pg8::EpiBf16, pg8::MoeSched<false>, true>(F.lds, F.wave, (const char*)(ws + WS_H), 512, S, E);
  }
}

struct Tok1 { u32x4 q0, q1, k; f32x4 cs[2], sn[2]; };
DI void p8b_transform1(const Ctx& F, const Params& P) {
  bf16_t* QKV = (bf16_t*)(P.ws + WS_PROJ);
  const float* cosT = (const float*)(P.ws + WS_ROPE); const float* sinT = cosT + SEQ * 32;
  const int lane = lane_id_v(), sub = lane & 7, grp = lane >> 3;
  float gq[8], gk[8];
#pragma unroll
  for (int j = 0; j < 8; ++j) { gq[j] = P.in[I_QN1][8 * sub + j]; gk[j] = P.in[I_KN1][8 * sub + j]; }
  const int kcol = 1024 + (grp & 3) * 64 + sub * 8;
  auto load = [&](Tok1& T, int m) {
    const int t = m & (SEQ - 1); const bf16_t* row = QKV + (size_t)m * W1;
    T.q0 = *(const u32x4*)(row + grp * 64 + sub * 8); T.q1 = *(const u32x4*)(row + 512 + grp * 64 + sub * 8); T.k = *(const u32x4*)(row + kcol);
    const f32x4* cp = (const f32x4*)(cosT + t * 32 + 8 * (sub & 3)); const f32x4* sp = (const f32x4*)(sinT + t * 32 + 8 * (sub & 3));
    T.cs[0] = cp[0]; T.cs[1] = cp[1]; T.sn[0] = sp[0]; T.sn[1] = sp[1];
  };
  auto process = [&](const Tok1& T, int m) {
    bf16_t* row = QKV + (size_t)m * W1;
    *(u32x4*)(row + grp * 64 + sub * 8) = normrope8(T.q0, gq, true, T.cs, T.sn, sub, 0.125f * LOG2E);
    *(u32x4*)(row + 512 + grp * 64 + sub * 8) = normrope8(T.q1, gq, true, T.cs, T.sn, sub, 0.125f * LOG2E);
    const u32x4 r = normrope8(T.k, gk, true, T.cs, T.sn, sub, 1.f);
    if (grp < 4) *(u32x4*)(row + kcol) = r;
  };
  Tok1 A, B;
  int m = F.gw;
  if (m < NTOK) load(A, m);
  while (m < NTOK) {
    const int m1 = m + F.NGW;
    if (m1 < NTOK) load(B, m1);
    process(A, m);
    if (m1 >= NTOK) break;
    const int m2 = m1 + F.NGW;
    if (m2 < NTOK) load(A, m2);
    process(B, m1);
    m = m2;
  }
}

DI void dil_phase(const Ctx& F, const Params& P) {
  const bf16_t* QKV = (const bf16_t*)(P.ws + WS_PROJ); bf16_t* MIX = (bf16_t*)(P.ws + WS_MIX);
  LAS unsigned char* kst = F.lds + F.wave * 8192;
  LAS unsigned char* vst = kst + 4096;
  float cshift; { const int l0 = lane_id_v(); cshift = 8.f * wave_max(fabsf(P.in[I_QN1][l0])) * wave_max(fabsf(P.in[I_KN1][l0])) * 1.02f; }
  const float c2 = cshift * LOG2E;
  const int gwv = ((F.G % 8 == 0) ? ((int)(blockIdx.x % 8) * (F.G / 8) + (int)(blockIdx.x / 8)) : (int)blockIdx.x) * 8 + F.wave;
  const int lane = lane_id_v(), c = lane & 31, half = lane >> 5, qi = c >> 2, gq = c & 3;
  const int q4 = (lane & 15) >> 2, p4 = lane & 3, blk = (lane >> 4) & 1;
  const int lrow = lane >> 3, lch = lane & 7;
  const int woff = lrow * 128 + ((lch ^ (lrow & 7)) << 4);
  const int kra = c * 128 + ((half ^ (c & 7)) << 4);
  const int r1 = 4 * half + q4;
  const int tra0 = r1 * 128 + (((2 * blk + (p4 >> 1)) ^ (r1 & 7)) << 4) + (p4 & 1) * 8;
  for (int it = gwv; it < 32768; it += F.NGW) {
    const int r = it & 15, tile = (it >> 4) & 31, kh = (it >> 9) & 3, b = it >> 11;
    const size_t rb = (size_t)b * SEQ; const int tmax = tile * 128 + r + 112, tq = tile * 128 + r + 16 * qi;
    bf16x8 qf[4];
    { const bf16_t* qp = QKV + (rb + tq) * W1 + (4 * kh + gq) * 64 + 8 * half;
#pragma unroll
      for (int ks = 0; ks < 4; ++ks) qf[ks] = *(const bf16x8*)(qp + 16 * ks); }
    f32x16 o0, o1;
#pragma unroll
    for (int i = 0; i < 16; ++i) { o0[i] = 0.f; o1[i] = 0.f; }
    float lsum = 0.f;
    const char* sbase = (const char*)(QKV + rb * W1 + 1024 + kh * 64) ;
    constexpr int RP = W1 * 2;
    u32x4 gk[4], gv[4];
    auto issue = [&](int ti) { const int sh = ti < 8 ? 0 : (ti < 13 ? 2 : 4), T = ti < 8 ? ti : (ti < 13 ? ti - 8 : ti - 13);
      const int v0 = (tmax - ((32 * T + lrow) << sh)) * RP + lch * 16; const int dv = (8 << sh) * RP;
#pragma unroll
      for (int i = 0; i < 4; ++i) { int vo = v0 - i * dv; vo = vo < lch * 16 ? lch * 16 : vo;
        const char* rp = sbase + (unsigned)vo; gk[i] = *(const u32x4*)rp; gv[i] = *(const u32x4*)(rp + 512); } };
    issue(0);
#pragma unroll 1
    for (int ti = 0; ti < 18; ++ti) {
      const int sh = ti < 8 ? 0 : (ti < 13 ? 2 : 4), T = ti < 8 ? ti : (ti < 13 ? ti - 8 : ti - 13);
#pragma unroll
      for (int i = 0; i < 4; ++i) { *(LAS u32x4*)(kst + woff + i * 1024) = gk[i]; *(LAS u32x4*)(vst + woff + i * 1024) = gv[i]; }
      if (ti + 1 < 18) issue(ti + 1);
      asm volatile("" ::: "memory");
      f32x16 s;
#pragma unroll
      for (int i = 0; i < 16; ++i) s[i] = -c2;
#pragma unroll
      for (int ks = 0; ks < 4; ++ks) { const bf16x8 kf = *(const LAS bf16x8*)(kst + (kra ^ (ks << 5))); s = __builtin_amdgcn_mfma_f32_32x32x16_bf16(kf, qf[ks], s, 0, 0, 0); }
      unsigned m32;
      { const int ei = (16 >> sh) * (7 - qi); const int nmax = tmax >> sh; const int hn = (ei + 128 < nmax) ? ei + 128 : nmax;
        const int lo = ei - 32 * T - 4 * half, hi = hn - 32 * T - 4 * half;
        const int loc = lo < 0 ? 0 : lo, hic = hi > 31 ? 31 : hi;
        m32 = (loc <= hic) ? ((0xFFFFFFFFu >> (31 - hic)) & (0xFFFFFFFFu << loc)) : 0u; }
#pragma unroll
      for (int reg = 0; reg < 16; ++reg) { const int mb = __builtin_amdgcn_sbfe((int)m32, (reg & 3) + 8 * (reg >> 2), 1);
        const float p = __int_as_float(__float_as_int(__builtin_amdgcn_exp2f(s[reg])) & mb); s[reg] = p; lsum += p; }
#pragma unroll
      for (int st = 0; st < 2; ++st) {
        u32x4 pw; pw.x = pk2(s[8 * st], s[8 * st + 1]); pw.y = pk2(s[8 * st + 2], s[8 * st + 3]); pw.z = pk2(s[8 * st + 4], s[8 * st + 5]); pw.w = pk2(s[8 * st + 6], s[8 * st + 7]);
        const bf16x8 pf = __builtin_bit_cast(bf16x8, pw);
#pragma unroll
        for (int dblk = 0; dblk < 2; ++dblk) {
          const int ta = (tra0 ^ (dblk << 6)) + st * 2048;
          const s16x4 lo4 = tr_read(vst + ta), hi4 = tr_read(vst + ta + 1024);
          const bf16x8 vf = __builtin_shufflevector(lo4, hi4, 0, 1, 2, 3, 4, 5, 6, 7);
          if (dblk == 0) o0 = __builtin_amdgcn_mfma_f32_32x32x16_bf16(vf, pf, o0, 0, 0, 0); else o1 = __builtin_amdgcn_mfma_f32_32x32x16_bf16(vf, pf, o1, 0, 0, 0);
        }
      }
      asm volatile("" ::: "memory");
    }
    lsum += __shfl_xor(lsum, 32);
    const float inv = 1.0f / lsum;
    bf16_t* op = MIX + (rb + tq) * DM + (4 * kh + gq) * 64 + 4 * half;
#pragma unroll
    for (int gI = 0; gI < 4; ++gI) {
      u32x2 w0; w0.x = pk2(o0[4 * gI] * inv, o0[4 * gI + 1] * inv); w0.y = pk2(o0[4 * gI + 2] * inv, o0[4 * gI + 3] * inv); *(u32x2*)(op + 8 * gI) = w0;
      u32x2 w1; w1.x = pk2(o1[4 * gI] * inv, o1[4 * gI + 1] * inv); w1.y = pk2(o1[4 * gI + 2] * inv, o1[4 * gI + 3] * inv); *(u32x2*)(op + 32 + 8 * gI) = w1;
    }
  }
}

#define XB_TMO      128
#define XB_XCNT(j)  (256  + 64 * (j))
#define XB_XSUB(j)  (1280 + 64 * (j))
#define XB_XGEN(j)  (2304 + 64 * (j))
#define XB_TOP      3328
#define XB_TOPGEN   3392
#define XCD_BAR_WORDS 3456
#define XB_SPIN_CAP (1u << 18)

__device__ __forceinline__ unsigned xb_ld(unsigned* p)              { return __hip_atomic_load(p, __ATOMIC_RELAXED, __HIP_MEMORY_SCOPE_AGENT); }
__device__ __forceinline__ unsigned xb_add(unsigned* p, unsigned v) { return __hip_atomic_fetch_add(p, v, __ATOMIC_RELAXED, __HIP_MEMORY_SCOPE_AGENT); }
__device__ __forceinline__ unsigned xb_xcc_id() { return (unsigned)__builtin_amdgcn_s_getreg((3 << 11) | 20) & 0xFu; }
#define XB_SPIN(cond, bar) do { unsigned _sp = 0; while (cond) { __builtin_amdgcn_s_sleep(1); \
    if ((++_sp & 255u) == 0u) { if (xb_ld(&(bar)[XB_TMO])) break; if (_sp > XB_SPIN_CAP) { atomicAdd(&(bar)[XB_TMO], 1u); break; } } } } while (0)

struct XcdBarrier {
    unsigned* bar; unsigned x;
    volatile LAS unsigned* st;
};

__device__ __forceinline__ XcdBarrier xcd_barrier_post(unsigned* bar, volatile LAS unsigned* st) {
    XcdBarrier b; b.bar = bar; b.x = xb_xcc_id(); b.st = st;
    if (threadIdx.x == 0) (void)xb_add(&bar[XB_XCNT(b.x)], 1u);
    return b;
}
__device__ __forceinline__ void xcd_barrier_complete(unsigned* bar, unsigned x, unsigned& nloc, unsigned& nx) {
    const unsigned G = gridDim.x * gridDim.y * gridDim.z;
    unsigned sum, cnt, mine, sp = 0u;
    for (;;) {
        sum = 0u; cnt = 0u; mine = 0u;
#pragma unroll
        for (unsigned j = 0; j < 16; ++j) { const unsigned c = xb_ld(&bar[XB_XCNT(j)]); sum += c; cnt += (c > 0u) ? 1u : 0u; mine = (j == x) ? c : mine; }
        if (sum == G) break;
        __builtin_amdgcn_s_sleep(1);
        if ((++sp & 255u) == 0u) { if (xb_ld(&bar[XB_TMO])) break; if (sp > XB_SPIN_CAP) { atomicAdd(&bar[XB_TMO], 1u); break; } }
    }
    nloc = mine > 0u ? mine : 1u; nx = cnt > 0u ? cnt : 1u;
}

__device__ __forceinline__ void xcd_barrier(const XcdBarrier& b) {
    asm volatile("s_waitcnt vmcnt(0)" ::: "memory");
    __syncthreads();
    if (threadIdx.x == 0) {
        unsigned* bar = b.bar;
        __builtin_amdgcn_s_waitcnt(0);
        unsigned nloc = b.st[0], nx = b.st[1];
        if (nloc == 0u) { xcd_barrier_complete(bar, b.x, nloc, nx); b.st[0] = nloc; b.st[1] = nx; }
        const unsigned old = xb_add(&bar[XB_XSUB(b.x)], 1u);
        const unsigned gen = old / nloc;
        if (old + 1u == (gen + 1u) * nloc) {
            __builtin_amdgcn_fence(__ATOMIC_RELEASE, "agent");
            asm volatile("s_waitcnt vmcnt(0)" ::: "memory");
            const unsigned og = xb_add(&bar[XB_TOP], 1u);
            const unsigned tg = og / nx;
            if (og + 1u == (tg + 1u) * nx) xb_add(&bar[XB_TOPGEN], 1u);
            else XB_SPIN(xb_ld(&bar[XB_TOPGEN]) == tg, bar);
            __builtin_amdgcn_fence(__ATOMIC_ACQUIRE, "agent");
            xb_add(&bar[XB_XGEN(b.x)], 1u);
            asm volatile("s_waitcnt vmcnt(0)" ::: "memory");
        } else {
            XB_SPIN(xb_ld(&bar[XB_XGEN(b.x)]) == gen, bar);
            __builtin_amdgcn_fence(__ATOMIC_ACQUIRE, "agent");
            asm volatile("s_waitcnt vmcnt(0)" ::: "memory");
        }
    }
    __syncthreads();
}


__global__ void __launch_bounds__(512, 2) fwd_megakernel(Params P) {
  extern __shared__ __attribute__((aligned(16))) unsigned char lds_raw[];
  cg::grid_group grid = cg::this_grid();
  Ctx F; F.lds = (LAS unsigned char*)lds_raw; F.wave = __builtin_amdgcn_readfirstlane((int)threadIdx.x >> 6);
  F.G = gridDim.x; F.gw = blockIdx.x * 8 + F.wave; F.NGW = F.G * 8;
  unsigned char* ws = P.ws;
  volatile LAS unsigned* xst = (volatile LAS unsigned*)(F.lds + LDS_BYTES - 16);
  if (threadIdx.x < 2) xst[threadIdx.x] = 0u;
  unsigned* xbar_words = (unsigned*)(ws + WS_CTL + 65536);
  __syncthreads();
  XcdBarrier xbar = xcd_barrier_post(xbar_words, xst);
#define GRID_BAR() xcd_barrier(xbar)

#ifndef PHMASK
#define PHMASK 0xFFFFFFFFu
#endif
#define PH(n) if ((PHMASK >> (n)) & 1u)
#if defined(TIMEDSA) && !defined(TIMEPH)
#define TIMEPH 99
#define TIMEN 1
#endif
#ifdef TIMEPH
  unsigned long long* tsw = (unsigned long long*)(ws + WS_CTL + 4096);
#define TS_BEGIN(n) if ((n) >= TIMEPH && (n) < TIMEPH + TIMEN && (n) == TIMEPH && blockIdx.x == 0 && threadIdx.x == 0) tsw[0] = __builtin_amdgcn_s_memrealtime();
#define TS_END(n) if ((n) == TIMEPH + TIMEN - 1 && blockIdx.x == 0 && threadIdx.x == 0) tsw[1] = __builtin_amdgcn_s_memrealtime();
#else
#define TS_BEGIN(n)
#define TS_END(n)
#endif
  TS_BEGIN(0)
  PH(0) p0_prologue(F, P);
  if (P.ws == nullptr) grid.sync();
  GRID_BAR();
  TS_END(0)
  TS_BEGIN(1)
  PH(1) {
    pg8::DenseSched S; S.init(NTOK, W0P, 1024, ws + WS_WIN0, F.G, (int)blockIdx.x);
    pg8::EpiProj0 E{(bf16_t*)(ws + WS_PROJ), (bf16_t*)(ws + WS_KF), (bf16_t*)(ws + WS_IKF), (bf16_t*)(ws + WS_VTF), P.in[I_QN0], P.in[I_KN0], (const float*)(ws + WS_ROPE), (const float*)(ws + WS_ROPE) + SEQ * 32};
    pg8::gemm_phase<pg8::EpiProj0, pg8::DenseSched, true>(F.lds, F.wave, (const char*)(ws + WS_XN), 1024, S, E);
  }
  GRID_BAR();
  TS_END(1)
  TS_BEGIN(2)
  PH(2) p1b_transform0(F, P);
  GRID_BAR();
  TS_END(2)
  TS_BEGIN(3)
  PH(3) dsa_phase(F, P);
  GRID_BAR();
  TS_END(3)
  TS_BEGIN(4)
  PH(4) {
    pg8::DenseSched S; S.init(NTOK, 1024, 1024, ws + WS_WOUT0, F.G, (int)blockIdx.x);
    pg8::EpiResB<true> E{P.in[I_X], (bf16_t*)(ws + WS_XB), DM};
    pg8::gemm_phase<pg8::EpiResB<true>, pg8::DenseSched, true>(F.lds, F.wave, (const char*)(ws + WS_MIX), 1024, S, E);
  }
  GRID_BAR();
  TS_END(4)
  TS_BEGIN(5)
  PH(5) router_phase(F, P, 0);
  GRID_BAR();
  TS_END(5)
  TS_BEGIN(6)
  PH(6) moe_gemms(F, P, 0, xbar);
  GRID_BAR();
  TS_END(6)
  TS_BEGIN(7)
  PH(7) combine_phase(F, P, 0, true);
  GRID_BAR();
  TS_END(7)
  TS_BEGIN(8)
  PH(8) {
    pg8::DenseSched S; S.init(NTOK, W1, 1024, ws + WS_WIN1, F.G, (int)blockIdx.x);
    pg8::EpiQKV1 E{(bf16_t*)(ws + WS_PROJ), P.in[I_QN1], P.in[I_KN1], (const float*)(ws + WS_ROPE), (const float*)(ws + WS_ROPE) + SEQ * 32};
    pg8::gemm_phase<pg8::EpiQKV1, pg8::DenseSched, true>(F.lds, F.wave, (const char*)(ws + WS_XN), 1024, S, E);
  }
  GRID_BAR();
  TS_END(8)
  TS_BEGIN(10)
  PH(10) dil_phase(F, P);
  GRID_BAR();
  TS_END(10)
  TS_BEGIN(11)
  PH(11) {
    pg8::DenseSched S; S.init(NTOK, 1024, 1024, ws + WS_WOUT1, F.G, (int)blockIdx.x);
    pg8::EpiResB<false> E{ws + WS_XB, (bf16_t*)(ws + WS_XB), DM};
    pg8::gemm_phase<pg8::EpiResB<false>, pg8::DenseSched, true>(F.lds, F.wave, (const char*)(ws + WS_MIX), 1024, S, E);
  }
  GRID_BAR();
  TS_END(11)
  TS_BEGIN(12)
  PH(12) router_phase(F, P, 1);
  GRID_BAR();
  TS_END(12)
  TS_BEGIN(13)
  PH(13) moe_gemms(F, P, 1, xbar);
  GRID_BAR();
  TS_END(13)
  TS_BEGIN(14)
  PH(14) combine_phase(F, P, 1, false);
#ifdef TIMEPH
  GRID_BAR();
  TS_END(14)
  GRID_BAR();
  { const unsigned long long dt = (tsw[1] - tsw[0]) * 4ull; const unsigned long long t0 = __builtin_amdgcn_s_memrealtime();
    while (__builtin_amdgcn_s_memrealtime() - t0 < dt) __builtin_amdgcn_s_sleep(32); }
#endif
}

extern "C" void kernel_launch(void* const* d_in, const int* in_sizes, int n_in, void* d_out, int out_size, void* d_ws, size_t ws_size, hipStream_t stream) {
  static int grid_blocks = 0;
  if (!grid_blocks) {
    if (n_in != 28 || out_size != NTOK * DM || ws_size < WS_END) { fprintf(stderr, "kernel_launch: unexpected shapes (n_in %d out %d ws %zu)\n", n_in, out_size, ws_size); grid_blocks = -1; return; }
    int dev = 0, cus = 0, per_cu = 0;
    (void)hipGetDevice(&dev);
    (void)hipDeviceGetAttribute(&cus, hipDeviceAttributeMultiprocessorCount, dev);
    (void)hipFuncSetAttribute((const void*)fwd_megakernel, hipFuncAttributeMaxDynamicSharedMemorySize, LDS_BYTES);
    (void)hipOccupancyMaxActiveBlocksPerMultiprocessor(&per_cu, (const void*)fwd_megakernel, 512, LDS_BYTES);
    if (per_cu < 1) per_cu = 1;
    grid_blocks = cus * per_cu;
  }
  if (grid_blocks < 0) return;
  Params p{};
  for (int i = 0; i < 28; ++i) p.in[i] = (const float*)d_in[i];
  p.out = (float*)d_out; p.ws = (unsigned char*)d_ws;
  (void)hipMemsetAsync((unsigned char*)d_ws + WS_CTL + 65536, 0, XCD_BAR_WORDS * 4, stream);
  void* args[] = {&p};
  hipError_t e = hipLaunchCooperativeKernel((const void*)fwd_megakernel, dim3(grid_blocks), dim3(512), args, LDS_BYTES, stream);
  if (e != hipSuccess) fprintf(stderr, "cooperative launch failed: %s (grid %d)\n", hipGetErrorString(e), grid_blocks);
}
```

```cpp
#include <hip/hip_runtime.h>
#include <hip/hip_cooperative_groups.h>
#include <cstdio>
#include <cstdint>
namespace cg = cooperative_groups;

#define LAS __attribute__((address_space(3)))
#define DI __device__ __forceinline__
typedef unsigned short bf16_t;
typedef short bf16x8 __attribute__((ext_vector_type(8)));
typedef short s16x4 __attribute__((ext_vector_type(4)));
typedef float f32x2 __attribute__((ext_vector_type(2)));
typedef float f32x4 __attribute__((ext_vector_type(4)));
typedef float f32x16 __attribute__((ext_vector_type(16)));
typedef unsigned u32x2 __attribute__((ext_vector_type(2)));
typedef unsigned u32x4 __attribute__((ext_vector_type(4)));
typedef int i32x4 __attribute__((ext_vector_type(4)));
typedef __bf16 bf16x2_t __attribute__((ext_vector_type(2)));

constexpr int NTOK = 65536, DM = 1024, SEQ = 4096, NBATCH = 16;
constexpr int W0P = 2560, W0V = 2500;
constexpr int W1 = 1536;
constexpr int C_CB = 0, C_CC = 512, C_CH = 1024, C_Q = 1536, C_K = 2048, C_V = 2112, C_IQ = 2176, C_IK = 2432, C_IW = 2496;
constexpr int NEXP = 32, DEXP = 512;
constexpr int MAXROWS = 139264;
constexpr float NORM_EPS = 1e-6f;
constexpr float LOG2E = 1.4426950408889634f;

constexpr size_t MiB = 1u << 20;
constexpr size_t WS_CTL = 0;
constexpr size_t WS_ROPE = 1 * MiB;
constexpr size_t WS_WR0 = 2 * MiB, WS_WR1 = 2 * MiB + 256 * 1024;
constexpr size_t WS_WIN0 = 3 * MiB, WS_WOUT0 = 8 * MiB, WS_WIN1 = 10 * MiB, WS_WOUT1 = 13 * MiB;
constexpr size_t WS_WGU0 = 16 * MiB, WS_WD0 = 80 * MiB, WS_WGU1 = 112 * MiB, WS_WD1 = 176 * MiB;
constexpr size_t WS_XN = 208 * MiB;
constexpr size_t WS_MIX = 337 * MiB;
constexpr size_t WS_H = 337 * MiB;
constexpr size_t WS_XB = 473 * MiB;
constexpr size_t WS_PROJ = 601 * MiB;
constexpr size_t WS_LIST = 921 * MiB;
constexpr size_t WS_ASG = 929 * MiB;
constexpr size_t WS_ASGG = 930 * MiB;
constexpr size_t WS_IKF = 931 * MiB, WS_KF = 939 * MiB, WS_VTF = 947 * MiB;
constexpr size_t WS_RSL = 955 * MiB;
constexpr size_t WS_END = 963 * MiB;

constexpr int LDS_BYTES = 155648;
constexpr int LDS_LIST = 131072;
constexpr int LDS_HIST = 139264;
constexpr int LDS_MISC = 131072 + 16384;

DI unsigned pk2(float lo, float hi) { f32x2 v = {lo, hi}; bf16x2_t b = __builtin_convertvector(v, bf16x2_t); return __builtin_bit_cast(unsigned, b); }
DI float bflo(unsigned w) { return __uint_as_float(w << 16); }
DI float bfhi(unsigned w) { return __uint_as_float(w & 0xffff0000u); }
DI float bf1(bf16_t h) { return __uint_as_float((unsigned)h << 16); }
DI int opaque(int x) { asm volatile("" : "+v"(x)); return x; }
DI int lane_id_v() { int l; asm volatile("v_mbcnt_lo_u32_b32 %0, -1, 0\n\tv_mbcnt_hi_u32_b32 %0, -1, %0" : "=v"(l)); return l; }
DI float wave_sum(float v) {
#pragma unroll
  for (int o = 1; o < 64; o <<= 1) v += __shfl_xor(v, o);
  return v;
}
DI float wave_max(float v) {
#pragma unroll
  for (int o = 1; o < 64; o <<= 1) v = fmaxf(v, __shfl_xor(v, o));
  return v;
}
DI unsigned wave_sum_u(unsigned v) {
#pragma unroll
  for (int o = 1; o < 64; o <<= 1) v += (unsigned)__shfl_xor((int)v, o);
  return v;
}

namespace pg8 {
constexpr int BM = 256, BK = 64, HALF = 128, HTB = HALF * BK * 2, STAGE_BYTES = 8 * HTB, NXCD = 8, WGM = 8;
DI int lds_byte(int r, int c) { const int st = (r >> 4) * 2 + (c >> 5), rr = r & 15, cc = c & 31, ob = rr * 64 + cc * 2; return st * 1024 + (ob ^ (((ob >> 9) & 1) << 5)); }
DI void stage_rc(int b, int& R, int& C) { const int st = b / 1024, sb = b % 1024, swz = sb ^ (((sb >> 9) & 1) << 5); R = (st >> 1) * 16 + swz / 64; C = (st & 1) * 32 + (swz % 64) / 2; }
DI int perm32(int rho) { const int n = rho >> 4, i = rho & 15; return 8 * (i >> 2) + 4 * n + (i & 3); }

struct Unit { const char* b; int p0, p1, p2, p3; };

struct EpiBf16 {
  static constexpr bool PERM = true;
  bf16_t* O; int ldc;
  DI void operator()(const f32x4 (&acc)[2][2][4][2], const Unit& u, int wr, int wc, int fr, int fq) const {
    const int row0 = u.p0 + wr * 64 + fr, col0 = u.p1 + wc * 32 + 8 * fq;
#pragma unroll
    for (int ai = 0; ai < 2; ++ai)
#pragma unroll
      for (int m = 0; m < 4; ++m) { bf16_t* rowp = O + (size_t)(row0 + ai * HALF + m * 16) * ldc + col0;
#pragma unroll
        for (int bj = 0; bj < 2; ++bj) { const f32x4 v0 = acc[ai][bj][m][0], v1 = acc[ai][bj][m][1];
          u32x4 w; w.x = pk2(v0[0], v0[1]); w.y = pk2(v0[2], v0[3]); w.z = pk2(v1[0], v1[1]); w.w = pk2(v1[2], v1[3]);
          *(u32x4*)(rowp + bj * HALF) = w; } }
  }
};
template <bool BASE_F32> struct EpiResB {
  static constexpr bool PERM = true;
  const void* base; bf16_t* out; int ldc;
  DI void operator()(const f32x4 (&acc)[2][2][4][2], const Unit& u, int wr, int wc, int fr, int fq) const {
    const int row0 = u.p0 + wr * 64 + fr, col0 = u.p1 + wc * 32 + 8 * fq;
#pragma unroll
    for (int ai = 0; ai < 2; ++ai)
#pragma unroll
      for (int m = 0; m < 4; ++m) { const size_t off = (size_t)(row0 + ai * HALF + m * 16) * ldc + col0;
#pragma unroll
        for (int bj = 0; bj < 2; ++bj) { f32x4 v0 = acc[ai][bj][m][0], v1 = acc[ai][bj][m][1];
          if (BASE_F32) { const float* bp = (const float*)base + off + bj * HALF; v0 = v0 + *(const f32x4*)bp; v1 = v1 + *(const f32x4*)(bp + 4); }
          else { const u32x4 b = *(const u32x4*)((const bf16_t*)base + off + bj * HALF);
            v0 = v0 + (f32x4){bflo(b.x), bfhi(b.x), bflo(b.y), bfhi(b.y)}; v1 = v1 + (f32x4){bflo(b.z), bfhi(b.z), bflo(b.w), bfhi(b.w)}; }
          u32x4 w; w.x = pk2(v0[0], v0[1]); w.y = pk2(v0[2], v0[3]); w.z = pk2(v1[0], v1[1]); w.w = pk2(v1[2], v1[3]);
          *(u32x4*)(out + off + bj * HALF) = w; } }
  }
};
struct EpiQKV1 {
  static constexpr bool PERM = true;
  bf16_t* O; const float* qg; const float* kg; const float* cosT; const float* sinT;
  DI void operator()(const f32x4 (&acc)[2][2][4][2], const Unit& u, int wr, int wc, int fr, int fq) const {
    const int tilec = u.p1 >> 8;
    const int row0 = u.p0 + wr * 64 + fr, col0 = u.p1 + wc * 64 + 8 * fq;
    if (tilec == 5) {
#pragma unroll
      for (int ai = 0; ai < 2; ++ai)
#pragma unroll
        for (int m = 0; m < 4; ++m) { bf16_t* rowp = O + (size_t)(row0 + ai * HALF + m * 16) * W1 + col0;
#pragma unroll
          for (int bj = 0; bj < 2; ++bj) { const f32x4 v0 = acc[ai][bj][m][0], v1 = acc[ai][bj][m][1];
            u32x4 w; w.x = pk2(v0[0], v0[1]); w.y = pk2(v0[2], v0[3]); w.z = pk2(v1[0], v1[1]); w.w = pk2(v1[2], v1[3]); *(u32x4*)(rowp + 32 * bj) = w; } }
      return;
    }
    const float* gp = (tilec == 4 ? kg : qg) + 8 * fq; const float osc = tilec == 4 ? 1.f : 0.125f * LOG2E;
    float g0[8], g1[8];
#pragma unroll
    for (int i = 0; i < 8; ++i) { g0[i] = gp[i]; g1[i] = gp[32 + i]; }
#pragma unroll
    for (int ai = 0; ai < 2; ++ai)
#pragma unroll
      for (int m = 0; m < 4; ++m) {
        const int row = row0 + ai * HALF + m * 16; const int t = row & (SEQ - 1);
        const f32x4 a0 = acc[ai][0][m][0], a1 = acc[ai][0][m][1], b0 = acc[ai][1][m][0], b1 = acc[ai][1][m][1];
        float x1[8] = {a0[0], a0[1], a0[2], a0[3], a1[0], a1[1], a1[2], a1[3]}, x2[8] = {b0[0], b0[1], b0[2], b0[3], b1[0], b1[1], b1[2], b1[3]};
        float ss = 0.f;
#pragma unroll
        for (int i = 0; i < 8; ++i) ss += x1[i] * x1[i] + x2[i] * x2[i];
        ss += __shfl_xor(ss, 16); ss += __shfl_xor(ss, 32);
        const float rstd = 1.0f / sqrtf(ss * (1.f / 64.f) + NORM_EPS);
        const f32x4* cp = (const f32x4*)(cosT + t * 32 + 8 * fq); const f32x4* sp = (const f32x4*)(sinT + t * 32 + 8 * fq);
        const f32x4 c0 = cp[0], c1 = cp[1], s0 = sp[0], s1 = sp[1];
        const float cv[8] = {c0[0], c0[1], c0[2], c0[3], c1[0], c1[1], c1[2], c1[3]}, sv[8] = {s0[0], s0[1], s0[2], s0[3], s1[0], s1[1], s1[2], s1[3]};
        float o1[8], o2[8];
#pragma unroll
        for (int i = 0; i < 8; ++i) { const float y1 = x1[i] * rstd * g0[i], y2 = x2[i] * rstd * g1[i]; o1[i] = (y1 * cv[i] - y2 * sv[i]) * osc; o2[i] = (y1 * sv[i] + y2 * cv[i]) * osc; }
        bf16_t* rowp = O + (size_t)row * W1 + col0;
        u32x4 w; w.x = pk2(o1[0], o1[1]); w.y = pk2(o1[2], o1[3]); w.z = pk2(o1[4], o1[5]); w.w = pk2(o1[6], o1[7]); *(u32x4*)rowp = w;
        w.x = pk2(o2[0], o2[1]); w.y = pk2(o2[2], o2[3]); w.z = pk2(o2[4], o2[5]); w.w = pk2(o2[6], o2[7]); *(u32x4*)(rowp + 32) = w;
      }
  }
};
struct EpiProj0 {
  static constexpr bool PERM = true;
  bf16_t* O; bf16_t* KFo; bf16_t* IKFo; bf16_t* VRo; const float* qg; const float* kg; const float* cosT; const float* sinT;
  DI void operator()(const f32x4 (&acc)[2][2][4][2], const Unit& u, int wr, int wc, int fr, int fq) const {
    const int grp64 = (u.p1 >> 6) + wc;
    const int row0 = u.p0 + wr * 64 + fr, col0 = u.p1 + wc * 64 + 8 * fq;
    const bool rope = (grp64 >= 24 && grp64 <= 32) || (grp64 >= 34 && grp64 <= 38);
    if (!rope) {
#pragma unroll
      for (int ai = 0; ai < 2; ++ai)
#pragma unroll
        for (int m = 0; m < 4; ++m) { const int row = row0 + ai * HALF + m * 16;
          bf16_t* rowp = grp64 == 33 ? VRo + (size_t)row * 64 + 8 * fq : O + (size_t)row * W0P + col0;
#pragma unroll
          for (int bj = 0; bj < 2; ++bj) { const f32x4 v0 = acc[ai][bj][m][0], v1 = acc[ai][bj][m][1];
            u32x4 w; w.x = pk2(v0[0], v0[1]); w.y = pk2(v0[2], v0[3]); w.z = pk2(v1[0], v1[1]); w.w = pk2(v1[2], v1[3]); *(u32x4*)(rowp + 32 * bj) = w; } }
      return;
    }
    const bool norm = grp64 <= 32;
    const float* gp = (grp64 == 32 ? kg : qg) + 8 * fq;
    float g0[8], g1[8];
#pragma unroll
    for (int i = 0; i < 8; ++i) { g0[i] = norm ? gp[i] : 1.f; g1[i] = norm ? gp[32 + i] : 1.f; }
    bf16_t* frag = grp64 == 32 ? KFo : (grp64 == 38 ? IKFo : nullptr);
#pragma unroll
    for (int ai = 0; ai < 2; ++ai)
#pragma unroll
      for (int m = 0; m < 4; ++m) {
        const int row = row0 + ai * HALF + m * 16; const int t = row & (SEQ - 1);
        const f32x4 a0 = acc[ai][0][m][0], a1 = acc[ai][0][m][1], b0 = acc[ai][1][m][0], b1 = acc[ai][1][m][1];
        float x1[8] = {a0[0], a0[1], a0[2], a0[3], a1[0], a1[1], a1[2], a1[3]}, x2[8] = {b0[0], b0[1], b0[2], b0[3], b1[0], b1[1], b1[2], b1[3]};
        float ss = 0.f;
#pragma unroll
        for (int i = 0; i < 8; ++i) ss += x1[i] * x1[i] + x2[i] * x2[i];
        ss += __shfl_xor(ss, 16); ss += __shfl_xor(ss, 32);
        const float rstd = norm ? 1.0f / sqrtf(ss * (1.f / 64.f) + NORM_EPS) : 1.f;
        const f32x4* cp = (const f32x4*)(cosT + t * 32 + 8 * fq); const f32x4* sp = (const f32x4*)(sinT + t * 32 + 8 * fq);
        const f32x4 c0 = cp[0], c1 = cp[1], s0 = sp[0], s1 = sp[1];
        const float cv[8] = {c0[0], c0[1], c0[2], c0[3], c1[0], c1[1], c1[2], c1[3]}, sv[8] = {s0[0], s0[1], s0[2], s0[3], s1[0], s1[1], s1[2], s1[3]};
        float o1[8], o2[8];
#pragma unroll
        for (int i = 0; i < 8; ++i) { const float y1 = x1[i] * rstd * g0[i], y2 = x2[i] * rstd * g1[i]; o1[i] = y1 * cv[i] - y2 * sv[i]; o2[i] = y1 * sv[i] + y2 * cv[i]; }
        u32x4 w1, w2; w1.x = pk2(o1[0], o1[1]); w1.y = pk2(o1[2], o1[3]); w1.z = pk2(o1[4], o1[5]); w1.w = pk2(o1[6], o1[7]);
        w2.x = pk2(o2[0], o2[1]); w2.y = pk2(o2[2], o2[3]); w2.z = pk2(o2[4], o2[5]); w2.w = pk2(o2[6], o2[7]);
        if (grp64 == 32) { bf16_t* kr = KFo + (size_t)row * 64 + 8 * fq; *(u32x4*)kr = w1; *(u32x4*)(kr + 32) = w2; }
        else if (frag) {
          const size_t fo = ((((size_t)(row >> 12) * 128 + (t >> 5)) * 4 + (fq >> 1)) * 64 + (fq & 1) * 32 + (t & 31)) * 8;
          *(u32x4*)(frag + fo) = w1; *(u32x4*)(frag + fo + 2 * 64 * 8) = w2;
        } else { bf16_t* rowp = O + (size_t)row * W0P + col0; *(u32x4*)rowp = w1; *(u32x4*)(rowp + 32) = w2; }
      }
  }
};
struct EpiResF32 {
  static constexpr bool PERM = false;
  const float* base; float* out; int ldc;
  DI void operator()(const f32x4 (&acc)[2][2][4][2], const Unit& u, int wr, int wc, int fr, int fq) const {
    const int row0 = u.p0 + wr * 64 + fr, col0 = u.p1 + wc * 32 + 4 * fq;
#pragma unroll
    for (int ai = 0; ai < 2; ++ai)
#pragma unroll
      for (int m = 0; m < 4; ++m) { const size_t off = (size_t)(row0 + ai * HALF + m * 16) * ldc + col0;
#pragma unroll
        for (int bj = 0; bj < 2; ++bj)
#pragma unroll
          for (int n = 0; n < 2; ++n) { const f32x4 bs = *(const f32x4*)(base + off + bj * HALF + n * 16); *(f32x4*)(out + off + bj * HALF + n * 16) = bs + acc[ai][bj][m][n]; } }
  }
};
DI float silu_mul(float g, float u) { return g * u * __builtin_amdgcn_rcpf(1.0f + __builtin_amdgcn_exp2f(-g * LOG2E)); }
struct EpiSwiGLU {
  static constexpr bool PERM = true;
  bf16_t* H; const float* RSL; const LAS int* cnt;
  DI void operator()(const f32x4 (&acc)[2][2][4][2], const Unit& u, int wr, int wc, int fr, int fq) const {
    const int row0 = u.p0 + wr * 64 + fr, col0 = u.p1 + wc * 32 + 8 * fq; const int ce = __builtin_amdgcn_readfirstlane(cnt[u.p2]);
#pragma unroll
    for (int ai = 0; ai < 2; ++ai)
#pragma unroll
      for (int m = 0; m < 4; ++m) { bf16_t* rowp = H + (size_t)(row0 + ai * HALF + m * 16) * DEXP + col0;
        const int lrow = u.p3 * BM + wr * 64 + fr + ai * HALF + m * 16; const float rs = (lrow < ce) ? RSL[u.p2 * 65536 + lrow] : 0.f;
        const f32x4 g0 = acc[ai][0][m][0] * rs, g1 = acc[ai][0][m][1] * rs, u0 = acc[ai][1][m][0] * rs, u1 = acc[ai][1][m][1] * rs;
        u32x4 w; w.x = pk2(silu_mul(g0[0], u0[0]), silu_mul(g0[1], u0[1])); w.y = pk2(silu_mul(g0[2], u0[2]), silu_mul(g0[3], u0[3]));
        w.z = pk2(silu_mul(g1[0], u1[0]), silu_mul(g1[1], u1[1])); w.w = pk2(silu_mul(g1[2], u1[2]), silu_mul(g1[3], u1[3]));
        *(u32x4*)rowp = w; }
  }
};

struct DenseSched {
  static constexpr bool NEXT_IN_LDS = false;
  int nM, nN, nwg, G, c, K; const char* Bt;
  DI void init(int M, int N, int K_, const void* Bt_, int G_, int c_) { nM = M / BM; nN = N / BM; nwg = nM * nN; G = G_; c = c_; K = K_; Bt = (const char*)Bt_; }
  DI bool next(int i, Unit& u) const {
    const long L = (long)i * G + c; if (L >= nwg) return false;
    int wgid = (int)L; { const int q = nwg / NXCD, r = nwg % NXCD, xcd = wgid % NXCD, off = wgid / NXCD; wgid = (xcd < r ? xcd * (q + 1) : r * (q + 1) + (xcd - r) * q) + off; }
    const int nig = WGM * nN, gid = wgid / nig, fm = gid * WGM, gsz = (nM - fm) < WGM ? (nM - fm) : WGM;
    const int pm = fm + ((wgid % nig) % gsz), pn = (wgid % nig) / gsz;
    u.p0 = pm * BM; u.p1 = pn * BM; u.p2 = 0; u.p3 = 0; u.b = Bt + (size_t)pn * BM * K * 2; return true;
  }
  DI void a_off(const Unit& u, const int (&R)[2], const int (&C)[2], unsigned (&o)[2][2]) const {
#pragma unroll
    for (int h = 0; h < 2; ++h)
#pragma unroll
      for (int i = 0; i < 2; ++i) o[h][i] = (unsigned)((u.p0 + h * HALF + R[i]) * K + C[i]) * 2u;
  }
};
template <bool GATHER> struct MoeSched {
  static constexpr bool NEXT_IN_LDS = GATHER;
  const LAS int* pb; const LAS int* cnt; const int* list; const char* W; int G, c, K;
  DI bool next(int i, Unit& u) const {
    const int L = i * G + c; const int total = __builtin_amdgcn_readfirstlane(pb[NEXP]) * 4; if (L >= total) return false;
    const int rbg = L >> 2, pn = L & 3; int e = 0;
    for (int j = 1; j < NEXP; ++j) e = (__builtin_amdgcn_readfirstlane(pb[j]) <= rbg) ? j : e;
    u.p0 = rbg * BM; u.p1 = pn * (GATHER ? 128 : 256); u.p2 = e; u.p3 = rbg - __builtin_amdgcn_readfirstlane(pb[e]);
    u.b = W + (size_t)(e * 1024 + pn * 256) * K * 2; return true;
  }
  DI void a_off(const Unit& u, const int (&R)[2], const int (&C)[2], unsigned (&o)[2][2]) const {
    if (GATHER) {
      const int ce = __builtin_amdgcn_readfirstlane(cnt[u.p2]);
#pragma unroll
      for (int h = 0; h < 2; ++h)
#pragma unroll
        for (int i = 0; i < 2; ++i) { const int row = u.p3 * BM + h * HALF + R[i]; const int tok = (row < ce) ? list[u.p2 * 65536 + row] : 0; o[h][i] = (unsigned)(tok * K + C[i]) * 2u; }
    } else {
#pragma unroll
      for (int h = 0; h < 2; ++h)
#pragma unroll
        for (int i = 0; i < 2; ++i) o[h][i] = (unsigned)((u.p0 + h * HALF + R[i]) * K + C[i]) * 2u;
    }
  }
};

template <class Epi, class Sched, bool ALIGN_EPI>
DI void gemm_phase(LAS unsigned char* lds, const int wave_id, const char* gA, const int K, const Sched& S, const Epi& E) {
  const int lane = lane_id_v(), wid = wave_id, tid = wid * 64 + lane, wr = wid >> 2, wc = wid & 3, fr = lane & 15, fq = lane >> 4;
  const int nt = K / BK;
  unsigned voffB[2];
  { int R, C; stage_rc(tid * 16, R, C);
    const int Rb = Epi::PERM ? ((R & ~31) + perm32(R & 31)) : R; voffB[0] = (unsigned)(Rb * K + C) * 2u; voffB[1] = voffB[0] + (unsigned)(64 * K * 2); }
#define PG8_RC(Rp, Cp) int Rp[2], Cp[2]; { int R_, C_; stage_rc(opaque(tid) * 16, R_, C_); Rp[0] = R_; Cp[0] = C_; Rp[1] = R_ + 64; Cp[1] = C_; }
  const size_t kstep = (size_t)(BK * 2);
  const size_t hstep = (size_t)HALF * K * 2;
  const unsigned ldsw = (unsigned)wid * 1024u;
  const int aoff = lds_byte(wr * 64 + fr, fq * 8), boff = lds_byte(wc * 32 + fr, fq * 8);
#define PG8_SA(b, h) (((b) * 2 + (h)) * HTB)
#define PG8_SB(b, h) ((4 + (b) * 2 + (h)) * HTB)
#define PG8_STAGE_B(bufoff, gbase) do { _Pragma("unroll") for (int _i = 0; _i < 2; ++_i) \
    __builtin_amdgcn_global_load_lds((const unsigned*)((const char*)(gbase) + voffB[_i]), (LAS unsigned*)(lds + (bufoff) + ldsw + _i * 8192), 16, 0, 0); } while (0)
#define PG8_STAGE_A(bufoff, kb, offs) do { _Pragma("unroll") for (int _i = 0; _i < 2; ++_i) \
    __builtin_amdgcn_global_load_lds((const unsigned*)(gA + (size_t)(kb) + (offs)[_i]), (LAS unsigned*)(lds + (bufoff) + ldsw + _i * 8192), 16, 0, 0); } while (0)
#define PG8_LDA(dst, b, h) do { _Pragma("unroll") for (int m = 0; m < 4; ++m) _Pragma("unroll") for (int k = 0; k < 2; ++k) dst[m][k] = *(const LAS bf16x8*)(lds + PG8_SA(b, h) + aoff + m * 2048 + k * 1024); } while (0)
#define PG8_LDB(dst, b, h) do { _Pragma("unroll") for (int n = 0; n < 2; ++n) _Pragma("unroll") for (int k = 0; k < 2; ++k) dst[n][k] = *(const LAS bf16x8*)(lds + PG8_SB(b, h) + boff + n * 2048 + k * 1024); } while (0)
#define PG8_MMA(ai, bj, At, Bt) do { __builtin_amdgcn_s_setprio(1); _Pragma("unroll") for (int m = 0; m < 4; ++m) _Pragma("unroll") for (int n = 0; n < 2; ++n) _Pragma("unroll") for (int k = 0; k < 2; ++k) \
    acc[ai][bj][m][n] = __builtin_amdgcn_mfma_f32_16x16x32_bf16(Bt[n][k], At[m][k], acc[ai][bj][m][n], 0, 0, 0); __builtin_amdgcn_s_setprio(0); } while (0)
#define PG8_WAIT_V(n) asm volatile("s_waitcnt vmcnt(" #n ")" ::: "memory")
#define PG8_WAIT_L(n) asm volatile("s_waitcnt lgkmcnt(" #n ")" ::: "memory")
#define PG8_BAR __builtin_amdgcn_s_barrier()
#define PG8_SCHED __builtin_amdgcn_sched_barrier(0)
  Unit cur, nxt; int ui = 0;
  if (!S.next(0, cur)) return;
  unsigned ca[2][2];
  { PG8_RC(Rp, Cp) S.a_off(cur, Rp, Cp, ca); }
  f32x4 acc[2][2][4][2];
#pragma unroll
  for (int a = 0; a < 2; ++a)
#pragma unroll
    for (int b = 0; b < 2; ++b)
#pragma unroll
      for (int m = 0; m < 4; ++m)
#pragma unroll
        for (int n = 0; n < 2; ++n) acc[a][b][m][n] = (f32x4){0.f, 0.f, 0.f, 0.f};
  bf16x8 At[4][2], B0[2][2], B1[2][2];
  const char* cB = cur.b;
  PG8_STAGE_B(PG8_SB(0, 0), cB); PG8_STAGE_B(PG8_SB(0, 1), cB + hstep); PG8_STAGE_A(PG8_SA(0, 0), 0, ca[0]); PG8_STAGE_A(PG8_SA(0, 1), 0, ca[1]);
  if (wr == 1) PG8_BAR;
  PG8_WAIT_V(2); PG8_BAR;
  PG8_STAGE_B(PG8_SB(1, 0), cB + kstep); PG8_STAGE_A(PG8_SA(1, 0), kstep, ca[0]); PG8_STAGE_B(PG8_SB(1, 1), cB + hstep + kstep);
  PG8_WAIT_V(6); PG8_BAR;
  for (;;) {
    const bool has_next = S.next(ui + 1, nxt);
    if (Sched::NEXT_IN_LDS) {
      unsigned na[2][2];
      if (has_next) { PG8_RC(Rp, Cp) S.a_off(nxt, Rp, Cp, na); }
      else {
#pragma unroll
        for (int h = 0; h < 2; ++h)
#pragma unroll
          for (int i = 0; i < 2; ++i) na[h][i] = ca[h][i];
      }
      *(LAS u32x4*)(lds + STAGE_BYTES + 8192 + tid * 16) = (u32x4){na[0][0], na[0][1], na[1][0], na[1][1]};
    }
    const char* nB = has_next ? nxt.b : cB;
    for (int t = 0; t < nt; t += 2) {
      const bool last = (t == nt - 2);
      PG8_LDB(B0, 0, 0); PG8_LDB(B1, 0, 1); PG8_SCHED; PG8_LDA(At, 0, 0); PG8_STAGE_A(PG8_SA(1, 1), (size_t)(t + 1) * kstep, ca[1]);
      PG8_WAIT_V(8); PG8_WAIT_L(0); PG8_BAR; PG8_MMA(0, 0, At, B0); PG8_MMA(0, 1, At, B1); PG8_BAR; PG8_SCHED;
      const size_t kb2 = last ? 0 : (size_t)(t + 2) * kstep;
      const char* b2 = last ? nB : cB + (size_t)(t + 2) * kstep;
      if (last) {
        if (Sched::NEXT_IN_LDS) { const u32x4 v = *(const LAS u32x4*)(lds + STAGE_BYTES + 8192 + tid * 16); ca[0][0] = v.x; ca[0][1] = v.y; ca[1][0] = v.z; ca[1][1] = v.w; }
        else if (has_next) { PG8_RC(Rp, Cp) S.a_off(nxt, Rp, Cp, ca); }
      }
      PG8_LDA(At, 0, 1); PG8_STAGE_B(PG8_SB(0, 0), b2); PG8_STAGE_B(PG8_SB(0, 1), b2 + hstep); PG8_STAGE_A(PG8_SA(0, 0), kb2, ca[0]);
      PG8_WAIT_V(8); PG8_WAIT_L(0); PG8_BAR; PG8_MMA(1, 0, At, B0); PG8_MMA(1, 1, At, B1); PG8_BAR; PG8_SCHED;
      PG8_LDB(B0, 1, 0); PG8_LDB(B1, 1, 1); PG8_SCHED; PG8_LDA(At, 1, 0); PG8_STAGE_A(PG8_SA(0, 1), kb2, ca[1]);
      PG8_WAIT_V(8); PG8_WAIT_L(0); PG8_BAR; PG8_MMA(0, 0, At, B0); PG8_MMA(0, 1, At, B1); PG8_BAR; PG8_SCHED;
      PG8_LDA(At, 1, 1); PG8_STAGE_B(PG8_SB(1, 0), b2 + kstep); PG8_STAGE_B(PG8_SB(1, 1), b2 + kstep + hstep); PG8_STAGE_A(PG8_SA(1, 0), kb2 + kstep, ca[0]);
      PG8_WAIT_V(8); PG8_WAIT_L(0); PG8_BAR; PG8_MMA(1, 0, At, B0); PG8_MMA(1, 1, At, B1); PG8_BAR; PG8_SCHED;
    }
    if constexpr (ALIGN_EPI) { if (wr == 0) PG8_BAR; }
    E(acc, cur, wr, wc, fr, fq);
    if (!has_next) break;
#pragma unroll
    for (int a = 0; a < 2; ++a)
#pragma unroll
      for (int b = 0; b < 2; ++b)
#pragma unroll
        for (int m = 0; m < 4; ++m)
#pragma unroll
          for (int n = 0; n < 2; ++n) acc[a][b][m][n] = (f32x4){0.f, 0.f, 0.f, 0.f};
    cur = nxt; cB = nB; ++ui;
    if constexpr (ALIGN_EPI) { if (wr == 1) PG8_BAR; }
  }
  PG8_WAIT_V(0);
  if constexpr (!ALIGN_EPI) { if (wr == 0) PG8_BAR; }
  PG8_BAR;
#undef PG8_RC
#undef PG8_SA
#undef PG8_SB
#undef PG8_STAGE_A
#undef PG8_STAGE_B
#undef PG8_LDA
#undef PG8_LDB
#undef PG8_MMA
#undef PG8_WAIT_V
#undef PG8_WAIT_L
#undef PG8_BAR
#undef PG8_SCHED
}
}

struct Params { const float* in[28]; float* out; unsigned char* ws; };
enum { I_X = 0, I_ANORM0, I_WIN0, I_CONVW, I_QN0, I_KN0, I_WOUT0, I_FNORM0, I_WRG0, I_BRG0, I_WRE0, I_BRE0, I_WG0, I_WU0, I_WD0,
       I_ANORM1, I_WIN1, I_QN1, I_KN1, I_WOUT1, I_FNORM1, I_WRG1, I_BRG1, I_WRE1, I_BRE1, I_WG1, I_WU1, I_WD1 };

struct Ctx { LAS unsigned char* lds; int wave, G, gw, NGW; };

struct TrDesc { const float* W; const float* gain; bf16_t* WT; int K, N, nvalid, mode, nblk, item; };
DI void tr_load(const TrDesc& d, int lane, f32x4 (&r)[8]) {
  const int kb = d.item / d.nblk, nb = d.item % d.nblk, k0 = 64 * kb, n = 32 * nb + 4 * (lane & 7);
#pragma unroll
  for (int i = 0; i < 8; ++i) { const int kk = 8 * i + (lane >> 3); r[i] = (n < d.nvalid) ? *(const f32x4*)(d.W + (size_t)(k0 + kk) * d.N + n) : (f32x4){0.f, 0.f, 0.f, 0.f}; }
}
DI void tr_finish(const TrDesc& d, int lane, const f32x4 (&r)[8], LAS float* scr) {
  const int kb = d.item / d.nblk, nb = d.item % d.nblk, k0 = 64 * kb, n0 = 32 * nb;
#pragma unroll
  for (int i = 0; i < 8; ++i) { const int kk = 8 * i + (lane >> 3); const float g = d.gain ? d.gain[k0 + kk] : 1.f; LAS float* s = scr + kk * 33 + 4 * (lane & 7);
    s[0] = r[i].x * g; s[1] = r[i].y * g; s[2] = r[i].z * g; s[3] = r[i].w * g; }
  asm volatile("s_waitcnt lgkmcnt(0)" ::: "memory");
  const int c = lane & 7;
#pragma unroll
  for (int j = 0; j < 4; ++j) { const int nn = (lane >> 3) + 8 * j; const LAS float* s = scr + (8 * c) * 33 + nn;
    u32x4 o; o.x = pk2(s[0 * 33], s[1 * 33]); o.y = pk2(s[2 * 33], s[3 * 33]); o.z = pk2(s[4 * 33], s[5 * 33]); o.w = pk2(s[6 * 33], s[7 * 33]);
    const int ng = n0 + nn; const int drow = (d.mode == 0) ? ng : (d.mode == 3 ? ((ng & ~255) + 128 * ((ng >> 5) & 1) + 32 * ((ng >> 6) & 3) + (ng & 31)) : ((ng >> 7) * 256 + (ng & 127) + (d.mode == 2 ? 128 : 0)));
    *(u32x4*)(d.WT + (size_t)drow * d.K + k0 + 8 * c) = o; }
  asm volatile("s_waitcnt lgkmcnt(0)" ::: "memory");
}
constexpr int TR_I_IN0 = 16 * 80, TR_I_OUT = 16 * 32, TR_I_GU = 32 * 16 * 16, TR_I_DN = 32 * 8 * 32, TR_I_IN1 = 16 * 48;
constexpr int TR_EARLY = TR_I_IN0 + TR_I_OUT, TR_MOE = 2 * TR_I_GU + TR_I_DN, TR_TOTAL = TR_EARLY + TR_MOE + TR_I_IN1 + TR_I_OUT + TR_MOE;
DI TrDesc tr_desc(const Params& P, int it) {
  unsigned char* ws = P.ws; TrDesc d; int r = it;
  if (r < TR_I_IN0) { d.W = P.in[I_WIN0]; d.gain = P.in[I_ANORM0]; d.WT = (bf16_t*)(ws + WS_WIN0); d.K = 1024; d.N = W0V; d.nvalid = W0V; d.mode = 3; d.nblk = 80; d.item = r; return d; }
  r -= TR_I_IN0;
  if (r < TR_I_OUT) { d.W = P.in[I_WOUT0]; d.gain = nullptr; d.WT = (bf16_t*)(ws + WS_WOUT0); d.K = 1024; d.N = 1024; d.nvalid = 1024; d.mode = 0; d.nblk = 32; d.item = r; return d; }
  r -= TR_I_OUT;
  int L = 0;
  if (r >= TR_MOE) { r -= TR_MOE;
    if (r < TR_I_IN1) { d.W = P.in[I_WIN1]; d.gain = P.in[I_ANORM1]; d.WT = (bf16_t*)(ws + WS_WIN1); d.K = 1024; d.N = W1; d.nvalid = W1; d.mode = 3; d.nblk = 48; d.item = r; return d; }
    r -= TR_I_IN1;
    if (r < TR_I_OUT) { d.W = P.in[I_WOUT1]; d.gain = nullptr; d.WT = (bf16_t*)(ws + WS_WOUT1); d.K = 1024; d.N = 1024; d.nvalid = 1024; d.mode = 0; d.nblk = 32; d.item = r; return d; }
    r -= TR_I_OUT; L = 1; }
  const float* fnorm = P.in[L ? I_FNORM1 : I_FNORM0];
  if (r < 2 * TR_I_GU) { const int up = r >= TR_I_GU; if (up) r -= TR_I_GU; const int e = r >> 8;
    d.W = P.in[up ? (L ? I_WU1 : I_WU0) : (L ? I_WG1 : I_WG0)] + (size_t)e * 1024 * 512; d.gain = fnorm; d.WT = (bf16_t*)(ws + (L ? WS_WGU1 : WS_WGU0)) + (size_t)e * 1024 * 1024;
    d.K = 1024; d.N = 512; d.nvalid = 512; d.mode = up ? 2 : 1; d.nblk = 16; d.item = r & 255; return d; }
  r -= 2 * TR_I_GU;
  { const int e = r >> 8; d.W = P.in[L ? I_WD1 : I_WD0] + (size_t)e * 512 * 1024; d.gain = nullptr; d.WT = (bf16_t*)(ws + (L ? WS_WD1 : WS_WD0)) + (size_t)e * 1024 * 512; d.K = 512; d.N = 1024; d.nvalid = 1024; d.mode = 0; d.nblk = 32; d.item = r & 255; return d; }
}
DI void rms_row_to_bf16(const float* xrow, bf16_t* orow, int lane) {
  const f32x4* xr = (const f32x4*)xrow + lane;
  f32x4 v[4]; float s = 0.f;
#pragma unroll
  for (int j = 0; j < 4; ++j) { v[j] = xr[64 * j]; s += (v[j].x * v[j].x + v[j].y * v[j].y) + (v[j].z * v[j].z + v[j].w * v[j].w); }
  const float rstd = 1.0f / sqrtf(wave_sum(s) * (1.f / DM) + NORM_EPS);
  unsigned long long* o8 = (unsigned long long*)orow + lane;
#pragma unroll
  for (int j = 0; j < 4; ++j) o8[64 * j] = (unsigned long long)pk2(v[j].x * rstd, v[j].y * rstd) | ((unsigned long long)pk2(v[j].z * rstd, v[j].w * rstd) << 32);
}
DI void p0_prologue(const Ctx& F, const Params& P) {
  unsigned char* ws = P.ws; const int lane = lane_id_v(); const int tid = F.wave * 64 + lane;
  LAS float* scr = (LAS float*)(F.lds + F.wave * 16384);
  {
    const int NIT = TR_EARLY;
    int it = F.gw;
    f32x4 ra[8], rb[8];
    TrDesc da, db;
    if (it < NIT) { da = tr_desc(P, it); tr_load(da, lane, ra); }
    while (it < NIT) {
      const int itn = it + F.NGW;
      if (itn < NIT) { db = tr_desc(P, itn); tr_load(db, lane, rb); }
      tr_finish(da, lane, ra, scr);
      if (itn >= NIT) break;
      const int itn2 = itn + F.NGW;
      if (itn2 < NIT) { da = tr_desc(P, itn2); tr_load(da, lane, ra); }
      tr_finish(db, lane, rb, scr);
      it = itn2;
    }
  }
  for (int m = F.gw; m < NTOK; m += F.NGW) rms_row_to_bf16(P.in[I_X] + (size_t)m * DM, (bf16_t*)(ws + WS_XN) + (size_t)m * DM, lane);
  const int gt = blockIdx.x * 512 + tid, NGT = F.G * 512;
  for (int i = gt; i < 512; i += NGT) ((unsigned*)(ws + WS_XN + (size_t)NTOK * DM * 2))[i] = 0u;
  for (int i = gt; i < 128; i += NGT) ((int*)(ws + WS_CTL))[i] = 0;
  for (int i = gt; i < SEQ * 32; i += NGT) {
    const int t = i >> 5, k = i & 31;
    const float inv = (float)exp2(-(double)k * (13.287712379549449 / 32.0));
    const float ang = (float)t * inv;
    const double rev = (double)ang * 0.15915494309189535; const float fr = (float)(rev - rint(rev));
    ((float*)(ws + WS_ROPE))[i] = __builtin_amdgcn_cosf(fr); ((float*)(ws + WS_ROPE))[SEQ * 32 + i] = __builtin_amdgcn_sinf(fr);
  }
  for (int i = gt; i < 2 * 36 * 1024; i += NGT) {
    const int L = i / (36 * 1024), r = i % (36 * 1024), j = r >> 10, k = r & 1023;
    const float g = P.in[L ? I_FNORM1 : I_FNORM0][k];
    float w; if (j < 4) w = P.in[L ? I_WRG1 : I_WRG0][k * 4 + j]; else { const int gg = (j - 4) >> 3, e = (j - 4) & 7; w = P.in[L ? I_WRE1 : I_WRE0][((size_t)gg * 1024 + k) * 8 + e]; }
    w *= g;
    const unsigned hi = pk2(w, 0.f) & 0xffffu; const float lo = w - __uint_as_float(hi << 16);
    bf16_t* base = (bf16_t*)(ws + (L ? WS_WR1 : WS_WR0));
    base[r] = (bf16_t)hi; base[36 * 1024 + r] = (bf16_t)(pk2(lo, 0.f) & 0xffffu);
  }
  for (int i = gt; i < 2 * 36; i += NGT) { const int L = i / 36, j = i % 36; ((float*)(ws + (L ? WS_WR1 : WS_WR0) + 147456))[j] = (j < 4) ? P.in[L ? I_BRG1 : I_BRG0][j] : P.in[L ? I_BRE1 : I_BRE0][j - 4]; }
}

DI u32x4 normrope8(const u32x4 w, const float (&gv)[8], bool do_norm, const f32x4 (&cs)[2], const f32x4 (&sn)[2], int sub, float oscale) {
  float v[8] = {bflo(w.x), bfhi(w.x), bflo(w.y), bfhi(w.y), bflo(w.z), bfhi(w.z), bflo(w.w), bfhi(w.w)};
  if (do_norm) {
    float s = 0.f;
#pragma unroll
    for (int j = 0; j < 8; ++j) s += v[j] * v[j];
    s += __shfl_xor(s, 1); s += __shfl_xor(s, 2); s += __shfl_xor(s, 4);
    const float rstd = 1.0f / sqrtf(s * (1.f / 64.f) + NORM_EPS);
#pragma unroll
    for (int j = 0; j < 8; ++j) v[j] = v[j] * rstd * gv[j];
  }
  const float sg = (sub & 4) ? 1.f : -1.f;
  const float cv[8] = {cs[0].x, cs[0].y, cs[0].z, cs[0].w, cs[1].x, cs[1].y, cs[1].z, cs[1].w};
  const float sv[8] = {sn[0].x, sn[0].y, sn[0].z, sn[0].w, sn[1].x, sn[1].y, sn[1].z, sn[1].w};
  float o[8];
#pragma unroll
  for (int j = 0; j < 8; ++j) { const float pr = __shfl_xor(v[j], 4); o[j] = (v[j] * cv[j] + sg * pr * sv[j]) * oscale; }
  u32x4 r; r.x = pk2(o[0], o[1]); r.y = pk2(o[2], o[3]); r.z = pk2(o[4], o[5]); r.w = pk2(o[6], o[7]);
  return r;
}
struct Tok0 { u32x4 cb, cc[3], ch[3]; };
DI void p1b_transform0(const Ctx& F, const Params& P) {
  bf16_t* PROJ = (bf16_t*)(P.ws + WS_PROJ); bf16_t* MIX = (bf16_t*)(P.ws + WS_MIX);
  const int lane = lane_id_v();
  float cw[8][3];
#pragma unroll
  for (int j = 0; j < 8; ++j) { const float* w = P.in[I_CONVW] + (8 * lane + j) * 3; cw[j][0] = w[0]; cw[j][1] = w[1]; cw[j][2] = w[2]; }
  auto load = [&](Tok0& T, int m) {
    const int t = m & (SEQ - 1); const bf16_t* row = PROJ + (size_t)m * W0P;
    T.cb = *(const u32x4*)(row + C_CB + 8 * lane);
#pragma unroll
    for (int d = 0; d < 3; ++d) { const int back = 2 - d; const bf16_t* r2 = row - (size_t)(t >= back ? back : 0) * W0P; T.cc[d] = *(const u32x4*)(r2 + C_CC + 8 * lane); T.ch[d] = *(const u32x4*)(r2 + C_CH + 8 * lane); }
  };
  auto process = [&](const Tok0& T, int m) {
    const int t = m & (SEQ - 1);
    { float u[3][8];
#pragma unroll
      for (int d = 0; d < 3; ++d) { const bool okd = t >= 2 - d; const u32x4 a = T.cc[d], b = T.ch[d];
        u[d][0] = okd ? bflo(a.x) * bflo(b.x) : 0.f; u[d][1] = okd ? bfhi(a.x) * bfhi(b.x) : 0.f; u[d][2] = okd ? bflo(a.y) * bflo(b.y) : 0.f; u[d][3] = okd ? bfhi(a.y) * bfhi(b.y) : 0.f;
        u[d][4] = okd ? bflo(a.z) * bflo(b.z) : 0.f; u[d][5] = okd ? bfhi(a.z) * bfhi(b.z) : 0.f; u[d][6] = okd ? bflo(a.w) * bflo(b.w) : 0.f; u[d][7] = okd ? bfhi(a.w) * bfhi(b.w) : 0.f; }
      const u32x4 cb = T.cb;
      const float cbv[8] = {bflo(cb.x), bfhi(cb.x), bflo(cb.y), bfhi(cb.y), bflo(cb.z), bfhi(cb.z), bflo(cb.w), bfhi(cb.w)};
      float o[8];
#pragma unroll
      for (int j = 0; j < 8; ++j) o[j] = cbv[j] * (u[0][j] * cw[j][0] + u[1][j] * cw[j][1] + u[2][j] * cw[j][2]);
      u32x4 r; r.x = pk2(o[0], o[1]); r.y = pk2(o[2], o[3]); r.z = pk2(o[4], o[5]); r.w = pk2(o[6], o[7]);
      *(u32x4*)(MIX + (size_t)m * DM + 8 * lane) = r; }
  };
  Tok0 A, B;
  int m = F.gw;
  if (m < NTOK) load(A, m);
  while (m < NTOK) {
    const int m1 = m + F.NGW;
    if (m1 < NTOK) load(B, m1);
    process(A, m);
    if (m1 >= NTOK) break;
    const int m2 = m1 + F.NGW;
    if (m2 < NTOK) load(A, m2);
    process(B, m1);
    m = m2;
  }
}

DI unsigned f2key(float f) { const unsigned b = __float_as_uint(f); return b ^ ((unsigned)((int)b >> 31) | 0x80000000u); }
DI s16x4 tr_read(LAS unsigned char* p) { typedef short v4i16_t __attribute__((ext_vector_type(4))); return __builtin_bit_cast(s16x4, __builtin_amdgcn_ds_read_tr16_b64_v4i16((LAS v4i16_t*)p)); }
#define DPP_U(v, ctrl) ((unsigned)__builtin_amdgcn_update_dpp(0, (int)(v), (ctrl), 0xF, 0xF, true))
DI unsigned wave_total_u(unsigned v) {
  v += DPP_U(v, 0xB1); v += DPP_U(v, 0x4E); v += DPP_U(v, 0x124); v += DPP_U(v, 0x128);
  return (unsigned)__builtin_amdgcn_readlane((int)v, 0) + (unsigned)__builtin_amdgcn_readlane((int)v, 16) + (unsigned)__builtin_amdgcn_readlane((int)v, 32) + (unsigned)__builtin_amdgcn_readlane((int)v, 48);
}
DI unsigned wave_maxall_u(unsigned v) {
  v = max(v, DPP_U(v, 0xB1)); v = max(v, DPP_U(v, 0x4E)); v = max(v, DPP_U(v, 0x124)); v = max(v, DPP_U(v, 0x128));
  const unsigned a = (unsigned)__builtin_amdgcn_readlane((int)v, 0), b = (unsigned)__builtin_amdgcn_readlane((int)v, 16), c = (unsigned)__builtin_amdgcn_readlane((int)v, 32), d = (unsigned)__builtin_amdgcn_readlane((int)v, 48);
  return max(max(a, b), max(c, d));
}
DI unsigned lane_prefix(unsigned long long m) { return __builtin_amdgcn_mbcnt_hi((unsigned)(m >> 32), __builtin_amdgcn_mbcnt_lo((unsigned)m, 0u)); }

DI void dsa_phase(const Ctx& F, const Params& P) {
  const bf16_t* PROJ = (const bf16_t*)(P.ws + WS_PROJ); bf16_t* MIX = (bf16_t*)(P.ws + WS_MIX);
  const bf16_t* IKF = (const bf16_t*)(P.ws + WS_IKF); const bf16_t* KF = (const bf16_t*)(P.ws + WS_KF); const bf16_t* VTF = (const bf16_t*)(P.ws + WS_VTF);
  LAS unsigned* sc = (LAS unsigned*)F.lds;
  LAS unsigned* msk32 = (LAS unsigned*)(F.lds + LDS_MISC);
  LAS float* trscr = (LAS float*)(F.lds + F.wave * 16384);
  int trk = 0;
  LAS float* part = (LAS float*)F.lds;
  const int w = F.wave;
  float cshift; { const int l0 = lane_id_v(); cshift = 8.f * wave_max(fabsf(P.in[I_QN0][l0])) * wave_max(fabsf(P.in[I_KN0][l0])) * 1.02f; }
  const float c1 = 0.125f * LOG2E, c2 = __builtin_amdgcn_readfirstlane(__float_as_int(cshift * LOG2E)) == 0 ? 0.f : __int_as_float(__builtin_amdgcn_readfirstlane(__float_as_int(cshift * LOG2E)));
#ifdef TIMEDSA
#ifndef TIMEBLK
#define TIMEBLK 0
#endif
  unsigned long long tacc = 0ull, tmark = 0ull;
#define DSA_T0(n) if (TIMEDSA == (n)) tmark = __builtin_amdgcn_s_memrealtime();
#define DSA_T1(n) if (TIMEDSA == (n)) tacc += __builtin_amdgcn_s_memrealtime() - tmark;
#else
#define DSA_T0(n)
#define DSA_T1(n)
#endif
  for (int v = blockIdx.x; v < 8192; v += gridDim.x) {
    const int cidx = v & 255, jj = v >> 8, b = jj >> 1, tb = (jj & 1) ? (511 - cidx) : cidx;
    const int t0 = tb * 8; const size_t rb = (size_t)b * SEQ;
    const int ntile = (t0 + 8 + 31) >> 5;
    const int lane = lane_id_v();
    const int c = lane & 31, half = lane >> 5, qc = c >> 2, hx = c & 3;
    DSA_T0(1)
    {
      bf16x8 af[4];
      { const bf16_t* ap = PROJ + (rb + t0 + qc) * W0P + C_IQ + hx * 64 + 8 * half;
#pragma unroll
        for (int ks = 0; ks < 4; ++ks) af[ks] = *(const bf16x8*)(ap + 16 * ks); }
      float wq[4][4];
#pragma unroll
      for (int g = 0; g < 4; ++g) { const u32x2 ww = *(const u32x2*)(PROJ + (rb + t0 + 2 * g + half) * W0P + C_IW);
        wq[g][0] = bflo(ww.x) * 0.0625f; wq[g][1] = bfhi(ww.x) * 0.0625f; wq[g][2] = bflo(ww.y) * 0.0625f; wq[g][3] = bfhi(ww.y) * 0.0625f; }
      const bf16_t* fb = IKF + ((size_t)b * 128 * 4 * 64 + lane) * 8;
      const int Tlast = ntile - 1;
      auto ld1 = [&](bf16x8 (&d)[4], int T) { const int Tc = T < Tlast ? T : Tlast;
#pragma unroll
        for (int ks = 0; ks < 4; ++ks) d[ks] = *(const bf16x8*)(fb + (size_t)(Tc * 4 + ks) * 512); };
      auto cp1 = [&](const bf16x8 (&bfr)[4], int T) {
        f32x16 acc;
#pragma unroll
        for (int i = 0; i < 16; ++i) acc[i] = 0.f;
#pragma unroll
        for (int ks = 0; ks < 4; ++ks) acc = __builtin_amdgcn_mfma_f32_32x32x16_bf16(af[ks], bfr[ks], acc, 0, 0, 0);
        const int s = 32 * T + c;
        const bool edge = 32 * T + 31 > t0;
#pragma unroll
        for (int g = 0; g < 4; ++g) {
          float sv = __builtin_fmaf(wq[g][3], fmaxf(acc[4 * g + 3], 0.f), __builtin_fmaf(wq[g][2], fmaxf(acc[4 * g + 2], 0.f), __builtin_fmaf(wq[g][1], fmaxf(acc[4 * g + 1], 0.f), __builtin_fmaf(wq[g][0], fmaxf(acc[4 * g], 0.f), 0.f))));
          const int ql = 2 * g + half;
          unsigned key = f2key(sv);
          if (edge) key = (s <= t0 + ql) ? key : 0u;
          sc[ql * 4096 + s] = key;
        } };
      bf16x8 r0[4], r1[4], r2[4], r3[4];
      if (w < ntile) { ld1(r0, w); ld1(r1, w + 8); ld1(r2, w + 16); ld1(r3, w + 24); }
      for (int T = w; T < ntile; T += 32) {
        cp1(r0, T); ld1(r0, T + 32); __builtin_amdgcn_sched_barrier(0);
        if (T + 8 < ntile) { cp1(r1, T + 8); ld1(r1, T + 40); __builtin_amdgcn_sched_barrier(0); }
        if (T + 16 < ntile) { cp1(r2, T + 16); ld1(r2, T + 48); __builtin_amdgcn_sched_barrier(0); }
        if (T + 24 < ntile) { cp1(r3, T + 24); ld1(r3, T + 56); __builtin_amdgcn_sched_barrier(0); }
      }
    }
    __syncthreads();
    asm volatile("" ::: "memory"); __builtin_amdgcn_sched_barrier(0);
    DSA_T1(1)
    DSA_T0(2)
    const int t = t0 + w;
    LAS unsigned* lst = (LAS unsigned*)(F.lds + LDS_LIST + w * 1024);
    int nvalid = 256;
    {
      const int lane = lane_id_v();
      if (t < 256) {
        nvalid = t + 1;
#pragma unroll
        for (int p = 0; p < 4; ++p) lst[p * 64 + lane] = (unsigned)(p * 64 + lane) << 7;
      } else {
        const int nch = (t >> 10) + 1;
        unsigned u[64];
#pragma unroll
        for (int ch = 0; ch < 4; ++ch) {
          if (ch < nch) {
#pragma unroll
            for (int k2 = 0; k2 < 16; ++k2) { const int j = 16 * ch + k2; const unsigned x = sc[w * 4096 + 64 * j + lane]; u[j] = (lane <= t - 64 * j) ? x : 0u; }
          } else {
#pragma unroll
            for (int k2 = 0; k2 < 16; ++k2) u[16 * ch + k2] = 0u;
          }
        }
        auto count_ge = [&](unsigned trial) -> unsigned { unsigned cnt = 0u;
#pragma unroll
          for (int ch = 0; ch < 4; ++ch) if (ch < nch) {
#pragma unroll
            for (int k2 = 0; k2 < 16; ++k2) cnt += (u[16 * ch + k2] >= trial) ? 1u : 0u;
          }
          return wave_total_u(cnt); };
        unsigned P, cnt = 0u, above = 0u;
        { unsigned mx = 0u;
#pragma unroll
          for (int ch = 0; ch < 4; ++ch) if (ch < nch) {
#pragma unroll
            for (int k2 = 0; k2 < 16; ++k2) mx = max(mx, u[16 * ch + k2]);
          }
          P = wave_maxall_u(mx) & 0xFF800000u; }
        bool found = false;
        for (int step = 0; step < 4; ++step) { cnt = count_ge(P); if (cnt >= 256u) { found = true; break; } above = cnt; P -= 0x00800000u; }
        if (!found) { unsigned p = 0u;
          for (int bit = 31; bit >= 23; --bit) { const unsigned tr = p | (1u << bit); if (count_ge(tr) >= 256u) p = tr; }
          P = p; cnt = count_ge(P); above = (P >= 0xFF800000u) ? 0u : count_ge(P + 0x00800000u); }
        bool exact = cnt == 256u;
        unsigned need = 256u - above;
        LAS unsigned* hist = (LAS unsigned*)(F.lds + LDS_HIST + w * 1280);
#define DSA_LEVEL(S) do { \
          *(LAS u32x4*)(hist + 4 * lane) = (u32x4){0u, 0u, 0u, 0u}; \
          asm volatile("" ::: "memory"); \
          const unsigned cap_ = 256u + (unsigned)lane; \
          _Pragma("unroll") for (int ch = 0; ch < 4; ++ch) if (ch < nch) { \
            _Pragma("unroll") for (int k2 = 0; k2 < 16; ++k2) { const unsigned y_ = min((u[16 * ch + k2] ^ P) >> (S), cap_); \
              __hip_atomic_fetch_add(hist + y_, 1u, __ATOMIC_RELAXED, __HIP_MEMORY_SCOPE_WORKGROUP); } } \
          asm volatile("s_waitcnt lgkmcnt(0)" ::: "memory"); \
          const u32x4 h_ = *(LAS u32x4*)(hist + 4 * lane); \
          const unsigned T_ = h_.x + h_.y + h_.z + h_.w; unsigned incl_ = T_; \
          _Pragma("unroll") for (int d_ = 1; d_ < 64; d_ *= 2) { const unsigned v_ = (unsigned)__shfl_down((int)incl_, d_, 64); incl_ += (lane + d_ < 64) ? v_ : 0u; } \
          const unsigned excl_ = incl_ - T_;                        \
          const bool hit_ = incl_ >= need && excl_ < need;          \
          unsigned c_ = excl_, b_ = 3u, hb_ = h_.w; \
          if (c_ + h_.w < need) { c_ += h_.w; b_ = 2u; hb_ = h_.z; if (c_ + h_.z < need) { c_ += h_.z; b_ = 1u; hb_ = h_.y; if (c_ + h_.y < need) { c_ += h_.y; b_ = 0u; hb_ = h_.x; } } } \
          const unsigned long long hm_ = __ballot(hit_); const int src_ = hm_ ? __builtin_ctzll(hm_) : 0; \
          const unsigned bin_ = (unsigned)__builtin_amdgcn_readlane((int)(4u * (unsigned)lane + b_), src_), ab_ = (unsigned)__builtin_amdgcn_readlane((int)c_, src_), hbb_ = (unsigned)__builtin_amdgcn_readlane((int)hb_, src_); \
          need -= ab_; P |= bin_ << (S); exact = hbb_ == need; } while (0)
        if (!exact) { DSA_LEVEL(15); if (!exact) { DSA_LEVEL(7); if (!exact) DSA_LEVEL(0); } }
        const unsigned thr = exact ? P - 1u : P;
        int base = 0;
#pragma unroll
        for (int ch = 0; ch < 4; ++ch) if (ch < nch) {
#pragma unroll
          for (int k2 = 0; k2 < 16; ++k2) { const int j = 16 * ch + k2; const bool sel = u[j] > thr; const unsigned long long m = __ballot(sel);
            if (sel) lst[base + (int)lane_prefix(m)] = (unsigned)(64 * j + lane) << 7;
            base += __builtin_popcountll(m); }
        }
        if (!exact) { const int need = 256 - base; int tbf = 0;
#pragma unroll
          for (int ch = 0; ch < 4; ++ch) if (ch < nch) {
#pragma unroll
            for (int k2 = 0; k2 < 16; ++k2) { const int j = 16 * ch + k2; const bool eq = u[j] == thr; const unsigned long long m = __ballot(eq); const int r = tbf + (int)lane_prefix(m);
              if (eq && r < need) lst[base + r] = (unsigned)(64 * j + lane) << 7;
              tbf += __builtin_popcountll(m); }
          } }
      }
    }
    asm volatile("" ::: "memory"); __builtin_amdgcn_sched_barrier(0);
    DSA_T1(2)
    DSA_T0(3)
    {
      DSA_T0(4)
      const int lane = lane_id_v(); const int hcol = lane & 15, g = lane >> 4;
      const unsigned char* KRb = P.ws + WS_KF + rb * 128; const unsigned char* VRb = P.ws + WS_VTF + rb * 128;
      LAS unsigned char* ring = F.lds + w * 16384;
      const int rl = lane >> 3;
      const unsigned pk0 = (unsigned)((lane & 7) ^ rl) << 4, pv0 = (unsigned)(lane & 7) << 4;
#define DSA_ISSUE(c) do { _Pragma("unroll") for (int i_ = 0; i_ < 4; ++i_) { const unsigned off_ = lst[32 * ((c) & 7) + 8 * i_ + rl]; \
        const unsigned char* src_ = ((c) < 8 ? KRb + (pk0 ^ (unsigned)(i_ << 4)) : VRb + pv0) + off_; \
        __builtin_amdgcn_global_load_lds((const unsigned*)src_, (LAS unsigned*)(ring + ((c) & 3) * 4096 + i_ * 1024), 16, 0, 0); } } while (0)
#define DSA_WAITV(n) asm volatile("s_waitcnt vmcnt(" #n ")" ::: "memory")
      bf16x8 qf[2];
      { const bf16_t* qp = PROJ + (rb + t) * W0P + C_Q + (hcol & 7) * 64 + 8 * g; const float qs = hcol < 8 ? 0.125f * LOG2E : 0.f;
#pragma unroll
        for (int ks = 0; ks < 2; ++ks) { const u32x4 qv = *(const u32x4*)(qp + 32 * ks);
          u32x4 qo; qo.x = pk2(bflo(qv.x) * qs, bfhi(qv.x) * qs); qo.y = pk2(bflo(qv.y) * qs, bfhi(qv.y) * qs); qo.z = pk2(bflo(qv.z) * qs, bfhi(qv.z) * qs); qo.w = pk2(bflo(qv.w) * qs, bfhi(qv.w) * qs);
          qf[ks] = __builtin_bit_cast(bf16x8, qo); } }
      asm volatile("s_waitcnt vmcnt(0)" ::: "memory");
      DSA_ISSUE(0); DSA_ISSUE(1); DSA_ISSUE(2); DSA_ISSUE(3);
      const unsigned ka0 = (unsigned)(hcol * 128 + ((g ^ ((hcol & 7) ^ (hcol >> 3))) << 4));
      bf16x8 pf[8];
      const bool full = nvalid == 256;
#define DSA_KSTEP(c, nwait) do { DSA_WAITV(nwait); \
        LAS unsigned char* kb_ = ring + ((c) & 3) * 4096; \
        const bf16x8 k00 = *(const LAS bf16x8*)(kb_ + ka0), k01 = *(const LAS bf16x8*)(kb_ + (ka0 ^ 64u)), k10 = *(const LAS bf16x8*)(kb_ + 2048 + (ka0 ^ 32u)), k11 = *(const LAS bf16x8*)(kb_ + 2048 + (ka0 ^ 96u)); \
        asm volatile("s_waitcnt lgkmcnt(0)" ::: "memory"); \
        DSA_ISSUE((c) + 4); \
        f32x4 a0_ = {-c2, -c2, -c2, -c2}, a1_ = {-c2, -c2, -c2, -c2}; \
        a0_ = __builtin_amdgcn_mfma_f32_16x16x32_bf16(k00, qf[0], a0_, 0, 0, 0); a1_ = __builtin_amdgcn_mfma_f32_16x16x32_bf16(k10, qf[0], a1_, 0, 0, 0); \
        a0_ = __builtin_amdgcn_mfma_f32_16x16x32_bf16(k01, qf[1], a0_, 0, 0, 0); a1_ = __builtin_amdgcn_mfma_f32_16x16x32_bf16(k11, qf[1], a1_, 0, 0, 0); \
        _Pragma("unroll") for (int r_ = 0; r_ < 4; ++r_) { \
          const float e0_ = __builtin_amdgcn_exp2f(a0_[r_]), e1_ = __builtin_amdgcn_exp2f(a1_[r_]); \
          a0_[r_] = (full || 32 * (c) + 4 * g + r_ < nvalid) ? e0_ : 0.f; a1_[r_] = (full || 32 * (c) + 16 + 4 * g + r_ < nvalid) ? e1_ : 0.f; } \
        u32x4 pw_; pw_.x = pk2(a0_[0], a0_[1]); pw_.y = pk2(a0_[2], a0_[3]); pw_.z = pk2(a1_[0], a1_[1]); pw_.w = pk2(a1_[2], a1_[3]); pf[c] = __builtin_bit_cast(bf16x8, pw_); \
        __builtin_amdgcn_sched_barrier(0); } while (0)
      DSA_KSTEP(0, 12); DSA_KSTEP(1, 12); DSA_KSTEP(2, 12); DSA_KSTEP(3, 12); DSA_KSTEP(4, 12); DSA_KSTEP(5, 12); DSA_KSTEP(6, 12); DSA_KSTEP(7, 12);
      f32x4 o[4], ol = {0.f, 0.f, 0.f, 0.f};
#pragma unroll
      for (int n = 0; n < 4; ++n) o[n] = (f32x4){0.f, 0.f, 0.f, 0.f};
      const bf16x8 ones8 = (bf16x8){0x3f80, 0x3f80, 0x3f80, 0x3f80, 0x3f80, 0x3f80, 0x3f80, 0x3f80};
      const int q4 = (lane & 15) >> 2, p4 = lane & 3;
      const unsigned va0 = (unsigned)((4 * g + q4) * 128 + 8 * p4);
#define DSA_VSTEP(c, nwait) do { DSA_WAITV(nwait); \
        LAS unsigned char* vb_ = ring + ((c) & 3) * 4096 + va0; \
        ol = __builtin_amdgcn_mfma_f32_16x16x32_bf16(ones8, pf[c], ol, 0, 0, 0); \
        _Pragma("unroll") for (int n = 0; n < 4; ++n) { \
          const s16x4 lo_ = tr_read(vb_ + 32 * n), hi_ = tr_read(vb_ + 2048 + 32 * n); \
          const bf16x8 vf_ = __builtin_shufflevector(lo_, hi_, 0, 1, 2, 3, 4, 5, 6, 7); \
          o[n] = __builtin_amdgcn_mfma_f32_16x16x32_bf16(vf_, pf[c], o[n], 0, 0, 0); } \
        if ((c) < 4) { asm volatile("s_waitcnt lgkmcnt(0)" ::: "memory"); DSA_ISSUE(12 + (c)); } \
        __builtin_amdgcn_sched_barrier(0); } while (0)
      DSA_VSTEP(0, 12); DSA_VSTEP(1, 12); DSA_VSTEP(2, 12); DSA_VSTEP(3, 12); DSA_VSTEP(4, 12); DSA_VSTEP(5, 8); DSA_VSTEP(6, 4); DSA_VSTEP(7, 0);
      if (hcol < 8) { const float inv = 1.0f / ol[0]; bf16_t* op = MIX + (rb + t) * DM + 512 + hcol * 64 + 4 * g;
#pragma unroll
        for (int n = 0; n < 4; ++n) { u32x2 w2; w2.x = pk2(o[n][0] * inv, o[n][1] * inv); w2.y = pk2(o[n][2] * inv, o[n][3] * inv); *(u32x2*)(op + 16 * n) = w2; } }
    }
    DSA_T1(4)
    DSA_T0(5)
    {
      const int tit = TR_EARLY + F.gw + trk * F.NGW;
      if (tit < TR_TOTAL) { const int tl = lane_id_v(); const TrDesc td = tr_desc(P, tit); f32x4 tr8[8]; tr_load(td, tl, tr8); tr_finish(td, tl, tr8, trscr); }
      ++trk;
    }
    DSA_T1(5)
    DSA_T0(6)
    __syncthreads();
    DSA_T1(6)
    DSA_T1(3)
  }
  for (;; ++trk) { const int tit = TR_EARLY + F.gw + trk * F.NGW; if (tit >= TR_TOTAL) break; const int tl = lane_id_v(); const TrDesc td = tr_desc(P, tit); f32x4 tr8[8]; tr_load(td, tl, tr8); tr_finish(td, tl, tr8, trscr); }
#ifdef TIMEDSA
  if (blockIdx.x == TIMEBLK && w == 0 && lane_id_v() == 0) { unsigned long long* tsw = (unsigned long long*)(P.ws + WS_CTL + 4096); tsw[0] = 0ull; tsw[1] = tacc; }
#endif
}

DI void route_lane(const float (&lg)[36], int& x0, int& x1, float& g0, float& g1) {
  int gs = 0; float gm = lg[0];
#pragma unroll
  for (int j = 1; j < 4; ++j) { const bool gt = lg[j] > gm; gm = gt ? lg[j] : gm; gs = gt ? j : gs; }
  float z = 0.f;
#pragma unroll
  for (int j = 0; j < 4; ++j) z += __expf(lg[j] - gm);
  const float pg = 1.0f / z;
  float le[8];
#pragma unroll
  for (int i = 0; i < 8; ++i) le[i] = gs == 0 ? lg[4 + i] : (gs == 1 ? lg[12 + i] : (gs == 2 ? lg[20 + i] : lg[28 + i]));
  int i0e = 0; float m0 = le[0];
#pragma unroll
  for (int i = 1; i < 8; ++i) { const bool gt = le[i] > m0; m0 = gt ? le[i] : m0; i0e = gt ? i : i0e; }
  int i1e = -1; float m1 = -INFINITY;
#pragma unroll
  for (int i = 0; i < 8; ++i) { const bool gt = (i != i0e) && (le[i] > m1); m1 = gt ? le[i] : m1; i1e = gt ? i : i1e; }
  const float e1 = __expf(m1 - m0);
  g0 = pg / (1.0f + e1); g1 = pg * e1 / (1.0f + e1);
  x0 = gs * 8 + i0e; x1 = gs * 8 + i1e;
}
DI void router_phase(const Ctx& F, const Params& P, int L) {
  unsigned char* ws = P.ws;
  constexpr int WSTR = 2064;
  constexpr int L_WH = 0, L_WL = 36 * WSTR, L_ZERO = 2 * 36 * WSTR, L_CNT = L_ZERO + WSTR, L_ASG = L_CNT + 256, L_RS = L_ASG + 4096;
  static_assert(L_ASG + 4096 <= LDS_BYTES - 16, "router LDS map");
  LAS unsigned char* lds = F.lds;
  LAS int* lcnt = (LAS int*)(lds + L_CNT); LAS int* lbase = lcnt + 32;
  LAS i32x4* lasg = (LAS i32x4*)(lds + L_ASG);
  const bf16_t* wsrc = (const bf16_t*)(ws + (L ? WS_WR1 : WS_WR0));
  const float* bias = (const float*)(ws + (L ? WS_WR1 : WS_WR0) + 147456);
  const int lane = lane_id_v(); const int w = F.wave; const int tid = w * 64 + lane;
  int* cnt = (int*)(ws + WS_CTL) + L * 64; int* list = (int*)(ws + WS_LIST); float* RSL = (float*)(ws + WS_RSL);
  int4* asg = (int4*)(ws + WS_ASG); float2* asgg = (float2*)(ws + WS_ASGG);
  const bf16_t* XB = (const bf16_t*)(ws + WS_XB);
  const int niter = (NTOK + F.NGW - 1) / F.NGW;
  for (int i0 = 0; i0 < niter; i0 += 32) {
    for (int i = tid; i < 2 * 36 * 128; i += 512) { const int row = i >> 7, ch = i & 127; *(LAS u32x4*)(lds + row * WSTR + ch * 16) = *(const u32x4*)(wsrc + row * 1024 + ch * 8); }
    for (int i = tid; i < 128; i += 512) *(LAS u32x4*)(lds + L_ZERO + i * 16) = (u32x4){0u, 0u, 0u, 0u};
    if (tid < 32) lcnt[tid] = 0;
    __syncthreads();
    const int c = lane & 31, half = lane >> 5;
    const int it_r = i0 + c; const int m_r = F.gw + it_r * F.NGW; const bool ok_r = (it_r < niter) && (m_r < NTOK);
    const bf16_t* arow = XB + (size_t)(ok_r ? m_r : F.gw) * DM + 8 * half;
    const int b0off = c * WSTR + 16 * half;
    const int b1off = (c < 4 ? (32 + c) * WSTR : (L_ZERO - L_WH)) + 16 * half;
    f32x16 d0, d1, dx;
#pragma unroll
    for (int i = 0; i < 16; ++i) { d0[i] = 0.f; d1[i] = 0.f; dx[i] = 0.f; }
    bf16x8 ar[8];
#pragma unroll
    for (int j = 0; j < 8; ++j) ar[j] = *(const bf16x8*)(arow + 16 * j);
    for (int k8 = 0; k8 < 64; k8 += 8) {
#pragma unroll
      for (int j = 0; j < 8; ++j) {
        const int ks = k8 + j;
        const bf16x8 a_cur = ar[j];
        const bf16x8 h0 = *(const LAS bf16x8*)(lds + L_WH + b0off + 32 * ks), l0 = *(const LAS bf16x8*)(lds + L_WL + b0off + 32 * ks);
        const bf16x8 h1 = *(const LAS bf16x8*)(lds + L_WH + b1off + 32 * ks), l1 = *(const LAS bf16x8*)(lds + (c < 4 ? L_WL : L_WH) + b1off + 32 * ks);
        d0 = __builtin_amdgcn_mfma_f32_32x32x16_bf16(a_cur, h0, d0, 0, 0, 0); d0 = __builtin_amdgcn_mfma_f32_32x32x16_bf16(a_cur, l0, d0, 0, 0, 0);
        d1 = __builtin_amdgcn_mfma_f32_32x32x16_bf16(a_cur, h1, d1, 0, 0, 0); d1 = __builtin_amdgcn_mfma_f32_32x32x16_bf16(a_cur, l1, d1, 0, 0, 0);
        dx = __builtin_amdgcn_mfma_f32_32x32x16_bf16(a_cur, a_cur, dx, 0, 0, 0);
        if (k8 + 8 < 64) ar[j] = *(const bf16x8*)(arow + 16 * (ks + 8));
      }
    }
    __syncthreads();
    LAS float* tw = (LAS float*)(lds + w * 8192);
#pragma unroll
    for (int i = 0; i < 16; ++i) { const int row = (i & 3) + 8 * (i >> 2) + 4 * half; tw[row * 40 + c] = d0[i]; if (c < 4) tw[row * 40 + 32 + c] = d1[i]; if (row == c) tw[row * 40 + 36] = dx[i]; }
    asm volatile("s_waitcnt lgkmcnt(0)" ::: "memory");
    if (lane < 32) {
      const int it_t = i0 + lane; const int m = F.gw + it_t * F.NGW;
      if (it_t < niter && m < NTOK) {
        const LAS f32x4* tr4 = (const LAS f32x4*)(tw + lane * 40);
        float raw[40];
#pragma unroll
        for (int q = 0; q < 10; ++q) { const f32x4 v4 = tr4[q]; raw[4 * q] = v4.x; raw[4 * q + 1] = v4.y; raw[4 * q + 2] = v4.z; raw[4 * q + 3] = v4.w; }
        const float rstd = 1.0f / sqrtf(raw[36] * (1.f / DM) + NORM_EPS);
        float lg[36];
#pragma unroll
        for (int j = 0; j < 36; ++j) lg[j] = raw[j] * rstd + bias[j];
        int x0, x1; float g0, g1; route_lane(lg, x0, x1, g0, g1);
        const int r0 = __hip_atomic_fetch_add(lcnt + x0, 1, __ATOMIC_RELAXED, __HIP_MEMORY_SCOPE_WORKGROUP);
        const int r1 = __hip_atomic_fetch_add(lcnt + x1, 1, __ATOMIC_RELAXED, __HIP_MEMORY_SCOPE_WORKGROUP);
        lasg[lane * 8 + w] = (i32x4){x0, x1, r0, r1}; asgg[m] = make_float2(g0, g1);
        tw[lane * 40 + 37] = rstd;
      }
    }
    __syncthreads();
    if (tid < 32) lbase[tid] = atomicAdd(cnt + tid, lcnt[tid]);
    __syncthreads();
    if (tid < 256) {
      const int ii = tid >> 3, wv = tid & 7; const int m = (int)blockIdx.x * 8 + wv + (i0 + ii) * F.NGW;
      if (i0 + ii < niter && m < NTOK) {
        const i32x4 a = lasg[tid]; const int r0 = lbase[a.x] + a.z, r1 = lbase[a.y] + a.w;
        const float rs = ((const LAS float*)(lds + wv * 8192))[ii * 40 + 37];
        list[a.x * 65536 + r0] = m; list[a.y * 65536 + r1] = m; asg[m] = make_int4(a.x, a.y, r0, r1);
        RSL[a.x * 65536 + r0] = rs; RSL[a.y * 65536 + r1] = rs;
      }
    }
    __syncthreads();
  }
}
DI void moe_setup(const Ctx& F, const Params& P, int L) {
  LAS int* pb = (LAS int*)(F.lds + LDS_MISC); LAS int* cl = pb + 64;
  const int* cnt = (const int*)(P.ws + WS_CTL) + L * 64;
  const int tid = F.wave * 64 + lane_id_v();
  __syncthreads();
  if (tid < 32) cl[tid] = cnt[tid];
  __syncthreads();
  if (tid == 0) { int a = 0; for (int e = 0; e < NEXP; ++e) { pb[e] = a; a += (cl[e] + 255) >> 8; } pb[NEXP] = a; }
  __syncthreads();
}
struct CRows { u32x2 x[4], y0[4], y1[4]; };
DI void combine_phase(const Ctx& F, const Params& P, int L, bool with_norm) {
  unsigned char* ws = P.ws;
  moe_setup(F, P, L);
  const LAS int* pb = (const LAS int*)(F.lds + LDS_MISC);
  const int4* asg = (const int4*)(ws + WS_ASG); const float2* asgg = (const float2*)(ws + WS_ASGG);
  const bf16_t* Y = (const bf16_t*)(ws + WS_PROJ); bf16_t* XN = (bf16_t*)(ws + WS_XN); bf16_t* XB = (bf16_t*)(ws + WS_XB);
  const int lane = lane_id_v();
  auto rows = [&](CRows& R, int m, const int4 a) {
    const size_t row0 = (size_t)pb[a.x] * 256 + a.z, row1 = (size_t)pb[a.y] * 256 + a.w;
    const u32x2* xr = (const u32x2*)(XB + (size_t)m * DM) + lane; const u32x2* y0 = (const u32x2*)(Y + row0 * DM) + lane; const u32x2* y1 = (const u32x2*)(Y + row1 * DM) + lane;
#pragma unroll
    for (int j = 0; j < 4; ++j) { R.x[j] = xr[64 * j]; R.y0[j] = y0[64 * j]; R.y1[j] = y1[64 * j]; } };
  auto finish = [&](const CRows& R, int m, const float2 gg) {
    u32x2* xr = (u32x2*)(XB + (size_t)m * DM) + lane; f32x4* orow = (f32x4*)(P.out + (size_t)m * DM) + lane;
    f32x4 v[4]; float ss = 0.f;
#pragma unroll
    for (int j = 0; j < 4; ++j) { const u32x2 xb = R.x[j], a0 = R.y0[j], a1 = R.y1[j]; f32x4 x = (f32x4){bflo(xb.x), bfhi(xb.x), bflo(xb.y), bfhi(xb.y)};
      x.x += gg.x * bflo(a0.x) + gg.y * bflo(a1.x); x.y += gg.x * bfhi(a0.x) + gg.y * bfhi(a1.x); x.z += gg.x * bflo(a0.y) + gg.y * bflo(a1.y); x.w += gg.x * bfhi(a0.y) + gg.y * bfhi(a1.y);
      if (with_norm) { u32x2 o; o.x = pk2(x.x, x.y); o.y = pk2(x.z, x.w); xr[64 * j] = o; } else orow[64 * j] = x;
      v[j] = x; ss += (x.x * x.x + x.y * x.y) + (x.z * x.z + x.w * x.w); }
    if (with_norm) {
      const float rstd = 1.0f / sqrtf(wave_sum(ss) * (1.f / DM) + NORM_EPS);
      unsigned long long* o8 = (unsigned long long*)(XN + (size_t)m * DM) + lane;
#pragma unroll
      for (int j = 0; j < 4; ++j) o8[64 * j] = (unsigned long long)pk2(v[j].x * rstd, v[j].y * rstd) | ((unsigned long long)pk2(v[j].z * rstd, v[j].w * rstd) << 32);
    } };
  const int n = (NTOK - F.gw + F.NGW - 1) / F.NGW;
  if (n <= 0) return;
  CRows RA, RB;
  int4 a0 = asg[F.gw]; float2 g0 = asgg[F.gw];
  int4 a1 = a0; float2 g1 = g0; if (n > 1) { a1 = asg[F.gw + F.NGW]; g1 = asgg[F.gw + F.NGW]; }
  rows(RA, F.gw, a0);
  for (int i = 0; i < n; i += 2) {
    const int m0 = F.gw + i * F.NGW, m1 = m0 + F.NGW, m2 = m1 + F.NGW, m3 = m2 + F.NGW;
    int4 a2 = a0; float2 g2 = g0; if (i + 2 < n) { a2 = asg[m2]; g2 = asgg[m2]; }
    if (i + 1 < n) rows(RB, m1, a1);
    finish(RA, m0, g0);
    if (i + 1 >= n) break;
    int4 a3 = a0; float2 g3 = g0; if (i + 3 < n) { a3 = asg[m3]; g3 = asgg[m3]; }
    if (i + 2 < n) rows(RA, m2, a2);
    finish(RB, m1, g1);
    a0 = a2; g0 = g2; a1 = a3; g1 = g3;
  }
}
template <class Bar> DI void moe_gemms(const Ctx& F, const Params& P, int L, const Bar& gbar) {
  unsigned char* ws = P.ws;
  const int vcu = (F.G % 8 == 0) ? ((int)(blockIdx.x % 8) * (F.G / 8) + (int)(blockIdx.x / 8)) : (int)blockIdx.x;
  moe_setup(F, P, L);
  {
    pg8::MoeSched<true> S{(const LAS int*)(F.lds + LDS_MISC), (const LAS int*)(F.lds + LDS_MISC) + 64, (const int*)(ws + WS_LIST), (const char*)(ws + (L ? WS_WGU1 : WS_WGU0)), F.G, vcu, 1024};
    pg8::EpiSwiGLU E{(bf16_t*)(ws + WS_H), (const float*)(ws + WS_RSL), (const LAS int*)(F.lds + LDS_MISC) + 64};
    pg8::gemm_phase<pg8::EpiSwiGLU, pg8::MoeSched<true>, true>(F.lds, F.wave, (const char*)(ws + WS_XB), 1024, S, E);
  }
  xcd_barrier(gbar);
  {
    pg8::MoeSched<false> S{(const LAS int*)(F.lds + LDS_MISC), (const LAS int*)(F.lds + LDS_MISC) + 64, nullptr, (const char*)(ws + (L ? WS_WD1 : WS_WD0)), F.G, vcu, 512};
    pg8::EpiBf16 E{(bf16_t*)(ws + WS_PROJ), DM};
    pg8::gemm_phase<pg8::EpiBf16, pg8::MoeSched<false>, true>(F.lds, F.wave, (const char*)(ws + WS_H), 512, S, E);
  }
}

struct Tok1 { u32x4 q0, q1, k; f32x4 cs[2], sn[2]; };
DI void p8b_transform1(const Ctx& F, const Params& P) {
  bf16_t* QKV = (bf16_t*)(P.ws + WS_PROJ);
  const float* cosT = (const float*)(P.ws + WS_ROPE); const float* sinT = cosT + SEQ * 32;
  const int lane = lane_id_v(), sub = lane & 7, grp = lane >> 3;
  float gq[8], gk[8];
#pragma unroll
  for (int j = 0; j < 8; ++j) { gq[j] = P.in[I_QN1][8 * sub + j]; gk[j] = P.in[I_KN1][8 * sub + j]; }
  const int kcol = 1024 + (grp & 3) * 64 + sub * 8;
  auto load = [&](Tok1& T, int m) {
    const int t = m & (SEQ - 1); const bf16_t* row = QKV + (size_t)m * W1;
    T.q0 = *(const u32x4*)(row + grp * 64 + sub * 8); T.q1 = *(const u32x4*)(row + 512 + grp * 64 + sub * 8); T.k = *(const u32x4*)(row + kcol);
    const f32x4* cp = (const f32x4*)(cosT + t * 32 + 8 * (sub & 3)); const f32x4* sp = (const f32x4*)(sinT + t * 32 + 8 * (sub & 3));
    T.cs[0] = cp[0]; T.cs[1] = cp[1]; T.sn[0] = sp[0]; T.sn[1] = sp[1];
  };
  auto process = [&](const Tok1& T, int m) {
    bf16_t* row = QKV + (size_t)m * W1;
    *(u32x4*)(row + grp * 64 + sub * 8) = normrope8(T.q0, gq, true, T.cs, T.sn, sub, 0.125f * LOG2E);
    *(u32x4*)(row + 512 + grp * 64 + sub * 8) = normrope8(T.q1, gq, true, T.cs, T.sn, sub, 0.125f * LOG2E);
    const u32x4 r = normrope8(T.k, gk, true, T.cs, T.sn, sub, 1.f);
    if (grp < 4) *(u32x4*)(row + kcol) = r;
  };
  Tok1 A, B;
  int m = F.gw;
  if (m < NTOK) load(A, m);
  while (m < NTOK) {
    const int m1 = m + F.NGW;
    if (m1 < NTOK) load(B, m1);
    process(A, m);
    if (m1 >= NTOK) break;
    const int m2 = m1 + F.NGW;
    if (m2 < NTOK) load(A, m2);
    process(B, m1);
    m = m2;
  }
}

DI void dil_phase(const Ctx& F, const Params& P) {
  const bf16_t* QKV = (const bf16_t*)(P.ws + WS_PROJ); bf16_t* MIX = (bf16_t*)(P.ws + WS_MIX);
  LAS unsigned char* kst = F.lds + F.wave * 8192;
  LAS unsigned char* vst = kst + 4096;
  float cshift; { const int l0 = lane_id_v(); cshift = 8.f * wave_max(fabsf(P.in[I_QN1][l0])) * wave_max(fabsf(P.in[I_KN1][l0])) * 1.02f; }
  const float c2 = cshift * LOG2E;
  const int gwv = ((F.G % 8 == 0) ? ((int)(blockIdx.x % 8) * (F.G / 8) + (int)(blockIdx.x / 8)) : (int)blockIdx.x) * 8 + F.wave;
  const int lane = lane_id_v(), c = lane & 31, half = lane >> 5, qi = c >> 2, gq = c & 3;
  const int q4 = (lane & 15) >> 2, p4 = lane & 3, blk = (lane >> 4) & 1;
  const int lrow = lane >> 3, lch = lane & 7;
  const int woff = lrow * 128 + ((lch ^ (lrow & 7)) << 4);
  const int kra = c * 128 + ((half ^ (c & 7)) << 4);
  const int r1 = 4 * half + q4;
  const int tra0 = r1 * 128 + (((2 * blk + (p4 >> 1)) ^ (r1 & 7)) << 4) + (p4 & 1) * 8;
  for (int it = gwv; it < 32768; it += F.NGW) {
    const int r = it & 15, tile = (it >> 4) & 31, kh = (it >> 9) & 3, b = it >> 11;
    const size_t rb = (size_t)b * SEQ; const int tmax = tile * 128 + r + 112, tq = tile * 128 + r + 16 * qi;
    bf16x8 qf[4];
    { const bf16_t* qp = QKV + (rb + tq) * W1 + (4 * kh + gq) * 64 + 8 * half;
#pragma unroll
      for (int ks = 0; ks < 4; ++ks) qf[ks] = *(const bf16x8*)(qp + 16 * ks); }
    f32x16 o0, o1;
#pragma unroll
    for (int i = 0; i < 16; ++i) { o0[i] = 0.f; o1[i] = 0.f; }
    float lsum = 0.f;
    const char* sbase = (const char*)(QKV + rb * W1 + 1024 + kh * 64) ;
    constexpr int RP = W1 * 2;
    u32x4 gk[4], gv[4];
    auto issue = [&](int ti) { const int sh = ti < 8 ? 0 : (ti < 13 ? 2 : 4), T = ti < 8 ? ti : (ti < 13 ? ti - 8 : ti - 13);
      const int v0 = (tmax - ((32 * T + lrow) << sh)) * RP + lch * 16; const int dv = (8 << sh) * RP;
#pragma unroll
      for (int i = 0; i < 4; ++i) { int vo = v0 - i * dv; vo = vo < lch * 16 ? lch * 16 : vo;
        const char* rp = sbase + (unsigned)vo; gk[i] = *(const u32x4*)rp; gv[i] = *(const u32x4*)(rp + 512); } };
    issue(0);
#pragma unroll 1
    for (int ti = 0; ti < 18; ++ti) {
      const int sh = ti < 8 ? 0 : (ti < 13 ? 2 : 4), T = ti < 8 ? ti : (ti < 13 ? ti - 8 : ti - 13);
#pragma unroll
      for (int i = 0; i < 4; ++i) { *(LAS u32x4*)(kst + woff + i * 1024) = gk[i]; *(LAS u32x4*)(vst + woff + i * 1024) = gv[i]; }
      if (ti + 1 < 18) issue(ti + 1);
      asm volatile("" ::: "memory");
      f32x16 s;
#pragma unroll
      for (int i = 0; i < 16; ++i) s[i] = -c2;
#pragma unroll
      for (int ks = 0; ks < 4; ++ks) { const bf16x8 kf = *(const LAS bf16x8*)(kst + (kra ^ (ks << 5))); s = __builtin_amdgcn_mfma_f32_32x32x16_bf16(kf, qf[ks], s, 0, 0, 0); }
      unsigned m32;
      { const int ei = (16 >> sh) * (7 - qi); const int nmax = tmax >> sh; const int hn = (ei + 128 < nmax) ? ei + 128 : nmax;
        const int lo = ei - 32 * T - 4 * half, hi = hn - 32 * T - 4 * half;
        const int loc = lo < 0 ? 0 : lo, hic = hi > 31 ? 31 : hi;
        m32 = (loc <= hic) ? ((0xFFFFFFFFu >> (31 - hic)) & (0xFFFFFFFFu << loc)) : 0u; }
#pragma unroll
      for (int reg = 0; reg < 16; ++reg) { const int mb = __builtin_amdgcn_sbfe((int)m32, (reg & 3) + 8 * (reg >> 2), 1);
        const float p = __int_as_float(__float_as_int(__builtin_amdgcn_exp2f(s[reg])) & mb); s[reg] = p; lsum += p; }
#pragma unroll
      for (int st = 0; st < 2; ++st) {
        u32x4 pw; pw.x = pk2(s[8 * st], s[8 * st + 1]); pw.y = pk2(s[8 * st + 2], s[8 * st + 3]); pw.z = pk2(s[8 * st + 4], s[8 * st + 5]); pw.w = pk2(s[8 * st + 6], s[8 * st + 7]);
        const bf16x8 pf = __builtin_bit_cast(bf16x8, pw);
#pragma unroll
        for (int dblk = 0; dblk < 2; ++dblk) {
          const int ta = (tra0 ^ (dblk << 6)) + st * 2048;
          const s16x4 lo4 = tr_read(vst + ta), hi4 = tr_read(vst + ta + 1024);
          const bf16x8 vf = __builtin_shufflevector(lo4, hi4, 0, 1, 2, 3, 4, 5, 6, 7);
          if (dblk == 0) o0 = __builtin_amdgcn_mfma_f32_32x32x16_bf16(vf, pf, o0, 0, 0, 0); else o1 = __builtin_amdgcn_mfma_f32_32x32x16_bf16(vf, pf, o1, 0, 0, 0);
        }
      }
      asm volatile("" ::: "memory");
    }
    lsum += __shfl_xor(lsum, 32);
    const float inv = 1.0f / lsum;
    bf16_t* op = MIX + (rb + tq) * DM + (4 * kh + gq) * 64 + 4 * half;
#pragma unroll
    for (int gI = 0; gI < 4; ++gI) {
      u32x2 w0; w0.x = pk2(o0[4 * gI] * inv, o0[4 * gI + 1] * inv); w0.y = pk2(o0[4 * gI + 2] * inv, o0[4 * gI + 3] * inv); *(u32x2*)(op + 8 * gI) = w0;
      u32x2 w1; w1.x = pk2(o1[4 * gI] * inv, o1[4 * gI + 1] * inv); w1.y = pk2(o1[4 * gI + 2] * inv, o1[4 * gI + 3] * inv); *(u32x2*)(op + 32 + 8 * gI) = w1;
    }
  }
}

#define XB_TMO      128
#define XB_XCNT(j)  (256  + 64 * (j))
#define XB_XSUB(j)  (1280 + 64 * (j))
#define XB_XGEN(j)  (2304 + 64 * (j))
#define XB_TOP      3328
#define XB_TOPGEN   3392
#define XCD_BAR_WORDS 3456
#define XB_SPIN_CAP (1u << 18)

__device__ __forceinline__ unsigned xb_ld(unsigned* p)              { return __hip_atomic_load(p, __ATOMIC_RELAXED, __HIP_MEMORY_SCOPE_AGENT); }
__device__ __forceinline__ unsigned xb_add(unsigned* p, unsigned v) { return __hip_atomic_fetch_add(p, v, __ATOMIC_RELAXED, __HIP_MEMORY_SCOPE_AGENT); }
__device__ __forceinline__ unsigned xb_xcc_id() { return (unsigned)__builtin_amdgcn_s_getreg((3 << 11) | 20) & 0xFu; }
#define XB_SPIN(cond, bar) do { unsigned _sp = 0; while (cond) { __builtin_amdgcn_s_sleep(1); \
    if ((++_sp & 255u) == 0u) { if (xb_ld(&(bar)[XB_TMO])) break; if (_sp > XB_SPIN_CAP) { atomicAdd(&(bar)[XB_TMO], 1u); break; } } } } while (0)

struct XcdBarrier {
    unsigned* bar; unsigned x;
    volatile LAS unsigned* st;
};

__device__ __forceinline__ XcdBarrier xcd_barrier_post(unsigned* bar, volatile LAS unsigned* st) {
    XcdBarrier b; b.bar = bar; b.x = xb_xcc_id(); b.st = st;
    if (threadIdx.x == 0) (void)xb_add(&bar[XB_XCNT(b.x)], 1u);
    return b;
}
__device__ __forceinline__ void xcd_barrier_complete(unsigned* bar, unsigned x, unsigned& nloc, unsigned& nx) {
    const unsigned G = gridDim.x * gridDim.y * gridDim.z;
    unsigned sum, cnt, mine, sp = 0u;
    for (;;) {
        sum = 0u; cnt = 0u; mine = 0u;
#pragma unroll
        for (unsigned j = 0; j < 16; ++j) { const unsigned c = xb_ld(&bar[XB_XCNT(j)]); sum += c; cnt += (c > 0u) ? 1u : 0u; mine = (j == x) ? c : mine; }
        if (sum == G) break;
        __builtin_amdgcn_s_sleep(1);
        if ((++sp & 255u) == 0u) { if (xb_ld(&bar[XB_TMO])) break; if (sp > XB_SPIN_CAP) { atomicAdd(&bar[XB_TMO], 1u); break; } }
    }
    nloc = mine > 0u ? mine : 1u; nx = cnt > 0u ? cnt : 1u;
}

__device__ __forceinline__ void xcd_barrier(const XcdBarrier& b) {
    asm volatile("s_waitcnt vmcnt(0)" ::: "memory");
    __syncthreads();
    if (threadIdx.x == 0) {
        unsigned* bar = b.bar;
        __builtin_amdgcn_s_waitcnt(0);
        unsigned nloc = b.st[0], nx = b.st[1];
        if (nloc == 0u) { xcd_barrier_complete(bar, b.x, nloc, nx); b.st[0] = nloc; b.st[1] = nx; }
        const unsigned old = xb_add(&bar[XB_XSUB(b.x)], 1u);
        const unsigned gen = old / nloc;
        if (old + 1u == (gen + 1u) * nloc) {
            __builtin_amdgcn_fence(__ATOMIC_RELEASE, "agent");
            asm volatile("s_waitcnt vmcnt(0)" ::: "memory");
            const unsigned og = xb_add(&bar[XB_TOP], 1u);
            const unsigned tg = og / nx;
            if (og + 1u == (tg + 1u) * nx) xb_add(&bar[XB_TOPGEN], 1u);
            else XB_SPIN(xb_ld(&bar[XB_TOPGEN]) == tg, bar);
            __builtin_amdgcn_fence(__ATOMIC_ACQUIRE, "agent");
            xb_add(&bar[XB_XGEN(b.x)], 1u);
            asm volatile("s_waitcnt vmcnt(0)" ::: "memory");
        } else {
            XB_SPIN(xb_ld(&bar[XB_XGEN(b.x)]) == gen, bar);
            __builtin_amdgcn_fence(__ATOMIC_ACQUIRE, "agent");
            asm volatile("s_waitcnt vmcnt(0)" ::: "memory");
        }
    }
    __syncthreads();
}


__global__ void __launch_bounds__(512, 2) fwd_megakernel(Params P) {
  extern __shared__ __attribute__((aligned(16))) unsigned char lds_raw[];
  cg::grid_group grid = cg::this_grid();
  Ctx F; F.lds = (LAS unsigned char*)lds_raw; F.wave = __builtin_amdgcn_readfirstlane((int)threadIdx.x >> 6);
  F.G = gridDim.x; F.gw = blockIdx.x * 8 + F.wave; F.NGW = F.G * 8;
  unsigned char* ws = P.ws;
  volatile LAS unsigned* xst = (volatile LAS unsigned*)(F.lds + LDS_BYTES - 16);
  if (threadIdx.x < 2) xst[threadIdx.x] = 0u;
  unsigned* xbar_words = (unsigned*)(ws + WS_CTL + 65536);
  __syncthreads();
  XcdBarrier xbar = xcd_barrier_post(xbar_words, xst);
#define GRID_BAR() xcd_barrier(xbar)

#ifndef PHMASK
#define PHMASK 0xFFFFFFFFu
#endif
#define PH(n) if ((PHMASK >> (n)) & 1u)
#if defined(TIMEDSA) && !defined(TIMEPH)
#define TIMEPH 99
#define TIMEN 1
#endif
#ifdef TIMEPH
  unsigned long long* tsw = (unsigned long long*)(ws + WS_CTL + 4096);
#define TS_BEGIN(n) if ((n) >= TIMEPH && (n) < TIMEPH + TIMEN && (n) == TIMEPH && blockIdx.x == 0 && threadIdx.x == 0) tsw[0] = __builtin_amdgcn_s_memrealtime();
#define TS_END(n) if ((n) == TIMEPH + TIMEN - 1 && blockIdx.x == 0 && threadIdx.x == 0) tsw[1] = __builtin_amdgcn_s_memrealtime();
#else
#define TS_BEGIN(n)
#define TS_END(n)
#endif
  TS_BEGIN(0)
  PH(0) p0_prologue(F, P);
  if (P.ws == nullptr) grid.sync();
  GRID_BAR();
  TS_END(0)
  TS_BEGIN(1)
  PH(1) {
    pg8::DenseSched S; S.init(NTOK, W0P, 1024, ws + WS_WIN0, F.G, (int)blockIdx.x);
    pg8::EpiProj0 E{(bf16_t*)(ws + WS_PROJ), (bf16_t*)(ws + WS_KF), (bf16_t*)(ws + WS_IKF), (bf16_t*)(ws + WS_VTF), P.in[I_QN0], P.in[I_KN0], (const float*)(ws + WS_ROPE), (const float*)(ws + WS_ROPE) + SEQ * 32};
    pg8::gemm_phase<pg8::EpiProj0, pg8::DenseSched, true>(F.lds, F.wave, (const char*)(ws + WS_XN), 1024, S, E);
  }
  GRID_BAR();
  TS_END(1)
  TS_BEGIN(2)
  PH(2) p1b_transform0(F, P);
  GRID_BAR();
  TS_END(2)
  TS_BEGIN(3)
  PH(3) dsa_phase(F, P);
  GRID_BAR();
  TS_END(3)
  TS_BEGIN(4)
  PH(4) {
    pg8::DenseSched S; S.init(NTOK, 1024, 1024, ws + WS_WOUT0, F.G, (int)blockIdx.x);
    pg8::EpiResB<true> E{P.in[I_X], (bf16_t*)(ws + WS_XB), DM};
    pg8::gemm_phase<pg8::EpiResB<true>, pg8::DenseSched, true>(F.lds, F.wave, (const char*)(ws + WS_MIX), 1024, S, E);
  }
  GRID_BAR();
  TS_END(4)
  TS_BEGIN(5)
  PH(5) router_phase(F, P, 0);
  GRID_BAR();
  TS_END(5)
  TS_BEGIN(6)
  PH(6) moe_gemms(F, P, 0, xbar);
  GRID_BAR();
  TS_END(6)
  TS_BEGIN(7)
  PH(7) combine_phase(F, P, 0, true);
  GRID_BAR();
  TS_END(7)
  TS_BEGIN(8)
  PH(8) {
    pg8::DenseSched S; S.init(NTOK, W1, 1024, ws + WS_WIN1, F.G, (int)blockIdx.x);
    pg8::EpiQKV1 E{(bf16_t*)(ws + WS_PROJ), P.in[I_QN1], P.in[I_KN1], (const float*)(ws + WS_ROPE), (const float*)(ws + WS_ROPE) + SEQ * 32};
    pg8::gemm_phase<pg8::EpiQKV1, pg8::DenseSched, true>(F.lds, F.wave, (const char*)(ws + WS_XN), 1024, S, E);
  }
  GRID_BAR();
  TS_END(8)
  TS_BEGIN(10)
  PH(10) dil_phase(F, P);
  GRID_BAR();
  TS_END(10)
  TS_BEGIN(11)
  PH(11) {
    pg8::DenseSched S; S.init(NTOK, 1024, 1024, ws + WS_WOUT1, F.G, (int)blockIdx.x);
    pg8::EpiResB<false> E{ws + WS_XB, (bf16_t*)(ws + WS_XB), DM};
    pg8::gemm_phase<pg8::EpiResB<false>, pg8::DenseSched, true>(F.lds, F.wave, (const char*)(ws + WS_MIX), 1024, S, E);
  }
  GRID_BAR();
  TS_END(11)
  TS_BEGIN(12)
  PH(12) router_phase(F, P, 1);
  GRID_BAR();
  TS_END(12)
  TS_BEGIN(13)
  PH(13) moe_gemms(F, P, 1, xbar);
  GRID_BAR();
  TS_END(13)
  TS_BEGIN(14)
  PH(14) combine_phase(F, P, 1, false);
#ifdef TIMEPH
  GRID_BAR();
  TS_END(14)
  GRID_BAR();
  { const unsigned long long dt = (tsw[1] - tsw[0]) * 4ull; const unsigned long long t0 = __builtin_amdgcn_s_memrealtime();
    while (__builtin_amdgcn_s_memrealtime() - t0 < dt) __builtin_amdgcn_s_sleep(32); }
#endif
}

extern "C" void kernel_launch(void* const* d_in, const int* in_sizes, int n_in, void* d_out, int out_size, void* d_ws, size_t ws_size, hipStream_t stream) {
  static int grid_blocks = 0;
  if (!grid_blocks) {
    if (n_in != 28 || out_size != NTOK * DM || ws_size < WS_END) { fprintf(stderr, "kernel_launch: unexpected shapes (n_in %d out %d ws %zu)\n", n_in, out_size, ws_size); grid_blocks = -1; return; }
    int dev = 0, cus = 0, per_cu = 0;
    (void)hipGetDevice(&dev);
    (void)hipDeviceGetAttribute(&cus, hipDeviceAttributeMultiprocessorCount, dev);
    (void)hipFuncSetAttribute((const void*)fwd_megakernel, hipFuncAttributeMaxDynamicSharedMemorySize, LDS_BYTES);
    (void)hipOccupancyMaxActiveBlocksPerMultiprocessor(&per_cu, (const void*)fwd_megakernel, 512, LDS_BYTES);
    if (per_cu < 1) per_cu = 1;
    grid_blocks = cus * per_cu;
  }
  if (grid_blocks < 0) return;
  Params p{};
  for (int i = 0; i < 28; ++i) p.in[i] = (const float*)d_in[i];
  p.out = (float*)d_out; p.ws = (unsigned char*)d_ws;
  (void)hipMemsetAsync((unsigned char*)d_ws + WS_CTL + 65536, 0, XCD_BAR_WORDS * 4, stream);
  void* args[] = {&p};
  hipError_t e = hipLaunchCooperativeKernel((const void*)fwd_megakernel, dim3(grid_blocks), dim3(512), args, LDS_BYTES, stream);
  if (e != hipSuccess) fprintf(stderr, "cooperative launch failed: %s (grid %d)\n", hipGetErrorString(e), grid_blocks);
}
```

```cpp
#include <hip/hip_runtime.h>
#include <hip/hip_cooperative_groups.h>
#include <cstdio>
#include <cstdint>
namespace cg = cooperative_groups;

#define LAS __attribute__((address_space(3)))
#define DI __device__ __forceinline__
typedef unsigned short bf16_t;
typedef short bf16x8 __attribute__((ext_vector_type(8)));
typedef short s16x4 __attribute__((ext_vector_type(4)));
typedef float f32x2 __attribute__((ext_vector_type(2)));
typedef float f32x4 __attribute__((ext_vector_type(4)));
typedef float f32x16 __attribute__((ext_vector_type(16)));
typedef unsigned u32x2 __attribute__((ext_vector_type(2)));
typedef unsigned u32x4 __attribute__((ext_vector_type(4)));
typedef int i32x4 __attribute__((ext_vector_type(4)));
typedef __bf16 bf16x2_t __attribute__((ext_vector_type(2)));

constexpr int NTOK = 65536, DM = 1024, SEQ = 4096, NBATCH = 16;
constexpr int W0P = 2560, W0V = 2500;
constexpr int W1 = 1536;
constexpr int C_CB = 0, C_CC = 512, C_CH = 1024, C_Q = 1536, C_K = 2048, C_V = 2112, C_IQ = 2176, C_IK = 2432, C_IW = 2496;
constexpr int NEXP = 32, DEXP = 512;
constexpr int MAXROWS = 139264;
constexpr float NORM_EPS = 1e-6f;
constexpr float LOG2E = 1.4426950408889634f;

constexpr size_t MiB = 1u << 20;
constexpr size_t WS_CTL = 0;
constexpr size_t WS_ROPE = 1 * MiB;
constexpr size_t WS_WR0 = 2 * MiB, WS_WR1 = 2 * MiB + 256 * 1024;
constexpr size_t WS_WIN0 = 3 * MiB, WS_WOUT0 = 8 * MiB, WS_WIN1 = 10 * MiB, WS_WOUT1 = 13 * MiB;
constexpr size_t WS_WGU0 = 16 * MiB, WS_WD0 = 80 * MiB, WS_WGU1 = 112 * MiB, WS_WD1 = 176 * MiB;
constexpr size_t WS_XN = 208 * MiB;
constexpr size_t WS_MIX = 337 * MiB;
constexpr size_t WS_H = 337 * MiB;
constexpr size_t WS_XB = 473 * MiB;
constexpr size_t WS_PROJ = 601 * MiB;
constexpr size_t WS_LIST = 921 * MiB;
constexpr size_t WS_ASG = 929 * MiB;
constexpr size_t WS_ASGG = 930 * MiB;
constexpr size_t WS_IKF = 931 * MiB, WS_KF = 939 * MiB, WS_VTF = 947 * MiB;
constexpr size_t WS_RSL = 955 * MiB;
constexpr size_t WS_END = 963 * MiB;

constexpr int LDS_BYTES = 155648;
constexpr int LDS_LIST = 131072;
constexpr int LDS_HIST = 139264;
constexpr int LDS_MISC = 131072 + 16384;

DI unsigned pk2(float lo, float hi) { f32x2 v = {lo, hi}; bf16x2_t b = __builtin_convertvector(v, bf16x2_t); return __builtin_bit_cast(unsigned, b); }
DI float bflo(unsigned w) { return __uint_as_float(w << 16); }
DI float bfhi(unsigned w) { return __uint_as_float(w & 0xffff0000u); }
DI float bf1(bf16_t h) { return __uint_as_float((unsigned)h << 16); }
DI int opaque(int x) { asm volatile("" : "+v"(x)); return x; }
DI int lane_id_v() { int l; asm volatile("v_mbcnt_lo_u32_b32 %0, -1, 0\n\tv_mbcnt_hi_u32_b32 %0, -1, %0" : "=v"(l)); return l; }
DI float wave_sum(float v) {
#pragma unroll
  for (int o = 1; o < 64; o <<= 1) v += __shfl_xor(v, o);
  return v;
}
DI float wave_max(float v) {
#pragma unroll
  for (int o = 1; o < 64; o <<= 1) v = fmaxf(v, __shfl_xor(v, o));
  return v;
}
DI unsigned wave_sum_u(unsigned v) {
#pragma unroll
  for (int o = 1; o < 64; o <<= 1) v += (unsigned)__shfl_xor((int)v, o);
  return v;
}

namespace pg8 {
constexpr int BM = 256, BK = 64, HALF = 128, HTB = HALF * BK * 2, STAGE_BYTES = 8 * HTB, NXCD = 8, WGM = 8;
DI int lds_byte(int r, int c) { const int st = (r >> 4) * 2 + (c >> 5), rr = r & 15, cc = c & 31, ob = rr * 64 + cc * 2; return st * 1024 + (ob ^ (((ob >> 9) & 1) << 5)); }
DI void stage_rc(int b, int& R, int& C) { const int st = b / 1024, sb = b % 1024, swz = sb ^ (((sb >> 9) & 1) << 5); R = (st >> 1) * 16 + swz / 64; C = (st & 1) * 32 + (swz % 64) / 2; }
DI int perm32(int rho) { const int n = rho >> 4, i = rho & 15; return 8 * (i >> 2) + 4 * n + (i & 3); }

struct Unit { const char* b; int p0, p1, p2, p3; };

struct EpiBf16 {
  static constexpr bool PERM = true;
  bf16_t* O; int ldc;
  DI void operator()(const f32x4 (&acc)[2][2][4][2], const Unit& u, int wr, int wc, int fr, int fq) const {
    const int row0 = u.p0 + wr * 64 + fr, col0 = u.p1 + wc * 32 + 8 * fq;
#pragma unroll
    for (int ai = 0; ai < 2; ++ai)
#pragma unroll
      for (int m = 0; m < 4; ++m) { bf16_t* rowp = O + (size_t)(row0 + ai * HALF + m * 16) * ldc + col0;
#pragma unroll
        for (int bj = 0; bj < 2; ++bj) { const f32x4 v0 = acc[ai][bj][m][0], v1 = acc[ai][bj][m][1];
          u32x4 w; w.x = pk2(v0[0], v0[1]); w.y = pk2(v0[2], v0[3]); w.z = pk2(v1[0], v1[1]); w.w = pk2(v1[2], v1[3]);
          *(u32x4*)(rowp + bj * HALF) = w; } }
  }
};
template <bool BASE_F32> struct EpiResB {
  static constexpr bool PERM = true;
  const void* base; bf16_t* out; int ldc;
  DI void operator()(const f32x4 (&acc)[2][2][4][2], const Unit& u, int wr, int wc, int fr, int fq) const {
    const int row0 = u.p0 + wr * 64 + fr, col0 = u.p1 + wc * 32 + 8 * fq;
#pragma unroll
    for (int ai = 0; ai < 2; ++ai)
#pragma unroll
      for (int m = 0; m < 4; ++m) { const size_t off = (size_t)(row0 + ai * HALF + m * 16) * ldc + col0;
#pragma unroll
        for (int bj = 0; bj < 2; ++bj) { f32x4 v0 = acc[ai][bj][m][0], v1 = acc[ai][bj][m][1];
          if (BASE_F32) { const float* bp = (const float*)base + off + bj * HALF; v0 = v0 + *(const f32x4*)bp; v1 = v1 + *(const f32x4*)(bp + 4); }
          else { const u32x4 b = *(const u32x4*)((const bf16_t*)base + off + bj * HALF);
            v0 = v0 + (f32x4){bflo(b.x), bfhi(b.x), bflo(b.y), bfhi(b.y)}; v1 = v1 + (f32x4){bflo(b.z), bfhi(b.z), bflo(b.w), bfhi(b.w)}; }
          u32x4 w; w.x = pk2(v0[0], v0[1]); w.y = pk2(v0[2], v0[3]); w.z = pk2(v1[0], v1[1]); w.w = pk2(v1[2], v1[3]);
          *(u32x4*)(out + off + bj * HALF) = w; } }
  }
};
struct EpiQKV1 {
  static constexpr bool PERM = true;
  bf16_t* O; const float* qg; const float* kg; const float* cosT; const float* sinT;
  DI void operator()(const f32x4 (&acc)[2][2][4][2], const Unit& u, int wr, int wc, int fr, int fq) const {
    const int tilec = u.p1 >> 8;
    const int row0 = u.p0 + wr * 64 + fr, col0 = u.p1 + wc * 64 + 8 * fq;
    if (tilec == 5) {
#pragma unroll
      for (int ai = 0; ai < 2; ++ai)
#pragma unroll
        for (int m = 0; m < 4; ++m) { bf16_t* rowp = O + (size_t)(row0 + ai * HALF + m * 16) * W1 + col0;
#pragma unroll
          for (int bj = 0; bj < 2; ++bj) { const f32x4 v0 = acc[ai][bj][m][0], v1 = acc[ai][bj][m][1];
            u32x4 w; w.x = pk2(v0[0], v0[1]); w.y = pk2(v0[2], v0[3]); w.z = pk2(v1[0], v1[1]); w.w = pk2(v1[2], v1[3]); *(u32x4*)(rowp + 32 * bj) = w; } }
      return;
    }
    const float* gp = (tilec == 4 ? kg : qg) + 8 * fq; const float osc = tilec == 4 ? 1.f : 0.125f * LOG2E;
    float g0[8], g1[8];
#pragma unroll
    for (int i = 0; i < 8; ++i) { g0[i] = gp[i]; g1[i] = gp[32 + i]; }
#pragma unroll
    for (int ai = 0; ai < 2; ++ai)
#pragma unroll
      for (int m = 0; m < 4; ++m) {
        const int row = row0 + ai * HALF + m * 16; const int t = row & (SEQ - 1);
        const f32x4 a0 = acc[ai][0][m][0], a1 = acc[ai][0][m][1], b0 = acc[ai][1][m][0], b1 = acc[ai][1][m][1];
        float x1[8] = {a0[0], a0[1], a0[2], a0[3], a1[0], a1[1], a1[2], a1[3]}, x2[8] = {b0[0], b0[1], b0[2], b0[3], b1[0], b1[1], b1[2], b1[3]};
        float ss = 0.f;
#pragma unroll
        for (int i = 0; i < 8; ++i) ss += x1[i] * x1[i] + x2[i] * x2[i];
        ss += __shfl_xor(ss, 16); ss += __shfl_xor(ss, 32);
        const float rstd = 1.0f / sqrtf(ss * (1.f / 64.f) + NORM_EPS);
        const f32x4* cp = (const f32x4*)(cosT + t * 32 + 8 * fq); const f32x4* sp = (const f32x4*)(sinT + t * 32 + 8 * fq);
        const f32x4 c0 = cp[0], c1 = cp[1], s0 = sp[0], s1 = sp[1];
        const float cv[8] = {c0[0], c0[1], c0[2], c0[3], c1[0], c1[1], c1[2], c1[3]}, sv[8] = {s0[0], s0[1], s0[2], s0[3], s1[0], s1[1], s1[2], s1[3]};
        float o1[8], o2[8];
#pragma unroll
        for (int i = 0; i < 8; ++i) { const float y1 = x1[i] * rstd * g0[i], y2 = x2[i] * rstd * g1[i]; o1[i] = (y1 * cv[i] - y2 * sv[i]) * osc; o2[i] = (y1 * sv[i] + y2 * cv[i]) * osc; }
        bf16_t* rowp = O + (size_t)row * W1 + col0;
        u32x4 w; w.x = pk2(o1[0], o1[1]); w.y = pk2(o1[2], o1[3]); w.z = pk2(o1[4], o1[5]); w.w = pk2(o1[6], o1[7]); *(u32x4*)rowp = w;
        w.x = pk2(o2[0], o2[1]); w.y = pk2(o2[2], o2[3]); w.z = pk2(o2[4], o2[5]); w.w = pk2(o2[6], o2[7]); *(u32x4*)(rowp + 32) = w;
      }
  }
};
struct EpiProj0 {
  static constexpr bool PERM = true;
  bf16_t* O; bf16_t* KFo; bf16_t* IKFo; bf16_t* VRo; const float* qg; const float* kg; const float* cosT; const float* sinT;
  DI void operator()(const f32x4 (&acc)[2][2][4][2], const Unit& u, int wr, int wc, int fr, int fq) const {
    const int grp64 = (u.p1 >> 6) + wc;
    const int row0 = u.p0 + wr * 64 + fr, col0 = u.p1 + wc * 64 + 8 * fq;
    const bool rope = (grp64 >= 24 && grp64 <= 32) || (grp64 >= 34 && grp64 <= 38);
    if (!rope) {
#pragma unroll
      for (int ai = 0; ai < 2; ++ai)
#pragma unroll
        for (int m = 0; m < 4; ++m) { const int row = row0 + ai * HALF + m * 16;
          bf16_t* rowp = grp64 == 33 ? VRo + (size_t)row * 64 + 8 * fq : O + (size_t)row * W0P + col0;
#pragma unroll
          for (int bj = 0; bj < 2; ++bj) { const f32x4 v0 = acc[ai][bj][m][0], v1 = acc[ai][bj][m][1];
            u32x4 w; w.x = pk2(v0[0], v0[1]); w.y = pk2(v0[2], v0[3]); w.z = pk2(v1[0], v1[1]); w.w = pk2(v1[2], v1[3]); *(u32x4*)(rowp + 32 * bj) = w; } }
      return;
    }
    const bool norm = grp64 <= 32;
    const float* gp = (grp64 == 32 ? kg : qg) + 8 * fq;
    float g0[8], g1[8];
#pragma unroll
    for (int i = 0; i < 8; ++i) { g0[i] = norm ? gp[i] : 1.f; g1[i] = norm ? gp[32 + i] : 1.f; }
    bf16_t* frag = grp64 == 32 ? KFo : (grp64 == 38 ? IKFo : nullptr);
#pragma unroll
    for (int ai = 0; ai < 2; ++ai)
#pragma unroll
      for (int m = 0; m < 4; ++m) {
        const int row = row0 + ai * HALF + m * 16; const int t = row & (SEQ - 1);
        const f32x4 a0 = acc[ai][0][m][0], a1 = acc[ai][0][m][1], b0 = acc[ai][1][m][0], b1 = acc[ai][1][m][1];
        float x1[8] = {a0[0], a0[1], a0[2], a0[3], a1[0], a1[1], a1[2], a1[3]}, x2[8] = {b0[0], b0[1], b0[2], b0[3], b1[0], b1[1], b1[2], b1[3]};
        float ss = 0.f;
#pragma unroll
        for (int i = 0; i < 8; ++i) ss += x1[i] * x1[i] + x2[i] * x2[i];
        ss += __shfl_xor(ss, 16); ss += __shfl_xor(ss, 32);
        const float rstd = norm ? 1.0f / sqrtf(ss * (1.f / 64.f) + NORM_EPS) : 1.f;
        const f32x4* cp = (const f32x4*)(cosT + t * 32 + 8 * fq); const f32x4* sp = (const f32x4*)(sinT + t * 32 + 8 * fq);
        const f32x4 c0 = cp[0], c1 = cp[1], s0 = sp[0], s1 = sp[1];
        const float cv[8] = {c0[0], c0[1], c0[2], c0[3], c1[0], c1[1], c1[2], c1[3]}, sv[8] = {s0[0], s0[1], s0[2], s0[3], s1[0], s1[1], s1[2], s1[3]};
        float o1[8], o2[8];
#pragma unroll
        for (int i = 0; i < 8; ++i) { const float y1 = x1[i] * rstd * g0[i], y2 = x2[i] * rstd * g1[i]; o1[i] = y1 * cv[i] - y2 * sv[i]; o2[i] = y1 * sv[i] + y2 * cv[i]; }
        u32x4 w1, w2; w1.x = pk2(o1[0], o1[1]); w1.y = pk2(o1[2], o1[3]); w1.z = pk2(o1[4], o1[5]); w1.w = pk2(o1[6], o1[7]);
        w2.x = pk2(o2[0], o2[1]); w2.y = pk2(o2[2], o2[3]); w2.z = pk2(o2[4], o2[5]); w2.w = pk2(o2[6], o2[7]);
        if (grp64 == 32) { bf16_t* kr = KFo + (size_t)row * 64 + 8 * fq; *(u32x4*)kr = w1; *(u32x4*)(kr + 32) = w2; }
        else if (frag) {
          const size_t fo = ((((size_t)(row >> 12) * 128 + (t >> 5)) * 4 + (fq >> 1)) * 64 + (fq & 1) * 32 + (t & 31)) * 8;
          *(u32x4*)(frag + fo) = w1; *(u32x4*)(frag + fo + 2 * 64 * 8) = w2;
        } else { bf16_t* rowp = O + (size_t)row * W0P + col0; *(u32x4*)rowp = w1; *(u32x4*)(rowp + 32) = w2; }
      }
  }
};
struct EpiResF32 {
  static constexpr bool PERM = false;
  const float* base; float* out; int ldc;
  DI void operator()(const f32x4 (&acc)[2][2][4][2], const Unit& u, int wr, int wc, int fr, int fq) const {
    const int row0 = u.p0 + wr * 64 + fr, col0 = u.p1 + wc * 32 + 4 * fq;
#pragma unroll
    for (int ai = 0; ai < 2; ++ai)
#pragma unroll
      for (int m = 0; m < 4; ++m) { const size_t off = (size_t)(row0 + ai * HALF + m * 16) * ldc + col0;
#pragma unroll
        for (int bj = 0; bj < 2; ++bj)
#pragma unroll
          for (int n = 0; n < 2; ++n) { const f32x4 bs = *(const f32x4*)(base + off + bj * HALF + n * 16); *(f32x4*)(out + off + bj * HALF + n * 16) = bs + acc[ai][bj][m][n]; } }
  }
};
DI float silu_mul(float g, float u) { return g * u * __builtin_amdgcn_rcpf(1.0f + __builtin_amdgcn_exp2f(-g * LOG2E)); }
struct EpiSwiGLU {
  static constexpr bool PERM = true;
  bf16_t* H; const float* RSL; const LAS int* cnt;
  DI void operator()(const f32x4 (&acc)[2][2][4][2], const Unit& u, int wr, int wc, int fr, int fq) const {
    const int row0 = u.p0 + wr * 64 + fr, col0 = u.p1 + wc * 32 + 8 * fq; const int ce = __builtin_amdgcn_readfirstlane(cnt[u.p2]);
#pragma unroll
    for (int ai = 0; ai < 2; ++ai)
#pragma unroll
      for (int m = 0; m < 4; ++m) { bf16_t* rowp = H + (size_t)(row0 + ai * HALF + m * 16) * DEXP + col0;
        const int lrow = u.p3 * BM + wr * 64 + fr + ai * HALF + m * 16; const float rs = (lrow < ce) ? RSL[u.p2 * 65536 + lrow] : 0.f;
        const f32x4 g0 = acc[ai][0][m][0] * rs, g1 = acc[ai][0][m][1] * rs, u0 = acc[ai][1][m][0] * rs, u1 = acc[ai][1][m][1] * rs;
        u32x4 w; w.x = pk2(silu_mul(g0[0], u0[0]), silu_mul(g0[1], u0[1])); w.y = pk2(silu_mul(g0[2], u0[2]), silu_mul(g0[3], u0[3]));
        w.z = pk2(silu_mul(g1[0], u1[0]), silu_mul(g1[1], u1[1])); w.w = pk2(silu_mul(g1[2], u1[2]), silu_mul(g1[3], u1[3]));
        *(u32x4*)rowp = w; }
  }
};

struct DenseSched {
  static constexpr bool NEXT_IN_LDS = false;
  int nM, nN, nwg, G, c, K; const char* Bt;
  DI void init(int M, int N, int K_, const void* Bt_, int G_, int c_) { nM = M / BM; nN = N / BM; nwg = nM * nN; G = G_; c = c_; K = K_; Bt = (const char*)Bt_; }
  DI bool next(int i, Unit& u) const {
    const long L = (long)i * G + c; if (L >= nwg) return false;
    int wgid = (int)L; { const int q = nwg / NXCD, r = nwg % NXCD, xcd = wgid % NXCD, off = wgid / NXCD; wgid = (xcd < r ? xcd * (q + 1) : r * (q + 1) + (xcd - r) * q) + off; }
    const int nig = WGM * nN, gid = wgid / nig, fm = gid * WGM, gsz = (nM - fm) < WGM ? (nM - fm) : WGM;
    const int pm = fm + ((wgid % nig) % gsz), pn = (wgid % nig) / gsz;
    u.p0 = pm * BM; u.p1 = pn * BM; u.p2 = 0; u.p3 = 0; u.b = Bt + (size_t)pn * BM * K * 2; return true;
  }
  DI void a_off(const Unit& u, const int (&R)[2], const int (&C)[2], unsigned (&o)[2][2]) const {
#pragma unroll
    for (int h = 0; h < 2; ++h)
#pragma unroll
      for (int i = 0; i < 2; ++i) o[h][i] = (unsigned)((u.p0 + h * HALF + R[i]) * K + C[i]) * 2u;
  }
};
template <bool GATHER> struct MoeSched {
  static constexpr bool NEXT_IN_LDS = GATHER;
  const LAS int* pb; const LAS int* cnt; const int* list; const char* W; int G, c, K;
  DI bool next(int i, Unit& u) const {
    const int L = i * G + c; const int total = __builtin_amdgcn_readfirstlane(pb[NEXP]) * 4; if (L >= total) return false;
    const int rbg = L >> 2, pn = L & 3; int e = 0;
    for (int j = 1; j < NEXP; ++j) e = (__builtin_amdgcn_readfirstlane(pb[j]) <= rbg) ? j : e;
    u.p0 = rbg * BM; u.p1 = pn * (GATHER ? 128 : 256); u.p2 = e; u.p3 = rbg - __builtin_amdgcn_readfirstlane(pb[e]);
    u.b = W + (size_t)(e * 1024 + pn * 256) * K * 2; return true;
  }
  DI void a_off(const Unit& u, const int (&R)[2], const int (&C)[2], unsigned (&o)[2][2]) const {
    if (GATHER) {
      const int ce = __builtin_amdgcn_readfirstlane(cnt[u.p2]);
#pragma unroll
      for (int h = 0; h < 2; ++h)
#pragma unroll
        for (int i = 0; i < 2; ++i) { const int row = u.p3 * BM + h * HALF + R[i]; const int tok = (row < ce) ? list[u.p2 * 65536 + row] : 0; o[h][i] = (unsigned)(tok * K + C[i]) * 2u; }
    } else {
#pragma unroll
      for (int h = 0; h < 2; ++h)
#pragma unroll
        for (int i = 0; i < 2; ++i) o[h][i] = (unsigned)((u.p0 + h * HALF + R[i]) * K + C[i]) * 2u;
    }
  }
};

template <class Epi, class Sched, bool ALIGN_EPI>
DI void gemm_phase(LAS unsigned char* lds, const int wave_id, const char* gA, const int K, const Sched& S, const Epi& E) {
  const int lane = lane_id_v(), wid = wave_id, tid = wid * 64 + lane, wr = wid >> 2, wc = wid & 3, fr = lane & 15, fq = lane >> 4;
  const int nt = K / BK;
  unsigned voffB[2];
  { int R, C; stage_rc(tid * 16, R, C);
    const int Rb = Epi::PERM ? ((R & ~31) + perm32(R & 31)) : R; voffB[0] = (unsigned)(Rb * K + C) * 2u; voffB[1] = voffB[0] + (unsigned)(64 * K * 2); }
#define PG8_RC(Rp, Cp) int Rp[2], Cp[2]; { int R_, C_; stage_rc(opaque(tid) * 16, R_, C_); Rp[0] = R_; Cp[0] = C_; Rp[1] = R_ + 64; Cp[1] = C_; }
  const size_t kstep = (size_t)(BK * 2);
  const size_t hstep = (size_t)HALF * K * 2;
  const unsigned ldsw = (unsigned)wid * 1024u;
  const int aoff = lds_byte(wr * 64 + fr, fq * 8), boff = lds_byte(wc * 32 + fr, fq * 8);
#define PG8_SA(b, h) (((b) * 2 + (h)) * HTB)
#define PG8_SB(b, h) ((4 + (b) * 2 + (h)) * HTB)
#define PG8_STAGE_B(bufoff, gbase) do { _Pragma("unroll") for (int _i = 0; _i < 2; ++_i) \
    __builtin_amdgcn_global_load_lds((const unsigned*)((const char*)(gbase) + voffB[_i]), (LAS unsigned*)(lds + (bufoff) + ldsw + _i * 8192), 16, 0, 0); } while (0)
#define PG8_STAGE_A(bufoff, kb, offs) do { _Pragma("unroll") for (int _i = 0; _i < 2; ++_i) \
    __builtin_amdgcn_global_load_lds((const unsigned*)(gA + (size_t)(kb) + (offs)[_i]), (LAS unsigned*)(lds + (bufoff) + ldsw + _i * 8192), 16, 0, 0); } while (0)
#define PG8_LDA(dst, b, h) do { _Pragma("unroll") for (int m = 0; m < 4; ++m) _Pragma("unroll") for (int k = 0; k < 2; ++k) dst[m][k] = *(const LAS bf16x8*)(lds + PG8_SA(b, h) + aoff + m * 2048 + k * 1024); } while (0)
#define PG8_LDB(dst, b, h) do { _Pragma("unroll") for (int n = 0; n < 2; ++n) _Pragma("unroll") for (int k = 0; k < 2; ++k) dst[n][k] = *(const LAS bf16x8*)(lds + PG8_SB(b, h) + boff + n * 2048 + k * 1024); } while (0)
#define PG8_MMA(ai, bj, At, Bt) do { __builtin_amdgcn_s_setprio(1); _Pragma("unroll") for (int m = 0; m < 4; ++m) _Pragma("unroll") for (int n = 0; n < 2; ++n) _Pragma("unroll") for (int k = 0; k < 2; ++k) \
    acc[ai][bj][m][n] = __builtin_amdgcn_mfma_f32_16x16x32_bf16(Bt[n][k], At[m][k], acc[ai][bj][m][n], 0, 0, 0); __builtin_amdgcn_s_setprio(0); } while (0)
#define PG8_WAIT_V(n) asm volatile("s_waitcnt vmcnt(" #n ")" ::: "memory")
#define PG8_WAIT_L(n) asm volatile("s_waitcnt lgkmcnt(" #n ")" ::: "memory")
#define PG8_BAR __builtin_amdgcn_s_barrier()
#define PG8_SCHED __builtin_amdgcn_sched_barrier(0)
  Unit cur, nxt; int ui = 0;
  if (!S.next(0, cur)) return;
  unsigned ca[2][2];
  { PG8_RC(Rp, Cp) S.a_off(cur, Rp, Cp, ca); }
  f32x4 acc[2][2][4][2];
#pragma unroll
  for (int a = 0; a < 2; ++a)
#pragma unroll
    for (int b = 0; b < 2; ++b)
#pragma unroll
      for (int m = 0; m < 4; ++m)
#pragma unroll
        for (int n = 0; n < 2; ++n) acc[a][b][m][n] = (f32x4){0.f, 0.f, 0.f, 0.f};
  bf16x8 At[4][2], B0[2][2], B1[2][2];
  const char* cB = cur.b;
  PG8_STAGE_B(PG8_SB(0, 0), cB); PG8_STAGE_B(PG8_SB(0, 1), cB + hstep); PG8_STAGE_A(PG8_SA(0, 0), 0, ca[0]); PG8_STAGE_A(PG8_SA(0, 1), 0, ca[1]);
  if (wr == 1) PG8_BAR;
  PG8_WAIT_V(2); PG8_BAR;
  PG8_STAGE_B(PG8_SB(1, 0), cB + kstep); PG8_STAGE_A(PG8_SA(1, 0), kstep, ca[0]); PG8_STAGE_B(PG8_SB(1, 1), cB + hstep + kstep);
  PG8_WAIT_V(6); PG8_BAR;
  for (;;) {
    const bool has_next = S.next(ui + 1, nxt);
    if (Sched::NEXT_IN_LDS) {
      unsigned na[2][2];
      if (has_next) { PG8_RC(Rp, Cp) S.a_off(nxt, Rp, Cp, na); }
      else {
#pragma unroll
        for (int h = 0; h < 2; ++h)
#pragma unroll
          for (int i = 0; i < 2; ++i) na[h][i] = ca[h][i];
      }
      *(LAS u32x4*)(lds + STAGE_BYTES + 8192 + tid * 16) = (u32x4){na[0][0], na[0][1], na[1][0], na[1][1]};
    }
    const char* nB = has_next ? nxt.b : cB;
    for (int t = 0; t < nt; t += 2) {
      const bool last = (t == nt - 2);
      PG8_LDB(B0, 0, 0); PG8_LDB(B1, 0, 1); PG8_SCHED; PG8_LDA(At, 0, 0); PG8_STAGE_A(PG8_SA(1, 1), (size_t)(t + 1) * kstep, ca[1]);
      PG8_WAIT_V(8); PG8_WAIT_L(0); PG8_BAR; PG8_MMA(0, 0, At, B0); PG8_MMA(0, 1, At, B1); PG8_BAR; PG8_SCHED;
      const size_t kb2 = last ? 0 : (size_t)(t + 2) * kstep;
      const char* b2 = last ? nB : cB + (size_t)(t + 2) * kstep;
      if (last) {
        if (Sched::NEXT_IN_LDS) { const u32x4 v = *(const LAS u32x4*)(lds + STAGE_BYTES + 8192 + tid * 16); ca[0][0] = v.x; ca[0][1] = v.y; ca[1][0] = v.z; ca[1][1] = v.w; }
        else if (has_next) { PG8_RC(Rp, Cp) S.a_off(nxt, Rp, Cp, ca); }
      }
      PG8_LDA(At, 0, 1); PG8_STAGE_B(PG8_SB(0, 0), b2); PG8_STAGE_B(PG8_SB(0, 1), b2 + hstep); PG8_STAGE_A(PG8_SA(0, 0), kb2, ca[0]);
      PG8_WAIT_V(8); PG8_WAIT_L(0); PG8_BAR; PG8_MMA(1, 0, At, B0); PG8_MMA(1, 1, At, B1); PG8_BAR; PG8_SCHED;
      PG8_LDB(B0, 1, 0); PG8_LDB(B1, 1, 1); PG8_SCHED; PG8_LDA(At, 1, 0); PG8_STAGE_A(PG8_SA(0, 1), kb2, ca[1]);
      PG8_WAIT_V(8); PG8_WAIT_L(0); PG8_BAR; PG8_MMA(0, 0, At, B0); PG8_MMA(0, 1, At, B1); PG8_BAR; PG8_SCHED;
      PG8_LDA(At, 1, 1); PG8_STAGE_B(PG8_SB(1, 0), b2 + kstep); PG8_STAGE_B(PG8_SB(1, 1), b2 + kstep + hstep); PG8_STAGE_A(PG8_SA(1, 0), kb2 + kstep, ca[0]);
      PG8_WAIT_V(8); PG8_WAIT_L(0); PG8_BAR; PG8_MMA(1, 0, At, B0); PG8_MMA(1, 1, At, B1); PG8_BAR; PG8_SCHED;
    }
    if constexpr (ALIGN_EPI) { if (wr == 0) PG8_BAR; }
    E(acc, cur, wr, wc, fr, fq);
    if (!has_next) break;
#pragma unroll
    for (int a = 0; a < 2; ++a)
#pragma unroll
      for (int b = 0; b < 2; ++b)
#pragma unroll
        for (int m = 0; m < 4; ++m)
#pragma unroll
          for (int n = 0; n < 2; ++n) acc[a][b][m][n] = (f32x4){0.f, 0.f, 0.f, 0.f};
    cur = nxt; cB = nB; ++ui;
    if constexpr (ALIGN_EPI) { if (wr == 1) PG8_BAR; }
  }
  PG8_WAIT_V(0);
  if constexpr (!ALIGN_EPI) { if (wr == 0) PG8_BAR; }
  PG8_BAR;
#undef PG8_RC
#undef PG8_SA
#undef PG8_SB
#undef PG8_STAGE_A
#undef PG8_STAGE_B
#undef PG8_LDA
#undef PG8_LDB
#undef PG8_MMA
#undef PG8_WAIT_V
#undef PG8_WAIT_L
#undef PG8_BAR
#undef PG8_SCHED
}
}

struct Params { const float* in[28]; float* out; unsigned char* ws; };
enum { I_X = 0, I_ANORM0, I_WIN0, I_CONVW, I_QN0, I_KN0, I_WOUT0, I_FNORM0, I_WRG0, I_BRG0, I_WRE0, I_BRE0, I_WG0, I_WU0, I_WD0,
       I_ANORM1, I_WIN1, I_QN1, I_KN1, I_WOUT1, I_FNORM1, I_WRG1, I_BRG1, I_WRE1, I_BRE1, I_WG1, I_WU1, I_WD1 };

struct Ctx { LAS unsigned char* lds; int wave, G, gw, NGW; };

struct TrDesc { const float* W; const float* gain; bf16_t* WT; int K, N, nvalid, mode, nblk, item; };
DI void tr_load(const TrDesc& d, int lane, f32x4 (&r)[8]) {
  const int kb = d.item / d.nblk, nb = d.item % d.nblk, k0 = 64 * kb, n = 32 * nb + 4 * (lane & 7);
#pragma unroll
  for (int i = 0; i < 8; ++i) { const int kk = 8 * i + (lane >> 3); r[i] = (n < d.nvalid) ? *(const f32x4*)(d.W + (size_t)(k0 + kk) * d.N + n) : (f32x4){0.f, 0.f, 0.f, 0.f}; }
}
DI void tr_finish(const TrDesc& d, int lane, const f32x4 (&r)[8], LAS float* scr) {
  const int kb = d.item / d.nblk, nb = d.item % d.nblk, k0 = 64 * kb, n0 = 32 * nb;
#pragma unroll
  for (int i = 0; i < 8; ++i) { const int kk = 8 * i + (lane >> 3); const float g = d.gain ? d.gain[k0 + kk] : 1.f; LAS float* s = scr + kk * 33 + 4 * (lane & 7);
    s[0] = r[i].x * g; s[1] = r[i].y * g; s[2] = r[i].z * g; s[3] = r[i].w * g; }
  asm volatile("s_waitcnt lgkmcnt(0)" ::: "memory");
  const int c = lane & 7;
#pragma unroll
  for (int j = 0; j < 4; ++j) { const int nn = (lane >> 3) + 8 * j; const LAS float* s = scr + (8 * c) * 33 + nn;
    u32x4 o; o.x = pk2(s[0 * 33], s[1 * 33]); o.y = pk2(s[2 * 33], s[3 * 33]); o.z = pk2(s[4 * 33], s[5 * 33]); o.w = pk2(s[6 * 33], s[7 * 33]);
    const int ng = n0 + nn; const int drow = (d.mode == 0) ? ng : (d.mode == 3 ? ((ng & ~255) + 128 * ((ng >> 5) & 1) + 32 * ((ng >> 6) & 3) + (ng & 31)) : ((ng >> 7) * 256 + (ng & 127) + (d.mode == 2 ? 128 : 0)));
    *(u32x4*)(d.WT + (size_t)drow * d.K + k0 + 8 * c) = o; }
  asm volatile("s_waitcnt lgkmcnt(0)" ::: "memory");
}
constexpr int TR_I_IN0 = 16 * 80, TR_I_OUT = 16 * 32, TR_I_GU = 32 * 16 * 16, TR_I_DN = 32 * 8 * 32, TR_I_IN1 = 16 * 48;
constexpr int TR_EARLY = TR_I_IN0 + TR_I_OUT, TR_MOE = 2 * TR_I_GU + TR_I_DN, TR_TOTAL = TR_EARLY + TR_MOE + TR_I_IN1 + TR_I_OUT + TR_MOE;
DI TrDesc tr_desc(const Params& P, int it) {
  unsigned char* ws = P.ws; TrDesc d; int r = it;
  if (r < TR_I_IN0) { d.W = P.in[I_WIN0]; d.gain = P.in[I_ANORM0]; d.WT = (bf16_t*)(ws + WS_WIN0); d.K = 1024; d.N = W0V; d.nvalid = W0V; d.mode = 3; d.nblk = 80; d.item = r; return d; }
  r -= TR_I_IN0;
  if (r < TR_I_OUT) { d.W = P.in[I_WOUT0]; d.gain = nullptr; d.WT = (bf16_t*)(ws + WS_WOUT0); d.K = 1024; d.N = 1024; d.nvalid = 1024; d.mode = 0; d.nblk = 32; d.item = r; return d; }
  r -= TR_I_OUT;
  int L = 0;
  if (r >= TR_MOE) { r -= TR_MOE;
    if (r < TR_I_IN1) { d.W = P.in[I_WIN1]; d.gain = P.in[I_ANORM1]; d.WT = (bf16_t*)(ws + WS_WIN1); d.K = 1024; d.N = W1; d.nvalid = W1; d.mode = 3; d.nblk = 48; d.item = r; return d; }
    r -= TR_I_IN1;
    if (r < TR_I_OUT) { d.W = P.in[I_WOUT1]; d.gain = nullptr; d.WT = (bf16_t*)(ws + WS_WOUT1); d.K = 1024; d.N = 1024; d.nvalid = 1024; d.mode = 0; d.nblk = 32; d.item = r; return d; }
    r -= TR_I_OUT; L = 1; }
  const float* fnorm = P.in[L ? I_FNORM1 : I_FNORM0];
  if (r < 2 * TR_I_GU) { const int up = r >= TR_I_GU; if (up) r -= TR_I_GU; const int e = r >> 8;
    d.W = P.in[up ? (L ? I_WU1 : I_WU0) : (L ? I_WG1 : I_WG0)] + (size_t)e * 1024 * 512; d.gain = fnorm; d.WT = (bf16_t*)(ws + (L ? WS_WGU1 : WS_WGU0)) + (size_t)e * 1024 * 1024;
    d.K = 1024; d.N = 512; d.nvalid = 512; d.mode = up ? 2 : 1; d.nblk = 16; d.item = r & 255; return d; }
  r -= 2 * TR_I_GU;
  { const int e = r >> 8; d.W = P.in[L ? I_WD1 : I_WD0] + (size_t)e * 512 * 1024; d.gain = nullptr; d.WT = (bf16_t*)(ws + (L ? WS_WD1 : WS_WD0)) + (size_t)e * 1024 * 512; d.K = 512; d.N = 1024; d.nvalid = 1024; d.mode = 0; d.nblk = 32; d.item = r & 255; return d; }
}
DI void rms_row_to_bf16(const float* xrow, bf16_t* orow, int lane) {
  const f32x4* xr = (const f32x4*)xrow + lane;
  f32x4 v[4]; float s = 0.f;
#pragma unroll
  for (int j = 0; j < 4; ++j) { v[j] = xr[64 * j]; s += (v[j].x * v[j].x + v[j].y * v[j].y) + (v[j].z * v[j].z + v[j].w * v[j].w); }
  const float rstd = 1.0f / sqrtf(wave_sum(s) * (1.f / DM) + NORM_EPS);
  unsigned long long* o8 = (unsigned long long*)orow + lane;
#pragma unroll
  for (int j = 0; j < 4; ++j) o8[64 * j] = (unsigned long long)pk2(v[j].x * rstd, v[j].y * rstd) | ((unsigned long long)pk2(v[j].z * rstd, v[j].w * rstd) << 32);
}
DI void p0_prologue(const Ctx& F, const Params& P) {
  unsigned char* ws = P.ws; const int lane = lane_id_v(); const int tid = F.wave * 64 + lane;
  LAS float* scr = (LAS float*)(F.lds + F.wave * 16384);
  {
    const int NIT = TR_EARLY;
    int it = F.gw;
    f32x4 ra[8], rb[8];
    TrDesc da, db;
    if (it < NIT) { da = tr_desc(P, it); tr_load(da, lane, ra); }
    while (it < NIT) {
      const int itn = it + F.NGW;
      if (itn < NIT) { db = tr_desc(P, itn); tr_load(db, lane, rb); }
      tr_finish(da, lane, ra, scr);
      if (itn >= NIT) break;
      const int itn2 = itn + F.NGW;
      if (itn2 < NIT) { da = tr_desc(P, itn2); tr_load(da, lane, ra); }
      tr_finish(db, lane, rb, scr);
      it = itn2;
    }
  }
  for (int m = F.gw; m < NTOK; m += F.NGW) rms_row_to_bf16(P.in[I_X] + (size_t)m * DM, (bf16_t*)(ws + WS_XN) + (size_t)m * DM, lane);
  const int gt = blockIdx.x * 512 + tid, NGT = F.G * 512;
  for (int i = gt; i < 512; i += NGT) ((unsigned*)(ws + WS_XN + (size_t)NTOK * DM * 2))[i] = 0u;
  for (int i = gt; i < 128; i += NGT) ((int*)(ws + WS_CTL))[i] = 0;
  for (int i = gt; i < SEQ * 32; i += NGT) {
    const int t = i >> 5, k = i & 31;
    const float inv = (float)exp2(-(double)k * (13.287712379549449 / 32.0));
    const float ang = (float)t * inv;
    const double rev = (double)ang * 0.15915494309189535; const float fr = (float)(rev - rint(rev));
    ((float*)(ws + WS_ROPE))[i] = __builtin_amdgcn_cosf(fr); ((float*)(ws + WS_ROPE))[SEQ * 32 + i] = __builtin_amdgcn_sinf(fr);
  }
  for (int i = gt; i < 2 * 36 * 1024; i += NGT) {
    const int L = i / (36 * 1024), r = i % (36 * 1024), j = r >> 10, k = r & 1023;
    const float g = P.in[L ? I_FNORM1 : I_FNORM0][k];
    float w; if (j < 4) w = P.in[L ? I_WRG1 : I_WRG0][k * 4 + j]; else { const int gg = (j - 4) >> 3, e = (j - 4) & 7; w = P.in[L ? I_WRE1 : I_WRE0][((size_t)gg * 1024 + k) * 8 + e]; }
    w *= g;
    const unsigned hi = pk2(w, 0.f) & 0xffffu; const float lo = w - __uint_as_float(hi << 16);
    bf16_t* base = (bf16_t*)(ws + (L ? WS_WR1 : WS_WR0));
    base[r] = (bf16_t)hi; base[36 * 1024 + r] = (bf16_t)(pk2(lo, 0.f) & 0xffffu);
  }
  for (int i = gt; i < 2 * 36; i += NGT) { const int L = i / 36, j = i % 36; ((float*)(ws + (L ? WS_WR1 : WS_WR0) + 147456))[j] = (j < 4) ? P.in[L ? I_BRG1 : I_BRG0][j] : P.in[L ? I_BRE1 : I_BRE0][j - 4]; }
}

DI u32x4 normrope8(const u32x4 w, const float (&gv)[8], bool do_norm, const f32x4 (&cs)[2], const f32x4 (&sn)[2], int sub, float oscale) {
  float v[8] = {bflo(w.x), bfhi(w.x), bflo(w.y), bfhi(w.y), bflo(w.z), bfhi(w.z), bflo(w.w), bfhi(w.w)};
  if (do_norm) {
    float s = 0.f;
#pragma unroll
    for (int j = 0; j < 8; ++j) s += v[j] * v[j];
    s += __shfl_xor(s, 1); s += __shfl_xor(s, 2); s += __shfl_xor(s, 4);
    const float rstd = 1.0f / sqrtf(s * (1.f / 64.f) + NORM_EPS);
#pragma unroll
    for (int j = 0; j < 8; ++j) v[j] = v[j] * rstd * gv[j];
  }
  const float sg = (sub & 4) ? 1.f : -1.f;
  const float cv[8] = {cs[0].x, cs[0].y, cs[0].z, cs[0].w, cs[1].x, cs[1].y, cs[1].z, cs[1].w};
  const float sv[8] = {sn[0].x, sn[0].y, sn[0].z, sn[0].w, sn[1].x, sn[1].y, sn[1].z, sn[1].w};
  float o[8];
#pragma unroll
  for (int j = 0; j < 8; ++j) { const float pr = __shfl_xor(v[j], 4); o[j] = (v[j] * cv[j] + sg * pr * sv[j]) * oscale; }
  u32x4 r; r.x = pk2(o[0], o[1]); r.y = pk2(o[2], o[3]); r.z = pk2(o[4], o[5]); r.w = pk2(o[6], o[7]);
  return r;
}
struct Tok0 { u32x4 cb, cc[3], ch[3]; };
DI void p1b_transform0(const Ctx& F, const Params& P) {
  bf16_t* PROJ = (bf16_t*)(P.ws + WS_PROJ); bf16_t* MIX = (bf16_t*)(P.ws + WS_MIX);
  const int lane = lane_id_v();
  float cw[8][3];
#pragma unroll
  for (int j = 0; j < 8; ++j) { const float* w = P.in[I_CONVW] + (8 * lane + j) * 3; cw[j][0] = w[0]; cw[j][1] = w[1]; cw[j][2] = w[2]; }
  auto load = [&](Tok0& T, int m) {
    const int t = m & (SEQ - 1); const bf16_t* row = PROJ + (size_t)m * W0P;
    T.cb = *(const u32x4*)(row + C_CB + 8 * lane);
#pragma unroll
    for (int d = 0; d < 3; ++d) { const int back = 2 - d; const bf16_t* r2 = row - (size_t)(t >= back ? back : 0) * W0P; T.cc[d] = *(const u32x4*)(r2 + C_CC + 8 * lane); T.ch[d] = *(const u32x4*)(r2 + C_CH + 8 * lane); }
  };
  auto process = [&](const Tok0& T, int m) {
    const int t = m & (SEQ - 1);
    { float u[3][8];
#pragma unroll
      for (int d = 0; d < 3; ++d) { const bool okd = t >= 2 - d; const u32x4 a = T.cc[d], b = T.ch[d];
        u[d][0] = okd ? bflo(a.x) * bflo(b.x) : 0.f; u[d][1] = okd ? bfhi(a.x) * bfhi(b.x) : 0.f; u[d][2] = okd ? bflo(a.y) * bflo(b.y) : 0.f; u[d][3] = okd ? bfhi(a.y) * bfhi(b.y) : 0.f;
        u[d][4] = okd ? bflo(a.z) * bflo(b.z) : 0.f; u[d][5] = okd ? bfhi(a.z) * bfhi(b.z) : 0.f; u[d][6] = okd ? bflo(a.w) * bflo(b.w) : 0.f; u[d][7] = okd ? bfhi(a.w) * bfhi(b.w) : 0.f; }
      const u32x4 cb = T.cb;
      const float cbv[8] = {bflo(cb.x), bfhi(cb.x), bflo(cb.y), bfhi(cb.y), bflo(cb.z), bfhi(cb.z), bflo(cb.w), bfhi(cb.w)};
      float o[8];
#pragma unroll
      for (int j = 0; j < 8; ++j) o[j] = cbv[j] * (u[0][j] * cw[j][0] + u[1][j] * cw[j][1] + u[2][j] * cw[j][2]);
      u32x4 r; r.x = pk2(o[0], o[1]); r.y = pk2(o[2], o[3]); r.z = pk2(o[4], o[5]); r.w = pk2(o[6], o[7]);
      *(u32x4*)(MIX + (size_t)m * DM + 8 * lane) = r; }
  };
  Tok0 A, B;
  int m = F.gw;
  if (m < NTOK) load(A, m);
  while (m < NTOK) {
    const int m1 = m + F.NGW;
    if (m1 < NTOK) load(B, m1);
    process(A, m);
    if (m1 >= NTOK) break;
    const int m2 = m1 + F.NGW;
    if (m2 < NTOK) load(A, m2);
    process(B, m1);
    m = m2;
  }
}

DI unsigned f2key(float f) { const unsigned b = __float_as_uint(f); return b ^ ((unsigned)((int)b >> 31) | 0x80000000u); }
DI s16x4 tr_read(LAS unsigned char* p) { typedef short v4i16_t __attribute__((ext_vector_type(4))); return __builtin_bit_cast(s16x4, __builtin_amdgcn_ds_read_tr16_b64_v4i16((LAS v4i16_t*)p)); }
#define DPP_U(v, ctrl) ((unsigned)__builtin_amdgcn_update_dpp(0, (int)(v), (ctrl), 0xF, 0xF, true))
DI unsigned wave_total_u(unsigned v) {
  v += DPP_U(v, 0xB1); v += DPP_U(v, 0x4E); v += DPP_U(v, 0x124); v += DPP_U(v, 0x128);
  return (unsigned)__builtin_amdgcn_readlane((int)v, 0) + (unsigned)__builtin_amdgcn_readlane((int)v, 16) + (unsigned)__builtin_amdgcn_readlane((int)v, 32) + (unsigned)__builtin_amdgcn_readlane((int)v, 48);
}
DI unsigned wave_maxall_u(unsigned v) {
  v = max(v, DPP_U(v, 0xB1)); v = max(v, DPP_U(v, 0x4E)); v = max(v, DPP_U(v, 0x124)); v = max(v, DPP_U(v, 0x128));
  const unsigned a = (unsigned)__builtin_amdgcn_readlane((int)v, 0), b = (unsigned)__builtin_amdgcn_readlane((int)v, 16), c = (unsigned)__builtin_amdgcn_readlane((int)v, 32), d = (unsigned)__builtin_amdgcn_readlane((int)v, 48);
  return max(max(a, b), max(c, d));
}
DI unsigned lane_prefix(unsigned long long m) { return __builtin_amdgcn_mbcnt_hi((unsigned)(m >> 32), __builtin_amdgcn_mbcnt_lo((unsigned)m, 0u)); }

DI void dsa_phase(const Ctx& F, const Params& P) {
  const bf16_t* PROJ = (const bf16_t*)(P.ws + WS_PROJ); bf16_t* MIX = (bf16_t*)(P.ws + WS_MIX);
  const bf16_t* IKF = (const bf16_t*)(P.ws + WS_IKF); const bf16_t* KF = (const bf16_t*)(P.ws + WS_KF); const bf16_t* VTF = (const bf16_t*)(P.ws + WS_VTF);
  LAS unsigned* sc = (LAS unsigned*)F.lds;
  LAS unsigned* msk32 = (LAS unsigned*)(F.lds + LDS_MISC);
  LAS float* trscr = (LAS float*)(F.lds + F.wave * 16384);
  LAS unsigned* dctl = (LAS unsigned*)(F.lds + LDS_HIST + 10240);
  if (threadIdx.x == 0) { dctl[0] = 0u; dctl[1] = 0u; }
  __syncthreads();
  int itn = 0;
#ifndef TR_HELP
#define TR_HELP 6
#endif
  auto tr_pop = [&]() -> int { unsigned k = 0u; if (lane_id_v() == 0) k = __hip_atomic_fetch_add(dctl + 1, 1u, __ATOMIC_RELAXED, __HIP_MEMORY_SCOPE_WORKGROUP);
    return TR_EARLY + (int)blockIdx.x + (int)__builtin_amdgcn_readfirstlane((int)k) * (int)gridDim.x; };
  LAS float* part = (LAS float*)F.lds;
  const int w = F.wave;
  float cshift; { const int l0 = lane_id_v(); cshift = 8.f * wave_max(fabsf(P.in[I_QN0][l0])) * wave_max(fabsf(P.in[I_KN0][l0])) * 1.02f; }
  const float c1 = 0.125f * LOG2E, c2 = __builtin_amdgcn_readfirstlane(__float_as_int(cshift * LOG2E)) == 0 ? 0.f : __int_as_float(__builtin_amdgcn_readfirstlane(__float_as_int(cshift * LOG2E)));
#ifdef TIMEDSA
#ifndef TIMEBLK
#define TIMEBLK 0
#endif
#ifndef TIMEWAVE
#define TIMEWAVE 0
#endif
  unsigned long long tacc = 0ull, tmark = 0ull;
#define DSA_T0(n) if (TIMEDSA == (n)) tmark = __builtin_amdgcn_s_memrealtime();
#define DSA_T1(n) if (TIMEDSA == (n)) tacc += __builtin_amdgcn_s_memrealtime() - tmark;
#else
#define DSA_T0(n)
#define DSA_T1(n)
#endif
  for (int v = blockIdx.x; v < 8192; v += gridDim.x) {
    const int cidx = v & 255, jj = v >> 8, b = jj >> 1, tb = (jj & 1) ? (511 - cidx) : cidx;
    const int t0 = tb * 8; const size_t rb = (size_t)b * SEQ;
    const int ntile = (t0 + 8 + 31) >> 5;
    const int lane = lane_id_v();
    const int c = lane & 31, half = lane >> 5, qc = c >> 2, hx = c & 3;
    DSA_T0(1)
    {
      bf16x8 af[4];
      { const bf16_t* ap = PROJ + (rb + t0 + qc) * W0P + C_IQ + hx * 64 + 8 * half;
#pragma unroll
        for (int ks = 0; ks < 4; ++ks) af[ks] = *(const bf16x8*)(ap + 16 * ks); }
      float wq[4][4];
#pragma unroll
      for (int g = 0; g < 4; ++g) { const u32x2 ww = *(const u32x2*)(PROJ + (rb + t0 + 2 * g + half) * W0P + C_IW);
        wq[g][0] = bflo(ww.x) * 0.0625f; wq[g][1] = bfhi(ww.x) * 0.0625f; wq[g][2] = bflo(ww.y) * 0.0625f; wq[g][3] = bfhi(ww.y) * 0.0625f; }
      const bf16_t* fb = IKF + ((size_t)b * 128 * 4 * 64 + lane) * 8;
      const int Tlast = ntile - 1;
      auto ld1 = [&](bf16x8 (&d)[4], int T) { const int Tc = T < Tlast ? T : Tlast;
#pragma unroll
        for (int ks = 0; ks < 4; ++ks) d[ks] = *(const bf16x8*)(fb + (size_t)(Tc * 4 + ks) * 512); };
      auto cp1 = [&](const bf16x8 (&bfr)[4], int T) {
        f32x16 acc;
#pragma unroll
        for (int i = 0; i < 16; ++i) acc[i] = 0.f;
#pragma unroll
        for (int ks = 0; ks < 4; ++ks) acc = __builtin_amdgcn_mfma_f32_32x32x16_bf16(af[ks], bfr[ks], acc, 0, 0, 0);
        const int s = 32 * T + c;
        const bool edge = 32 * T + 31 > t0;
#pragma unroll
        for (int g = 0; g < 4; ++g) {
          float sv = __builtin_fmaf(wq[g][3], fmaxf(acc[4 * g + 3], 0.f), __builtin_fmaf(wq[g][2], fmaxf(acc[4 * g + 2], 0.f), __builtin_fmaf(wq[g][1], fmaxf(acc[4 * g + 1], 0.f), __builtin_fmaf(wq[g][0], fmaxf(acc[4 * g], 0.f), 0.f))));
          const int ql = 2 * g + half;
          unsigned key = f2key(sv);
          if (edge) key = (s <= t0 + ql) ? key : 0u;
          sc[ql * 4096 + s] = key;
        } };
      bf16x8 r0[4], r1[4], r2[4], r3[4];
      if (w < ntile) { ld1(r0, w); ld1(r1, w + 8); ld1(r2, w + 16); ld1(r3, w + 24); }
      for (int T = w; T < ntile; T += 32) {
        cp1(r0, T); ld1(r0, T + 32); __builtin_amdgcn_sched_barrier(0);
        if (T + 8 < ntile) { cp1(r1, T + 8); ld1(r1, T + 40); __builtin_amdgcn_sched_barrier(0); }
        if (T + 16 < ntile) { cp1(r2, T + 16); ld1(r2, T + 48); __builtin_amdgcn_sched_barrier(0); }
        if (T + 24 < ntile) { cp1(r3, T + 24); ld1(r3, T + 56); __builtin_amdgcn_sched_barrier(0); }
      }
    }
    __syncthreads();
    asm volatile("" ::: "memory"); __builtin_amdgcn_sched_barrier(0);
    DSA_T1(1)
    DSA_T0(2)
    const int t = t0 + w;
    LAS unsigned* lst = (LAS unsigned*)(F.lds + LDS_LIST + w * 1024);
    int nvalid = 256;
    {
      const int lane = lane_id_v();
      if (t < 256) {
        nvalid = t + 1;
#pragma unroll
        for (int p = 0; p < 4; ++p) lst[p * 64 + lane] = (unsigned)(p * 64 + lane) << 7;
      } else {
        const int nch = (t >> 10) + 1;
        unsigned u[64];
#pragma unroll
        for (int ch = 0; ch < 4; ++ch) {
          if (ch < nch) {
#pragma unroll
            for (int k2 = 0; k2 < 16; ++k2) { const int j = 16 * ch + k2; const unsigned x = sc[w * 4096 + 64 * j + lane]; u[j] = (lane <= t - 64 * j) ? x : 0u; }
          } else {
#pragma unroll
            for (int k2 = 0; k2 < 16; ++k2) u[16 * ch + k2] = 0u;
          }
        }
        auto count_ge = [&](unsigned trial) -> unsigned { unsigned cnt = 0u;
#pragma unroll
          for (int ch = 0; ch < 4; ++ch) if (ch < nch) {
#pragma unroll
            for (int k2 = 0; k2 < 16; ++k2) cnt += (u[16 * ch + k2] >= trial) ? 1u : 0u;
          }
          return wave_total_u(cnt); };
        unsigned P, cnt = 0u, above = 0u;
        { unsigned mx = 0u;
#pragma unroll
          for (int ch = 0; ch < 4; ++ch) if (ch < nch) {
#pragma unroll
            for (int k2 = 0; k2 < 16; ++k2) mx = max(mx, u[16 * ch + k2]);
          }
          P = wave_maxall_u(mx) & 0xFF800000u; }
        bool found = false;
        for (int step = 0; step < 4; ++step) { cnt = count_ge(P); if (cnt >= 256u) { found = true; break; } above = cnt; P -= 0x00800000u; }
        if (!found) { unsigned p = 0u;
          for (int bit = 31; bit >= 23; --bit) { const unsigned tr = p | (1u << bit); if (count_ge(tr) >= 256u) p = tr; }
          P = p; cnt = count_ge(P); above = (P >= 0xFF800000u) ? 0u : count_ge(P + 0x00800000u); }
        bool exact = cnt == 256u;
        unsigned need = 256u - above;
        LAS unsigned* hist = (LAS unsigned*)(F.lds + LDS_HIST + w * 1280);
#define DSA_LEVEL(S) do { \
          *(LAS u32x4*)(hist + 4 * lane) = (u32x4){0u, 0u, 0u, 0u}; \
          asm volatile("" ::: "memory"); \
          const unsigned cap_ = 256u + (unsigned)lane; \
          _Pragma("unroll") for (int ch = 0; ch < 4; ++ch) if (ch < nch) { \
            _Pragma("unroll") for (int k2 = 0; k2 < 16; ++k2) { const unsigned y_ = min((u[16 * ch + k2] ^ P) >> (S), cap_); \
              __hip_atomic_fetch_add(hist + y_, 1u, __ATOMIC_RELAXED, __HIP_MEMORY_SCOPE_WORKGROUP); } } \
          asm volatile("s_waitcnt lgkmcnt(0)" ::: "memory"); \
          const u32x4 h_ = *(LAS u32x4*)(hist + 4 * lane); \
          const unsigned T_ = h_.x + h_.y + h_.z + h_.w; unsigned incl_ = T_; \
          _Pragma("unroll") for (int d_ = 1; d_ < 64; d_ *= 2) { const unsigned v_ = (unsigned)__shfl_down((int)incl_, d_, 64); incl_ += (lane + d_ < 64) ? v_ : 0u; } \
          const unsigned excl_ = incl_ - T_;                        \
          const bool hit_ = incl_ >= need && excl_ < need;          \
          unsigned c_ = excl_, b_ = 3u, hb_ = h_.w; \
          if (c_ + h_.w < need) { c_ += h_.w; b_ = 2u; hb_ = h_.z; if (c_ + h_.z < need) { c_ += h_.z; b_ = 1u; hb_ = h_.y; if (c_ + h_.y < need) { c_ += h_.y; b_ = 0u; hb_ = h_.x; } } } \
          const unsigned long long hm_ = __ballot(hit_); const int src_ = hm_ ? __builtin_ctzll(hm_) : 0; \
          const unsigned bin_ = (unsigned)__builtin_amdgcn_readlane((int)(4u * (unsigned)lane + b_), src_), ab_ = (unsigned)__builtin_amdgcn_readlane((int)c_, src_), hbb_ = (unsigned)__builtin_amdgcn_readlane((int)hb_, src_); \
          need -= ab_; P |= bin_ << (S); exact = hbb_ == need; } while (0)
        if (!exact) { DSA_LEVEL(15); if (!exact) { DSA_LEVEL(7); if (!exact) DSA_LEVEL(0); } }
        const unsigned thr = exact ? P - 1u : P;
        int base = 0;
#pragma unroll
        for (int ch = 0; ch < 4; ++ch) if (ch < nch) {
#pragma unroll
          for (int k2 = 0; k2 < 16; ++k2) { const int j = 16 * ch + k2; const bool sel = u[j] > thr; const unsigned long long m = __ballot(sel);
            if (sel) lst[base + (int)lane_prefix(m)] = (unsigned)(64 * j + lane) << 7;
            base += __builtin_popcountll(m); }
        }
        if (!exact) { const int need = 256 - base; int tbf = 0;
#pragma unroll
          for (int ch = 0; ch < 4; ++ch) if (ch < nch) {
#pragma unroll
            for (int k2 = 0; k2 < 16; ++k2) { const int j = 16 * ch + k2; const bool eq = u[j] == thr; const unsigned long long m = __ballot(eq); const int r = tbf + (int)lane_prefix(m);
              if (eq && r < need) lst[base + r] = (unsigned)(64 * j + lane) << 7;
              tbf += __builtin_popcountll(m); }
          } }
      }
    }
    asm volatile("" ::: "memory"); __builtin_amdgcn_sched_barrier(0);
    DSA_T1(2)
    DSA_T0(3)
    {
      DSA_T0(4)
      const int lane = lane_id_v(); const int hcol = lane & 15, g = lane >> 4;
      const unsigned char* KRb = P.ws + WS_KF + rb * 128; const unsigned char* VRb = P.ws + WS_VTF + rb * 128;
      LAS unsigned char* ring = F.lds + w * 16384;
      const int rl = lane >> 3;
      const unsigned pk0 = (unsigned)((lane & 7) ^ rl) << 4, pv0 = (unsigned)(lane & 7) << 4;
#define DSA_ISSUE(c) do { _Pragma("unroll") for (int i_ = 0; i_ < 4; ++i_) { const unsigned off_ = lst[32 * ((c) & 7) + 8 * i_ + rl]; \
        const unsigned char* src_ = ((c) < 8 ? KRb + (pk0 ^ (unsigned)(i_ << 4)) : VRb + pv0) + off_; \
        __builtin_amdgcn_global_load_lds((const unsigned*)src_, (LAS unsigned*)(ring + ((c) & 3) * 4096 + i_ * 1024), 16, 0, 0); } } while (0)
#define DSA_WAITV(n) asm volatile("s_waitcnt vmcnt(" #n ")" ::: "memory")
      bf16x8 qf[2];
      { const bf16_t* qp = PROJ + (rb + t) * W0P + C_Q + (hcol & 7) * 64 + 8 * g; const float qs = hcol < 8 ? 0.125f * LOG2E : 0.f;
#pragma unroll
        for (int ks = 0; ks < 2; ++ks) { const u32x4 qv = *(const u32x4*)(qp + 32 * ks);
          u32x4 qo; qo.x = pk2(bflo(qv.x) * qs, bfhi(qv.x) * qs); qo.y = pk2(bflo(qv.y) * qs, bfhi(qv.y) * qs); qo.z = pk2(bflo(qv.z) * qs, bfhi(qv.z) * qs); qo.w = pk2(bflo(qv.w) * qs, bfhi(qv.w) * qs);
          qf[ks] = __builtin_bit_cast(bf16x8, qo); } }
      asm volatile("s_waitcnt vmcnt(0)" ::: "memory");
      DSA_ISSUE(0); DSA_ISSUE(1); DSA_ISSUE(2); DSA_ISSUE(3);
      const unsigned ka0 = (unsigned)(hcol * 128 + ((g ^ ((hcol & 7) ^ (hcol >> 3))) << 4));
      bf16x8 pf[8];
      const bool full = nvalid == 256;
#define DSA_KSTEP(c, nwait) do { DSA_WAITV(nwait); \
        LAS unsigned char* kb_ = ring + ((c) & 3) * 4096; \
        const bf16x8 k00 = *(const LAS bf16x8*)(kb_ + ka0), k01 = *(const LAS bf16x8*)(kb_ + (ka0 ^ 64u)), k10 = *(const LAS bf16x8*)(kb_ + 2048 + (ka0 ^ 32u)), k11 = *(const LAS bf16x8*)(kb_ + 2048 + (ka0 ^ 96u)); \
        asm volatile("s_waitcnt lgkmcnt(0)" ::: "memory"); \
        DSA_ISSUE((c) + 4); \
        f32x4 a0_ = {-c2, -c2, -c2, -c2}, a1_ = {-c2, -c2, -c2, -c2}; \
        a0_ = __builtin_amdgcn_mfma_f32_16x16x32_bf16(k00, qf[0], a0_, 0, 0, 0); a1_ = __builtin_amdgcn_mfma_f32_16x16x32_bf16(k10, qf[0], a1_, 0, 0, 0); \
        a0_ = __builtin_amdgcn_mfma_f32_16x16x32_bf16(k01, qf[1], a0_, 0, 0, 0); a1_ = __builtin_amdgcn_mfma_f32_16x16x32_bf16(k11, qf[1], a1_, 0, 0, 0); \
        _Pragma("unroll") for (int r_ = 0; r_ < 4; ++r_) { \
          const float e0_ = __builtin_amdgcn_exp2f(a0_[r_]), e1_ = __builtin_amdgcn_exp2f(a1_[r_]); \
          a0_[r_] = (full || 32 * (c) + 4 * g + r_ < nvalid) ? e0_ : 0.f; a1_[r_] = (full || 32 * (c) + 16 + 4 * g + r_ < nvalid) ? e1_ : 0.f; } \
        u32x4 pw_; pw_.x = pk2(a0_[0], a0_[1]); pw_.y = pk2(a0_[2], a0_[3]); pw_.z = pk2(a1_[0], a1_[1]); pw_.w = pk2(a1_[2], a1_[3]); pf[c] = __builtin_bit_cast(bf16x8, pw_); \
        __builtin_amdgcn_sched_barrier(0); } while (0)
      DSA_KSTEP(0, 12); DSA_KSTEP(1, 12); DSA_KSTEP(2, 12); DSA_KSTEP(3, 12); DSA_KSTEP(4, 12); DSA_KSTEP(5, 12); DSA_KSTEP(6, 12); DSA_KSTEP(7, 12);
      f32x4 o[4], ol = {0.f, 0.f, 0.f, 0.f};
#pragma unroll
      for (int n = 0; n < 4; ++n) o[n] = (f32x4){0.f, 0.f, 0.f, 0.f};
      const bf16x8 ones8 = (bf16x8){0x3f80, 0x3f80, 0x3f80, 0x3f80, 0x3f80, 0x3f80, 0x3f80, 0x3f80};
      const int q4 = (lane & 15) >> 2, p4 = lane & 3;
      const unsigned va0 = (unsigned)((4 * g + q4) * 128 + 8 * p4);
#define DSA_VSTEP(c, nwait) do { DSA_WAITV(nwait); \
        LAS unsigned char* vb_ = ring + ((c) & 3) * 4096 + va0; \
        ol = __builtin_amdgcn_mfma_f32_16x16x32_bf16(ones8, pf[c], ol, 0, 0, 0); \
        _Pragma("unroll") for (int n = 0; n < 4; ++n) { \
          const s16x4 lo_ = tr_read(vb_ + 32 * n), hi_ = tr_read(vb_ + 2048 + 32 * n); \
          const bf16x8 vf_ = __builtin_shufflevector(lo_, hi_, 0, 1, 2, 3, 4, 5, 6, 7); \
          o[n] = __builtin_amdgcn_mfma_f32_16x16x32_bf16(vf_, pf[c], o[n], 0, 0, 0); } \
        if ((c) < 4) { asm volatile("s_waitcnt lgkmcnt(0)" ::: "memory"); DSA_ISSUE(12 + (c)); } \
        __builtin_amdgcn_sched_barrier(0); } while (0)
      DSA_VSTEP(0, 12); DSA_VSTEP(1, 12); DSA_VSTEP(2, 12); DSA_VSTEP(3, 12); DSA_VSTEP(4, 12); DSA_VSTEP(5, 8); DSA_VSTEP(6, 4); DSA_VSTEP(7, 0);
      if (hcol < 8) { const float inv = 1.0f / ol[0]; bf16_t* op = MIX + (rb + t) * DM + 512 + hcol * 64 + 4 * g;
#pragma unroll
        for (int n = 0; n < 4; ++n) { u32x2 w2; w2.x = pk2(o[n][0] * inv, o[n][1] * inv); w2.y = pk2(o[n][2] * inv, o[n][3] * inv); *(u32x2*)(op + 16 * n) = w2; } }
    }
    DSA_T1(4)
    DSA_T0(5)
    {
      unsigned a = 0u; if (lane_id_v() == 0) a = __hip_atomic_fetch_add(dctl, 1u, __ATOMIC_RELAXED, __HIP_MEMORY_SCOPE_WORKGROUP);
      a = (unsigned)__builtin_amdgcn_readfirstlane((int)a) - 8u * (unsigned)itn; ++itn;
      if (a < (unsigned)TR_HELP) { const int tit = tr_pop();
        if (tit < TR_TOTAL) { const int tl = lane_id_v(); const TrDesc td = tr_desc(P, tit); f32x4 tr8[8]; tr_load(td, tl, tr8); tr_finish(td, tl, tr8, trscr); } }
    }
    DSA_T1(5)
    DSA_T0(6)
    __syncthreads();
    DSA_T1(6)
    DSA_T1(3)
  }
  for (;;) { const int tit = tr_pop(); if (tit >= TR_TOTAL) break; const int tl = lane_id_v(); const TrDesc td = tr_desc(P, tit); f32x4 tr8[8]; tr_load(td, tl, tr8); tr_finish(td, tl, tr8, trscr); }
#ifdef TIMEDSA
  if (blockIdx.x == TIMEBLK && w == TIMEWAVE && lane_id_v() == 0) { unsigned long long* tsw = (unsigned long long*)(P.ws + WS_CTL + 4096); tsw[0] = 0ull; tsw[1] = tacc; }
#endif
}

DI void route_lane(const float (&lg)[36], int& x0, int& x1, float& g0, float& g1) {
  int gs = 0; float gm = lg[0];
#pragma unroll
  for (int j = 1; j < 4; ++j) { const bool gt = lg[j] > gm; gm = gt ? lg[j] : gm; gs = gt ? j : gs; }
  float z = 0.f;
#pragma unroll
  for (int j = 0; j < 4; ++j) z += __expf(lg[j] - gm);
  const float pg = 1.0f / z;
  float le[8];
#pragma unroll
  for (int i = 0; i < 8; ++i) le[i] = gs == 0 ? lg[4 + i] : (gs == 1 ? lg[12 + i] : (gs == 2 ? lg[20 + i] : lg[28 + i]));
  int i0e = 0; float m0 = le[0];
#pragma unroll
  for (int i = 1; i < 8; ++i) { const bool gt = le[i] > m0; m0 = gt ? le[i] : m0; i0e = gt ? i : i0e; }
  int i1e = -1; float m1 = -INFINITY;
#pragma unroll
  for (int i = 0; i < 8; ++i) { const bool gt = (i != i0e) && (le[i] > m1); m1 = gt ? le[i] : m1; i1e = gt ? i : i1e; }
  const float e1 = __expf(m1 - m0);
  g0 = pg / (1.0f + e1); g1 = pg * e1 / (1.0f + e1);
  x0 = gs * 8 + i0e; x1 = gs * 8 + i1e;
}
DI void router_phase(const Ctx& F, const Params& P, int L) {
  unsigned char* ws = P.ws;
  constexpr int WSTR = 2064;
  constexpr int L_WH = 0, L_WL = 36 * WSTR, L_ZERO = 2 * 36 * WSTR, L_CNT = L_ZERO + WSTR, L_ASG = L_CNT + 256, L_RS = L_ASG + 4096;
  static_assert(L_ASG + 4096 <= LDS_BYTES - 16, "router LDS map");
  LAS unsigned char* lds = F.lds;
  LAS int* lcnt = (LAS int*)(lds + L_CNT); LAS int* lbase = lcnt + 32;
  LAS i32x4* lasg = (LAS i32x4*)(lds + L_ASG);
  const bf16_t* wsrc = (const bf16_t*)(ws + (L ? WS_WR1 : WS_WR0));
  const float* bias = (const float*)(ws + (L ? WS_WR1 : WS_WR0) + 147456);
  const int lane = lane_id_v(); const int w = F.wave; const int tid = w * 64 + lane;
  int* cnt = (int*)(ws + WS_CTL) + L * 64; int* list = (int*)(ws + WS_LIST); float* RSL = (float*)(ws + WS_RSL);
  int4* asg = (int4*)(ws + WS_ASG); float2* asgg = (float2*)(ws + WS_ASGG);
  const bf16_t* XB = (const bf16_t*)(ws + WS_XB);
  const int niter = (NTOK + F.NGW - 1) / F.NGW;
  for (int i0 = 0; i0 < niter; i0 += 32) {
    for (int i = tid; i < 2 * 36 * 128; i += 512) { const int row = i >> 7, ch = i & 127; *(LAS u32x4*)(lds + row * WSTR + ch * 16) = *(const u32x4*)(wsrc + row * 1024 + ch * 8); }
    for (int i = tid; i < 128; i += 512) *(LAS u32x4*)(lds + L_ZERO + i * 16) = (u32x4){0u, 0u, 0u, 0u};
    if (tid < 32) lcnt[tid] = 0;
    __syncthreads();
    const int c = lane & 31, half = lane >> 5;
    const int it_r = i0 + c; const int m_r = F.gw + it_r * F.NGW; const bool ok_r = (it_r < niter) && (m_r < NTOK);
    const bf16_t* arow = XB + (size_t)(ok_r ? m_r : F.gw) * DM + 8 * half;
    const int b0off = c * WSTR + 16 * half;
    const int b1off = (c < 4 ? (32 + c) * WSTR : (L_ZERO - L_WH)) + 16 * half;
    f32x16 d0, d1, dx;
#pragma unroll
    for (int i = 0; i < 16; ++i) { d0[i] = 0.f; d1[i] = 0.f; dx[i] = 0.f; }
    bf16x8 ar[8];
#pragma unroll
    for (int j = 0; j < 8; ++j) ar[j] = *(const bf16x8*)(arow + 16 * j);
    for (int k8 = 0; k8 < 64; k8 += 8) {
#pragma unroll
      for (int j = 0; j < 8; ++j) {
        const int ks = k8 + j;
        const bf16x8 a_cur = ar[j];
        const bf16x8 h0 = *(const LAS bf16x8*)(lds + L_WH + b0off + 32 * ks), l0 = *(const LAS bf16x8*)(lds + L_WL + b0off + 32 * ks);
        const bf16x8 h1 = *(const LAS bf16x8*)(lds + L_WH + b1off + 32 * ks), l1 = *(const LAS bf16x8*)(lds + (c < 4 ? L_WL : L_WH) + b1off + 32 * ks);
        d0 = __builtin_amdgcn_mfma_f32_32x32x16_bf16(a_cur, h0, d0, 0, 0, 0); d0 = __builtin_amdgcn_mfma_f32_32x32x16_bf16(a_cur, l0, d0, 0, 0, 0);
        d1 = __builtin_amdgcn_mfma_f32_32x32x16_bf16(a_cur, h1, d1, 0, 0, 0); d1 = __builtin_amdgcn_mfma_f32_32x32x16_bf16(a_cur, l1, d1, 0, 0, 0);
        dx = __builtin_amdgcn_mfma_f32_32x32x16_bf16(a_cur, a_cur, dx, 0, 0, 0);
        if (k8 + 8 < 64) ar[j] = *(const bf16x8*)(arow + 16 * (ks + 8));
      }
    }
    __syncthreads();
    LAS float* tw = (LAS float*)(lds + w * 8192);
#pragma unroll
    for (int i = 0; i < 16; ++i) { const int row = (i & 3) + 8 * (i >> 2) + 4 * half; tw[row * 40 + c] = d0[i]; if (c < 4) tw[row * 40 + 32 + c] = d1[i]; if (row == c) tw[row * 40 + 36] = dx[i]; }
    asm volatile("s_waitcnt lgkmcnt(0)" ::: "memory");
    if (lane < 32) {
      const int it_t = i0 + lane; const int m = F.gw + it_t * F.NGW;
      if (it_t < niter && m < NTOK) {
        const LAS f32x4* tr4 = (const LAS f32x4*)(tw + lane * 40);
        float raw[40];
#pragma unroll
        for (int q = 0; q < 10; ++q) { const f32x4 v4 = tr4[q]; raw[4 * q] = v4.x; raw[4 * q + 1] = v4.y; raw[4 * q + 2] = v4.z; raw[4 * q + 3] = v4.w; }
        const float rstd = 1.0f / sqrtf(raw[36] * (1.f / DM) + NORM_EPS);
        float lg[36];
#pragma unroll
        for (int j = 0; j < 36; ++j) lg[j] = raw[j] * rstd + bias[j];
        int x0, x1; float g0, g1; route_lane(lg, x0, x1, g0, g1);
        const int r0 = __hip_atomic_fetch_add(lcnt + x0, 1, __ATOMIC_RELAXED, __HIP_MEMORY_SCOPE_WORKGROUP);
        const int r1 = __hip_atomic_fetch_add(lcnt + x1, 1, __ATOMIC_RELAXED, __HIP_MEMORY_SCOPE_WORKGROUP);
        lasg[lane * 8 + w] = (i32x4){x0, x1, r0, r1}; asgg[m] = make_float2(g0, g1);
        tw[lane * 40 + 37] = rstd;
      }
    }
    __syncthreads();
    if (tid < 32) lbase[tid] = atomicAdd(cnt + tid, lcnt[tid]);
    __syncthreads();
    if (tid < 256) {
      const int ii = tid >> 3, wv = tid & 7; const int m = (int)blockIdx.x * 8 + wv + (i0 + ii) * F.NGW;
      if (i0 + ii < niter && m < NTOK) {
        const i32x4 a = lasg[tid]; const int r0 = lbase[a.x] + a.z, r1 = lbase[a.y] + a.w;
        const float rs = ((const LAS float*)(lds + wv * 8192))[ii * 40 + 37];
        list[a.x * 65536 + r0] = m; list[a.y * 65536 + r1] = m; asg[m] = make_int4(a.x, a.y, r0, r1);
        RSL[a.x * 65536 + r0] = rs; RSL[a.y * 65536 + r1] = rs;
      }
    }
    __syncthreads();
  }
}
DI void moe_setup(const Ctx& F, const Params& P, int L) {
  LAS int* pb = (LAS int*)(F.lds + LDS_MISC); LAS int* cl = pb + 64;
  const int* cnt = (const int*)(P.ws + WS_CTL) + L * 64;
  const int tid = F.wave * 64 + lane_id_v();
  __syncthreads();
  if (tid < 32) cl[tid] = cnt[tid];
  __syncthreads();
  if (tid == 0) { int a = 0; for (int e = 0; e < NEXP; ++e) { pb[e] = a; a += (cl[e] + 255) >> 8; } pb[NEXP] = a; }
  __syncthreads();
}
struct CRows { u32x2 x[4], y0[4], y1[4]; };
DI void combine_phase(const Ctx& F, const Params& P, int L, bool with_norm) {
  unsigned char* ws = P.ws;
  moe_setup(F, P, L);
  const LAS int* pb = (const LAS int*)(F.lds + LDS_MISC);
  const int4* asg = (const int4*)(ws + WS_ASG); const float2* asgg = (const float2*)(ws + WS_ASGG);
  const bf16_t* Y = (const bf16_t*)(ws + WS_PROJ); bf16_t* XN = (bf16_t*)(ws + WS_XN); bf16_t* XB = (bf16_t*)(ws + WS_XB);
  const int lane = lane_id_v();
  auto rows = [&](CRows& R, int m, const int4 a) {
    const size_t row0 = (size_t)pb[a.x] * 256 + a.z, row1 = (size_t)pb[a.y] * 256 + a.w;
    const u32x2* xr = (const u32x2*)(XB + (size_t)m * DM) + lane; const u32x2* y0 = (const u32x2*)(Y + row0 * DM) + lane; const u32x2* y1 = (const u32x2*)(Y + row1 * DM) + lane;
#pragma unroll
    for (int j = 0; j < 4; ++j) { R.x[j] = xr[64 * j]; R.y0[j] = y0[64 * j]; R.y1[j] = y1[64 * j]; } };
  auto finish = [&](const CRows& R, int m, const float2 gg) {
    u32x2* xr = (u32x2*)(XB + (size_t)m * DM) + lane; f32x4* orow = (f32x4*)(P.out + (size_t)m * DM) + lane;
    f32x4 v[4]; float ss = 0.f;
#pragma unroll
    for (int j = 0; j < 4; ++j) { const u32x2 xb = R.x[j], a0 = R.y0[j], a1 = R.y1[j]; f32x4 x = (f32x4){bflo(xb.x), bfhi(xb.x), bflo(xb.y), bfhi(xb.y)};
      x.x += gg.x * bflo(a0.x) + gg.y * bflo(a1.x); x.y += gg.x * bfhi(a0.x) + gg.y * bfhi(a1.x); x.z += gg.x * bflo(a0.y) + gg.y * bflo(a1.y); x.w += gg.x * bfhi(a0.y) + gg.y * bfhi(a1.y);
      if (with_norm) { u32x2 o; o.x = pk2(x.x, x.y); o.y = pk2(x.z, x.w); xr[64 * j] = o; } else orow[64 * j] = x;
      v[j] = x; ss += (x.x * x.x + x.y * x.y) + (x.z * x.z + x.w * x.w); }
    if (with_norm) {
      const float rstd = 1.0f / sqrtf(wave_sum(ss) * (1.f / DM) + NORM_EPS);
      unsigned long long* o8 = (unsigned long long*)(XN + (size_t)m * DM) + lane;
#pragma unroll
      for (int j = 0; j < 4; ++j) o8[64 * j] = (unsigned long long)pk2(v[j].x * rstd, v[j].y * rstd) | ((unsigned long long)pk2(v[j].z * rstd, v[j].w * rstd) << 32);
    } };
  const int n = (NTOK - F.gw + F.NGW - 1) / F.NGW;
  if (n <= 0) return;
  CRows RA, RB;
  int4 a0 = asg[F.gw]; float2 g0 = asgg[F.gw];
  int4 a1 = a0; float2 g1 = g0; if (n > 1) { a1 = asg[F.gw + F.NGW]; g1 = asgg[F.gw + F.NGW]; }
  rows(RA, F.gw, a0);
  for (int i = 0; i < n; i += 2) {
    const int m0 = F.gw + i * F.NGW, m1 = m0 + F.NGW, m2 = m1 + F.NGW, m3 = m2 + F.NGW;
    int4 a2 = a0; float2 g2 = g0; if (i + 2 < n) { a2 = asg[m2]; g2 = asgg[m2]; }
    if (i + 1 < n) rows(RB, m1, a1);
    finish(RA, m0, g0);
    if (i + 1 >= n) break;
    int4 a3 = a0; float2 g3 = g0; if (i + 3 < n) { a3 = asg[m3]; g3 = asgg[m3]; }
    if (i + 2 < n) rows(RA, m2, a2);
    finish(RB, m1, g1);
    a0 = a2; g0 = g2; a1 = a3; g1 = g3;
  }
}
template <class Bar> DI void moe_gemms(const Ctx& F, const Params& P, int L, const Bar& gbar) {
  unsigned char* ws = P.ws;
  const int vcu = (F.G % 8 == 0) ? ((int)(blockIdx.x % 8) * (F.G / 8) + (int)(blockIdx.x / 8)) : (int)blockIdx.x;
  moe_setup(F, P, L);
  {
    pg8::MoeSched<true> S{(const LAS int*)(F.lds + LDS_MISC), (const LAS int*)(F.lds + LDS_MISC) + 64, (const int*)(ws + WS_LIST), (const char*)(ws + (L ? WS_WGU1 : WS_WGU0)), F.G, vcu, 1024};
    pg8::EpiSwiGLU E{(bf16_t*)(ws + WS_H), (const float*)(ws + WS_RSL), (const LAS int*)(F.lds + LDS_MISC) + 64};
    pg8::gemm_phase<pg8::EpiSwiGLU, pg8::MoeSched<true>, true>(F.lds, F.wave, (const char*)(ws + WS_XB), 1024, S, E);
  }
  xcd_barrier(gbar);
  {
    pg8::MoeSched<false> S{(const LAS int*)(F.lds + LDS_MISC), (const LAS int*)(F.lds + LDS_MISC) + 64, nullptr, (const char*)(ws + (L ? WS_WD1 : WS_WD0)), F.G, vcu, 512};
    pg8::EpiBf16 E{(bf16_t*)(ws + WS_PROJ), DM};
    pg8::gemm_phase<pg8::EpiBf16, pg8::MoeSched<false>, true>(F.lds, F.wave, (const char*)(ws + WS_H), 512, S, E);
  }
}

struct Tok1 { u32x4 q0, q1, k; f32x4 cs[2], sn[2]; };
DI void p8b_transform1(const Ctx& F, const Params& P) {
  bf16_t* QKV = (bf16_t*)(P.ws + WS_PROJ);
  const float* cosT = (const float*)(P.ws + WS_ROPE); const float* sinT = cosT + SEQ * 32;
  const int lane = lane_id_v(), sub = lane & 7, grp = lane >> 3;
  float gq[8], gk[8];
#pragma unroll
  for (int j = 0; j < 8; ++j) { gq[j] = P.in[I_QN1][8 * sub + j]; gk[j] = P.in[I_KN1][8 * sub + j]; }
  const int kcol = 1024 + (grp & 3) * 64 + sub * 8;
  auto load = [&](Tok1& T, int m) {
    const int t = m & (SEQ - 1); const bf16_t* row = QKV + (size_t)m * W1;
    T.q0 = *(const u32x4*)(row + grp * 64 + sub * 8); T.q1 = *(const u32x4*)(row + 512 + grp * 64 + sub * 8); T.k = *(const u32x4*)(row + kcol);
    const f32x4* cp = (const f32x4*)(cosT + t * 32 + 8 * (sub & 3)); const f32x4* sp = (const f32x4*)(sinT + t * 32 + 8 * (sub & 3));
    T.cs[0] = cp[0]; T.cs[1] = cp[1]; T.sn[0] = sp[0]; T.sn[1] = sp[1];
  };
  auto process = [&](const Tok1& T, int m) {
    bf16_t* row = QKV + (size_t)m * W1;
    *(u32x4*)(row + grp * 64 + sub * 8) = normrope8(T.q0, gq, true, T.cs, T.sn, sub, 0.125f * LOG2E);
    *(u32x4*)(row + 512 + grp * 64 + sub * 8) = normrope8(T.q1, gq, true, T.cs, T.sn, sub, 0.125f * LOG2E);
    const u32x4 r = normrope8(T.k, gk, true, T.cs, T.sn, sub, 1.f);
    if (grp < 4) *(u32x4*)(row + kcol) = r;
  };
  Tok1 A, B;
  int m = F.gw;
  if (m < NTOK) load(A, m);
  while (m < NTOK) {
    const int m1 = m + F.NGW;
    if (m1 < NTOK) load(B, m1);
    process(A, m);
    if (m1 >= NTOK) break;
    const int m2 = m1 + F.NGW;
    if (m2 < NTOK) load(A, m2);
    process(B, m1);
    m = m2;
  }
}

DI void dil_phase(const Ctx& F, const Params& P) {
  const bf16_t* QKV = (const bf16_t*)(P.ws + WS_PROJ); bf16_t* MIX = (bf16_t*)(P.ws + WS_MIX);
  LAS unsigned char* kst = F.lds + F.wave * 8192;
  LAS unsigned char* vst = kst + 4096;
  float cshift; { const int l0 = lane_id_v(); cshift = 8.f * wave_max(fabsf(P.in[I_QN1][l0])) * wave_max(fabsf(P.in[I_KN1][l0])) * 1.02f; }
  const float c2 = cshift * LOG2E;
  const int gwv = ((F.G % 8 == 0) ? ((int)(blockIdx.x % 8) * (F.G / 8) + (int)(blockIdx.x / 8)) : (int)blockIdx.x) * 8 + F.wave;
  const int lane = lane_id_v(), c = lane & 31, half = lane >> 5, qi = c >> 2, gq = c & 3;
  const int q4 = (lane & 15) >> 2, p4 = lane & 3, blk = (lane >> 4) & 1;
  const int lrow = lane >> 3, lch = lane & 7;
  const int woff = lrow * 128 + ((lch ^ (lrow & 7)) << 4);
  const int kra = c * 128 + ((half ^ (c & 7)) << 4);
  const int r1 = 4 * half + q4;
  const int tra0 = r1 * 128 + (((2 * blk + (p4 >> 1)) ^ (r1 & 7)) << 4) + (p4 & 1) * 8;
  for (int it = gwv; it < 32768; it += F.NGW) {
    const int r = it & 15, tile = (it >> 4) & 31, kh = (it >> 9) & 3, b = it >> 11;
    const size_t rb = (size_t)b * SEQ; const int tmax = tile * 128 + r + 112, tq = tile * 128 + r + 16 * qi;
    bf16x8 qf[4];
    { const bf16_t* qp = QKV + (rb + tq) * W1 + (4 * kh + gq) * 64 + 8 * half;
#pragma unroll
      for (int ks = 0; ks < 4; ++ks) qf[ks] = *(const bf16x8*)(qp + 16 * ks); }
    f32x16 o0, o1;
#pragma unroll
    for (int i = 0; i < 16; ++i) { o0[i] = 0.f; o1[i] = 0.f; }
    float lsum = 0.f;
    const char* sbase = (const char*)(QKV + rb * W1 + 1024 + kh * 64) ;
    constexpr int RP = W1 * 2;
    u32x4 gk[4], gv[4];
    auto issue = [&](int ti) { const int sh = ti < 8 ? 0 : (ti < 13 ? 2 : 4), T = ti < 8 ? ti : (ti < 13 ? ti - 8 : ti - 13);
      const int v0 = (tmax - ((32 * T + lrow) << sh)) * RP + lch * 16; const int dv = (8 << sh) * RP;
#pragma unroll
      for (int i = 0; i < 4; ++i) { int vo = v0 - i * dv; vo = vo < lch * 16 ? lch * 16 : vo;
        const char* rp = sbase + (unsigned)vo; gk[i] = *(const u32x4*)rp; gv[i] = *(const u32x4*)(rp + 512); } };
    issue(0);
#pragma unroll 1
    for (int ti = 0; ti < 18; ++ti) {
      const int sh = ti < 8 ? 0 : (ti < 13 ? 2 : 4), T = ti < 8 ? ti : (ti < 13 ? ti - 8 : ti - 13);
#pragma unroll
      for (int i = 0; i < 4; ++i) { *(LAS u32x4*)(kst + woff + i * 1024) = gk[i]; *(LAS u32x4*)(vst + woff + i * 1024) = gv[i]; }
      if (ti + 1 < 18) issue(ti + 1);
      asm volatile("" ::: "memory");
      f32x16 s;
#pragma unroll
      for (int i = 0; i < 16; ++i) s[i] = -c2;
#pragma unroll
      for (int ks = 0; ks < 4; ++ks) { const bf16x8 kf = *(const LAS bf16x8*)(kst + (kra ^ (ks << 5))); s = __builtin_amdgcn_mfma_f32_32x32x16_bf16(kf, qf[ks], s, 0, 0, 0); }
      unsigned m32;
      { const int ei = (16 >> sh) * (7 - qi); const int nmax = tmax >> sh; const int hn = (ei + 128 < nmax) ? ei + 128 : nmax;
        const int lo = ei - 32 * T - 4 * half, hi = hn - 32 * T - 4 * half;
        const int loc = lo < 0 ? 0 : lo, hic = hi > 31 ? 31 : hi;
        m32 = (loc <= hic) ? ((0xFFFFFFFFu >> (31 - hic)) & (0xFFFFFFFFu << loc)) : 0u; }
#pragma unroll
      for (int reg = 0; reg < 16; ++reg) { const int mb = __builtin_amdgcn_sbfe((int)m32, (reg & 3) + 8 * (reg >> 2), 1);
        const float p = __int_as_float(__float_as_int(__builtin_amdgcn_exp2f(s[reg])) & mb); s[reg] = p; lsum += p; }
#pragma unroll
      for (int st = 0; st < 2; ++st) {
        u32x4 pw; pw.x = pk2(s[8 * st], s[8 * st + 1]); pw.y = pk2(s[8 * st + 2], s[8 * st + 3]); pw.z = pk2(s[8 * st + 4], s[8 * st + 5]); pw.w = pk2(s[8 * st + 6], s[8 * st + 7]);
        const bf16x8 pf = __builtin_bit_cast(bf16x8, pw);
#pragma unroll
        for (int dblk = 0; dblk < 2; ++dblk) {
          const int ta = (tra0 ^ (dblk << 6)) + st * 2048;
          const s16x4 lo4 = tr_read(vst + ta), hi4 = tr_read(vst + ta + 1024);
          const bf16x8 vf = __builtin_shufflevector(lo4, hi4, 0, 1, 2, 3, 4, 5, 6, 7);
          if (dblk == 0) o0 = __builtin_amdgcn_mfma_f32_32x32x16_bf16(vf, pf, o0, 0, 0, 0); else o1 = __builtin_amdgcn_mfma_f32_32x32x16_bf16(vf, pf, o1, 0, 0, 0);
        }
      }
      asm volatile("" ::: "memory");
    }
    lsum += __shfl_xor(lsum, 32);
    const float inv = 1.0f / lsum;
    bf16_t* op = MIX + (rb + tq) * DM + (4 * kh + gq) * 64 + 4 * half;
#pragma unroll
    for (int gI = 0; gI < 4; ++gI) {
      u32x2 w0; w0.x = pk2(o0[4 * gI] * inv, o0[4 * gI + 1] * inv); w0.y = pk2(o0[4 * gI + 2] * inv, o0[4 * gI + 3] * inv); *(u32x2*)(op + 8 * gI) = w0;
      u32x2 w1; w1.x = pk2(o1[4 * gI] * inv, o1[4 * gI + 1] * inv); w1.y = pk2(o1[4 * gI + 2] * inv, o1[4 * gI + 3] * inv); *(u32x2*)(op + 32 + 8 * gI) = w1;
    }
  }
}

#define XB_TMO      128
#define XB_XCNT(j)  (256  + 64 * (j))
#define XB_XSUB(j)  (1280 + 64 * (j))
#define XB_XGEN(j)  (2304 + 64 * (j))
#define XB_TOP      3328
#define XB_TOPGEN   3392
#define XCD_BAR_WORDS 3456
#define XB_SPIN_CAP (1u << 18)

__device__ __forceinline__ unsigned xb_ld(unsigned* p)              { return __hip_atomic_load(p, __ATOMIC_RELAXED, __HIP_MEMORY_SCOPE_AGENT); }
__device__ __forceinline__ unsigned xb_add(unsigned* p, unsigned v) { return __hip_atomic_fetch_add(p, v, __ATOMIC_RELAXED, __HIP_MEMORY_SCOPE_AGENT); }
__device__ __forceinline__ unsigned xb_xcc_id() { return (unsigned)__builtin_amdgcn_s_getreg((3 << 11) | 20) & 0xFu; }
#define XB_SPIN(cond, bar) do { unsigned _sp = 0; while (cond) { __builtin_amdgcn_s_sleep(1); \
    if ((++_sp & 255u) == 0u) { if (xb_ld(&(bar)[XB_TMO])) break; if (_sp > XB_SPIN_CAP) { atomicAdd(&(bar)[XB_TMO], 1u); break; } } } } while (0)

struct XcdBarrier {
    unsigned* bar; unsigned x;
    volatile LAS unsigned* st;
};

__device__ __forceinline__ XcdBarrier xcd_barrier_post(unsigned* bar, volatile LAS unsigned* st) {
    XcdBarrier b; b.bar = bar; b.x = xb_xcc_id(); b.st = st;
    if (threadIdx.x == 0) (void)xb_add(&bar[XB_XCNT(b.x)], 1u);
    return b;
}
__device__ __forceinline__ void xcd_barrier_complete(unsigned* bar, unsigned x, unsigned& nloc, unsigned& nx) {
    const unsigned G = gridDim.x * gridDim.y * gridDim.z;
    unsigned sum, cnt, mine, sp = 0u;
    for (;;) {
        sum = 0u; cnt = 0u; mine = 0u;
#pragma unroll
        for (unsigned j = 0; j < 16; ++j) { const unsigned c = xb_ld(&bar[XB_XCNT(j)]); sum += c; cnt += (c > 0u) ? 1u : 0u; mine = (j == x) ? c : mine; }
        if (sum == G) break;
        __builtin_amdgcn_s_sleep(1);
        if ((++sp & 255u) == 0u) { if (xb_ld(&bar[XB_TMO])) break; if (sp > XB_SPIN_CAP) { atomicAdd(&bar[XB_TMO], 1u); break; } }
    }
    nloc = mine > 0u ? mine : 1u; nx = cnt > 0u ? cnt : 1u;
}

__device__ __forceinline__ void xcd_barrier(const XcdBarrier& b) {
    asm volatile("s_waitcnt vmcnt(0)" ::: "memory");
    __syncthreads();
    if (threadIdx.x == 0) {
        unsigned* bar = b.bar;
        __builtin_amdgcn_s_waitcnt(0);
        unsigned nloc = b.st[0], nx = b.st[1];
        if (nloc == 0u) { xcd_barrier_complete(bar, b.x, nloc, nx); b.st[0] = nloc; b.st[1] = nx; }
        const unsigned old = xb_add(&bar[XB_XSUB(b.x)], 1u);
        const unsigned gen = old / nloc;
        if (old + 1u == (gen + 1u) * nloc) {
            __builtin_amdgcn_fence(__ATOMIC_RELEASE, "agent");
            asm volatile("s_waitcnt vmcnt(0)" ::: "memory");
            const unsigned og = xb_add(&bar[XB_TOP], 1u);
            const unsigned tg = og / nx;
            if (og + 1u == (tg + 1u) * nx) xb_add(&bar[XB_TOPGEN], 1u);
            else XB_SPIN(xb_ld(&bar[XB_TOPGEN]) == tg, bar);
            __builtin_amdgcn_fence(__ATOMIC_ACQUIRE, "agent");
            xb_add(&bar[XB_XGEN(b.x)], 1u);
            asm volatile("s_waitcnt vmcnt(0)" ::: "memory");
        } else {
            XB_SPIN(xb_ld(&bar[XB_XGEN(b.x)]) == gen, bar);
            __builtin_amdgcn_fence(__ATOMIC_ACQUIRE, "agent");
            asm volatile("s_waitcnt vmcnt(0)" ::: "memory");
        }
    }
    __syncthreads();
}


__global__ void __launch_bounds__(512, 2) fwd_megakernel(Params P) {
  extern __shared__ __attribute__((aligned(16))) unsigned char lds_raw[];
  cg::grid_group grid = cg::this_grid();
  Ctx F; F.lds = (LAS unsigned char*)lds_raw; F.wave = __builtin_amdgcn_readfirstlane((int)threadIdx.x >> 6);
  F.G = gridDim.x; F.gw = blockIdx.x * 8 + F.wave; F.NGW = F.G * 8;
  unsigned char* ws = P.ws;
  volatile LAS unsigned* xst = (volatile LAS unsigned*)(F.lds + LDS_BYTES - 16);
  if (threadIdx.x < 2) xst[threadIdx.x] = 0u;
  unsigned* xbar_words = (unsigned*)(ws + WS_CTL + 65536);
  __syncthreads();
  XcdBarrier xbar = xcd_barrier_post(xbar_words, xst);
#define GRID_BAR() xcd_barrier(xbar)

#ifndef PHMASK
#define PHMASK 0xFFFFFFFFu
#endif
#define PH(n) if ((PHMASK >> (n)) & 1u)
#if defined(TIMEDSA) && !defined(TIMEPH)
#define TIMEPH 99
#define TIMEN 1
#endif
#ifdef TIMEPH
  unsigned long long* tsw = (unsigned long long*)(ws + WS_CTL + 4096);
#define TS_BEGIN(n) if ((n) >= TIMEPH && (n) < TIMEPH + TIMEN && (n) == TIMEPH && blockIdx.x == 0 && threadIdx.x == 0) tsw[0] = __builtin_amdgcn_s_memrealtime();
#define TS_END(n) if ((n) == TIMEPH + TIMEN - 1 && blockIdx.x == 0 && threadIdx.x == 0) tsw[1] = __builtin_amdgcn_s_memrealtime();
#else
#define TS_BEGIN(n)
#define TS_END(n)
#endif
  TS_BEGIN(0)
  PH(0) p0_prologue(F, P);
  if (P.ws == nullptr) grid.sync();
  GRID_BAR();
  TS_END(0)
  TS_BEGIN(1)
  PH(1) {
    pg8::DenseSched S; S.init(NTOK, W0P, 1024, ws + WS_WIN0, F.G, (int)blockIdx.x);
    pg8::EpiProj0 E{(bf16_t*)(ws + WS_PROJ), (bf16_t*)(ws + WS_KF), (bf16_t*)(ws + WS_IKF), (bf16_t*)(ws + WS_VTF), P.in[I_QN0], P.in[I_KN0], (const float*)(ws + WS_ROPE), (const float*)(ws + WS_ROPE) + SEQ * 32};
    pg8::gemm_phase<pg8::EpiProj0, pg8::DenseSched, true>(F.lds, F.wave, (const char*)(ws + WS_XN), 1024, S, E);
  }
  GRID_BAR();
  TS_END(1)
  TS_BEGIN(2)
  PH(2) p1b_transform0(F, P);
  GRID_BAR();
  TS_END(2)
  TS_BEGIN(3)
  PH(3) dsa_phase(F, P);
  GRID_BAR();
  TS_END(3)
  TS_BEGIN(4)
  PH(4) {
    pg8::DenseSched S; S.init(NTOK, 1024, 1024, ws + WS_WOUT0, F.G, (int)blockIdx.x);
    pg8::EpiResB<true> E{P.in[I_X], (bf16_t*)(ws + WS_XB), DM};
    pg8::gemm_phase<pg8::EpiResB<true>, pg8::DenseSched, true>(F.lds, F.wave, (const char*)(ws + WS_MIX), 1024, S, E);
  }
  GRID_BAR();
  TS_END(4)
  TS_BEGIN(5)
  PH(5) router_phase(F, P, 0);
  GRID_BAR();
  TS_END(5)
  TS_BEGIN(6)
  PH(6) moe_gemms(F, P, 0, xbar);
  GRID_BAR();
  TS_END(6)
  TS_BEGIN(7)
  PH(7) combine_phase(F, P, 0, true);
  GRID_BAR();
  TS_END(7)
  TS_BEGIN(8)
  PH(8) {
    pg8::DenseSched S; S.init(NTOK, W1, 1024, ws + WS_WIN1, F.G, (int)blockIdx.x);
    pg8::EpiQKV1 E{(bf16_t*)(ws + WS_PROJ), P.in[I_QN1], P.in[I_KN1], (const float*)(ws + WS_ROPE), (const float*)(ws + WS_ROPE) + SEQ * 32};
    pg8::gemm_phase<pg8::EpiQKV1, pg8::DenseSched, true>(F.lds, F.wave, (const char*)(ws + WS_XN), 1024, S, E);
  }
  GRID_BAR();
  TS_END(8)
  TS_BEGIN(10)
  PH(10) dil_phase(F, P);
  GRID_BAR();
  TS_END(10)
  TS_BEGIN(11)
  PH(11) {
    pg8::DenseSched S; S.init(NTOK, 1024, 1024, ws + WS_WOUT1, F.G, (int)blockIdx.x);
    pg8::EpiResB<false> E{ws + WS_XB, (bf16_t*)(ws + WS_XB), DM};
    pg8::gemm_phase<pg8::EpiResB<false>, pg8::DenseSched, true>(F.lds, F.wave, (const char*)(ws + WS_MIX), 1024, S, E);
  }
  GRID_BAR();
  TS_END(11)
  TS_BEGIN(12)
  PH(12) router_phase(F, P, 1);
  GRID_BAR();
  TS_END(12)
  TS_BEGIN(13)
  PH(13) moe_gemms(F, P, 1, xbar);
  GRID_BAR();
  TS_END(13)
  TS_BEGIN(14)
  PH(14) combine_phase(F, P, 1, false);
#ifdef TIMEPH
  GRID_BAR();
  TS_END(14)
  GRID_BAR();
  { const unsigned long long dt = (tsw[1] - tsw[0]) * 4ull; const unsigned long long t0 = __builtin_amdgcn_s_memrealtime();
    while (__builtin_amdgcn_s_memrealtime() - t0 < dt) __builtin_amdgcn_s_sleep(32); }
#endif
}

extern "C" void kernel_launch(void* const* d_in, const int* in_sizes, int n_in, void* d_out, int out_size, void* d_ws, size_t ws_size, hipStream_t stream) {
  static int grid_blocks = 0;
  if (!grid_blocks) {
    if (n_in != 28 || out_size != NTOK * DM || ws_size < WS_END) { fprintf(stderr, "kernel_launch: unexpected shapes (n_in %d out %d ws %zu)\n", n_in, out_size, ws_size); grid_blocks = -1; return; }
    int dev = 0, cus = 0, per_cu = 0;
    (void)hipGetDevice(&dev);
    (void)hipDeviceGetAttribute(&cus, hipDeviceAttributeMultiprocessorCount, dev);
    (void)hipFuncSetAttribute((const void*)fwd_megakernel, hipFuncAttributeMaxDynamicSharedMemorySize, LDS_BYTES);
    (void)hipOccupancyMaxActiveBlocksPerMultiprocessor(&per_cu, (const void*)fwd_megakernel, 512, LDS_BYTES);
    if (per_cu < 1) per_cu = 1;
    grid_blocks = cus * per_cu;
  }
  if (grid_blocks < 0) return;
  Params p{};
  for (int i = 0; i < 28; ++i) p.in[i] = (const float*)d_in[i];
  p.out = (float*)d_out; p.ws = (unsigned char*)d_ws;
  (void)hipMemsetAsync((unsigned char*)d_ws + WS_CTL + 65536, 0, XCD_BAR_WORDS * 4, stream);
  void* args[] = {&p};
  hipError_t e = hipLaunchCooperativeKernel((const void*)fwd_megakernel, dim3(grid_blocks), dim3(512), args, LDS_BYTES, stream);
  if (e != hipSuccess) fprintf(stderr, "cooperative launch failed: %s (grid %d)\n", hipGetErrorString(e), grid_blocks);
}
```
